# Optimizing an MI355X kernel written in HIP

```python
import math
import jax, jax.numpy as jnp
from jax import lax
import numpy as np

D_MODEL = 1024
BATCH = 8
SEQ = 2048
DEPTH = 4
DEC_BATCH = 128
DEC_SEQ = 1
PAST_LEN = 16384
PAGE_SIZE = 128

N_AB = (DEPTH + 1) // 2
N_C = DEPTH // 2
CONV_W = 4
W_A = D_MODEL
H_A = 8
BW_A = W_A // H_A
LRU_C = 8.0
H_B = 8
DK = 128
DV = 128
W_B = H_B * DV
QKV_B = 2 * H_B * DK + H_B * DV
CHUNK = 64
IN_AB = 2 * W_A + QKV_B + W_B + 2 * H_B
OUT_AB = W_A + W_B
W_C = D_MODEL
CG = 16
G_C = W_C // CG
P_C = 64
EPS = 1e-6

kernel_name = "hybrid_rglru_gdn_s5_step"


def rms_norm(x, w):
    x32 = x.astype(jnp.float32)
    y = x32 * lax.rsqrt(jnp.mean(x32 * x32, axis=-1, keepdims=True) + EPS)
    return (y * w.astype(jnp.float32)).astype(x.dtype)


def l2_norm(t):
    return t * lax.rsqrt(jnp.sum(t * t, axis=-1, keepdims=True) + EPS)


def causal_conv(x, buf, w):
    L = x.shape[1]
    xp = jnp.concatenate([buf.astype(x.dtype), x], axis=1)
    y = sum(xp[:, j:j + L] * w[j] for j in range(CONV_W))
    return y, xp[:, L:]


def linear_combine(e1, e2):
    a1, b1 = e1
    a2, b2 = e2
    return a1 * a2, a2 * b1 + b2


def rg_lru(x, gx_w, gx_b, ga_w, ga_b, a_param, h0, start_pos):
    B, L, _ = x.shape
    xb = x.reshape(B, L, H_A, BW_A)
    gate_x = jax.nn.sigmoid(jnp.einsum("blhi,hij->blhj", xb, gx_w).reshape(B, L, W_A) + gx_b)
    gate_a = jax.nn.sigmoid(jnp.einsum("blhi,hij->blhj", xb, ga_w).reshape(B, L, W_A) + ga_b)
    log_a = -LRU_C * gate_a * jax.nn.softplus(-a_param)
    a = jnp.exp(log_a)
    mult = jnp.sqrt(-jnp.expm1(2.0 * log_a))
    if start_pos == 0:
        mult = mult.at[:, 0].set(1.0)
    b = mult * gate_x * x
    b = b.at[:, 0].add(a[:, 0] * h0)
    _, h = lax.associative_scan(linear_combine, (a, b), axis=1)
    return h, h[:, -1]


def gated_delta_rule(q, k, v, g, beta, s0):
    B, L, H, _ = q.shape
    n = -(-L // CHUNK)
    pad = n * CHUNK - L

    def blocks(t):
        t = jnp.pad(t, [(0, 0), (0, pad)] + [(0, 0)] * (t.ndim - 2))
        t = t.reshape((B, n, CHUNK) + t.shape[2:])
        return jnp.moveaxis(t, (1, 2), (0, 3))

    qb, kb, vb, gb, bb = blocks(q), blocks(k), blocks(v), blocks(g), blocks(beta)
    gc = jnp.cumsum(gb, axis=-1)
    idx = jnp.arange(CHUNK)
    tri = idx[:, None] >= idx[None, :]
    strict = idx[:, None] > idx[None, :]
    decay = jnp.exp(jnp.where(tri, gc[..., :, None] - gc[..., None, :], -jnp.inf))
    k_beta = kb * bb[..., None]
    A = jnp.where(strict, jnp.einsum("nbhid,nbhjd->nbhij", k_beta, kb) * decay, 0.0)
    eye = jnp.eye(CHUNK, dtype=A.dtype)
    rhs = jnp.concatenate([vb * bb[..., None], k_beta * jnp.exp(gc)[..., None]], axis=-1)
    sol = lax.linalg.triangular_solve(A + eye, rhs, left_side=True, lower=True)
    u, w = sol[..., :DV], sol[..., DV:]
    qk = jnp.where(tri, jnp.einsum("nbhid,nbhjd->nbhij", qb, kb) * decay, 0.0)

    def step(S, inp):
        qc, kc, uc, wc, gcc, qkc = inp
        v_new = uc - jnp.einsum("bhck,bhkv->bhcv", wc, S)
        o = (jnp.einsum("bhck,bhkv->bhcv", qc * jnp.exp(gcc)[..., None], S)
             + jnp.einsum("bhij,bhjv->bhiv", qkc, v_new))
        g_last = gcc[..., -1:]
        S = (S * jnp.exp(g_last)[..., None]
             + jnp.einsum("bhck,bhcv->bhkv", kc * jnp.exp(g_last - gcc)[..., None], v_new))
        return S, o

    S, o = lax.scan(step, s0, (qb, kb, u, w, gc, qk))
    o = jnp.moveaxis(o, (0, 3), (1, 2)).reshape(B, n * CHUNK, H, DV)[:, :L]
    return o, S


def ab_mixer(h, conv_a, lru_h, conv_b, delta_s, start_pos, in_w, out_w, conv_a_w, conv_a_b,
             gx_w, gx_b, ga_w, ga_b, a_param, conv_b_w, a_log, dt_bias, gnorm_w):
    B, L, _ = h.shape
    f32 = jnp.float32
    proj = jnp.dot(h, in_w)
    cuts = np.cumsum([W_A, W_A, QKV_B, W_B, H_B]).tolist()
    xa, za, qkv, zb, b_raw, a_raw = jnp.split(proj, cuts, axis=-1)
    xa_c, new_conv_a = causal_conv(xa, conv_a, conv_a_w)
    xa_c = (xa_c + conv_a_b).astype(f32)
    ya, new_lru = rg_lru(xa_c, gx_w.astype(f32), gx_b.astype(f32), ga_w.astype(f32),
                         ga_b.astype(f32), a_param.astype(f32), lru_h.astype(f32), start_pos)
    ya = ya * jax.nn.silu(za.astype(f32))
    qkv_c, new_conv_b = causal_conv(qkv, conv_b, conv_b_w)
    qkv_c = jax.nn.silu(qkv_c.astype(f32))
    q, k, v = jnp.split(qkv_c, [H_B * DK, 2 * H_B * DK], axis=-1)
    q = l2_norm(q.reshape(B, L, H_B, DK)) * (DK ** -0.5)
    k = l2_norm(k.reshape(B, L, H_B, DK))
    v = v.reshape(B, L, H_B, DV)
    beta = jax.nn.sigmoid(b_raw.astype(f32))
    g = -jnp.exp(a_log.astype(f32)) * jax.nn.softplus(a_raw.astype(f32) + dt_bias.astype(f32))
    o, new_delta = gated_delta_rule(q, k, v, g, beta, delta_s.astype(f32))
    o = rms_norm(o, gnorm_w) * jax.nn.silu(zb.astype(f32).reshape(B, L, H_B, DV))
    y = jnp.concatenate([ya, o.reshape(B, L, W_B)], axis=-1).astype(h.dtype)
    return jnp.dot(y, out_w), new_conv_a, new_lru, new_conv_b, new_delta


def s5_mixer(h, s_re, s_im, in_w, out_w, a_re, a_im, b_re, b_im, c_re, c_im, d, log_dt,
             glu_w, glu_b):
    B, L, _ = h.shape
    f32 = jnp.float32
    u, z = jnp.split(jnp.dot(h, in_w), 2, axis=-1)
    u32 = u.astype(f32)
    A = lax.complex(a_re.astype(f32), a_im.astype(f32))
    dt = jnp.exp(log_dt.astype(f32))[:, None]
    A_bar = jnp.exp(A * dt)
    B_bar = ((A_bar - 1.0) / A)[..., None] * lax.complex(b_re.astype(f32), b_im.astype(f32))
    Bu = jnp.einsum("gpc,blgc->lbgp", B_bar,
                    u32.reshape(B, L, G_C, CG).astype(jnp.complex64))
    x0 = lax.complex(s_re.astype(f32), s_im.astype(f32))
    Bu = Bu.at[0].add(A_bar * x0)
    a_el = jnp.broadcast_to(A_bar, (L, 1, G_C, P_C))
    _, xs = lax.associative_scan(linear_combine, (a_el, Bu), axis=0)
    C = lax.complex(c_re.astype(f32), c_im.astype(f32))
    y = jnp.einsum("gcp,lbgp->blgc", C, xs).real.reshape(B, L, W_C) + d.astype(f32) * u32
    y = jax.nn.gelu(y)
    y = y * jax.nn.sigmoid(jnp.dot(y, glu_w.astype(f32)) + glu_b.astype(f32))
    y = (y * jax.nn.silu(z.astype(f32))).astype(h.dtype)
    return jnp.dot(y, out_w), xs[-1].real, xs[-1].imag


def trunk(x, c, conv_a, lru_h, conv_b, delta_s, s5_re, s5_im, start_pos, w):
    n_ca, n_lru, n_cb, n_ds, n_sr, n_si = [], [], [], [], [], []
    for i in range(DEPTH):
        j = i // 2
        mod = jnp.dot(jax.nn.silu(c), w["mod_w"][i]) + w["mod_b"][i]
        shift, scale, gate = jnp.split(mod[:, None, :], 3, axis=-1)
        h = rms_norm(x, w["norm_w"][i]) * (1.0 + scale) + shift
        if i % 2 == 0:
            y, ca, lh, cb, ds = ab_mixer(
                h, conv_a[j], lru_h[j], conv_b[j], delta_s[j], start_pos,
                w["ab_in_w"][j], w["ab_out_w"][j], w["conv_a_w"][j], w["conv_a_b"][j],
                w["lru_gx_w"][j], w["lru_gx_b"][j], w["lru_ga_w"][j], w["lru_ga_b"][j],
                w["lru_a_param"][j], w["conv_b_w"][j], w["gdn_a_log"][j],
                w["gdn_dt_bias"][j], w["gdn_norm_w"][j])
            n_ca.append(ca.astype(conv_a.dtype))
            n_lru.append(lh.astype(lru_h.dtype))
            n_cb.append(cb.astype(conv_b.dtype))
            n_ds.append(ds.astype(delta_s.dtype))
        else:
            y, sr, si = s5_mixer(
                h, s5_re[j], s5_im[j], w["c_in_w"][j], w["c_out_w"][j],
                w["s5_a_re"][j], w["s5_a_im"][j], w["s5_b_re"][j], w["s5_b_im"][j],
                w["s5_c_re"][j], w["s5_c_im"][j], w["s5_d"][j], w["s5_log_dt"][j],
                w["glu_w"][j], w["glu_b"][j])
            n_sr.append(sr.astype(s5_re.dtype))
            n_si.append(si.astype(s5_im.dtype))
        x = x + (gate * y).astype(x.dtype)
    y = rms_norm(x, w["final_norm_w"])
    return (y, jnp.stack(n_ca), jnp.stack(n_lru), jnp.stack(n_cb), jnp.stack(n_ds),
            jnp.stack(n_sr), jnp.stack(n_si))


def setup_inputs(seed: int = 0) -> dict:
    key = jax.random.key(seed)
    ks = list(jax.random.split(key, 48))
    f32 = jnp.float32

    def nrm(shape, s):
        return jax.random.normal(ks.pop(), shape, f32) * s

    def unif(shape, lo, hi):
        return jax.random.uniform(ks.pop(), shape, f32, lo, hi)

    a8 = unif((N_AB, W_A), 0.9, 0.999)
    base = a8 ** (1.0 / LRU_C)
    dt_b = jnp.exp(unif((N_AB, H_B), math.log(1e-3), math.log(1e-1)))
    return {
        "x_prompt": nrm((BATCH, SEQ, D_MODEL), 1.0),
        "x_sample": nrm((DEC_BATCH, DEC_SEQ, D_MODEL), 1.0),
        "c_prompt": nrm((BATCH, D_MODEL), 1.0),
        "c_sample": nrm((DEC_BATCH, D_MODEL), 1.0),
        "state_conv_a": nrm((N_AB, DEC_BATCH, CONV_W - 1, W_A), 1.0),
        "state_lru": nrm((N_AB, DEC_BATCH, W_A), 0.5),
        "state_conv_b": nrm((N_AB, DEC_BATCH, CONV_W - 1, QKV_B), 1.0),
        "state_delta": nrm((N_AB, DEC_BATCH, H_B, DK, DV), 0.1),
        "state_s5_re": nrm((N_C, DEC_BATCH, G_C, P_C), 0.1),
        "state_s5_im": nrm((N_C, DEC_BATCH, G_C, P_C), 0.1),
        "norm_w": 1.0 + nrm((DEPTH, D_MODEL), 0.01),
        "mod_w": nrm((DEPTH, D_MODEL, 3 * D_MODEL), D_MODEL ** -0.5),
        "mod_b": nrm((DEPTH, 3 * D_MODEL), 0.01),
        "ab_in_w": nrm((N_AB, D_MODEL, IN_AB), D_MODEL ** -0.5),
        "ab_out_w": nrm((N_AB, OUT_AB, D_MODEL), OUT_AB ** -0.5),
        "conv_a_w": nrm((N_AB, CONV_W, W_A), CONV_W ** -0.5),
        "conv_a_b": nrm((N_AB, W_A), 0.01),
        "lru_gx_w": nrm((N_AB, H_A, BW_A, BW_A), BW_A ** -0.5),
        "lru_gx_b": nrm((N_AB, W_A), 0.01),
        "lru_ga_w": nrm((N_AB, H_A, BW_A, BW_A), BW_A ** -0.5),
        "lru_ga_b": nrm((N_AB, W_A), 0.01),
        "lru_a_param": jnp.log(base) - jnp.log1p(-base),
        "conv_b_w": nrm((N_AB, CONV_W, QKV_B), CONV_W ** -0.5),
        "gdn_a_log": jnp.log(unif((N_AB, H_B), 1.0, 16.0)),
        "gdn_dt_bias": dt_b + jnp.log(-jnp.expm1(-dt_b)),
        "gdn_norm_w": 1.0 + nrm((N_AB, DV), 0.01),
        "c_in_w": nrm((N_C, D_MODEL, 2 * W_C), D_MODEL ** -0.5),
        "c_out_w": nrm((N_C, W_C, D_MODEL), W_C ** -0.5),
        "s5_a_re": -0.5 + nrm((N_C, G_C, P_C), 0.01),
        "s5_a_im": jnp.pi * jnp.arange(P_C, dtype=f32) + nrm((N_C, G_C, P_C), 0.01),
        "s5_b_re": nrm((N_C, G_C, P_C, CG), (2 * CG) ** -0.5),
        "s5_b_im": nrm((N_C, G_C, P_C, CG), (2 * CG) ** -0.5),
        "s5_c_re": nrm((N_C, G_C, CG, P_C), P_C ** -0.5),
        "s5_c_im": nrm((N_C, G_C, CG, P_C), P_C ** -0.5),
        "s5_d": nrm((N_C, W_C), 1.0),
        "s5_log_dt": unif((N_C, G_C), math.log(1e-3), math.log(1e-1)),
        "glu_w": nrm((N_C, W_C, W_C), W_C ** -0.5),
        "glu_b": nrm((N_C, W_C), 0.01),
        "final_norm_w": 1.0 + nrm((D_MODEL,), 0.01),
    }


def reference(x_prompt, x_sample, c_prompt, c_sample, state_conv_a, state_lru, state_conv_b,
              state_delta, state_s5_re, state_s5_im, norm_w, mod_w, mod_b, ab_in_w, ab_out_w,
              conv_a_w, conv_a_b, lru_gx_w, lru_gx_b, lru_ga_w, lru_ga_b, lru_a_param,
              conv_b_w, gdn_a_log, gdn_dt_bias, gdn_norm_w, c_in_w, c_out_w, s5_a_re, s5_a_im,
              s5_b_re, s5_b_im, s5_c_re, s5_c_im, s5_d, s5_log_dt, glu_w, glu_b, final_norm_w):
    w = dict(norm_w=norm_w, mod_w=mod_w, mod_b=mod_b, ab_in_w=ab_in_w, ab_out_w=ab_out_w,
             conv_a_w=conv_a_w, conv_a_b=conv_a_b, lru_gx_w=lru_gx_w, lru_gx_b=lru_gx_b,
             lru_ga_w=lru_ga_w, lru_ga_b=lru_ga_b, lru_a_param=lru_a_param, conv_b_w=conv_b_w,
             gdn_a_log=gdn_a_log, gdn_dt_bias=gdn_dt_bias, gdn_norm_w=gdn_norm_w,
             c_in_w=c_in_w, c_out_w=c_out_w, s5_a_re=s5_a_re, s5_a_im=s5_a_im,
             s5_b_re=s5_b_re, s5_b_im=s5_b_im, s5_c_re=s5_c_re, s5_c_im=s5_c_im, s5_d=s5_d,
             s5_log_dt=s5_log_dt, glu_w=glu_w, glu_b=glu_b, final_norm_w=final_norm_w)
    nb = x_prompt.shape[0]
    z_conv_a = jnp.zeros((N_AB, nb, CONV_W - 1, W_A), state_conv_a.dtype)
    z_lru = jnp.zeros((N_AB, nb, W_A), state_lru.dtype)
    z_conv_b = jnp.zeros((N_AB, nb, CONV_W - 1, QKV_B), state_conv_b.dtype)
    z_delta = jnp.zeros((N_AB, nb, H_B, DK, DV), state_delta.dtype)
    z_s5_re = jnp.zeros((N_C, nb, G_C, P_C), state_s5_re.dtype)
    z_s5_im = jnp.zeros((N_C, nb, G_C, P_C), state_s5_im.dtype)
    y_prompt, p_conv_a, p_lru, p_conv_b, p_delta, p_s5_re, p_s5_im = trunk(
        x_prompt, c_prompt, z_conv_a, z_lru, z_conv_b, z_delta, z_s5_re, z_s5_im, 0, w)
    y_sample, s_conv_a, s_lru, s_conv_b, s_delta, s_s5_re, s_s5_im = trunk(
        x_sample, c_sample, state_conv_a, state_lru, state_conv_b, state_delta,
        state_s5_re, state_s5_im, PAST_LEN, w)
    return (y_prompt, y_sample, p_conv_a, p_lru, p_conv_b, p_delta, p_s5_re, p_s5_im,
            s_conv_a, s_lru, s_conv_b, s_delta, s_s5_re, s_s5_im)
```

```cpp
#include <hip/hip_runtime.h>
#include <hip/hip_cooperative_groups.h>
#include <cstdio>
namespace cg = cooperative_groups;
__device__ __forceinline__ int tidx_() { int t = threadIdx.x; asm volatile("" : "+v"(t)); return t; }
__device__ __forceinline__ int bidx_() { int t = blockIdx.x; asm volatile("" : "+s"(t)); return t; }
__device__ __forceinline__ int gdim_() { int t = gridDim.x; asm volatile("" : "+s"(t)); return t; }
namespace pg8 {
#define PG8_LAS __attribute__((address_space(3)))
typedef unsigned short bf16_t;
typedef short bf16x8 __attribute__((ext_vector_type(8)));
typedef float f32x4 __attribute__((ext_vector_type(4)));
typedef unsigned u32x4 __attribute__((ext_vector_type(4)));
constexpr int BM = 256, BK = 64, HALF = 128, HTB = HALF * BK * 2  , STAGE_BYTES = 8 * HTB, NXCD = 8, WGM = 8;

__host__ __device__ __forceinline__ int lds_byte(int r, int c) { const int st = (r >> 4) * 2 + (c >> 5), rr = r & 15, cc = c & 31, ob = rr * 64 + cc * 2; return st * 1024 + (ob ^ (((ob >> 9) & 1) << 5)); }
__host__ __device__ __forceinline__ void stage_rc(int b, int& R, int& C) { const int st = b / 1024, sb = b % 1024, swz = sb ^ (((sb >> 9) & 1) << 5); R = (st >> 1) * 16 + swz / 64; C = (st & 1) * 32 + (swz % 64) / 2; }
__host__ __device__ __forceinline__ int perm32(int rho) { const int n = rho >> 4, i = rho & 15; return 8 * (i >> 2) + 4 * n + (i & 3); }

struct Unit { int pm, pn; };
struct Gemm { const bf16_t* A; const bf16_t* Bt; int M, N, K; };

struct StaticOrder {
    int nM, nN, nwg, G, c;
    __host__ __device__ void init(int M, int N, int G_, int c_) { nM = M / BM; nN = N / BM; nwg = nM * nN; G = G_; c = c_; }
    __host__ __device__ bool next(int i, Unit& u) const {
        const long L = (long)i * G + c; if (L >= nwg) return false;
        int wgid = (int)L; { const int q = nwg / NXCD, r = nwg % NXCD, xcd = wgid % NXCD, off = wgid / NXCD; wgid = (xcd < r ? xcd * (q + 1) : r * (q + 1) + (xcd - r) * q) + off; }
        const int nig = WGM * nN, gid = wgid / nig, fm = gid * WGM, gsz = (nM - fm) < WGM ? (nM - fm) : WGM;
        u.pm = fm + ((wgid % nig) % gsz); u.pn = (wgid % nig) / gsz; return true;
    }
    __device__ __forceinline__ void a_ready(const Unit&) const {}
    __device__ __forceinline__ void done(const Unit&) const {}
};
typedef float f32x2cv __attribute__((ext_vector_type(2)));
typedef __bf16 bf16x2cv __attribute__((ext_vector_type(2)));
__device__ __forceinline__ unsigned cvt_pk_bf16(float lo, float hi) { f32x2cv v = {lo, hi}; bf16x2cv b = __builtin_convertvector(v, bf16x2cv); return __builtin_bit_cast(unsigned, b); }
typedef float f32x2 __attribute__((ext_vector_type(2)));
__device__ __forceinline__ f32x2 gelu_pk(f32x2 v) {
    const f32x2 av = __builtin_elementwise_abs(v), d = av * 0.2316418882f + 1.0f;
    f32x2 t; t.x = __builtin_amdgcn_rcpf(d.x); t.y = __builtin_amdgcn_rcpf(d.y);
    f32x2 q = t * 0.5307027145f + (-0.7265760135f); q = q * t + 0.7107068705f; q = q * t + (-0.142248368f); q = q * t + 0.127414796f; q = q * t;
    const f32x2 s = (v * v) * (-0.72134752044f);
    f32x2 e; e.x = __builtin_amdgcn_exp2f(s.x); e.y = __builtin_amdgcn_exp2f(s.y);
    const f32x2 m = v * (q * e), r = v - m;
    f32x2 o; o.x = v.x < 0.f ? m.x : r.x; o.y = v.y < 0.f ? m.y : r.y; return o;
}

struct EpiF32 {
    static constexpr bool PERM = false, AFTER_DRAIN = false;
    float* C; int ldc; const float* bias;
    __device__ __forceinline__ void operator()(const f32x4 (&acc)[2][2][4][2], const Unit& u, int wr, int wc, int fr, int fq) const {
        const int row0 = u.pm * BM + wr * 64 + fr, col0 = u.pn * BM + wc * 32 + 4 * fq;
        f32x4 bv[2][2];
#pragma unroll
        for (int bj = 0; bj < 2; ++bj)
#pragma unroll
            for (int n = 0; n < 2; ++n) bv[bj][n] = bias ? *(const f32x4*)(bias + col0 + bj * HALF + n * 16) : (f32x4){0.f, 0.f, 0.f, 0.f};
#pragma unroll
        for (int ai = 0; ai < 2; ++ai)
#pragma unroll
            for (int m = 0; m < 4; ++m) { float* rowp = C + (size_t)(row0 + ai * HALF + m * 16) * ldc + col0;
#pragma unroll
                for (int bj = 0; bj < 2; ++bj)
#pragma unroll
                    for (int n = 0; n < 2; ++n) *(f32x4*)(rowp + bj * HALF + n * 16) = acc[ai][bj][m][n] + bv[bj][n]; }
    }
};
template <int ACT  > struct EpiBf16 {
    static constexpr bool PERM = true, AFTER_DRAIN = false;
    bf16_t* O; int ldc; const float* bias; int split_cols; size_t split_stride;
    __device__ __forceinline__ void operator()(const f32x4 (&acc)[2][2][4][2], const Unit& u, int wr, int wc, int fr, int fq) const {
        const int row0 = u.pm * BM + wr * 64 + fr; int colt = u.pn * BM; bf16_t* base = O;
        if (split_cols) { const int t = colt / split_cols; base += (size_t)t * split_stride; colt -= t * split_cols; }
        const int col0 = colt + wc * 32 + 8 * fq, bcol0 = u.pn * BM + wc * 32 + 8 * fq;
        f32x4 bv[2][2];
#pragma unroll
        for (int bj = 0; bj < 2; ++bj)
#pragma unroll
            for (int n = 0; n < 2; ++n) bv[bj][n] = bias ? *(const f32x4*)(bias + bcol0 + bj * HALF + 4 * n) : (f32x4){0.f, 0.f, 0.f, 0.f};
#pragma unroll
        for (int ai = 0; ai < 2; ++ai)
#pragma unroll
            for (int m = 0; m < 4; ++m) { bf16_t* rowp = base + (size_t)(row0 + ai * HALF + m * 16) * ldc + col0;
#pragma unroll
                for (int bj = 0; bj < 2; ++bj) { f32x4 v0 = acc[ai][bj][m][0] + bv[bj][0], v1 = acc[ai][bj][m][1] + bv[bj][1];
                    if (ACT == 1) { f32x2 a = gelu_pk((f32x2){v0[0], v0[1]}), b = gelu_pk((f32x2){v0[2], v0[3]}), c = gelu_pk((f32x2){v1[0], v1[1]}), d = gelu_pk((f32x2){v1[2], v1[3]});
                        v0 = (f32x4){a.x, a.y, b.x, b.y}; v1 = (f32x4){c.x, c.y, d.x, d.y}; }
                    if (ACT == 2) {
#pragma unroll
                        for (int j = 0; j < 4; ++j) { v0[j] = 0.5f * v0[j] * (1.0f + erff(v0[j] * 0.70710678f)); v1[j] = 0.5f * v1[j] * (1.0f + erff(v1[j] * 0.70710678f)); } }
                    u32x4 w; w.x = cvt_pk_bf16(v0[0], v0[1]); w.y = cvt_pk_bf16(v0[2], v0[3]); w.z = cvt_pk_bf16(v1[0], v1[1]); w.w = cvt_pk_bf16(v1[2], v1[3]);
                    *(u32x4*)(rowp + bj * HALF) = w; } }
    }
};
template <class Epi, class Sched, bool STAMP = false>
__device__ __forceinline__ void gemm_phase(PG8_LAS unsigned char* lds, const Gemm g, const Sched& S, const Epi& E, unsigned long long* stamps) {
    const int tid = tidx_(), wid = __builtin_amdgcn_readfirstlane(tid >> 6), lane = tid & 63, wr = wid >> 2, wc = wid & 3, fr = lane & 15, fq = lane >> 4;
    const int K = g.K, nt = K / BK;
    int ts_lo = 0, ts_hi = 0, nts = 0; const unsigned long long rt_entry = STAMP ? (unsigned long long)wall_clock64() : 0ull;
#define PG8_STAMP() do { if (STAMP && wid == 0 && nts < 64) { const unsigned long long _c = (unsigned long long)clock64(); \
        ts_lo = (lane == nts) ? (int)(unsigned)_c : ts_lo; ts_hi = (lane == nts) ? (int)(unsigned)(_c >> 32) : ts_hi; ++nts; } } while (0)
    PG8_STAMP();
    unsigned voffA[2], voffB[2];
#pragma unroll
    for (int i = 0; i < 2; ++i) { int R, C; stage_rc(tid * 16 + i * 8192, R, C); const int Rb = Epi::PERM ? ((R & ~31) + perm32(R & 31)) : R;
        voffA[i] = (unsigned)(R * K + C) * 2u; voffB[i] = (unsigned)(Rb * K + C) * 2u; }
    const size_t kstep = (size_t)(BK * 2);
    const size_t hstep = (size_t)HALF * K * 2;
    const size_t tstep = 2 * hstep;
    const unsigned ldsw = (unsigned)wid * 1024u;
    const int aoff = lds_byte(wr * 64 + fr, fq * 8), boff = lds_byte(wc * 32 + fr, fq * 8);
#define PG8_SA(b, h) (((b) * 2 + (h)) * HTB)
#define PG8_SB(b, h) ((4 + (b) * 2 + (h)) * HTB)
#define PG8_STAGE(bufoff, gbase, voff) do { _Pragma("unroll") for (int _i = 0; _i < 2; ++_i) \
        __builtin_amdgcn_global_load_lds((const unsigned*)((const char*)(gbase) + (voff)[_i]), (PG8_LAS unsigned*)(lds + (bufoff) + ldsw + _i * 8192), 16, 0, 0); } while (0)
#define PG8_LDA(dst, b, h) do { _Pragma("unroll") for (int m = 0; m < 4; ++m) _Pragma("unroll") for (int k = 0; k < 2; ++k) dst[m][k] = *(const PG8_LAS bf16x8*)(lds + PG8_SA(b, h) + aoff + m * 2048 + k * 1024); } while (0)
#define PG8_LDB(dst, b, h) do { _Pragma("unroll") for (int n = 0; n < 2; ++n) _Pragma("unroll") for (int k = 0; k < 2; ++k) dst[n][k] = *(const PG8_LAS bf16x8*)(lds + PG8_SB(b, h) + boff + n * 2048 + k * 1024); } while (0)
#define PG8_MMA(ai, bj, At, Bt) do { __builtin_amdgcn_s_setprio(1); _Pragma("unroll") for (int m = 0; m < 4; ++m) _Pragma("unroll") for (int n = 0; n < 2; ++n) _Pragma("unroll") for (int k = 0; k < 2; ++k) \
        acc[ai][bj][m][n] = __builtin_amdgcn_mfma_f32_16x16x32_bf16(Bt[n][k], At[m][k], acc[ai][bj][m][n], 0, 0, 0); __builtin_amdgcn_s_setprio(0); } while (0)
#define PG8_WAIT_V(n) asm volatile("s_waitcnt vmcnt(" #n ")" ::: "memory")
#define PG8_WAIT_L(n) asm volatile("s_waitcnt lgkmcnt(" #n ")" ::: "memory")
#define PG8_BAR __builtin_amdgcn_s_barrier()
#define PG8_SCHED __builtin_amdgcn_sched_barrier(0)
    Unit cur, nxt; int ui = 0;
    if (!S.next(0, cur)) return;
    f32x4 acc[2][2][4][2];
#pragma unroll
    for (int a = 0; a < 2; ++a)
#pragma unroll
        for (int b = 0; b < 2; ++b)
#pragma unroll
            for (int m = 0; m < 4; ++m)
#pragma unroll
                for (int n = 0; n < 2; ++n) acc[a][b][m][n] = (f32x4){0.f, 0.f, 0.f, 0.f};
    bf16x8 At[4][2], B0[2][2], B1[2][2];
    const char* cA = (const char*)g.A + (size_t)cur.pm * tstep; const char* cB = (const char*)g.Bt + (size_t)cur.pn * tstep;
    S.a_ready(cur);
    PG8_STAGE(PG8_SB(0, 0), cB, voffB); PG8_STAGE(PG8_SA(0, 0), cA, voffA); PG8_STAGE(PG8_SB(0, 1), cB + hstep, voffB); PG8_STAGE(PG8_SA(0, 1), cA + hstep, voffA);
    if (wr == 1) PG8_BAR;
    PG8_WAIT_V(4); PG8_BAR;
    PG8_STAGE(PG8_SB(1, 0), cB + kstep, voffB); PG8_STAGE(PG8_SA(1, 0), cA + kstep, voffA); PG8_STAGE(PG8_SB(1, 1), cB + hstep + kstep, voffB);
    PG8_WAIT_V(6); PG8_BAR;
    PG8_STAMP();
    for (;;) {
        const bool has_next = S.next(ui + 1, nxt);
        const char* nA = has_next ? (const char*)g.A + (size_t)nxt.pm * tstep : cA; const char* nB = has_next ? (const char*)g.Bt + (size_t)nxt.pn * tstep : cB;
        for (int t = 0; t < nt; t += 2) {
            const bool last = (t == nt - 2);
            const char* a1 = cA + (size_t)(t + 1) * kstep;
            const char* a2 = last ? nA : cA + (size_t)(t + 2) * kstep; const char* b2 = last ? nB : cB + (size_t)(t + 2) * kstep;
            const char* a3 = a2 + kstep; const char* b3 = b2 + kstep;
            if (last && has_next) S.a_ready(nxt);
            PG8_LDB(B0, 0, 0); PG8_SCHED; PG8_LDA(At, 0, 0); PG8_STAGE(PG8_SA(1, 1), a1 + hstep, voffA);
            PG8_WAIT_L(8); PG8_BAR; PG8_WAIT_L(0); PG8_MMA(0, 0, At, B0); PG8_BAR; PG8_SCHED;
            PG8_LDB(B1, 0, 1); PG8_STAGE(PG8_SB(0, 0), b2, voffB);
            PG8_BAR; PG8_WAIT_L(0); PG8_MMA(0, 1, At, B1); PG8_BAR;
            PG8_LDA(At, 0, 1); PG8_STAGE(PG8_SA(0, 0), a2, voffA);
            PG8_BAR; PG8_WAIT_L(0); PG8_MMA(1, 0, At, B0); PG8_BAR; PG8_SCHED;
            PG8_STAGE(PG8_SB(0, 1), b2 + hstep, voffB);
            PG8_WAIT_V(6); PG8_BAR; PG8_MMA(1, 1, At, B1); PG8_BAR;
            PG8_LDB(B0, 1, 0); PG8_SCHED; PG8_LDA(At, 1, 0); PG8_STAGE(PG8_SA(0, 1), a2 + hstep, voffA);
            PG8_WAIT_L(8); PG8_BAR; PG8_WAIT_L(0); PG8_MMA(0, 0, At, B0); PG8_BAR; PG8_SCHED;
            PG8_LDB(B1, 1, 1); PG8_STAGE(PG8_SB(1, 0), b3, voffB);
            PG8_BAR; PG8_WAIT_L(0); PG8_MMA(0, 1, At, B1); PG8_BAR;
            PG8_LDA(At, 1, 1); PG8_STAGE(PG8_SA(1, 0), a3, voffA);
            PG8_BAR; PG8_WAIT_L(0); PG8_MMA(1, 0, At, B0); PG8_BAR; PG8_SCHED;
            PG8_STAGE(PG8_SB(1, 1), b3 + hstep, voffB);
            PG8_WAIT_V(6); PG8_BAR; PG8_MMA(1, 1, At, B1); PG8_BAR;
        }
        PG8_STAMP();
        if constexpr (!Epi::AFTER_DRAIN) { E(acc, cur, wr, wc, fr, fq); S.done(cur); }
        PG8_STAMP();
        if (!has_next) break;
#pragma unroll
        for (int a = 0; a < 2; ++a)
#pragma unroll
            for (int b = 0; b < 2; ++b)
#pragma unroll
                for (int m = 0; m < 4; ++m)
#pragma unroll
                    for (int n = 0; n < 2; ++n) acc[a][b][m][n] = (f32x4){0.f, 0.f, 0.f, 0.f};
        cur = nxt; cA = nA; cB = nB; ++ui;
    }
    PG8_WAIT_V(0);
    if (wr == 0) PG8_BAR;
    PG8_BAR;
    if constexpr (Epi::AFTER_DRAIN) { E.fused(acc, cur, wr, wc, fr, fq, lds, wid, lane); S.done(cur); }
    PG8_STAMP();
    if (STAMP && wid == 0) { stamps[lane] = lane < nts ? (((unsigned long long)(unsigned)ts_hi << 32) | (unsigned)ts_lo) : 0ull;
        if (lane == 62) stamps[62] = rt_entry; if (lane == 63) stamps[63] = (unsigned long long)wall_clock64(); }
#undef PG8_STAMP
#undef PG8_SA
#undef PG8_SB
#undef PG8_STAGE
#undef PG8_LDA
#undef PG8_LDB
#undef PG8_MMA
#undef PG8_WAIT_V
#undef PG8_WAIT_L
#undef PG8_BAR
#undef PG8_SCHED
}
}

using pg8::bf16_t; using pg8::bf16x8; using pg8::f32x4; using pg8::u32x4; using pg8::cvt_pk_bf16;
typedef unsigned u32x2 __attribute__((ext_vector_type(2)));
#define DEVI __device__ __forceinline__
#define LAS __attribute__((address_space(3)))

constexpr int NPR = 16384, NRV = 16512, NRP = 16640;
constexpr int LDS_BYTES = 135168;
constexpr int LDS_MISC = 131072;

constexpr size_t WS_CTL = 0;
constexpr size_t WS_WT_MOD = 4096;
constexpr size_t WS_WT_INAB = WS_WT_MOD + 25165824;
constexpr size_t WS_WT_OUTAB = WS_WT_INAB + 25165824;
constexpr size_t WS_WT_CIN = WS_WT_OUTAB + 8388608;
constexpr size_t WS_WT_GLU = WS_WT_CIN + 8388608;
constexpr size_t WS_WT_COUT = WS_WT_GLU + 4194304;
constexpr size_t WS_WT_LRU = WS_WT_COUT + 4194304;
constexpr size_t WS_SILUC = WS_WT_LRU + 1048576;
constexpr size_t WS_MOD = WS_SILUC + 524288;
constexpr size_t WS_TAIL = WS_MOD + 12582912;
constexpr size_t WS_YBUF = WS_TAIL + 1064960;
constexpr size_t WS_PROJ = WS_YBUF + 68157440;
constexpr size_t WS_UT = WS_PROJ + 204472320;
constexpr size_t WS_WB = WS_UT + 33554432;
constexpr size_t WS_QT = WS_WB + 33554432;
constexpr size_t WS_KT = WS_QT + 33554432;
constexpr size_t WS_EGL = WS_KT + 33554432;
constexpr size_t WS_END = WS_EGL + 8192;
constexpr size_t WS_QK = WS_WT_MOD;
constexpr size_t WS_Y2 = WS_YBUF + 34078720;

constexpr size_t O_YP = 0, O_YS = 16777216, O_PCA = O_YS + 131072, O_PLRU = O_PCA + 49152, O_PCB = O_PLRU + 16384, O_PDEL = O_PCB + 147456,
                 O_PSR = O_PDEL + 2097152, O_PSI = O_PSR + 65536, O_SCA = O_PSI + 65536, O_SLRU = O_SCA + 786432, O_SCB = O_SLRU + 262144,
                 O_SDEL = O_SCB + 2359296, O_SSR = O_SDEL + 33554432, O_SSI = O_SSR + 1048576, O_END = O_SSI + 1048576;

enum { I_XP = 0, I_XS, I_CP, I_CS, I_SCA, I_SLRU, I_SCB, I_SDEL, I_SSR, I_SSI, I_NORMW, I_MODW, I_MODB, I_ABIN, I_ABOUT, I_CAW, I_CAB, I_GXW, I_GXB, I_GAW, I_GAB, I_APAR,
       I_CBW, I_ALOG, I_DTB, I_GNW, I_CIN, I_COUT, I_ARE, I_AIM, I_BRE, I_BIM, I_CRE, I_CIM, I_S5D, I_LOGDT, I_GLUW, I_GLUB, I_FNW, N_IN };

struct Params {
  const float* in[N_IN];
  float* out;
  unsigned char* ws;
  int ph_lo, ph_hi;
};

typedef const Params __attribute__((address_space(4)))* KP;
DEVI float bf2f(unsigned v16) { return __uint_as_float(v16 << 16); }
DEVI float bflo(unsigned w) { return __uint_as_float(w << 16); }
DEVI float bfhi(unsigned w) { return __uint_as_float(w & 0xffff0000u); }
DEVI bf16_t f2bf(float f) { return (bf16_t)(cvt_pk_bf16(f, 0.f) & 0xffffu); }
DEVI float sigmoidf_(float x) { return 1.f / (1.f + __expf(-x)); }
DEVI float siluf_(float x) { return x / (1.f + __expf(-x)); }
DEVI float softplusf_(float x) { return x > 20.f ? x : log1pf(__expf(x)); }
DEVI float geluf_(float x) { const float z = 0.7978845608028654f * (x + 0.044715f * x * x * x); const float e = __expf(2.f * z); const float t = 1.f - 2.f / (1.f + e); return 0.5f * x * (1.f + t); }
DEVI float wave_sum(float v) {
#pragma unroll
  for (int o = 32; o >= 1; o >>= 1) v += __shfl_xor(v, o);
  return v;
}
DEVI void unpack8(const u32x4 w, float (&f)[8]) { f[0] = bflo(w.x); f[1] = bfhi(w.x); f[2] = bflo(w.y); f[3] = bfhi(w.y); f[4] = bflo(w.z); f[5] = bfhi(w.z); f[6] = bflo(w.w); f[7] = bfhi(w.w); }
DEVI u32x4 pack8(const float (&f)[8]) { u32x4 w; w.x = cvt_pk_bf16(f[0], f[1]); w.y = cvt_pk_bf16(f[2], f[3]); w.z = cvt_pk_bf16(f[4], f[5]); w.w = cvt_pk_bf16(f[6], f[7]); return w; }
DEVI bf16x8 as_bf16x8(const u32x4 w) { union { u32x4 u; bf16x8 b; } c; c.u = w; return c.b; }
DEVI f32x4 mfma16(bf16x8 a, bf16x8 b, f32x4 c) { return __builtin_amdgcn_mfma_f32_16x16x32_bf16(a, b, c, 0, 0, 0); }

struct EpiRes {
  static constexpr bool PERM = false, AFTER_DRAIN = false;
  const float* xp; const float* xs; float* xo; const float* gate;
  __device__ __forceinline__ void operator()(const f32x4 (&acc)[2][2][4][2], const pg8::Unit& u, int wr, int wc, int fr, int fq) const {
    const int row0 = u.pm * 256 + wr * 64 + fr, col0 = u.pn * 256 + wc * 32 + 4 * fq;
#pragma unroll
    for (int ai = 0; ai < 2; ++ai)
#pragma unroll
      for (int m = 0; m < 4; ++m) {
        const int row = row0 + ai * 128 + m * 16;
        if (row < NRV) {
          const float* xi = (row < NPR ? xp + (size_t)row * 1024 : xs + (size_t)(row - NPR) * 1024) + col0;
          const int mrow = row < NPR ? (row >> 11) : 8 + (row - NPR);
          const float* gp = gate + (size_t)mrow * 12288 + col0;
          float* op = xo + (size_t)row * 1024 + col0;
#pragma unroll
          for (int bj = 0; bj < 2; ++bj)
#pragma unroll
            for (int n = 0; n < 2; ++n) {
              const f32x4 xv = *(const f32x4*)(xi + bj * 128 + n * 16), gv = *(const f32x4*)(gp + bj * 128 + n * 16);
              *(f32x4*)(op + bj * 128 + n * 16) = xv + gv * acc[ai][bj][m][n];
            }
        }
      }
  }
};
struct EpiGlu {
  static constexpr bool PERM = true, AFTER_DRAIN = false;
  const bf16_t* y1; const bf16_t* z; bf16_t* y2; const float* bias;
  __device__ __forceinline__ void operator()(const f32x4 (&acc)[2][2][4][2], const pg8::Unit& u, int wr, int wc, int fr, int fq) const {
    const int row0 = u.pm * 256 + wr * 64 + fr, col0 = u.pn * 256 + wc * 32 + 8 * fq;
#pragma unroll
    for (int ai = 0; ai < 2; ++ai)
#pragma unroll
      for (int m = 0; m < 4; ++m) {
        const int row = row0 + ai * 128 + m * 16;
#pragma unroll
        for (int bj = 0; bj < 2; ++bj) {
          const int col = col0 + bj * 128;
          const f32x4 b0 = *(const f32x4*)(bias + col), b1 = *(const f32x4*)(bias + col + 4);
          const u32x4 yw = *(const u32x4*)(y1 + (size_t)row * 1024 + col), zw = *(const u32x4*)(z + (size_t)row * 2048 + col);
          float yf[8], zf[8], o[8]; unpack8(yw, yf); unpack8(zw, zf);
          const f32x4 a0 = acc[ai][bj][m][0] + b0, a1 = acc[ai][bj][m][1] + b1;
#pragma unroll
          for (int e = 0; e < 4; ++e) { o[e] = yf[e] * sigmoidf_(a0[e]) * siluf_(zf[e]); o[4 + e] = yf[4 + e] * sigmoidf_(a1[e]) * siluf_(zf[4 + e]); }
          *(u32x4*)(y2 + (size_t)row * 1024 + col) = pack8(o);
        }
      }
  }
};

DEVI void transpose_tile(const float* __restrict__ src, int ldsrc, bf16_t* __restrict__ dst, int lddst, int k0, int n0, float* tile) {
  const int tid = tidx_();
  { const int tx = tid & 15, ty = tid >> 4;
#pragma unroll
    for (int pp = 0; pp < 2; ++pp) { const int k = ty + pp * 32; const float4 v = *(const float4*)(src + (size_t)(k0 + k) * ldsrc + n0 + tx * 4);
      tile[k * 65 + tx * 4 + 0] = v.x; tile[k * 65 + tx * 4 + 1] = v.y; tile[k * 65 + tx * 4 + 2] = v.z; tile[k * 65 + tx * 4 + 3] = v.w; } }
  __syncthreads();
  { const int n = tid >> 3, ks = (tid & 7) * 8; float f[8];
#pragma unroll
    for (int j = 0; j < 8; ++j) f[j] = tile[(ks + j) * 65 + n];
    *(u32x4*)(dst + (size_t)(n0 + n) * lddst + k0 + ks) = pack8(f); }
  __syncthreads();
}
DEVI void phase_prep(KP p, float* lds) {
  for (int t = bidx_(); t < 9344; t += gdim_()) {
    const float* src; bf16_t* dst; int ldsrc, lddst, k0, n0; int tt = t;
    if (tt < 3072) { const int mat = tt / 768, r = tt % 768; k0 = (r / 48) * 64; n0 = (r % 48) * 64; src = p->in[I_MODW] + (size_t)mat * 1024 * 3072; ldsrc = 3072; dst = (bf16_t*)(p->ws + WS_WT_MOD) + (size_t)mat * 3072 * 1024; lddst = 1024; }
    else if ((tt -= 3072) < 3072) { const int mat = tt / 1536, r = tt % 1536; k0 = (r / 96) * 64; n0 = (r % 96) * 64; src = p->in[I_ABIN] + (size_t)mat * 1024 * 6160; ldsrc = 6160; dst = (bf16_t*)(p->ws + WS_WT_INAB) + (size_t)mat * 6144 * 1024; lddst = 1024; }
    else if ((tt -= 3072) < 1024) { const int mat = tt / 512, r = tt % 512; k0 = (r / 16) * 64; n0 = (r % 16) * 64; src = p->in[I_ABOUT] + (size_t)mat * 2048 * 1024; ldsrc = 1024; dst = (bf16_t*)(p->ws + WS_WT_OUTAB) + (size_t)mat * 1024 * 2048; lddst = 2048; }
    else if ((tt -= 1024) < 1024) { const int mat = tt / 512, r = tt % 512; k0 = (r / 32) * 64; n0 = (r % 32) * 64; src = p->in[I_CIN] + (size_t)mat * 1024 * 2048; ldsrc = 2048; dst = (bf16_t*)(p->ws + WS_WT_CIN) + (size_t)mat * 2048 * 1024; lddst = 1024; }
    else if ((tt -= 1024) < 512) { const int mat = tt / 256, r = tt % 256; k0 = (r / 16) * 64; n0 = (r % 16) * 64; src = p->in[I_COUT] + (size_t)mat * 1024 * 1024; ldsrc = 1024; dst = (bf16_t*)(p->ws + WS_WT_COUT) + (size_t)mat * 1024 * 1024; lddst = 1024; }
    else if ((tt -= 512) < 512) { const int mat = tt / 256, r = tt % 256; k0 = (r / 16) * 64; n0 = (r % 16) * 64; src = p->in[I_GLUW] + (size_t)mat * 1024 * 1024; ldsrc = 1024; dst = (bf16_t*)(p->ws + WS_WT_GLU) + (size_t)mat * 1024 * 1024; lddst = 1024; }
    else { tt -= 512; const int gate = tt / 64; const int r2 = tt % 64; const int mat = r2 / 4, r = r2 % 4;
      k0 = (r / 2) * 64; n0 = (r % 2) * 64; src = p->in[gate ? I_GAW : I_GXW] + (size_t)mat * 16384; ldsrc = 128;
      dst = (bf16_t*)(p->ws + WS_WT_LRU) + (size_t)(((mat >> 3) * 2 + gate) * 8 + (mat & 7)) * 16384; lddst = 128; }
    transpose_tile(src, ldsrc, dst, lddst, k0, n0, lds);
  }
  bf16_t* sc = (bf16_t*)(p->ws + WS_SILUC);
  for (int e = bidx_() * 512 + tidx_(); e < 256 * 1024 / 4; e += gdim_() * 512) {
    const int row = e >> 8, c4 = (e & 255) * 4; float4 v = make_float4(0.f, 0.f, 0.f, 0.f);
    if (row < 8) v = *(const float4*)(p->in[I_CP] + row * 1024 + c4); else if (row < 136) v = *(const float4*)(p->in[I_CS] + (row - 8) * 1024 + c4);
    u32x2 w; w.x = cvt_pk_bf16(row < 136 ? siluf_(v.x) : 0.f, row < 136 ? siluf_(v.y) : 0.f); w.y = cvt_pk_bf16(row < 136 ? siluf_(v.z) : 0.f, row < 136 ? siluf_(v.w) : 0.f);
    *(u32x2*)(sc + row * 1024 + c4) = w;
  }
}

DEVI void phase_norm(KP p, int layer, float* lds) {
  const int tid = tidx_(), lane = tid & 63, wave = tid >> 6;
  const bool tail = (layer & 1) == 0; const int j = layer >> 1;
  if (tail) {
    const float* W = p->in[I_ABIN] + (size_t)j * 1024 * 6160 + 6144;
    for (int e = tid; e < 4096; e += 512) { const int k = e >> 2, c4 = (e & 3) * 4; const float4 v = *(const float4*)(W + (size_t)k * 6160 + c4);
      lds[(c4 + 0) * 1024 + k] = v.x; lds[(c4 + 1) * 1024 + k] = v.y; lds[(c4 + 2) * 1024 + k] = v.z; lds[(c4 + 3) * 1024 + k] = v.w; }
    __syncthreads();
  }
  const float* nw = p->in[I_NORMW] + layer * 1024;
  const float* modb = (const float*)(p->ws + WS_MOD);
  bf16_t* hb = (bf16_t*)(p->ws + WS_YBUF);
  float* tl = (float*)(p->ws + WS_TAIL);
  for (int r = bidx_() * 8 + wave; r < NRV; r += gdim_() * 8) {
    const float* xr = (layer == 0) ? (r < NPR ? p->in[I_XP] + (size_t)r * 1024 : p->in[I_XS] + (size_t)(r - NPR) * 1024) : p->out + (size_t)r * 1024;
    const int mrow = r < NPR ? (r >> 11) : 8 + (r - NPR);
    const float* md = modb + (size_t)mrow * 12288 + layer * 3072;
    float4 v[4]; float ss = 0.f;
#pragma unroll
    for (int i = 0; i < 4; ++i) { v[i] = *(const float4*)(xr + i * 256 + lane * 4); ss += v[i].x * v[i].x + v[i].y * v[i].y + v[i].z * v[i].z + v[i].w * v[i].w; }
    ss = wave_sum(ss);
    const float rinv = rsqrtf(ss * (1.f / 1024.f) + 1e-6f);
#pragma unroll
    for (int i = 0; i < 4; ++i) { const int k = i * 256 + lane * 4;
      const float4 w4 = *(const float4*)(nw + k), sh = *(const float4*)(md + k), sc = *(const float4*)(md + 1024 + k);
      float4 h; h.x = v[i].x * rinv * w4.x * (1.f + sc.x) + sh.x; h.y = v[i].y * rinv * w4.y * (1.f + sc.y) + sh.y; h.z = v[i].z * rinv * w4.z * (1.f + sc.z) + sh.z; h.w = v[i].w * rinv * w4.w * (1.f + sc.w) + sh.w;
      v[i] = h; u32x2 w; w.x = cvt_pk_bf16(h.x, h.y); w.y = cvt_pk_bf16(h.z, h.w); *(u32x2*)(hb + (size_t)r * 1024 + k) = w; }
    if (tail) {
      float keep = 0.f;
#pragma unroll
      for (int c = 0; c < 16; ++c) { float pt = 0.f;
#pragma unroll
        for (int i = 0; i < 4; ++i) { const float4 w4 = *(const float4*)(lds + c * 1024 + i * 256 + lane * 4); pt += v[i].x * w4.x + v[i].y * w4.y + v[i].z * w4.z + v[i].w * w4.w; }
        pt = wave_sum(pt); if (lane == c) keep = pt; }
      if (lane < 16) tl[(size_t)r * 16 + lane] = keep;
    }
  }
}

DEVI void lru_item(KP p, int j, int item, unsigned char* lds) {
  const int tid = tidx_(), lane = tid & 63, wave = tid >> 6;
  const bool prompt = item < 128;
  const int b = prompt ? (item >> 4) : 0, hd = prompt ? ((item >> 1) & 7) : ((item - 128) >> 1), half = item & 1;
  bf16_t* WX = (bf16_t*)lds;
  bf16_t* XA = (bf16_t*)(lds + 34816);
  float* AA = (float*)(lds + 52224);
  float* BB = (float*)(lds + 69632);
  const bf16_t* proj = (const bf16_t*)(p->ws + WS_PROJ);
  bf16_t* ybuf = (bf16_t*)(p->ws + WS_YBUF);
  { const bf16_t* wt = (const bf16_t*)(p->ws + WS_WT_LRU);
#pragma unroll
    for (int q = 0; q < 4; ++q) { const int e = tid + q * 512, gate = e >> 10, o = (e & 1023) >> 4, c8 = e & 15;
      *(u32x4*)(WX + (gate * 64 + o) * 136 + c8 * 8) = *(const u32x4*)(wt + ((size_t)((j * 2 + gate) * 8 + hd) * 128 + half * 64 + o) * 128 + c8 * 8); } }
  const int ch8 = tid & 15, rsub = tid >> 4, chb = hd * 128 + ch8 * 8;
  float cw[4][8], cb[8];
#pragma unroll
  for (int t = 0; t < 4; ++t)
#pragma unroll
    for (int e = 0; e < 8; ++e) cw[t][e] = p->in[I_CAW][(size_t)(j * 4 + t) * 1024 + chb + e];
#pragma unroll
  for (int e = 0; e < 8; ++e) cb[e] = p->in[I_CAB][j * 1024 + chb + e];
  const int rt = wave >> 1, chh = wave & 1, l15 = lane & 15, lq = lane >> 4;
  float gxb[2], gab[2], spv[2];
#pragma unroll
  for (int c2 = 0; c2 < 2; ++c2) { const int gch = hd * 128 + half * 64 + chh * 32 + c2 * 16 + l15;
    gxb[c2] = p->in[I_GXB][j * 1024 + gch]; gab[c2] = p->in[I_GAB][j * 1024 + gch]; spv[c2] = softplusf_(-p->in[I_APAR][j * 1024 + gch]); }
  const int sch = hd * 128 + half * 64 + tid;
  float hcar = 0.f;
  const int ntiles = prompt ? 32 : 2;
  for (int tile = 0; tile < ntiles; ++tile) {
#pragma unroll
    for (int pp = 0; pp < 2; ++pp) {
      const int i = rsub + pp * 32;
      float acc[8], x3[8];
#pragma unroll
      for (int e = 0; e < 8; ++e) acc[e] = cb[e];
      if (prompt) {
        const int t = tile * 64 + i;
#pragma unroll
        for (int tap = 0; tap < 4; ++tap) { const int tt = t - 3 + tap; float xf[8];
          if (tt >= 0) { const u32x4 w = *(const u32x4*)(proj + (size_t)(b * 2048 + tt) * 6144 + chb); unpack8(w, xf); }
          else {
#pragma unroll
            for (int e = 0; e < 8; ++e) xf[e] = 0.f; }
#pragma unroll
          for (int e = 0; e < 8; ++e) acc[e] += cw[tap][e] * xf[e];
          if (tap == 3) {
#pragma unroll
            for (int e = 0; e < 8; ++e) x3[e] = xf[e]; } }
        if (tile == 31 && i >= 61 && half == 0) { float* o = p->out + O_PCA + (size_t)((j * 8 + b) * 3 + (i - 61)) * 1024 + chb;
          *(float4*)o = make_float4(x3[0], x3[1], x3[2], x3[3]); *(float4*)(o + 4) = make_float4(x3[4], x3[5], x3[6], x3[7]); }
      } else {
        const int brow = tile * 64 + i;
        const float* st = p->in[I_SCA] + (size_t)((j * 128 + brow) * 3) * 1024 + chb;
        float* so = p->out + O_SCA + (size_t)((j * 128 + brow) * 3) * 1024 + chb;
#pragma unroll
        for (int tap = 0; tap < 3; ++tap) { const float4 s0 = *(const float4*)(st + tap * 1024), s1 = *(const float4*)(st + tap * 1024 + 4);
          const float xf[8] = {s0.x, s0.y, s0.z, s0.w, s1.x, s1.y, s1.z, s1.w};
#pragma unroll
          for (int e = 0; e < 8; ++e) acc[e] += cw[tap][e] * xf[e];
          if (tap >= 1 && half == 0) { *(float4*)(so + (tap - 1) * 1024) = s0; *(float4*)(so + (tap - 1) * 1024 + 4) = s1; } }
        const u32x4 w = *(const u32x4*)(proj + (size_t)(NPR + brow) * 6144 + chb); unpack8(w, x3);
#pragma unroll
        for (int e = 0; e < 8; ++e) acc[e] += cw[3][e] * x3[e];
        if (half == 0) { *(float4*)(so + 2 * 1024) = make_float4(x3[0], x3[1], x3[2], x3[3]); *(float4*)(so + 2 * 1024 + 4) = make_float4(x3[4], x3[5], x3[6], x3[7]); }
      }
      *(u32x4*)(XA + i * 136 + ch8 * 8) = pack8(acc);
    }
    __syncthreads();
    f32x4 accx[2], acca[2];
#pragma unroll
    for (int c2 = 0; c2 < 2; ++c2) { accx[c2] = (f32x4){0.f, 0.f, 0.f, 0.f}; acca[c2] = (f32x4){0.f, 0.f, 0.f, 0.f}; }
#pragma unroll
    for (int kk = 0; kk < 4; ++kk) {
      const bf16x8 a = *(const bf16x8*)(XA + (rt * 16 + l15) * 136 + lq * 8 + kk * 32);
#pragma unroll
      for (int c2 = 0; c2 < 2; ++c2) {
        const bf16x8 bx = *(const bf16x8*)(WX + (chh * 32 + c2 * 16 + l15) * 136 + lq * 8 + kk * 32);
        const bf16x8 ba = *(const bf16x8*)(WX + (64 + chh * 32 + c2 * 16 + l15) * 136 + lq * 8 + kk * 32);
        accx[c2] = mfma16(a, bx, accx[c2]); acca[c2] = mfma16(a, ba, acca[c2]);
      }
    }
#pragma unroll
    for (int c2 = 0; c2 < 2; ++c2)
#pragma unroll
      for (int r = 0; r < 4; ++r) {
        const int row = rt * 16 + lq * 4 + r, oc = chh * 32 + c2 * 16 + l15;
        const float gx = sigmoidf_(accx[c2][r] + gxb[c2]), ga = sigmoidf_(acca[c2][r] + gab[c2]);
        const float log_a = -8.f * ga * spv[c2];
        const float a = __expf(log_a);
        float mult = sqrtf(-expm1f(2.f * log_a));
        if (prompt && tile == 0 && row == 0) mult = 1.f;
        const float xv = bf2f(XA[row * 136 + half * 64 + oc]);
        AA[row * 68 + oc] = a; BB[row * 68 + oc] = mult * gx * xv;
      }
    __syncthreads();
    if (tid < 64) {
      if (prompt) {
        for (int i = 0; i < 64; ++i) { hcar = AA[i * 68 + tid] * hcar + BB[i * 68 + tid]; BB[i * 68 + tid] = hcar; }
      } else {
        for (int i = 0; i < 64; ++i) { const int brow = tile * 64 + i; const float h0 = p->in[I_SLRU][(size_t)(j * 128 + brow) * 1024 + sch];
          const float hh = AA[i * 68 + tid] * h0 + BB[i * 68 + tid]; BB[i * 68 + tid] = hh; p->out[O_SLRU + (size_t)(j * 128 + brow) * 1024 + sch] = hh; }
      }
    }
    __syncthreads();
    { const int i = tid >> 3, oc8 = (tid & 7) * 8;
      const size_t grow = prompt ? (size_t)(b * 2048 + tile * 64 + i) : (size_t)(NPR + tile * 64 + i);
      const u32x4 zw = *(const u32x4*)(proj + grow * 6144 + 1024 + hd * 128 + half * 64 + oc8);
      float zf[8], o[8]; unpack8(zw, zf);
#pragma unroll
      for (int e = 0; e < 8; ++e) o[e] = BB[i * 68 + oc8 + e] * siluf_(zf[e]);
      *(u32x4*)(ybuf + grow * 2048 + hd * 128 + half * 64 + oc8) = pack8(o); }
    __syncthreads();
  }
  if (prompt && tid < 64) p->out[O_PLRU + (size_t)(j * 8 + b) * 1024 + sch] = hcar;
}

DEVI void gdn_prep_item(KP p, int j, int cid, unsigned char* lds) {
  const int tid = tidx_(), lane = tid & 63, wave = tid >> 6;
  const int b = cid >> 8, h = (cid >> 5) & 7, c = cid & 31;
  const int row0 = b * 2048 + c * 64;
  bf16_t* QN = (bf16_t*)lds; bf16_t* KN = (bf16_t*)(lds + 17408); bf16_t* VN = (bf16_t*)(lds + 34816);
  float* AM = (float*)(lds + 52224); float* GC = (float*)(lds + 69632); float* BETA = (float*)(lds + 69888); float* BEG = (float*)(lds + 70144);
  const bf16_t* proj = (const bf16_t*)(p->ws + WS_PROJ);
  const float* tl = (const float*)(p->ws + WS_TAIL);
  if (wave == 0) {
    const float* t = tl + (size_t)(row0 + lane) * 16;
    float g = -__expf(p->in[I_ALOG][j * 8 + h]) * softplusf_(t[8 + h] + p->in[I_DTB][j * 8 + h]);
    const float beta = sigmoidf_(t[h]);
#pragma unroll
    for (int o = 1; o < 64; o <<= 1) { const float v = __shfl_up(g, o); if (lane >= o) g += v; }
    GC[lane] = g; BETA[lane] = beta; BEG[lane] = beta * __expf(g);
  }
#pragma unroll 1
  for (int pi = 0; pi < 6; ++pi) {
    const int pair = tid + 512 * pi, part = pair >> 10, rem = pair & 1023, i = rem >> 4, cgp = rem & 15;
    const int col = part * 1024 + h * 128 + cgp * 8;
    float acc[8], x3[8];
#pragma unroll
    for (int e = 0; e < 8; ++e) acc[e] = 0.f;
#pragma unroll
    for (int tap = 0; tap < 4; ++tap) { const int tt = c * 64 + i - 3 + tap; float xf[8];
      if (tt >= 0) { const u32x4 w = *(const u32x4*)(proj + (size_t)(b * 2048 + tt) * 6144 + 2048 + col); unpack8(w, xf); }
      else {
#pragma unroll
        for (int e = 0; e < 8; ++e) xf[e] = 0.f; }
      const float* cwp = p->in[I_CBW] + (size_t)(j * 4 + tap) * 3072 + col;
      const float4 w0 = *(const float4*)cwp, w1 = *(const float4*)(cwp + 4);
      acc[0] += w0.x * xf[0]; acc[1] += w0.y * xf[1]; acc[2] += w0.z * xf[2]; acc[3] += w0.w * xf[3];
      acc[4] += w1.x * xf[4]; acc[5] += w1.y * xf[5]; acc[6] += w1.z * xf[6]; acc[7] += w1.w * xf[7];
      if (tap == 3) {
#pragma unroll
        for (int e = 0; e < 8; ++e) x3[e] = xf[e]; } }
    if (c == 31 && i >= 61) { float* o = p->out + O_PCB + (size_t)((j * 8 + b) * 3 + (i - 61)) * 3072 + col;
      *(float4*)o = make_float4(x3[0], x3[1], x3[2], x3[3]); *(float4*)(o + 4) = make_float4(x3[4], x3[5], x3[6], x3[7]); }
    float ss = 0.f;
#pragma unroll
    for (int e = 0; e < 8; ++e) { acc[e] = siluf_(acc[e]); ss += acc[e] * acc[e]; }
    ss += __shfl_xor(ss, 1); ss += __shfl_xor(ss, 2); ss += __shfl_xor(ss, 4); ss += __shfl_xor(ss, 8);
    float scl = 1.f;
    if (part == 0) scl = rsqrtf(ss + 1e-6f) * 0.08838834764831845f; else if (part == 1) scl = rsqrtf(ss + 1e-6f);
#pragma unroll
    for (int e = 0; e < 8; ++e) acc[e] *= scl;
    bf16_t* dstp = part == 0 ? QN : (part == 1 ? KN : VN);
    *(u32x4*)(dstp + i * 136 + cgp * 8) = pack8(acc);
  }
  __syncthreads();
  {
    const int rt = wave >> 1, ctp = (wave & 1) * 2, l15 = lane & 15, lq = lane >> 4;
    f32x4 kka[2], qka[2];
#pragma unroll
    for (int c2 = 0; c2 < 2; ++c2) { kka[c2] = (f32x4){0.f, 0.f, 0.f, 0.f}; qka[c2] = (f32x4){0.f, 0.f, 0.f, 0.f}; }
#pragma unroll
    for (int kk = 0; kk < 4; ++kk) {
      const bf16x8 ak = *(const bf16x8*)(KN + (rt * 16 + l15) * 136 + lq * 8 + kk * 32);
      const bf16x8 aq = *(const bf16x8*)(QN + (rt * 16 + l15) * 136 + lq * 8 + kk * 32);
#pragma unroll
      for (int c2 = 0; c2 < 2; ++c2) { const bf16x8 bk = *(const bf16x8*)(KN + ((ctp + c2) * 16 + l15) * 136 + lq * 8 + kk * 32);
        kka[c2] = mfma16(ak, bk, kka[c2]); qka[c2] = mfma16(aq, bk, qka[c2]); }
    }
    bf16_t* qkg = (bf16_t*)(p->ws + WS_QK) + (size_t)cid * 4096;
#pragma unroll
    for (int c2 = 0; c2 < 2; ++c2)
#pragma unroll
      for (int r = 0; r < 4; ++r) {
        const int i = rt * 16 + lq * 4 + r, jj = (ctp + c2) * 16 + l15;
        const float dec = __expf(fminf(GC[i] - GC[jj], 0.f));
        AM[i * 68 + jj] = (i > jj) ? BETA[i] * kka[c2][r] * dec : 0.f;
        qkg[i * 64 + jj] = f2bf((i >= jj) ? qka[c2][r] * dec : 0.f);
      }
  }
  __syncthreads();
  if (tid < 256) {
    const int cc = tid;
    const bf16_t* rsrc = (cc < 128) ? (VN + cc) : (KN + (cc - 128));
    const float* rfac = (cc < 128) ? BETA : BEG;
    float x[64];
#pragma unroll
    for (int i = 0; i < 64; ++i) x[i] = 0.f;
#ifndef SOLVE_N
#define SOLVE_N 64
#endif
#pragma unroll
    for (int i = 0; i < SOLVE_N; ++i) {
      float s = bf2f(rsrc[i * 136]) * rfac[i];
#pragma unroll
      for (int j4 = 0; j4 < (i + 3) / 4; ++j4) { const f32x4 a = *(const f32x4*)(AM + i * 68 + j4 * 4);
        s -= a[0] * x[j4 * 4 + 0]; s -= a[1] * x[j4 * 4 + 1]; s -= a[2] * x[j4 * 4 + 2]; s -= a[3] * x[j4 * 4 + 3]; }
      asm volatile("" : "+v"(s) :: "memory");
      x[i] = s;
    }
    if (cc < 128) {
      bf16_t* ut = (bf16_t*)(p->ws + WS_UT) + (size_t)cid * 8192 + cc * 64;
#pragma unroll
      for (int s8 = 0; s8 < 8; ++s8) { u32x4 w; w.x = cvt_pk_bf16(x[s8 * 8 + 0], x[s8 * 8 + 1]); w.y = cvt_pk_bf16(x[s8 * 8 + 2], x[s8 * 8 + 3]); w.z = cvt_pk_bf16(x[s8 * 8 + 4], x[s8 * 8 + 5]); w.w = cvt_pk_bf16(x[s8 * 8 + 6], x[s8 * 8 + 7]);
        *(u32x4*)(ut + s8 * 8) = w; }
    } else {
      bf16_t* wb = (bf16_t*)(p->ws + WS_WB) + (size_t)cid * 8192 + (cc - 128);
#pragma unroll
      for (int i = 0; i < 64; ++i) wb[i * 128] = f2bf(x[i]);
    }
  } else {
    const int t2 = tid - 256;
    { const int i = t2 >> 2, dseg = (t2 & 3) * 32; const float eg = __expf(GC[i]);
      bf16_t* qt = (bf16_t*)(p->ws + WS_QT) + (size_t)cid * 8192 + i * 128 + dseg;
#pragma unroll
      for (int s = 0; s < 4; ++s) { float f[8]; unpack8(*(const u32x4*)(QN + i * 136 + dseg + s * 8), f);
#pragma unroll
        for (int e = 0; e < 8; ++e) f[e] *= eg;
        *(u32x4*)(qt + s * 8) = pack8(f); } }
    { const int d = t2 >> 1, iseg = (t2 & 1) * 32; const float gl = GC[63];
      bf16_t* kt = (bf16_t*)(p->ws + WS_KT) + (size_t)cid * 8192 + d * 64 + iseg;
#pragma unroll
      for (int s = 0; s < 4; ++s) { float f[8];
#pragma unroll
        for (int e = 0; e < 8; ++e) { const int i = iseg + s * 8 + e; f[e] = bf2f(KN[i * 136 + d]) * __expf(gl - GC[i]); }
        *(u32x4*)(kt + s * 8) = pack8(f); } }
    if (t2 == 0) ((float*)(p->ws + WS_EGL))[cid] = __expf(GC[63]);
  }
}

DEVI void gdn_decode_item(KP p, int j, int item, unsigned char* lds) {
  const int tid = tidx_(), lane = tid & 63, wave = tid >> 6;
  const int b = item >> 3, h = item & 7;
  const size_t row = NPR + b;
  float* QKV = (float*)lds; float* RED = (float*)(lds + 1536); float* PART = (float*)(lds + 2048);
  const bf16_t* proj = (const bf16_t*)(p->ws + WS_PROJ);
  if (tid < 384) {
    const int part = tid >> 7, ch = tid & 127, col = part * 1024 + h * 128 + ch;
    const float* st = p->in[I_SCB] + (size_t)((j * 128 + b) * 3) * 3072 + col;
    const float x0 = st[0], x1 = st[3072], x2 = st[6144], x3 = bf2f(proj[row * 6144 + 2048 + col]);
    const float* cw = p->in[I_CBW] + (size_t)(j * 4) * 3072 + col;
    const float val = siluf_(cw[0] * x0 + cw[3072] * x1 + cw[6144] * x2 + cw[9216] * x3);
    float* so = p->out + O_SCB + (size_t)((j * 128 + b) * 3) * 3072 + col;
    so[0] = x1; so[3072] = x2; so[6144] = x3;
    QKV[tid] = val;
    const float ss = wave_sum(val * val);
    if (lane == 0) RED[wave] = ss;
  }
  __syncthreads();
  const float rq = rsqrtf(RED[0] + RED[1] + 1e-6f) * 0.08838834764831845f, rk = rsqrtf(RED[2] + RED[3] + 1e-6f);
  const float* t = (const float*)(p->ws + WS_TAIL) + row * 16;
  const float g = -__expf(p->in[I_ALOG][j * 8 + h]) * softplusf_(t[8 + h] + p->in[I_DTB][j * 8 + h]);
  const float beta = sigmoidf_(t[h]), eg = __expf(g);
  const int dv4 = tid & 31, dkq = tid >> 5;
  const float* S0 = p->in[I_SDEL] + (size_t)((j * 128 + b) * 8 + h) * 16384;
  float* S1 = p->out + O_SDEL + (size_t)((j * 128 + b) * 8 + h) * 16384;
  float4 s[8]; float4 pt = make_float4(0.f, 0.f, 0.f, 0.f);
#pragma unroll
  for (int r = 0; r < 8; ++r) { const int dk = dkq * 8 + r; s[r] = *(const float4*)(S0 + dk * 128 + dv4 * 4); const float kd = QKV[128 + dk] * rk;
    pt.x += s[r].x * kd; pt.y += s[r].y * kd; pt.z += s[r].z * kd; pt.w += s[r].w * kd; }
  *(float4*)(PART + dkq * 128 + dv4 * 4) = pt;
  __syncthreads();
  float4 kv = make_float4(0.f, 0.f, 0.f, 0.f);
#pragma unroll
  for (int q = 0; q < 16; ++q) { const float4 v = *(const float4*)(PART + q * 128 + dv4 * 4); kv.x += v.x; kv.y += v.y; kv.z += v.z; kv.w += v.w; }
  const float4 vv = *(const float4*)(QKV + 256 + dv4 * 4);
  float4 vn; vn.x = beta * (vv.x - eg * kv.x); vn.y = beta * (vv.y - eg * kv.y); vn.z = beta * (vv.z - eg * kv.z); vn.w = beta * (vv.w - eg * kv.w);
  __syncthreads();
  float4 po = make_float4(0.f, 0.f, 0.f, 0.f);
#pragma unroll
  for (int r = 0; r < 8; ++r) { const int dk = dkq * 8 + r; const float kd = QKV[128 + dk] * rk, qd = QKV[dk] * rq;
    float4 n; n.x = eg * s[r].x + kd * vn.x; n.y = eg * s[r].y + kd * vn.y; n.z = eg * s[r].z + kd * vn.z; n.w = eg * s[r].w + kd * vn.w;
    *(float4*)(S1 + dk * 128 + dv4 * 4) = n;
    po.x += n.x * qd; po.y += n.y * qd; po.z += n.z * qd; po.w += n.w * qd; }
  *(float4*)(PART + dkq * 128 + dv4 * 4) = po;
  __syncthreads();
  float o = 0.f;
  if (tid < 128) {
#pragma unroll
    for (int q = 0; q < 16; ++q) o += PART[q * 128 + tid];
    const float ss = wave_sum(o * o);
    if (lane == 0) RED[8 + wave] = ss;
  }
  __syncthreads();
  if (tid < 128) {
    const float rinv = rsqrtf((RED[8] + RED[9]) * (1.f / 128.f) + 1e-6f);
    const float zb = bf2f(proj[row * 6144 + 5120 + h * 128 + tid]);
    ((bf16_t*)(p->ws + WS_YBUF))[row * 2048 + 1024 + h * 128 + tid] = f2bf(o * rinv * p->in[I_GNW][j * 128 + tid] * siluf_(zb));
  }
}

DEVI void phase_mixprep(KP p, int layer, unsigned char* lds, int ph) {
  const int j = layer >> 1;
  unsigned* ctr = (unsigned*)(p->ws + WS_CTL) + ph;
  int* slot = (int*)(lds + LDS_MISC);
  for (;;) {
    __syncthreads();
    if (tidx_() == 0) *slot = (int)atomicAdd(ctr, 1u);
    __syncthreads();
    const int it = *slot;
    if (it >= 3216) break;
#ifndef SUBMASK
#define SUBMASK 7
#endif
    if (it < 144) { if (SUBMASK & 1) lru_item(p, j, it, lds); }
    else if (it < 2192) { if (SUBMASK & 2) gdn_prep_item(p, j, it - 144, lds); }
    else { if (SUBMASK & 4) gdn_decode_item(p, j, it - 2192, lds); }
  }
}

struct GdnFrags { u32x4 wf[4], qf[4], qkf[2], ktf[2][2]; u32x2 uf; float egl; };
DEVI void gdn_load(GdnFrags& f, KP p, int cid, int s, int rt, int ct, int l15, int lq) {
  const bf16_t* wb = (const bf16_t*)(p->ws + WS_WB) + (size_t)cid * 8192;
  const bf16_t* qt = (const bf16_t*)(p->ws + WS_QT) + (size_t)cid * 8192;
  const bf16_t* kt = (const bf16_t*)(p->ws + WS_KT) + (size_t)cid * 8192;
  const bf16_t* qk = (const bf16_t*)(p->ws + WS_QK) + (size_t)cid * 4096;
  const bf16_t* ut = (const bf16_t*)(p->ws + WS_UT) + (size_t)cid * 8192;
#pragma unroll
  for (int kk = 0; kk < 4; ++kk) { f.wf[kk] = *(const u32x4*)(wb + (rt * 16 + l15) * 128 + lq * 8 + kk * 32); f.qf[kk] = *(const u32x4*)(qt + (rt * 16 + l15) * 128 + lq * 8 + kk * 32); }
#pragma unroll
  for (int kk = 0; kk < 2; ++kk) { f.qkf[kk] = *(const u32x4*)(qk + (rt * 16 + l15) * 64 + lq * 8 + kk * 32);
#pragma unroll
    for (int d2 = 0; d2 < 2; ++d2) f.ktf[d2][kk] = *(const u32x4*)(kt + ((rt * 2 + d2) * 16 + l15) * 64 + lq * 8 + kk * 32); }
  f.uf = *(const u32x2*)(ut + (s * 32 + ct * 16 + l15) * 64 + rt * 16 + lq * 4);
  f.egl = ((const float*)(p->ws + WS_EGL))[cid];
}
DEVI void phase_gdnseq(KP p, int layer, unsigned char* lds) {
  const int tid = tidx_(), lane = tid & 63, wave = tid >> 6;
  const int j = layer >> 1, rt = wave >> 1, ct = wave & 1, l15 = lane & 15, lq = lane >> 4;
  bf16_t* ST = (bf16_t*)lds;
  bf16_t* VT = (bf16_t*)(lds + 8704);
  bf16_t* ybuf = (bf16_t*)(p->ws + WS_YBUF);
  for (int item = bidx_(); item < 256; item += gdim_()) {
    const int bh = item >> 2, s = item & 3, b = bh >> 3, h = bh & 7;
    __syncthreads();
    for (int e = tid; e < 32 * 136 / 2; e += 512) ((unsigned*)ST)[e] = 0u;
    f32x4 sacc[2]; sacc[0] = (f32x4){0.f, 0.f, 0.f, 0.f}; sacc[1] = (f32x4){0.f, 0.f, 0.f, 0.f};
    GdnFrags nx; gdn_load(nx, p, bh * 32, s, rt, ct, l15, lq);
    __syncthreads();
    for (int c = 0; c < 32; ++c) {
      const GdnFrags cu = nx;
      if (c + 1 < 32) gdn_load(nx, p, bh * 32 + c + 1, s, rt, ct, l15, lq);
      f32x4 wsa = (f32x4){0.f, 0.f, 0.f, 0.f}, oa = (f32x4){0.f, 0.f, 0.f, 0.f};
#pragma unroll
      for (int kk = 0; kk < 4; ++kk) { const bf16x8 sb = *(const bf16x8*)(ST + (ct * 16 + l15) * 136 + lq * 8 + kk * 32);
        wsa = mfma16(as_bf16x8(cu.wf[kk]), sb, wsa); oa = mfma16(as_bf16x8(cu.qf[kk]), sb, oa); }
      { const float u0 = bflo(cu.uf.x), u1 = bfhi(cu.uf.x), u2 = bflo(cu.uf.y), u3 = bfhi(cu.uf.y);
        u32x2 w; w.x = cvt_pk_bf16(u0 - wsa[0], u1 - wsa[1]); w.y = cvt_pk_bf16(u2 - wsa[2], u3 - wsa[3]);
        *(u32x2*)(VT + (ct * 16 + l15) * 72 + rt * 16 + lq * 4) = w; }
      __syncthreads();
      bf16x8 vb[2];
#pragma unroll
      for (int kk = 0; kk < 2; ++kk) vb[kk] = *(const bf16x8*)(VT + (ct * 16 + l15) * 72 + lq * 8 + kk * 32);
#pragma unroll
      for (int kk = 0; kk < 2; ++kk) oa = mfma16(as_bf16x8(cu.qkf[kk]), vb[kk], oa);
#pragma unroll
      for (int d2 = 0; d2 < 2; ++d2) { sacc[d2] = sacc[d2] * cu.egl;
#pragma unroll
        for (int kk = 0; kk < 2; ++kk) sacc[d2] = mfma16(as_bf16x8(cu.ktf[d2][kk]), vb[kk], sacc[d2]); }
      { const size_t row = (size_t)(b * 2048 + c * 64 + rt * 16 + lq * 4);
        bf16_t* yo = ybuf + row * 2048 + 1024 + h * 128 + s * 32 + ct * 16 + l15;
#pragma unroll
        for (int r = 0; r < 4; ++r) yo[(size_t)r * 2048] = f2bf(oa[r]); }
#pragma unroll
      for (int d2 = 0; d2 < 2; ++d2) { u32x2 w; w.x = cvt_pk_bf16(sacc[d2][0], sacc[d2][1]); w.y = cvt_pk_bf16(sacc[d2][2], sacc[d2][3]);
        *(u32x2*)(ST + (ct * 16 + l15) * 136 + (rt * 2 + d2) * 16 + lq * 4) = w; }
      __syncthreads();
    }
    float* pd = p->out + O_PDEL + (size_t)((j * 8 + b) * 8 + h) * 16384;
#pragma unroll
    for (int d2 = 0; d2 < 2; ++d2)
#pragma unroll
      for (int r = 0; r < 4; ++r) pd[(size_t)((rt * 2 + d2) * 16 + lq * 4 + r) * 128 + s * 32 + ct * 16 + l15] = sacc[d2][r];
  }
}

DEVI void phase_onorm(KP p, int layer) {
  const int tid = tidx_(), lane = tid & 63, wave = tid >> 6, j = layer >> 1;
  bf16_t* ybuf = (bf16_t*)(p->ws + WS_YBUF); const bf16_t* proj = (const bf16_t*)(p->ws + WS_PROJ);
  float gw[16];
#pragma unroll
  for (int e = 0; e < 16; ++e) gw[e] = p->in[I_GNW][j * 128 + ((lane * 16 + e) & 127)];
  for (int r = bidx_() * 8 + wave; r < NPR; r += gdim_() * 8) {
    bf16_t* yp = ybuf + (size_t)r * 2048 + 1024 + lane * 16; const bf16_t* zp = proj + (size_t)r * 6144 + 5120 + lane * 16;
    float o[16], z[16]; { float t[8]; unpack8(*(const u32x4*)yp, t);
#pragma unroll
      for (int e = 0; e < 8; ++e) o[e] = t[e];
      unpack8(*(const u32x4*)(yp + 8), t);
#pragma unroll
      for (int e = 0; e < 8; ++e) o[8 + e] = t[e];
      unpack8(*(const u32x4*)zp, t);
#pragma unroll
      for (int e = 0; e < 8; ++e) z[e] = t[e];
      unpack8(*(const u32x4*)(zp + 8), t);
#pragma unroll
      for (int e = 0; e < 8; ++e) z[8 + e] = t[e]; }
    float ss = 0.f;
#pragma unroll
    for (int e = 0; e < 16; ++e) ss += o[e] * o[e];
    ss += __shfl_xor(ss, 1); ss += __shfl_xor(ss, 2); ss += __shfl_xor(ss, 4);
    const float rinv = rsqrtf(ss * (1.f / 128.f) + 1e-6f);
    float a[8], c[8];
#pragma unroll
    for (int e = 0; e < 8; ++e) { a[e] = o[e] * rinv * gw[e] * siluf_(z[e]); c[e] = o[8 + e] * rinv * gw[8 + e] * siluf_(z[8 + e]); }
    *(u32x4*)yp = pack8(a); *(u32x4*)(yp + 8) = pack8(c);
  }
}

DEVI void phase_s5(KP p, int layer, unsigned char* lds) {
  const int tid = tidx_(), lane = tid & 63, wave = tid >> 6, jc = layer >> 1, l15 = lane & 15, lq = lane >> 4;
  float* BU = (float*)(lds + wave * 12800);
  bf16_t* XB = (bf16_t*)(lds + wave * 12800 + 8448);
  const bf16_t* proj = (const bf16_t*)(p->ws + WS_PROJ);
  bf16_t* y1 = (bf16_t*)(p->ws + WS_YBUF);
  for (int q = wave * gdim_() + bidx_(); q < 1024; q += 8 * gdim_()) {
    const bool prompt = q < 512;
    const int g = q & 63, bq = (q & 511) >> 6;
    const int gi = jc * 64 + g;
    const float dt = __expf(p->in[I_LOGDT][gi]);
    float abr, abi;
    { const float are = p->in[I_ARE][gi * 64 + lane], aim = p->in[I_AIM][gi * 64 + lane]; const float mag = __expf(are * dt); float sn, cs; sn = __sinf(aim * dt); cs = __cosf(aim * dt); abr = mag * cs; abi = mag * sn; }
    bf16x8 Bf[8], Cf[4];
#pragma unroll
    for (int nt = 0; nt < 8; ++nt) {
      float v[8];
#pragma unroll
      for (int e = 0; e < 8; ++e) v[e] = 0.f;
      if (lq < 2) {
        const int pp = (nt & 3) * 16 + l15;
        const float are = p->in[I_ARE][gi * 64 + pp], aim = p->in[I_AIM][gi * 64 + pp]; const float mag = __expf(are * dt); float sn, cs; sn = __sinf(aim * dt); cs = __cosf(aim * dt);
        const float nr = mag * cs - 1.f, ni = mag * sn, den = 1.f / (are * are + aim * aim);
        const float cr = (nr * are + ni * aim) * den, ci = (ni * are - nr * aim) * den;
        const float* br = p->in[I_BRE] + (size_t)(gi * 64 + pp) * 16 + lq * 8; const float* bi = p->in[I_BIM] + (size_t)(gi * 64 + pp) * 16 + lq * 8;
#pragma unroll
        for (int e = 0; e < 8; ++e) v[e] = (nt >= 4) ? (cr * bi[e] + ci * br[e]) : (cr * br[e] - ci * bi[e]);
      }
      Bf[nt] = as_bf16x8(pack8(v));
    }
#pragma unroll
    for (int kk = 0; kk < 4; ++kk) { const int comp0 = lq * 8 + kk * 32; const bool im = comp0 >= 64; const int pc = comp0 & 63;
      const float* src = (im ? p->in[I_CIM] : p->in[I_CRE]) + (size_t)(gi * 16 + l15) * 64 + pc; float v[8];
#pragma unroll
      for (int e = 0; e < 8; ++e) v[e] = im ? -src[e] : src[e];
      Cf[kk] = as_bf16x8(pack8(v)); }
    const float dch = p->in[I_S5D][jc * 1024 + g * 16 + l15];
    float xr = 0.f, xi = 0.f;
    const int nch = prompt ? 128 : 1;
    const size_t rbase = prompt ? (size_t)bq * 2048 : (size_t)(NPR + bq * 16);
    u32x4 unx = (u32x4){0u, 0u, 0u, 0u}; bf16_t uenx[4];
    if (lq < 2) unx = *(const u32x4*)(proj + (rbase + l15) * 2048 + g * 16 + lq * 8);
#pragma unroll
    for (int r = 0; r < 4; ++r) uenx[r] = proj[(rbase + lq * 4 + r) * 2048 + g * 16 + l15];
    for (int ck = 0; ck < nch; ++ck) {
      const size_t row0 = rbase + (size_t)ck * 16;
      const u32x4 ucur = unx; bf16_t uec[4];
#pragma unroll
      for (int r = 0; r < 4; ++r) uec[r] = uenx[r];
      if (ck + 1 < nch) { if (lq < 2) unx = *(const u32x4*)(proj + (row0 + 16 + l15) * 2048 + g * 16 + lq * 8);
#pragma unroll
        for (int r = 0; r < 4; ++r) uenx[r] = proj[(row0 + 16 + lq * 4 + r) * 2048 + g * 16 + l15]; }
#pragma unroll
      for (int nt = 0; nt < 8; ++nt) { const f32x4 acc = mfma16(as_bf16x8(ucur), Bf[nt], (f32x4){0.f, 0.f, 0.f, 0.f});
#pragma unroll
        for (int r = 0; r < 4; ++r) BU[(lq * 4 + r) * 132 + nt * 16 + l15] = acc[r]; }
      asm volatile("s_waitcnt lgkmcnt(0)" ::: "memory");
      if (prompt) {
#pragma unroll 4
        for (int t = 0; t < 16; ++t) { const float br = BU[t * 132 + lane], bi = BU[t * 132 + 64 + lane];
          const float nr = abr * xr - abi * xi + br, ni = abr * xi + abi * xr + bi; xr = nr; xi = ni;
          XB[t * 136 + lane] = f2bf(xr); XB[t * 136 + 64 + lane] = f2bf(xi); }
      } else {
#pragma unroll 2
        for (int t = 0; t < 16; ++t) { const float br = BU[t * 132 + lane], bi = BU[t * 132 + 64 + lane];
          const size_t si = ((size_t)(jc * 128 + bq * 16 + t) * 64 + g) * 64 + lane;
          const float x0r = p->in[I_SSR][si], x0i = p->in[I_SSI][si];
          const float nr = abr * x0r - abi * x0i + br, ni = abr * x0i + abi * x0r + bi;
          p->out[O_SSR + si] = nr; p->out[O_SSI + si] = ni;
          XB[t * 136 + lane] = f2bf(nr); XB[t * 136 + 64 + lane] = f2bf(ni); }
      }
      asm volatile("s_waitcnt lgkmcnt(0)" ::: "memory");
      f32x4 ya = (f32x4){0.f, 0.f, 0.f, 0.f};
#pragma unroll
      for (int kk = 0; kk < 4; ++kk) ya = mfma16(*(const bf16x8*)(XB + l15 * 136 + lq * 8 + kk * 32), Cf[kk], ya);
#pragma unroll
      for (int r = 0; r < 4; ++r) { const float y = ya[r] + dch * bf2f(uec[r]); y1[(row0 + lq * 4 + r) * 1024 + g * 16 + l15] = f2bf(geluf_(y)); }
    }
    if (prompt) { const size_t si = ((size_t)(jc * 8 + bq) * 64 + g) * 64 + lane; p->out[O_PSR + si] = xr; p->out[O_PSI + si] = xi; }
  }
}

DEVI void phase_final(KP p) {
  const int tid = tidx_(), lane = tid & 63, wave = tid >> 6;
  const float* nw = p->in[I_FNW];
  for (int r = bidx_() * 8 + wave; r < NRV; r += gdim_() * 8) {
    float* xr = p->out + (size_t)r * 1024; float4 v[4]; float ss = 0.f;
#pragma unroll
    for (int i = 0; i < 4; ++i) { v[i] = *(const float4*)(xr + i * 256 + lane * 4); ss += v[i].x * v[i].x + v[i].y * v[i].y + v[i].z * v[i].z + v[i].w * v[i].w; }
    ss = wave_sum(ss);
    const float rinv = rsqrtf(ss * (1.f / 1024.f) + 1e-6f);
#pragma unroll
    for (int i = 0; i < 4; ++i) { const float4 w4 = *(const float4*)(nw + i * 256 + lane * 4); float4 o; o.x = v[i].x * rinv * w4.x; o.y = v[i].y * rinv * w4.y; o.z = v[i].z * rinv * w4.z; o.w = v[i].w * rinv * w4.w;
      *(float4*)(xr + i * 256 + lane * 4) = o; }
  }
}

constexpr int N_PHASES = 25;
#ifndef ONLY_KIND
#define ONLY_KIND -1
#endif
#define KON(k) ((ONLY_KIND < 0 || ONLY_KIND == (k)) && kind == (k))
__global__ void __launch_bounds__(512, 2) mega(Params p_unused) {
  extern __shared__ __attribute__((aligned(16))) unsigned char shm[];
  cg::grid_group grid = cg::this_grid();
  PG8_LAS unsigned char* ldsg = (PG8_LAS unsigned char*)shm;
  KP p0 = (KP)__builtin_amdgcn_kernarg_segment_ptr();
  const int ph_lo = p0->ph_lo, ph_hi = p0->ph_hi;
  for (int ph = ph_lo; ph < ph_hi; ++ph) {
    KP p = p0; asm volatile("" : "+s"(p));
    int kind, layer = 0;
    if (ph == 0) kind = 0; else if (ph == 1) kind = 1; else if (ph == 24) kind = 12;
    else { const int q = ph - 2, pair = q / 11, rem = q % 11;
      if (rem < 6) { layer = 2 * pair; kind = (rem == 0) ? 2 : 2 + rem; }
      else { layer = 2 * pair + 1; const int s = rem - 6; kind = (s == 0) ? 2 : 7 + s; } }
    const int j = layer >> 1;
    if (KON(0)) phase_prep(p, (float*)shm);
    else if (KON(2)) phase_norm(p, layer, (float*)shm);
    else if (KON(4)) phase_mixprep(p, layer, shm, ph);
    else if (KON(5)) phase_gdnseq(p, layer, shm);
    else if (KON(6)) phase_onorm(p, layer);
    else if (KON(9)) phase_s5(p, layer, shm);
    else if (KON(12)) phase_final(p);
    else if (KON(1)) {
      pg8::Gemm g{(const bf16_t*)(p->ws + WS_SILUC), (const bf16_t*)(p->ws + WS_WT_MOD), 256, 12288, 1024};
      pg8::StaticOrder S; S.init(256, 12288, gdim_(), bidx_());
      pg8::EpiF32 E{(float*)(p->ws + WS_MOD), 12288, p->in[I_MODB]};
      pg8::gemm_phase<pg8::EpiF32, pg8::StaticOrder, false>(ldsg, g, S, E, nullptr);
    } else if (KON(3) || KON(8)) {
      const bool ab = kind == 3; const int N = ab ? 6144 : 2048;
      pg8::Gemm g{(const bf16_t*)(p->ws + WS_YBUF), ab ? (const bf16_t*)(p->ws + WS_WT_INAB) + (size_t)j * 6144 * 1024 : (const bf16_t*)(p->ws + WS_WT_CIN) + (size_t)j * 2048 * 1024, NRP, N, 1024};
      pg8::StaticOrder S; S.init(NRP, N, gdim_(), bidx_());
      pg8::EpiBf16<0> E{(bf16_t*)(p->ws + WS_PROJ), N, nullptr, 0, 0};
      pg8::gemm_phase<pg8::EpiBf16<0>, pg8::StaticOrder, false>(ldsg, g, S, E, nullptr);
    } else if (KON(7) || KON(11)) {
      const bool ab = kind == 7; const int K = ab ? 2048 : 1024;
      pg8::Gemm g{ab ? (const bf16_t*)(p->ws + WS_YBUF) : (const bf16_t*)(p->ws + WS_Y2), ab ? (const bf16_t*)(p->ws + WS_WT_OUTAB) + (size_t)j * 1024 * 2048 : (const bf16_t*)(p->ws + WS_WT_COUT) + (size_t)j * 1024 * 1024, NRP, 1024, K};
      pg8::StaticOrder S; S.init(NRP, 1024, gdim_(), bidx_());
      EpiRes E{layer == 0 ? p->in[I_XP] : p->out, layer == 0 ? p->in[I_XS] : p->out + (size_t)NPR * 1024, p->out, (const float*)(p->ws + WS_MOD) + layer * 3072 + 2048};
      pg8::gemm_phase<EpiRes, pg8::StaticOrder, false>(ldsg, g, S, E, nullptr);
    } else if (KON(10)) {
      pg8::Gemm g{(const bf16_t*)(p->ws + WS_YBUF), (const bf16_t*)(p->ws + WS_WT_GLU) + (size_t)j * 1024 * 1024, NRP, 1024, 1024};
      pg8::StaticOrder S; S.init(NRP, 1024, gdim_(), bidx_());
      EpiGlu E{(const bf16_t*)(p->ws + WS_YBUF), (const bf16_t*)(p->ws + WS_PROJ) + 1024, (bf16_t*)(p->ws + WS_Y2), p->in[I_GLUB] + j * 1024};
      pg8::gemm_phase<EpiGlu, pg8::StaticOrder, false>(ldsg, g, S, E, nullptr);
    }
    if (ph + 1 < ph_hi) grid.sync();
  }
}

#ifndef MK_MULTI
#define MK_MULTI 0
#endif
#ifndef PH_HI
#define PH_HI N_PHASES
#endif
extern "C" void kernel_launch(void* const* d_in, const int* in_sizes, int n_in, void* d_out, int out_size, void* d_ws, size_t ws_size, hipStream_t stream) {
  static int grid = 0;
  if (grid == 0) {
    if (n_in != N_IN || (size_t)out_size != O_END || ws_size < WS_END) { fprintf(stderr, "kernel_launch: unexpected shapes: n_in %d out %d ws %zu (need %zu)\n", n_in, out_size, ws_size, (size_t)WS_END); grid = -1; return; }
    int dev = 0, cus = 0, per_cu = 0;
    if (hipGetDevice(&dev) != hipSuccess || hipDeviceGetAttribute(&cus, hipDeviceAttributeMultiprocessorCount, dev) != hipSuccess) { grid = -1; return; }
    if (hipFuncSetAttribute((const void*)mega, hipFuncAttributeMaxDynamicSharedMemorySize, LDS_BYTES) != hipSuccess) { fprintf(stderr, "kernel_launch: hipFuncSetAttribute failed\n"); grid = -1; return; }
    if (hipOccupancyMaxActiveBlocksPerMultiprocessor(&per_cu, (const void*)mega, 512, LDS_BYTES) != hipSuccess || per_cu < 1) { fprintf(stderr, "kernel_launch: occupancy query says %d\n", per_cu); per_cu = 1; }
    (void)hipGetLastError();
    grid = cus;
  }
  if (grid < 0) return;
  if (hipMemsetAsync((char*)d_ws + WS_CTL, 0, 4096, stream) != hipSuccess) { fprintf(stderr, "kernel_launch: memset failed\n"); return; }
  Params p{};
  for (int i = 0; i < N_IN; ++i) p.in[i] = (const float*)d_in[i];
  p.out = (float*)d_out; p.ws = (unsigned char*)d_ws;
#if MK_MULTI
  for (int ph = 0; ph < N_PHASES; ++ph) { p.ph_lo = ph; p.ph_hi = ph + 1; hipLaunchKernelGGL(mega, dim3(grid), dim3(512), LDS_BYTES, stream, p); }
#else
  p.ph_lo = 0; p.ph_hi = PH_HI;
  void* args[] = {&p};
  hipError_t e = hipLaunchCooperativeKernel((void*)mega, dim3(grid), dim3(512), args, LDS_BYTES, stream);
  if (e != hipSuccess) fprintf(stderr, "kernel_launch: cooperative launch failed: %s (grid %d)\n", hipGetErrorString(e), grid);
#endif
}
```

```cpp
#include <hip/hip_runtime.h>
#include <hip/hip_cooperative_groups.h>
#include <cstdio>
namespace cg = cooperative_groups;
__device__ __forceinline__ int tidx_() { int t = threadIdx.x; asm volatile("" : "+v"(t)); return t; }
__device__ __forceinline__ int bidx_() { int t = blockIdx.x; asm volatile("" : "+s"(t)); return t; }
__device__ __forceinline__ int gdim_() { int t = gridDim.x; asm volatile("" : "+s"(t)); return t; }
namespace pg8 {
#define PG8_LAS __attribute__((address_space(3)))
typedef unsigned short bf16_t;
typedef short bf16x8 __attribute__((ext_vector_type(8)));
typedef float f32x4 __attribute__((ext_vector_type(4)));
typedef unsigned u32x4 __attribute__((ext_vector_type(4)));
constexpr int BM = 256, BK = 64, HALF = 128, HTB = HALF * BK * 2  , STAGE_BYTES = 8 * HTB, NXCD = 8, WGM = 8;

__host__ __device__ __forceinline__ int lds_byte(int r, int c) { const int st = (r >> 4) * 2 + (c >> 5), rr = r & 15, cc = c & 31, ob = rr * 64 + cc * 2; return st * 1024 + (ob ^ (((ob >> 9) & 1) << 5)); }
__host__ __device__ __forceinline__ void stage_rc(int b, int& R, int& C) { const int st = b / 1024, sb = b % 1024, swz = sb ^ (((sb >> 9) & 1) << 5); R = (st >> 1) * 16 + swz / 64; C = (st & 1) * 32 + (swz % 64) / 2; }
__host__ __device__ __forceinline__ int perm32(int rho) { const int n = rho >> 4, i = rho & 15; return 8 * (i >> 2) + 4 * n + (i & 3); }

struct Unit { int pm, pn; };
struct Gemm { const bf16_t* A; const bf16_t* Bt; int M, N, K; };

struct StaticOrder {
    int nM, nN, nwg, G, c;
    __host__ __device__ void init(int M, int N, int G_, int c_) { nM = M / BM; nN = N / BM; nwg = nM * nN; G = G_; c = c_; }
    __host__ __device__ bool next(int i, Unit& u) const {
        const long L = (long)i * G + c; if (L >= nwg) return false;
        int wgid = (int)L; { const int q = nwg / NXCD, r = nwg % NXCD, xcd = wgid % NXCD, off = wgid / NXCD; wgid = (xcd < r ? xcd * (q + 1) : r * (q + 1) + (xcd - r) * q) + off; }
        const int nig = WGM * nN, gid = wgid / nig, fm = gid * WGM, gsz = (nM - fm) < WGM ? (nM - fm) : WGM;
        u.pm = fm + ((wgid % nig) % gsz); u.pn = (wgid % nig) / gsz; return true;
    }
    __device__ __forceinline__ void a_ready(const Unit&) const {}
    __device__ __forceinline__ void done(const Unit&) const {}
};
typedef float f32x2cv __attribute__((ext_vector_type(2)));
typedef __bf16 bf16x2cv __attribute__((ext_vector_type(2)));
__device__ __forceinline__ unsigned cvt_pk_bf16(float lo, float hi) { f32x2cv v = {lo, hi}; bf16x2cv b = __builtin_convertvector(v, bf16x2cv); return __builtin_bit_cast(unsigned, b); }
typedef float f32x2 __attribute__((ext_vector_type(2)));
__device__ __forceinline__ f32x2 gelu_pk(f32x2 v) {
    const f32x2 av = __builtin_elementwise_abs(v), d = av * 0.2316418882f + 1.0f;
    f32x2 t; t.x = __builtin_amdgcn_rcpf(d.x); t.y = __builtin_amdgcn_rcpf(d.y);
    f32x2 q = t * 0.5307027145f + (-0.7265760135f); q = q * t + 0.7107068705f; q = q * t + (-0.142248368f); q = q * t + 0.127414796f; q = q * t;
    const f32x2 s = (v * v) * (-0.72134752044f);
    f32x2 e; e.x = __builtin_amdgcn_exp2f(s.x); e.y = __builtin_amdgcn_exp2f(s.y);
    const f32x2 m = v * (q * e), r = v - m;
    f32x2 o; o.x = v.x < 0.f ? m.x : r.x; o.y = v.y < 0.f ? m.y : r.y; return o;
}

struct EpiF32 {
    static constexpr bool PERM = false, AFTER_DRAIN = false;
    float* C; int ldc; const float* bias;
    __device__ __forceinline__ void operator()(const f32x4 (&acc)[2][2][4][2], const Unit& u, int wr, int wc, int fr, int fq) const {
        const int row0 = u.pm * BM + wr * 64 + fr, col0 = u.pn * BM + wc * 32 + 4 * fq;
        f32x4 bv[2][2];
#pragma unroll
        for (int bj = 0; bj < 2; ++bj)
#pragma unroll
            for (int n = 0; n < 2; ++n) bv[bj][n] = bias ? *(const f32x4*)(bias + col0 + bj * HALF + n * 16) : (f32x4){0.f, 0.f, 0.f, 0.f};
#pragma unroll
        for (int ai = 0; ai < 2; ++ai)
#pragma unroll
            for (int m = 0; m < 4; ++m) { float* rowp = C + (size_t)(row0 + ai * HALF + m * 16) * ldc + col0;
#pragma unroll
                for (int bj = 0; bj < 2; ++bj)
#pragma unroll
                    for (int n = 0; n < 2; ++n) *(f32x4*)(rowp + bj * HALF + n * 16) = acc[ai][bj][m][n] + bv[bj][n]; }
    }
};
template <int ACT  > struct EpiBf16 {
    static constexpr bool PERM = true, AFTER_DRAIN = false;
    bf16_t* O; int ldc; const float* bias; int split_cols; size_t split_stride;
    __device__ __forceinline__ void operator()(const f32x4 (&acc)[2][2][4][2], const Unit& u, int wr, int wc, int fr, int fq) const {
        const int row0 = u.pm * BM + wr * 64 + fr; int colt = u.pn * BM; bf16_t* base = O;
        if (split_cols) { const int t = colt / split_cols; base += (size_t)t * split_stride; colt -= t * split_cols; }
        const int col0 = colt + wc * 32 + 8 * fq, bcol0 = u.pn * BM + wc * 32 + 8 * fq;
        f32x4 bv[2][2];
#pragma unroll
        for (int bj = 0; bj < 2; ++bj)
#pragma unroll
            for (int n = 0; n < 2; ++n) bv[bj][n] = bias ? *(const f32x4*)(bias + bcol0 + bj * HALF + 4 * n) : (f32x4){0.f, 0.f, 0.f, 0.f};
#pragma unroll
        for (int ai = 0; ai < 2; ++ai)
#pragma unroll
            for (int m = 0; m < 4; ++m) { bf16_t* rowp = base + (size_t)(row0 + ai * HALF + m * 16) * ldc + col0;
#pragma unroll
                for (int bj = 0; bj < 2; ++bj) { f32x4 v0 = acc[ai][bj][m][0] + bv[bj][0], v1 = acc[ai][bj][m][1] + bv[bj][1];
                    if (ACT == 1) { f32x2 a = gelu_pk((f32x2){v0[0], v0[1]}), b = gelu_pk((f32x2){v0[2], v0[3]}), c = gelu_pk((f32x2){v1[0], v1[1]}), d = gelu_pk((f32x2){v1[2], v1[3]});
                        v0 = (f32x4){a.x, a.y, b.x, b.y}; v1 = (f32x4){c.x, c.y, d.x, d.y}; }
                    if (ACT == 2) {
#pragma unroll
                        for (int j = 0; j < 4; ++j) { v0[j] = 0.5f * v0[j] * (1.0f + erff(v0[j] * 0.70710678f)); v1[j] = 0.5f * v1[j] * (1.0f + erff(v1[j] * 0.70710678f)); } }
                    u32x4 w; w.x = cvt_pk_bf16(v0[0], v0[1]); w.y = cvt_pk_bf16(v0[2], v0[3]); w.z = cvt_pk_bf16(v1[0], v1[1]); w.w = cvt_pk_bf16(v1[2], v1[3]);
                    *(u32x4*)(rowp + bj * HALF) = w; } }
    }
};
template <class Epi, class Sched, bool STAMP = false>
__device__ __forceinline__ void gemm_phase(PG8_LAS unsigned char* lds, const Gemm g, const Sched& S, const Epi& E, unsigned long long* stamps) {
    const int tid = tidx_(), wid = __builtin_amdgcn_readfirstlane(tid >> 6), lane = tid & 63, wr = wid >> 2, wc = wid & 3, fr = lane & 15, fq = lane >> 4;
    const int K = g.K, nt = K / BK;
    int ts_lo = 0, ts_hi = 0, nts = 0; const unsigned long long rt_entry = STAMP ? (unsigned long long)wall_clock64() : 0ull;
#define PG8_STAMP() do { if (STAMP && wid == 0 && nts < 64) { const unsigned long long _c = (unsigned long long)clock64(); \
        ts_lo = (lane == nts) ? (int)(unsigned)_c : ts_lo; ts_hi = (lane == nts) ? (int)(unsigned)(_c >> 32) : ts_hi; ++nts; } } while (0)
    PG8_STAMP();
    unsigned voffA[2], voffB[2];
#pragma unroll
    for (int i = 0; i < 2; ++i) { int R, C; stage_rc(tid * 16 + i * 8192, R, C); const int Rb = Epi::PERM ? ((R & ~31) + perm32(R & 31)) : R;
        voffA[i] = (unsigned)(R * K + C) * 2u; voffB[i] = (unsigned)(Rb * K + C) * 2u; }
    const size_t kstep = (size_t)(BK * 2);
    const size_t hstep = (size_t)HALF * K * 2;
    const size_t tstep = 2 * hstep;
    const unsigned ldsw = (unsigned)wid * 1024u;
    const int aoff = lds_byte(wr * 64 + fr, fq * 8), boff = lds_byte(wc * 32 + fr, fq * 8);
#define PG8_SA(b, h) (((b) * 2 + (h)) * HTB)
#define PG8_SB(b, h) ((4 + (b) * 2 + (h)) * HTB)
#define PG8_STAGE(bufoff, gbase, voff) do { _Pragma("unroll") for (int _i = 0; _i < 2; ++_i) \
        __builtin_amdgcn_global_load_lds((const unsigned*)((const char*)(gbase) + (voff)[_i]), (PG8_LAS unsigned*)(lds + (bufoff) + ldsw + _i * 8192), 16, 0, 0); } while (0)
#define PG8_LDA(dst, b, h) do { _Pragma("unroll") for (int m = 0; m < 4; ++m) _Pragma("unroll") for (int k = 0; k < 2; ++k) dst[m][k] = *(const PG8_LAS bf16x8*)(lds + PG8_SA(b, h) + aoff + m * 2048 + k * 1024); } while (0)
#define PG8_LDB(dst, b, h) do { _Pragma("unroll") for (int n = 0; n < 2; ++n) _Pragma("unroll") for (int k = 0; k < 2; ++k) dst[n][k] = *(const PG8_LAS bf16x8*)(lds + PG8_SB(b, h) + boff + n * 2048 + k * 1024); } while (0)
#define PG8_MMA(ai, bj, At, Bt) do { __builtin_amdgcn_s_setprio(1); _Pragma("unroll") for (int m = 0; m < 4; ++m) _Pragma("unroll") for (int n = 0; n < 2; ++n) _Pragma("unroll") for (int k = 0; k < 2; ++k) \
        acc[ai][bj][m][n] = __builtin_amdgcn_mfma_f32_16x16x32_bf16(Bt[n][k], At[m][k], acc[ai][bj][m][n], 0, 0, 0); __builtin_amdgcn_s_setprio(0); } while (0)
#define PG8_WAIT_V(n) asm volatile("s_waitcnt vmcnt(" #n ")" ::: "memory")
#define PG8_WAIT_L(n) asm volatile("s_waitcnt lgkmcnt(" #n ")" ::: "memory")
#define PG8_BAR __builtin_amdgcn_s_barrier()
#define PG8_SCHED __builtin_amdgcn_sched_barrier(0)
    Unit cur, nxt; int ui = 0;
    if (!S.next(0, cur)) return;
    f32x4 acc[2][2][4][2];
#pragma unroll
    for (int a = 0; a < 2; ++a)
#pragma unroll
        for (int b = 0; b < 2; ++b)
#pragma unroll
            for (int m = 0; m < 4; ++m)
#pragma unroll
                for (int n = 0; n < 2; ++n) acc[a][b][m][n] = (f32x4){0.f, 0.f, 0.f, 0.f};
    bf16x8 At[4][2], B0[2][2], B1[2][2];
    const char* cA = (const char*)g.A + (size_t)cur.pm * tstep; const char* cB = (const char*)g.Bt + (size_t)cur.pn * tstep;
    S.a_ready(cur);
    PG8_STAGE(PG8_SB(0, 0), cB, voffB); PG8_STAGE(PG8_SA(0, 0), cA, voffA); PG8_STAGE(PG8_SB(0, 1), cB + hstep, voffB); PG8_STAGE(PG8_SA(0, 1), cA + hstep, voffA);
    if (wr == 1) PG8_BAR;
    PG8_WAIT_V(4); PG8_BAR;
    PG8_STAGE(PG8_SB(1, 0), cB + kstep, voffB); PG8_STAGE(PG8_SA(1, 0), cA + kstep, voffA); PG8_STAGE(PG8_SB(1, 1), cB + hstep + kstep, voffB);
    PG8_WAIT_V(6); PG8_BAR;
    PG8_STAMP();
    for (;;) {
        const bool has_next = S.next(ui + 1, nxt);
        const char* nA = has_next ? (const char*)g.A + (size_t)nxt.pm * tstep : cA; const char* nB = has_next ? (const char*)g.Bt + (size_t)nxt.pn * tstep : cB;
        for (int t = 0; t < nt; t += 2) {
            const bool last = (t == nt - 2);
            const char* a1 = cA + (size_t)(t + 1) * kstep;
            const char* a2 = last ? nA : cA + (size_t)(t + 2) * kstep; const char* b2 = last ? nB : cB + (size_t)(t + 2) * kstep;
            const char* a3 = a2 + kstep; const char* b3 = b2 + kstep;
            if (last && has_next) S.a_ready(nxt);
            PG8_LDB(B0, 0, 0); PG8_SCHED; PG8_LDA(At, 0, 0); PG8_STAGE(PG8_SA(1, 1), a1 + hstep, voffA);
            PG8_WAIT_L(8); PG8_BAR; PG8_WAIT_L(0); PG8_MMA(0, 0, At, B0); PG8_BAR; PG8_SCHED;
            PG8_LDB(B1, 0, 1); PG8_STAGE(PG8_SB(0, 0), b2, voffB);
            PG8_BAR; PG8_WAIT_L(0); PG8_MMA(0, 1, At, B1); PG8_BAR;
            PG8_LDA(At, 0, 1); PG8_STAGE(PG8_SA(0, 0), a2, voffA);
            PG8_BAR; PG8_WAIT_L(0); PG8_MMA(1, 0, At, B0); PG8_BAR; PG8_SCHED;
            PG8_STAGE(PG8_SB(0, 1), b2 + hstep, voffB);
            PG8_WAIT_V(6); PG8_BAR; PG8_MMA(1, 1, At, B1); PG8_BAR;
            PG8_LDB(B0, 1, 0); PG8_SCHED; PG8_LDA(At, 1, 0); PG8_STAGE(PG8_SA(0, 1), a2 + hstep, voffA);
            PG8_WAIT_L(8); PG8_BAR; PG8_WAIT_L(0); PG8_MMA(0, 0, At, B0); PG8_BAR; PG8_SCHED;
            PG8_LDB(B1, 1, 1); PG8_STAGE(PG8_SB(1, 0), b3, voffB);
            PG8_BAR; PG8_WAIT_L(0); PG8_MMA(0, 1, At, B1); PG8_BAR;
            PG8_LDA(At, 1, 1); PG8_STAGE(PG8_SA(1, 0), a3, voffA);
            PG8_BAR; PG8_WAIT_L(0); PG8_MMA(1, 0, At, B0); PG8_BAR; PG8_SCHED;
            PG8_STAGE(PG8_SB(1, 1), b3 + hstep, voffB);
            PG8_WAIT_V(6); PG8_BAR; PG8_MMA(1, 1, At, B1); PG8_BAR;
        }
        PG8_STAMP();
        if constexpr (!Epi::AFTER_DRAIN) { E(acc, cur, wr, wc, fr, fq); S.done(cur); }
        PG8_STAMP();
        if (!has_next) break;
#pragma unroll
        for (int a = 0; a < 2; ++a)
#pragma unroll
            for (int b = 0; b < 2; ++b)
#pragma unroll
                for (int m = 0; m < 4; ++m)
#pragma unroll
                    for (int n = 0; n < 2; ++n) acc[a][b][m][n] = (f32x4){0.f, 0.f, 0.f, 0.f};
        cur = nxt; cA = nA; cB = nB; ++ui;
    }
    PG8_WAIT_V(0);
    if (wr == 0) PG8_BAR;
    PG8_BAR;
    if constexpr (Epi::AFTER_DRAIN) { E.fused(acc, cur, wr, wc, fr, fq, lds, wid, lane); S.done(cur); }
    PG8_STAMP();
    if (STAMP && wid == 0) { stamps[lane] = lane < nts ? (((unsigned long long)(unsigned)ts_hi << 32) | (unsigned)ts_lo) : 0ull;
        if (lane == 62) stamps[62] = rt_entry; if (lane == 63) stamps[63] = (unsigned long long)wall_clock64(); }
#undef PG8_STAMP
#undef PG8_SA
#undef PG8_SB
#undef PG8_STAGE
#undef PG8_LDA
#undef PG8_LDB
#undef PG8_MMA
#undef PG8_WAIT_V
#undef PG8_WAIT_L
#undef PG8_BAR
#undef PG8_SCHED
}
}
#define LAS __attribute__((address_space(3)))
#define XB_TMO      128
#define XB_XCNT(j)  (256  + 64 * (j))
#define XB_XSUB(j)  (1280 + 64 * (j))
#define XB_XGEN(j)  (2304 + 64 * (j))
#define XB_TOP      3328
#define XB_TOPGEN   3392
#define XCD_BAR_WORDS 3456
#define XB_SPIN_CAP (1u << 18)

__device__ __forceinline__ unsigned xb_ld(unsigned* p)              { return __hip_atomic_load(p, __ATOMIC_RELAXED, __HIP_MEMORY_SCOPE_AGENT); }
__device__ __forceinline__ unsigned xb_add(unsigned* p, unsigned v) { return __hip_atomic_fetch_add(p, v, __ATOMIC_RELAXED, __HIP_MEMORY_SCOPE_AGENT); }
__device__ __forceinline__ unsigned xb_xcc_id() { return (unsigned)__builtin_amdgcn_s_getreg((3 << 11) | 20) & 0xFu; }
#define XB_SPIN(cond, bar) do { unsigned _sp = 0; while (cond) { __builtin_amdgcn_s_sleep(1); \
    if ((++_sp & 255u) == 0u) { if (xb_ld(&(bar)[XB_TMO])) break; if (_sp > XB_SPIN_CAP) { atomicAdd(&(bar)[XB_TMO], 1u); break; } } } } while (0)

struct XcdBarrier {
    unsigned* bar; unsigned x;
    volatile LAS unsigned* st;
};

__device__ __forceinline__ XcdBarrier xcd_barrier_post(unsigned* bar, volatile LAS unsigned* st) {
    XcdBarrier b; b.bar = bar; b.x = xb_xcc_id(); b.st = st;
    if (threadIdx.x == 0) (void)xb_add(&bar[XB_XCNT(b.x)], 1u);
    return b;
}
__device__ __forceinline__ void xcd_barrier_complete(unsigned* bar, unsigned x, unsigned& nloc, unsigned& nx) {
    const unsigned G = gridDim.x * gridDim.y * gridDim.z;
    unsigned sum, cnt, mine, sp = 0u;
    for (;;) {
        sum = 0u; cnt = 0u; mine = 0u;
#pragma unroll
        for (unsigned j = 0; j < 16; ++j) { const unsigned c = xb_ld(&bar[XB_XCNT(j)]); sum += c; cnt += (c > 0u) ? 1u : 0u; mine = (j == x) ? c : mine; }
        if (sum == G) break;
        __builtin_amdgcn_s_sleep(1);
        if ((++sp & 255u) == 0u) { if (xb_ld(&bar[XB_TMO])) break; if (sp > XB_SPIN_CAP) { atomicAdd(&bar[XB_TMO], 1u); break; } }
    }
    nloc = mine > 0u ? mine : 1u; nx = cnt > 0u ? cnt : 1u;
}

__device__ __forceinline__ void xcd_barrier(const XcdBarrier& b) {
    asm volatile("s_waitcnt vmcnt(0)" ::: "memory");
    __syncthreads();
    if (threadIdx.x == 0) {
        unsigned* bar = b.bar;
        __builtin_amdgcn_s_waitcnt(0);
        unsigned nloc = b.st[0], nx = b.st[1];
        if (nloc == 0u) { xcd_barrier_complete(bar, b.x, nloc, nx); b.st[0] = nloc; b.st[1] = nx; }
        const unsigned old = xb_add(&bar[XB_XSUB(b.x)], 1u);
        const unsigned gen = old / nloc;
        if (old + 1u == (gen + 1u) * nloc) {
            __builtin_amdgcn_fence(__ATOMIC_RELEASE, "agent");
            asm volatile("s_waitcnt vmcnt(0)" ::: "memory");
            __builtin_amdgcn_s_sleep(127); __builtin_amdgcn_s_sleep(127);
            const unsigned og = xb_add(&bar[XB_TOP], 1u);
            const unsigned tg = og / nx;
            if (og + 1u == (tg + 1u) * nx) xb_add(&bar[XB_TOPGEN], 1u);
            else XB_SPIN(xb_ld(&bar[XB_TOPGEN]) == tg, bar);
            __builtin_amdgcn_fence(__ATOMIC_ACQUIRE, "agent");
            xb_add(&bar[XB_XGEN(b.x)], 1u);
            asm volatile("s_waitcnt vmcnt(0)" ::: "memory");
        } else {
            XB_SPIN(xb_ld(&bar[XB_XGEN(b.x)]) == gen, bar);
            __builtin_amdgcn_fence(__ATOMIC_ACQUIRE, "agent");
            asm volatile("s_waitcnt vmcnt(0)" ::: "memory");
        }
    }
    __syncthreads();
}


using pg8::bf16_t; using pg8::bf16x8; using pg8::f32x4; using pg8::u32x4; using pg8::cvt_pk_bf16;
typedef unsigned u32x2 __attribute__((ext_vector_type(2)));
#define DEVI __device__ __forceinline__

constexpr int NPR = 16384, NRV = 16512, NRP = 16640;
constexpr int LDS_BYTES = 135168;
constexpr int LDS_MISC = 131072;

constexpr size_t WS_CTL = 0;
constexpr size_t WS_WT_MOD = 32768;
constexpr size_t WS_WT_INAB = WS_WT_MOD + 25165824;
constexpr size_t WS_WT_OUTAB = WS_WT_INAB + 25165824;
constexpr size_t WS_WT_CIN = WS_WT_OUTAB + 8388608;
constexpr size_t WS_WT_GLU = WS_WT_CIN + 8388608;
constexpr size_t WS_WT_COUT = WS_WT_GLU + 4194304;
constexpr size_t WS_WT_LRU = WS_WT_COUT + 4194304;
constexpr size_t WS_SILUC = WS_WT_LRU + 1048576;
constexpr size_t WS_MOD = WS_SILUC + 524288;
constexpr size_t WS_TAIL = WS_MOD + 12582912;
constexpr size_t WS_YBUF = WS_TAIL + 1064960;
constexpr size_t WS_PROJ = WS_YBUF + 68157440;
constexpr size_t WS_UT = WS_PROJ + 204472320;
constexpr size_t WS_WB = WS_UT + 33554432;
constexpr size_t WS_QT = WS_WB + 33554432;
constexpr size_t WS_KT = WS_QT + 33554432;
constexpr size_t WS_EGL = WS_KT + 33554432;
constexpr size_t WS_WT_TAIL = WS_EGL + 8192;
constexpr size_t WS_END = WS_WT_TAIL + 65536;
constexpr size_t WS_QK = WS_WT_MOD;
constexpr size_t WS_Y2 = WS_YBUF + 34078720;

constexpr size_t O_YP = 0, O_YS = 16777216, O_PCA = O_YS + 131072, O_PLRU = O_PCA + 49152, O_PCB = O_PLRU + 16384, O_PDEL = O_PCB + 147456,
                 O_PSR = O_PDEL + 2097152, O_PSI = O_PSR + 65536, O_SCA = O_PSI + 65536, O_SLRU = O_SCA + 786432, O_SCB = O_SLRU + 262144,
                 O_SDEL = O_SCB + 2359296, O_SSR = O_SDEL + 33554432, O_SSI = O_SSR + 1048576, O_END = O_SSI + 1048576;

enum { I_XP = 0, I_XS, I_CP, I_CS, I_SCA, I_SLRU, I_SCB, I_SDEL, I_SSR, I_SSI, I_NORMW, I_MODW, I_MODB, I_ABIN, I_ABOUT, I_CAW, I_CAB, I_GXW, I_GXB, I_GAW, I_GAB, I_APAR,
       I_CBW, I_ALOG, I_DTB, I_GNW, I_CIN, I_COUT, I_ARE, I_AIM, I_BRE, I_BIM, I_CRE, I_CIM, I_S5D, I_LOGDT, I_GLUW, I_GLUB, I_FNW, N_IN };

struct Params {
  const float* in[N_IN];
  float* out;
  unsigned char* ws;
  int ph_lo, ph_hi;
};

typedef const Params __attribute__((address_space(4)))* KP;
DEVI float bf2f(unsigned v16) { return __uint_as_float(v16 << 16); }
DEVI float bflo(unsigned w) { return __uint_as_float(w << 16); }
DEVI float bfhi(unsigned w) { return __uint_as_float(w & 0xffff0000u); }
DEVI bf16_t f2bf(float f) { return (bf16_t)(cvt_pk_bf16(f, 0.f) & 0xffffu); }
DEVI float fexp_(float x) { return __builtin_amdgcn_exp2f(x * 1.4426950408889634f); }
DEVI float sigmoidf_(float x) { return __builtin_amdgcn_rcpf(1.f + fexp_(-x)); }
DEVI float siluf_(float x) { return x * __builtin_amdgcn_rcpf(1.f + fexp_(-x)); }
DEVI float softplusf_(float x) { return x > 20.f ? x : log1pf(__expf(x)); }
DEVI float geluf_(float x) { const float z = 0.7978845608028654f * (x + 0.044715f * x * x * x); const float e = fexp_(2.f * z); return x - x * __builtin_amdgcn_rcpf(1.f + e); }
DEVI void lds_barrier() { asm volatile("s_waitcnt lgkmcnt(0)" ::: "memory"); __builtin_amdgcn_s_barrier(); asm volatile("" ::: "memory"); }
DEVI float wave_sum(float v) {
#pragma unroll
  for (int o = 32; o >= 1; o >>= 1) v += __shfl_xor(v, o);
  return v;
}
DEVI void unpack8(const u32x4 w, float (&f)[8]) { f[0] = bflo(w.x); f[1] = bfhi(w.x); f[2] = bflo(w.y); f[3] = bfhi(w.y); f[4] = bflo(w.z); f[5] = bfhi(w.z); f[6] = bflo(w.w); f[7] = bfhi(w.w); }
DEVI u32x4 pack8(const float (&f)[8]) { u32x4 w; w.x = cvt_pk_bf16(f[0], f[1]); w.y = cvt_pk_bf16(f[2], f[3]); w.z = cvt_pk_bf16(f[4], f[5]); w.w = cvt_pk_bf16(f[6], f[7]); return w; }
DEVI bf16x8 as_bf16x8(const u32x4 w) { union { u32x4 u; bf16x8 b; } c; c.u = w; return c.b; }
DEVI f32x4 mfma16(bf16x8 a, bf16x8 b, f32x4 c) { return __builtin_amdgcn_mfma_f32_16x16x32_bf16(a, b, c, 0, 0, 0); }

struct EpiRes {
  static constexpr bool PERM = false, AFTER_DRAIN = false;
  const float* xp; const float* xs; float* xo; const float* gate;
  __device__ __forceinline__ void operator()(const f32x4 (&acc)[2][2][4][2], const pg8::Unit& u, int wr, int wc, int fr, int fq) const {
    const int row0 = u.pm * 256 + wr * 64 + fr, col0 = u.pn * 256 + wc * 32 + 4 * fq;
#pragma unroll
    for (int ai = 0; ai < 2; ++ai)
#pragma unroll
      for (int m = 0; m < 4; ++m) {
        const int row = row0 + ai * 128 + m * 16;
        if (row < NRV) {
          const float* xi = (row < NPR ? xp + (size_t)row * 1024 : xs + (size_t)(row - NPR) * 1024) + col0;
          const int mrow = row < NPR ? (row >> 11) : 8 + (row - NPR);
          const float* gp = gate + (size_t)mrow * 12288 + col0;
          float* op = xo + (size_t)row * 1024 + col0;
#pragma unroll
          for (int bj = 0; bj < 2; ++bj)
#pragma unroll
            for (int n = 0; n < 2; ++n) {
              const f32x4 xv = *(const f32x4*)(xi + bj * 128 + n * 16), gv = *(const f32x4*)(gp + bj * 128 + n * 16);
              *(f32x4*)(op + bj * 128 + n * 16) = xv + gv * acc[ai][bj][m][n];
            }
        }
      }
  }
};
struct EpiGlu {
  static constexpr bool PERM = true, AFTER_DRAIN = false;
  const bf16_t* y1; const bf16_t* z; bf16_t* y2; const float* bias;
  __device__ __forceinline__ void operator()(const f32x4 (&acc)[2][2][4][2], const pg8::Unit& u, int wr, int wc, int fr, int fq) const {
    const int row0 = u.pm * 256 + wr * 64 + fr, col0 = u.pn * 256 + wc * 32 + 8 * fq;
#pragma unroll
    for (int ai = 0; ai < 2; ++ai)
#pragma unroll
      for (int m = 0; m < 4; ++m) {
        const int row = row0 + ai * 128 + m * 16;
#pragma unroll
        for (int bj = 0; bj < 2; ++bj) {
          const int col = col0 + bj * 128;
          const f32x4 b0 = *(const f32x4*)(bias + col), b1 = *(const f32x4*)(bias + col + 4);
          const u32x4 yw = *(const u32x4*)(y1 + (size_t)row * 1024 + col), zw = *(const u32x4*)(z + (size_t)row * 2048 + col);
          float yf[8], zf[8], o[8]; unpack8(yw, yf); unpack8(zw, zf);
          const f32x4 a0 = acc[ai][bj][m][0] + b0, a1 = acc[ai][bj][m][1] + b1;
#pragma unroll
          for (int e = 0; e < 4; ++e) { o[e] = yf[e] * sigmoidf_(a0[e]) * siluf_(zf[e]); o[4 + e] = yf[4 + e] * sigmoidf_(a1[e]) * siluf_(zf[4 + e]); }
          *(u32x4*)(y2 + (size_t)row * 1024 + col) = pack8(o);
        }
      }
  }
};

struct TileDesc { const float* src; bf16_t* dst; int ldsrc, lddst, k0, n0; };
DEVI TileDesc prep_tile(KP p, int t) {
  TileDesc d; int tt = t;
  if (tt < 3072) { const int mat = tt / 768, r = tt % 768; d.k0 = (r / 48) * 64; d.n0 = (r % 48) * 64; d.src = p->in[I_MODW] + (size_t)mat * 1024 * 3072; d.ldsrc = 3072; d.dst = (bf16_t*)(p->ws + WS_WT_MOD) + (size_t)mat * 3072 * 1024; d.lddst = 1024; }
  else if ((tt -= 3072) < 3072) { const int mat = tt / 1536, r = tt % 1536; d.k0 = (r / 96) * 64; d.n0 = (r % 96) * 64; d.src = p->in[I_ABIN] + (size_t)mat * 1024 * 6160; d.ldsrc = 6160; d.dst = (bf16_t*)(p->ws + WS_WT_INAB) + (size_t)mat * 6144 * 1024; d.lddst = 1024; }
  else if ((tt -= 3072) < 1024) { const int mat = tt / 512, r = tt % 512; d.k0 = (r / 16) * 64; d.n0 = (r % 16) * 64; d.src = p->in[I_ABOUT] + (size_t)mat * 2048 * 1024; d.ldsrc = 1024; d.dst = (bf16_t*)(p->ws + WS_WT_OUTAB) + (size_t)mat * 1024 * 2048; d.lddst = 2048; }
  else if ((tt -= 1024) < 1024) { const int mat = tt / 512, r = tt % 512; d.k0 = (r / 32) * 64; d.n0 = (r % 32) * 64; d.src = p->in[I_CIN] + (size_t)mat * 1024 * 2048; d.ldsrc = 2048; d.dst = (bf16_t*)(p->ws + WS_WT_CIN) + (size_t)mat * 2048 * 1024; d.lddst = 1024; }
  else if ((tt -= 1024) < 512) { const int mat = tt / 256, r = tt % 256; d.k0 = (r / 16) * 64; d.n0 = (r % 16) * 64; d.src = p->in[I_COUT] + (size_t)mat * 1024 * 1024; d.ldsrc = 1024; d.dst = (bf16_t*)(p->ws + WS_WT_COUT) + (size_t)mat * 1024 * 1024; d.lddst = 1024; }
  else if ((tt -= 512) < 512) { const int mat = tt / 256, r = tt % 256; d.k0 = (r / 16) * 64; d.n0 = (r % 16) * 64; d.src = p->in[I_GLUW] + (size_t)mat * 1024 * 1024; d.ldsrc = 1024; d.dst = (bf16_t*)(p->ws + WS_WT_GLU) + (size_t)mat * 1024 * 1024; d.lddst = 1024; }
  else { tt -= 512; const int gate = tt / 64; const int r2 = tt % 64; const int mat = r2 / 4, r = r2 % 4;
    d.k0 = (r / 2) * 64; d.n0 = (r % 2) * 64; d.src = p->in[gate ? I_GAW : I_GXW] + (size_t)mat * 16384; d.ldsrc = 128;
    d.dst = (bf16_t*)(p->ws + WS_WT_LRU) + (size_t)(((mat >> 3) * 2 + gate) * 8 + (mat & 7)) * 16384; d.lddst = 128; }
  return d;
}
DEVI void phase_prep(KP p, float* lds) {
  const int tid = tidx_(), tx = tid & 15, ty = tid >> 4, nn = tid >> 3, ks = (tid & 7) * 8;
  for (int t0 = bidx_(); t0 < 9344; t0 += 4 * gdim_()) {
    float4 v[4][2];
#pragma unroll
    for (int q = 0; q < 4; ++q) { const int t = t0 + q * gdim_();
      if (t < 9344) { const TileDesc d = prep_tile(p, t);
#pragma unroll
        for (int pp = 0; pp < 2; ++pp) v[q][pp] = *(const float4*)(d.src + (size_t)(d.k0 + ty + pp * 32) * d.ldsrc + d.n0 + tx * 4); } }
#pragma unroll
    for (int q = 0; q < 4; ++q) { float* tile = lds + q * 4160;
#pragma unroll
      for (int pp = 0; pp < 2; ++pp) { const int k = ty + pp * 32; tile[k * 65 + tx * 4 + 0] = v[q][pp].x; tile[k * 65 + tx * 4 + 1] = v[q][pp].y; tile[k * 65 + tx * 4 + 2] = v[q][pp].z; tile[k * 65 + tx * 4 + 3] = v[q][pp].w; } }
    __syncthreads();
#pragma unroll
    for (int q = 0; q < 4; ++q) { const int t = t0 + q * gdim_();
      if (t < 9344) { const TileDesc d = prep_tile(p, t); const float* tile = lds + q * 4160; float f[8];
#pragma unroll
        for (int jx = 0; jx < 8; ++jx) f[jx] = tile[(ks + jx) * 65 + nn];
        *(u32x4*)(d.dst + (size_t)(d.n0 + nn) * d.lddst + d.k0 + ks) = pack8(f); } }
    __syncthreads();
  }
  { bf16_t* wtt = (bf16_t*)(p->ws + WS_WT_TAIL);
    for (int e = bidx_() * 512 + tidx_(); e < 32768; e += gdim_() * 512) { const int jj = e >> 14, cc = (e >> 10) & 15, k = e & 1023;
      wtt[e] = f2bf(p->in[I_ABIN][(size_t)jj * 1024 * 6160 + (size_t)k * 6160 + 6144 + cc]); } }
  bf16_t* sc = (bf16_t*)(p->ws + WS_SILUC);
  for (int e = bidx_() * 512 + tidx_(); e < 256 * 1024 / 4; e += gdim_() * 512) {
    const int row = e >> 8, c4 = (e & 255) * 4; float4 v = make_float4(0.f, 0.f, 0.f, 0.f);
    if (row < 8) v = *(const float4*)(p->in[I_CP] + row * 1024 + c4); else if (row < 136) v = *(const float4*)(p->in[I_CS] + (row - 8) * 1024 + c4);
    u32x2 w; w.x = cvt_pk_bf16(row < 136 ? siluf_(v.x) : 0.f, row < 136 ? siluf_(v.y) : 0.f); w.y = cvt_pk_bf16(row < 136 ? siluf_(v.z) : 0.f, row < 136 ? siluf_(v.w) : 0.f);
    *(u32x2*)(sc + row * 1024 + c4) = w;
  }
}

DEVI void norm_row2(const float* x0, const float* x1, bool two, const float (&wm)[16], const float (&sh)[16], bf16_t* h0, bf16_t* h1, int lane) {
  float4 v0[4], v1[4]; float s0 = 0.f, s1 = 0.f;
#pragma unroll
  for (int i = 0; i < 4; ++i) { v0[i] = *(const float4*)(x0 + i * 256 + lane * 4); v1[i] = two ? *(const float4*)(x1 + i * 256 + lane * 4) : make_float4(0.f, 0.f, 0.f, 0.f); }
#pragma unroll
  for (int i = 0; i < 4; ++i) { s0 += v0[i].x * v0[i].x + v0[i].y * v0[i].y + v0[i].z * v0[i].z + v0[i].w * v0[i].w; s1 += v1[i].x * v1[i].x + v1[i].y * v1[i].y + v1[i].z * v1[i].z + v1[i].w * v1[i].w; }
#pragma unroll
  for (int o = 32; o >= 1; o >>= 1) { s0 += __shfl_xor(s0, o); s1 += __shfl_xor(s1, o); }
  const float r0 = __builtin_amdgcn_rsqf(s0 * (1.f / 1024.f) + 1e-6f), r1 = __builtin_amdgcn_rsqf(s1 * (1.f / 1024.f) + 1e-6f);
#pragma unroll
  for (int i = 0; i < 4; ++i) { const int k = i * 256 + lane * 4;
    u32x2 w; w.x = cvt_pk_bf16(v0[i].x * r0 * wm[i * 4 + 0] + sh[i * 4 + 0], v0[i].y * r0 * wm[i * 4 + 1] + sh[i * 4 + 1]); w.y = cvt_pk_bf16(v0[i].z * r0 * wm[i * 4 + 2] + sh[i * 4 + 2], v0[i].w * r0 * wm[i * 4 + 3] + sh[i * 4 + 3]);
    *(u32x2*)(h0 + k) = w;
    if (two) { u32x2 w2; w2.x = cvt_pk_bf16(v1[i].x * r1 * wm[i * 4 + 0] + sh[i * 4 + 0], v1[i].y * r1 * wm[i * 4 + 1] + sh[i * 4 + 1]); w2.y = cvt_pk_bf16(v1[i].z * r1 * wm[i * 4 + 2] + sh[i * 4 + 2], v1[i].w * r1 * wm[i * 4 + 3] + sh[i * 4 + 3]);
      *(u32x2*)(h1 + k) = w2; } }
}
DEVI void norm_coefs(KP p, int layer, int mrow, int lane, float (&wm)[16], float (&sh)[16]) {
  const float* nw = p->in[I_NORMW] + layer * 1024;
  const float* md = (const float*)(p->ws + WS_MOD) + (size_t)mrow * 12288 + layer * 3072;
#pragma unroll
  for (int i = 0; i < 4; ++i) { const int k = i * 256 + lane * 4; const float4 w4 = *(const float4*)(nw + k), s4 = *(const float4*)(md + k), c4 = *(const float4*)(md + 1024 + k);
    wm[i * 4 + 0] = w4.x * (1.f + c4.x); wm[i * 4 + 1] = w4.y * (1.f + c4.y); wm[i * 4 + 2] = w4.z * (1.f + c4.z); wm[i * 4 + 3] = w4.w * (1.f + c4.w);
    sh[i * 4 + 0] = s4.x; sh[i * 4 + 1] = s4.y; sh[i * 4 + 2] = s4.z; sh[i * 4 + 3] = s4.w; }
}
DEVI void phase_norm(KP p, int layer, float* lds) {
  const int tid = tidx_(), lane = tid & 63, wave = tid >> 6;
  bf16_t* hb = (bf16_t*)(p->ws + WS_YBUF);
  float wm[16], sh[16];
  for (int gw = bidx_() * 8 + wave; gw < 2048; gw += gdim_() * 8) {
    const int r0 = gw * 8;
    norm_coefs(p, layer, r0 >> 11, lane, wm, sh);
    const float* xb = (layer == 0) ? p->in[I_XP] : p->out;
#pragma unroll 1
    for (int i = 0; i < 8; i += 2) norm_row2(xb + (size_t)(r0 + i) * 1024, xb + (size_t)(r0 + i + 1) * 1024, true, wm, sh, hb + (size_t)(r0 + i) * 1024, hb + (size_t)(r0 + i + 1) * 1024, lane);
    if (gw < 128) {
      norm_coefs(p, layer, 8 + gw, lane, wm, sh);
      const float* xs = (layer == 0) ? p->in[I_XS] + (size_t)gw * 1024 : p->out + (size_t)(NPR + gw) * 1024;
      norm_row2(xs, xs, false, wm, sh, hb + (size_t)(NPR + gw) * 1024, hb, lane);
    }
  }
}
DEVI void tail_gemm(KP p, int j) {
  const int tid = tidx_(), lane = tid & 63, wave = tid >> 6, l15 = lane & 15, lq = lane >> 4;
  const bf16_t* hb = (const bf16_t*)(p->ws + WS_YBUF);
  const bf16_t* bp = (const bf16_t*)(p->ws + WS_WT_TAIL) + (size_t)j * 16384 + l15 * 1024 + lq * 8;
  float* tl = (float*)(p->ws + WS_TAIL);
  for (int t = bidx_() * 8 + wave; t < 1032; t += gdim_() * 8) {
    const bf16_t* ap = hb + (size_t)(t * 16 + l15) * 1024 + lq * 8;
    f32x4 acc0 = (f32x4){0.f, 0.f, 0.f, 0.f}, acc1 = (f32x4){0.f, 0.f, 0.f, 0.f};
#pragma unroll 1
    for (int k0 = 0; k0 < 1024; k0 += 256) {
      u32x4 a[8], b[8];
#pragma unroll
      for (int u = 0; u < 8; ++u) { a[u] = *(const u32x4*)(ap + k0 + u * 32); b[u] = *(const u32x4*)(bp + k0 + u * 32); }
#pragma unroll
      for (int u = 0; u < 8; u += 2) { acc0 = mfma16(as_bf16x8(a[u]), as_bf16x8(b[u]), acc0); acc1 = mfma16(as_bf16x8(a[u + 1]), as_bf16x8(b[u + 1]), acc1); }
    }
    acc0 = acc0 + acc1;
#pragma unroll
    for (int r = 0; r < 4; ++r) tl[(size_t)(t * 16 + lq * 4 + r) * 16 + l15] = acc0[r];
  }
}

DEVI void lru_item(KP p, int j, int item, unsigned char* lds) {
  const int tid = tidx_(), lane = tid & 63, wave = tid >> 6;
  const bool prompt = item < 128;
  const int b = prompt ? (item >> 4) : 0, hd = prompt ? ((item >> 1) & 7) : ((item - 128) >> 1), half = item & 1;
  bf16_t* WX = (bf16_t*)lds;
  bf16_t* XA = (bf16_t*)(lds + 34816);
  float* AA = (float*)(lds + 52224);
  float* BB = (float*)(lds + 69632);
  bf16_t* RAW = (bf16_t*)(lds + 87040);
  float* CAR = (float*)(lds + 105472);
  const bf16_t* proj = (const bf16_t*)(p->ws + WS_PROJ);
  bf16_t* ybuf = (bf16_t*)(p->ws + WS_YBUF);
  { const bf16_t* wt = (const bf16_t*)(p->ws + WS_WT_LRU);
#pragma unroll
    for (int q = 0; q < 4; ++q) { const int e = tid + q * 512, gate = e >> 10, o = (e & 1023) >> 4, c8 = e & 15;
      *(u32x4*)(WX + (gate * 64 + o) * 136 + c8 * 8) = *(const u32x4*)(wt + ((size_t)((j * 2 + gate) * 8 + hd) * 128 + half * 64 + o) * 128 + c8 * 8); } }
  const int ch8 = tid & 15, rsub = tid >> 4, chb = hd * 128 + ch8 * 8;
  float cw[4][8], cb[8];
#pragma unroll
  for (int t = 0; t < 4; ++t)
#pragma unroll
    for (int e = 0; e < 8; ++e) cw[t][e] = p->in[I_CAW][(size_t)(j * 4 + t) * 1024 + chb + e];
#pragma unroll
  for (int e = 0; e < 8; ++e) cb[e] = p->in[I_CAB][j * 1024 + chb + e];
  const int rt = wave >> 1, chh = wave & 1, l15 = lane & 15, lq = lane >> 4;
  float gxb[2], gab[2], spv[2];
#pragma unroll
  for (int c2 = 0; c2 < 2; ++c2) { const int gch = hd * 128 + half * 64 + chh * 32 + c2 * 16 + l15;
    gxb[c2] = p->in[I_GXB][j * 1024 + gch]; gab[c2] = p->in[I_GAB][j * 1024 + gch]; spv[c2] = softplusf_(-p->in[I_APAR][j * 1024 + gch]); }
  const int sch = hd * 128 + half * 64 + lane;
  float hcar = 0.f;
  const int ntiles = prompt ? 32 : 2;
  u32x4 pre[3];
  if (prompt) {
#pragma unroll
    for (int q = 0; q < 3; ++q) { const int e = tid + q * 512, row = e >> 4, c8 = e & 15, t = row - 3; pre[q] = (u32x4){0u, 0u, 0u, 0u};
      if (e < 1072 && t >= 0) pre[q] = *(const u32x4*)(proj + (size_t)(b * 2048 + t) * 6144 + hd * 128 + c8 * 8); }
  }
  for (int tile = 0; tile < ntiles; ++tile) {
    bf16_t zav[8];
#pragma unroll
    for (int i = 0; i < 8; ++i) { const size_t grow = prompt ? (size_t)(b * 2048 + tile * 64 + wave * 8 + i) : (size_t)(NPR + tile * 64 + wave * 8 + i); zav[i] = proj[grow * 6144 + 1024 + sch]; }
    if (prompt) {
#pragma unroll
      for (int q = 0; q < 3; ++q) { const int e = tid + q * 512; if (e < 1072) *(u32x4*)(RAW + (e >> 4) * 136 + (e & 15) * 8) = pre[q]; }
      if (tile + 1 < ntiles) {
#pragma unroll
        for (int q = 0; q < 3; ++q) { const int e = tid + q * 512, row = e >> 4, c8 = e & 15, t = (tile + 1) * 64 + row - 3;
          if (e < 1072) pre[q] = *(const u32x4*)(proj + (size_t)(b * 2048 + t) * 6144 + hd * 128 + c8 * 8); }
      }
      lds_barrier();
#pragma unroll
      for (int pp = 0; pp < 2; ++pp) {
        const int i = rsub + pp * 32; float acc[8];
#pragma unroll
        for (int e = 0; e < 8; ++e) acc[e] = cb[e];
#pragma unroll
        for (int tap = 0; tap < 4; ++tap) { float xf[8]; unpack8(*(const u32x4*)(RAW + (i + tap) * 136 + ch8 * 8), xf);
#pragma unroll
          for (int e = 0; e < 8; ++e) acc[e] += cw[tap][e] * xf[e]; }
        *(u32x4*)(XA + i * 136 + ch8 * 8) = pack8(acc);
      }
      if (tile == 31 && half == 0 && tid < 48) { const int r3 = tid >> 4, c8 = tid & 15; float xf[8]; unpack8(*(const u32x4*)(RAW + (64 + r3) * 136 + c8 * 8), xf);
        float* o = p->out + O_PCA + (size_t)((j * 8 + b) * 3 + r3) * 1024 + hd * 128 + c8 * 8;
        *(float4*)o = make_float4(xf[0], xf[1], xf[2], xf[3]); *(float4*)(o + 4) = make_float4(xf[4], xf[5], xf[6], xf[7]); }
    } else {
#pragma unroll
      for (int pp = 0; pp < 2; ++pp) {
        const int i = rsub + pp * 32; float acc[8], x3[8];
#pragma unroll
        for (int e = 0; e < 8; ++e) acc[e] = cb[e];
        const int brow = tile * 64 + i;
        const float* st = p->in[I_SCA] + (size_t)((j * 128 + brow) * 3) * 1024 + chb;
        float* so = p->out + O_SCA + (size_t)((j * 128 + brow) * 3) * 1024 + chb;
#pragma unroll
        for (int tap = 0; tap < 3; ++tap) { const float4 s0 = *(const float4*)(st + tap * 1024), s1 = *(const float4*)(st + tap * 1024 + 4);
          const float xf[8] = {s0.x, s0.y, s0.z, s0.w, s1.x, s1.y, s1.z, s1.w};
#pragma unroll
          for (int e = 0; e < 8; ++e) acc[e] += cw[tap][e] * xf[e];
          if (tap >= 1 && half == 0) { *(float4*)(so + (tap - 1) * 1024) = s0; *(float4*)(so + (tap - 1) * 1024 + 4) = s1; } }
        const u32x4 w = *(const u32x4*)(proj + (size_t)(NPR + brow) * 6144 + chb); unpack8(w, x3);
#pragma unroll
        for (int e = 0; e < 8; ++e) acc[e] += cw[3][e] * x3[e];
        if (half == 0) { *(float4*)(so + 2 * 1024) = make_float4(x3[0], x3[1], x3[2], x3[3]); *(float4*)(so + 2 * 1024 + 4) = make_float4(x3[4], x3[5], x3[6], x3[7]); }
        *(u32x4*)(XA + i * 136 + ch8 * 8) = pack8(acc);
      }
    }
    lds_barrier();
    f32x4 accx[2], acca[2];
#pragma unroll
    for (int c2 = 0; c2 < 2; ++c2) { accx[c2] = (f32x4){0.f, 0.f, 0.f, 0.f}; acca[c2] = (f32x4){0.f, 0.f, 0.f, 0.f}; }
#pragma unroll
    for (int kk = 0; kk < 4; ++kk) {
      const bf16x8 a = *(const bf16x8*)(XA + (rt * 16 + l15) * 136 + lq * 8 + kk * 32);
#pragma unroll
      for (int c2 = 0; c2 < 2; ++c2) {
        const bf16x8 bx = *(const bf16x8*)(WX + (chh * 32 + c2 * 16 + l15) * 136 + lq * 8 + kk * 32);
        const bf16x8 ba = *(const bf16x8*)(WX + (64 + chh * 32 + c2 * 16 + l15) * 136 + lq * 8 + kk * 32);
        accx[c2] = mfma16(a, bx, accx[c2]); acca[c2] = mfma16(a, ba, acca[c2]);
      }
    }
#pragma unroll
    for (int c2 = 0; c2 < 2; ++c2)
#pragma unroll
      for (int r = 0; r < 4; ++r) {
        const int row = rt * 16 + lq * 4 + r, oc = chh * 32 + c2 * 16 + l15;
        const float gx = sigmoidf_(accx[c2][r] + gxb[c2]), ga = sigmoidf_(acca[c2][r] + gab[c2]);
        const float log_a = -8.f * ga * spv[c2];
        const float a = fexp_(log_a);
        float mult = __builtin_amdgcn_sqrtf(fmaxf(1.f - a * a, 0.f));
        if (prompt && tile == 0 && row == 0) mult = 1.f;
        const float xv = bf2f(XA[row * 136 + half * 64 + oc]);
        AA[row * 68 + oc] = a; BB[row * 68 + oc] = mult * gx * xv;
      }
    lds_barrier();
    float hl[8], pc[8];
    { float h = 0.f, P = 1.f;
#pragma unroll
      for (int i = 0; i < 8; ++i) { const float a = AA[(wave * 8 + i) * 68 + lane], bv = BB[(wave * 8 + i) * 68 + lane];
        if (prompt) { h = a * h + bv; P *= a; hl[i] = h; pc[i] = P; } else { hl[i] = bv; pc[i] = a; } }
      CAR[(wave * 64 + lane) * 2] = P; CAR[(wave * 64 + lane) * 2 + 1] = h; }
    lds_barrier();
    float cin = 0.f;
    if (prompt) { float c = hcar;
#pragma unroll
      for (int s = 0; s < 8; ++s) { const float Ps = CAR[(s * 64 + lane) * 2], Es = CAR[(s * 64 + lane) * 2 + 1]; if (s == wave) cin = c; c = Ps * c + Es; }
      hcar = c; }
#pragma unroll
    for (int i = 0; i < 8; ++i) {
      const int rowl = tile * 64 + wave * 8 + i;
      float hv;
      if (prompt) hv = hl[i] + pc[i] * cin;
      else { const float h0 = p->in[I_SLRU][(size_t)(j * 128 + rowl) * 1024 + sch]; hv = pc[i] * h0 + hl[i]; p->out[O_SLRU + (size_t)(j * 128 + rowl) * 1024 + sch] = hv; }
      const size_t grow = prompt ? (size_t)(b * 2048 + rowl) : (size_t)(NPR + rowl);
      ybuf[grow * 2048 + sch] = f2bf(hv * siluf_(bf2f(zav[i])));
    }
  }
  if (prompt && wave == 0) p->out[O_PLRU + (size_t)(j * 8 + b) * 1024 + sch] = hcar;
}

DEVI void gdn_prep_item(KP p, int j, int cid, unsigned char* lds) {
  const int tid = tidx_(), lane = tid & 63, wave = tid >> 6;
  const int b = cid >> 8, h = (cid >> 5) & 7, c = cid & 31;
  const int row0 = b * 2048 + c * 64;
  bf16_t* QN = (bf16_t*)lds; bf16_t* KN = (bf16_t*)(lds + 17408); bf16_t* VN = (bf16_t*)(lds + 34816);
  float* AM = (float*)(lds + 52224); float* GC = (float*)(lds + 69632); float* BETA = (float*)(lds + 69888); float* BEG = (float*)(lds + 70144);
  const bf16_t* proj = (const bf16_t*)(p->ws + WS_PROJ);
  const float* tl = (const float*)(p->ws + WS_TAIL);
  if (wave == 0) {
    const float* t = tl + (size_t)(row0 + lane) * 16;
    float g = -fexp_(p->in[I_ALOG][j * 8 + h]) * softplusf_(t[8 + h] + p->in[I_DTB][j * 8 + h]);
    const float beta = sigmoidf_(t[h]);
#pragma unroll
    for (int o = 1; o < 64; o <<= 1) { const float v = __shfl_up(g, o); if (lane >= o) g += v; }
    GC[lane] = g; BETA[lane] = beta; BEG[lane] = beta * fexp_(g);
  }
  bf16_t* RAWB = (bf16_t*)(lds + 70656);
  bf16_t* AMB = (bf16_t*)(lds + 70656);
  bf16_t* XT = (bf16_t*)(lds + 79872);
  float* CORR = (float*)lds;
  float* CW = (float*)(lds + 123184);
  {
    u32x4 rv[7];
#pragma unroll
    for (int q = 0; q < 7; ++q) { const int e = tid + 512 * q, row = e / 48, c16 = e - row * 48, tt = c * 64 + row - 3; rv[q] = (u32x4){0u, 0u, 0u, 0u};
      if (e < 3216 && tt >= 0) rv[q] = *(const u32x4*)(proj + (size_t)(b * 2048 + tt) * 6144 + 2048 + (c16 >> 4) * 1024 + h * 128 + (c16 & 15) * 8); }
    float4 wv = make_float4(0.f, 0.f, 0.f, 0.f);
    if (tid < 384) { const int tap = tid / 96, lc = (tid - tap * 96) * 4; wv = *(const float4*)(p->in[I_CBW] + (size_t)(j * 4 + tap) * 3072 + (lc >> 7) * 1024 + h * 128 + (lc & 127)); }
#pragma unroll
    for (int q = 0; q < 7; ++q) { const int e = tid + 512 * q, row = e / 48, c16 = e - row * 48; if (e < 3216) *(u32x4*)(RAWB + row * 392 + c16 * 8) = rv[q]; }
    if (tid < 384) { const int tap = tid / 96, lc = (tid - tap * 96) * 4; *(float4*)(CW + tap * 384 + lc) = wv; }
  }
  lds_barrier();
  if (c == 31 && tid < 144) { const int r3 = tid / 48, c16 = tid - r3 * 48; float xf[8]; unpack8(*(const u32x4*)(RAWB + (64 + r3) * 392 + c16 * 8), xf);
    float* o = p->out + O_PCB + (size_t)((j * 8 + b) * 3 + r3) * 3072 + (c16 >> 4) * 1024 + h * 128 + (c16 & 15) * 8;
    *(float4*)o = make_float4(xf[0], xf[1], xf[2], xf[3]); *(float4*)(o + 4) = make_float4(xf[4], xf[5], xf[6], xf[7]); }
#pragma unroll 2
  for (int pi = 0; pi < 6; ++pi) {
    const int pair = tid + 512 * pi, part = pair >> 10, rem = pair & 1023, i = rem >> 4, cgp = rem & 15;
    float acc[8];
#pragma unroll
    for (int e = 0; e < 8; ++e) acc[e] = 0.f;
#pragma unroll
    for (int tap = 0; tap < 4; ++tap) { float xf[8]; unpack8(*(const u32x4*)(RAWB + (i + tap) * 392 + part * 128 + cgp * 8), xf);
      const float4 w0 = *(const float4*)(CW + tap * 384 + part * 128 + cgp * 8), w1 = *(const float4*)(CW + tap * 384 + part * 128 + cgp * 8 + 4);
      acc[0] += w0.x * xf[0]; acc[1] += w0.y * xf[1]; acc[2] += w0.z * xf[2]; acc[3] += w0.w * xf[3];
      acc[4] += w1.x * xf[4]; acc[5] += w1.y * xf[5]; acc[6] += w1.z * xf[6]; acc[7] += w1.w * xf[7]; }
    float ss = 0.f;
#pragma unroll
    for (int e = 0; e < 8; ++e) { acc[e] = siluf_(acc[e]); ss += acc[e] * acc[e]; }
    ss += __shfl_xor(ss, 1); ss += __shfl_xor(ss, 2); ss += __shfl_xor(ss, 4); ss += __shfl_xor(ss, 8);
    float scl = 1.f;
    if (part == 0) scl = __builtin_amdgcn_rsqf(ss + 1e-6f) * 0.08838834764831845f; else if (part == 1) scl = __builtin_amdgcn_rsqf(ss + 1e-6f);
#pragma unroll
    for (int e = 0; e < 8; ++e) acc[e] *= scl;
    bf16_t* dstp = part == 0 ? QN : (part == 1 ? KN : VN);
    *(u32x4*)(dstp + i * 136 + cgp * 8) = pack8(acc);
  }
  lds_barrier();
  {
    const int rt = wave >> 1, ctp = (wave & 1) * 2, l15 = lane & 15, lq = lane >> 4;
    f32x4 kka[2], qka[2];
#pragma unroll
    for (int c2 = 0; c2 < 2; ++c2) { kka[c2] = (f32x4){0.f, 0.f, 0.f, 0.f}; qka[c2] = (f32x4){0.f, 0.f, 0.f, 0.f}; }
#pragma unroll
    for (int kk = 0; kk < 4; ++kk) {
      const bf16x8 ak = *(const bf16x8*)(KN + (rt * 16 + l15) * 136 + lq * 8 + kk * 32);
      const bf16x8 aq = *(const bf16x8*)(QN + (rt * 16 + l15) * 136 + lq * 8 + kk * 32);
#pragma unroll
      for (int c2 = 0; c2 < 2; ++c2) { const bf16x8 bk = *(const bf16x8*)(KN + ((ctp + c2) * 16 + l15) * 136 + lq * 8 + kk * 32);
        kka[c2] = mfma16(ak, bk, kka[c2]); qka[c2] = mfma16(aq, bk, qka[c2]); }
    }
    bf16_t* qkg = (bf16_t*)(p->ws + WS_QK) + (size_t)cid * 4096;
#pragma unroll
    for (int c2 = 0; c2 < 2; ++c2)
#pragma unroll
      for (int r = 0; r < 4; ++r) {
        const int i = rt * 16 + lq * 4 + r, jj = (ctp + c2) * 16 + l15;
        const float dec = fexp_(fminf(GC[i] - GC[jj], 0.f));
        const float aval = (i > jj) ? BETA[i] * kka[c2][r] * dec : 0.f;
        AM[i * 68 + jj] = aval; AMB[i * 72 + jj] = f2bf(aval);
        qkg[(((i >> 4) * 2 + (jj >> 5)) * 64 + ((jj & 31) >> 3) * 16 + (i & 15)) * 8 + (jj & 7)] = f2bf((i >= jj) ? qka[c2][r] * dec : 0.f);
      }
  }
  lds_barrier();
  const int cc = tid & 255;
  const bf16_t* rsrc = (cc < 128) ? (VN + cc) : (KN + (cc - 128));
  const float* rfac = (cc < 128) ? BETA : BEG;
#pragma unroll
  for (int bi = 0; bi < 4; ++bi) {
    if (bi > 0) {
      const int l15 = lane & 15, lq = lane >> 4;
#pragma unroll
      for (int n2 = 0; n2 < 2; ++n2) { const int nt = wave * 2 + n2; f32x4 acc = (f32x4){0.f, 0.f, 0.f, 0.f};
#pragma unroll
        for (int kk = 0; kk < (bi * 16 + 31) / 32; ++kk) { const int k0 = lq * 8 + kk * 32; const bool valid = k0 < bi * 16;
          u32x4 av = *(const u32x4*)(AMB + (bi * 16 + l15) * 72 + k0), bv = *(const u32x4*)(XT + (nt * 16 + l15) * 72 + k0);
          if (!valid) { av = (u32x4){0u, 0u, 0u, 0u}; bv = (u32x4){0u, 0u, 0u, 0u}; }
          acc = mfma16(as_bf16x8(av), as_bf16x8(bv), acc); }
#pragma unroll
        for (int r = 0; r < 4; ++r) CORR[(lq * 4 + r) * 260 + nt * 16 + l15] = acc[r]; }
      lds_barrier();
    }
    if (tid < 256) {
      float xb[16], rh[16];
#pragma unroll
      for (int ii = 0; ii < 16; ++ii) { const int i = bi * 16 + ii; rh[ii] = bf2f(rsrc[i * 136]) * rfac[i]; if (bi > 0) rh[ii] -= CORR[ii * 260 + cc]; }
#pragma unroll
      for (int rg = 0; rg < 4; ++rg) {
        f32x4 a[4][4];
#pragma unroll
        for (int q = 0; q < 4; ++q)
#pragma unroll
          for (int g4 = 0; g4 <= rg; ++g4) a[q][g4] = *(const f32x4*)(AM + (bi * 16 + rg * 4 + q) * 68 + bi * 16 + g4 * 4);
#pragma unroll
        for (int q = 0; q < 4; ++q) { const int ii = rg * 4 + q; float s = rh[ii];
#pragma unroll
          for (int jj = 0; jj < ii; ++jj) s -= a[q][jj >> 2][jj & 3] * xb[jj];
          xb[ii] = s; }
        asm volatile("" : "+v"(xb[rg * 4 + 3]) :: "memory");
      }
      u32x4 w0, w1;
      w0.x = cvt_pk_bf16(xb[0], xb[1]); w0.y = cvt_pk_bf16(xb[2], xb[3]); w0.z = cvt_pk_bf16(xb[4], xb[5]); w0.w = cvt_pk_bf16(xb[6], xb[7]);
      w1.x = cvt_pk_bf16(xb[8], xb[9]); w1.y = cvt_pk_bf16(xb[10], xb[11]); w1.z = cvt_pk_bf16(xb[12], xb[13]); w1.w = cvt_pk_bf16(xb[14], xb[15]);
      if (bi < 3) { *(u32x4*)(XT + cc * 72 + bi * 16) = w0; *(u32x4*)(XT + cc * 72 + bi * 16 + 8) = w1; }
      if (cc < 128) {
        bf16_t* ut = (bf16_t*)(p->ws + WS_UT) + (size_t)cid * 8192 + cc * 64 + bi * 16;
        *(u32x4*)ut = w0; *(u32x4*)(ut + 8) = w1;
      } else {
        const int dk = cc - 128;
        bf16_t* wb = (bf16_t*)(p->ws + WS_WB) + (size_t)cid * 8192 + ((bi * 4 + (dk >> 5)) * 64 + ((dk & 31) >> 3) * 16) * 8 + (dk & 7);
#pragma unroll
        for (int ii = 0; ii < 16; ++ii) wb[ii * 8] = f2bf(xb[ii]);
      }
    } else if (bi == 0) {
      const int t2 = tid - 256;
      { const int i = t2 >> 2, dseg = (t2 & 3) * 32; const float eg = fexp_(GC[i]);
        bf16_t* qt = (bf16_t*)(p->ws + WS_QT) + (size_t)cid * 8192 + (((i >> 4) * 4 + (t2 & 3)) * 64 + (i & 15)) * 8;
#pragma unroll
        for (int s = 0; s < 4; ++s) { float f[8]; unpack8(*(const u32x4*)(QN + i * 136 + dseg + s * 8), f);
#pragma unroll
          for (int e = 0; e < 8; ++e) f[e] *= eg;
          *(u32x4*)(qt + s * 128) = pack8(f); } }
      { const int d = t2 >> 1, iseg = (t2 & 1) * 32; const float gl = GC[63];
        bf16_t* kt = (bf16_t*)(p->ws + WS_KT) + (size_t)cid * 8192 + (((d >> 4) * 2 + (t2 & 1)) * 64 + (d & 15)) * 8;
#pragma unroll
        for (int s = 0; s < 4; ++s) { float f[8];
#pragma unroll
          for (int e = 0; e < 8; ++e) { const int i = iseg + s * 8 + e; f[e] = bf2f(KN[i * 136 + d]) * fexp_(gl - GC[i]); }
          *(u32x4*)(kt + s * 128) = pack8(f); } }
      if (t2 == 0) ((float*)(p->ws + WS_EGL))[cid] = fexp_(GC[63]);
    }
    if (bi < 3) lds_barrier();
  }
}

DEVI void gdn_decode_item(KP p, int j, int item, unsigned char* lds) {
  const int tid = tidx_(), lane = tid & 63, wave = tid >> 6;
  const int b = item >> 3, h = item & 7;
  const size_t row = NPR + b;
  float* QKV = (float*)lds; float* RED = (float*)(lds + 1536); float* PART = (float*)(lds + 2048);
  const bf16_t* proj = (const bf16_t*)(p->ws + WS_PROJ);
  const int dv4 = tid & 31, dkq = tid >> 5;
  const float* S0 = p->in[I_SDEL] + (size_t)((j * 128 + b) * 8 + h) * 16384;
  float4 s[8];
#pragma unroll
  for (int r = 0; r < 8; ++r) s[r] = *(const float4*)(S0 + (dkq * 8 + r) * 128 + dv4 * 4);
  const float* t = (const float*)(p->ws + WS_TAIL) + row * 16;
  const float traw_a = t[8 + h], traw_b = t[h], alog = p->in[I_ALOG][j * 8 + h], dtb = p->in[I_DTB][j * 8 + h];
  if (tid < 384) {
    const int part = tid >> 7, ch = tid & 127, col = part * 1024 + h * 128 + ch;
    const float* st = p->in[I_SCB] + (size_t)((j * 128 + b) * 3) * 3072 + col;
    const float x0 = st[0], x1 = st[3072], x2 = st[6144], x3 = bf2f(proj[row * 6144 + 2048 + col]);
    const float* cw = p->in[I_CBW] + (size_t)(j * 4) * 3072 + col;
    const float val = siluf_(cw[0] * x0 + cw[3072] * x1 + cw[6144] * x2 + cw[9216] * x3);
    float* so = p->out + O_SCB + (size_t)((j * 128 + b) * 3) * 3072 + col;
    so[0] = x1; so[3072] = x2; so[6144] = x3;
    QKV[tid] = val;
    const float ss = wave_sum(val * val);
    if (lane == 0) RED[wave] = ss;
  }
  lds_barrier();
  const float rq = __builtin_amdgcn_rsqf(RED[0] + RED[1] + 1e-6f) * 0.08838834764831845f, rk = __builtin_amdgcn_rsqf(RED[2] + RED[3] + 1e-6f);
  const float g = -fexp_(alog) * softplusf_(traw_a + dtb);
  const float beta = sigmoidf_(traw_b), eg = fexp_(g);
  float* S1 = p->out + O_SDEL + (size_t)((j * 128 + b) * 8 + h) * 16384;
  float4 pt = make_float4(0.f, 0.f, 0.f, 0.f);
#pragma unroll
  for (int r = 0; r < 8; ++r) { const int dk = dkq * 8 + r; const float kd = QKV[128 + dk] * rk;
    pt.x += s[r].x * kd; pt.y += s[r].y * kd; pt.z += s[r].z * kd; pt.w += s[r].w * kd; }
  *(float4*)(PART + dkq * 128 + dv4 * 4) = pt;
  lds_barrier();
  float4 kv = make_float4(0.f, 0.f, 0.f, 0.f);
#pragma unroll
  for (int q = 0; q < 16; ++q) { const float4 v = *(const float4*)(PART + q * 128 + dv4 * 4); kv.x += v.x; kv.y += v.y; kv.z += v.z; kv.w += v.w; }
  const float4 vv = *(const float4*)(QKV + 256 + dv4 * 4);
  float4 vn; vn.x = beta * (vv.x - eg * kv.x); vn.y = beta * (vv.y - eg * kv.y); vn.z = beta * (vv.z - eg * kv.z); vn.w = beta * (vv.w - eg * kv.w);
  lds_barrier();
  float4 po = make_float4(0.f, 0.f, 0.f, 0.f);
#pragma unroll
  for (int r = 0; r < 8; ++r) { const int dk = dkq * 8 + r; const float kd = QKV[128 + dk] * rk, qd = QKV[dk] * rq;
    float4 n; n.x = eg * s[r].x + kd * vn.x; n.y = eg * s[r].y + kd * vn.y; n.z = eg * s[r].z + kd * vn.z; n.w = eg * s[r].w + kd * vn.w;
    *(float4*)(S1 + dk * 128 + dv4 * 4) = n;
    po.x += n.x * qd; po.y += n.y * qd; po.z += n.z * qd; po.w += n.w * qd; }
  *(float4*)(PART + dkq * 128 + dv4 * 4) = po;
  lds_barrier();
  float o = 0.f;
  if (tid < 128) {
#pragma unroll
    for (int q = 0; q < 16; ++q) o += PART[q * 128 + tid];
    const float ss = wave_sum(o * o);
    if (lane == 0) RED[8 + wave] = ss;
  }
  lds_barrier();
  if (tid < 128) {
    const float rinv = __builtin_amdgcn_rsqf((RED[8] + RED[9]) * (1.f / 128.f) + 1e-6f);
    const float zb = bf2f(proj[row * 6144 + 5120 + h * 128 + tid]);
    ((bf16_t*)(p->ws + WS_YBUF))[row * 2048 + 1024 + h * 128 + tid] = f2bf(o * rinv * p->in[I_GNW][j * 128 + tid] * siluf_(zb));
  }
}

DEVI void phase_mixprep(KP p, int layer, unsigned char* lds, int ph, int submask) {
  const int j = layer >> 1;
  unsigned* ctr = (unsigned*)(p->ws + WS_CTL) + 4096 + ph;
  int* slot = (int*)(lds + LDS_MISC);
  const bool lead = tidx_() == 0;
  int nxt = 0; if (lead) nxt = (int)atomicAdd(ctr, 1u);
  for (;;) {
    if (lead) *slot = nxt;
    lds_barrier();
    const int it = *slot;
    lds_barrier();
    if (it >= 3216) break;
    if (lead) nxt = (int)atomicAdd(ctr, 1u);
    if (it < 144) { if (submask & 1) lru_item(p, j, it, lds); }
    else if (it < 2192) { if (submask & 2) gdn_prep_item(p, j, it - 144, lds); }
    else { if (submask & 4) gdn_decode_item(p, j, it - 2192, lds); }
  }
}

struct GdnFrags { u32x4 wf[4], qf[4], qkf[2], ktf[2][2]; u32x2 uf; float egl; };
DEVI void gdn_load(GdnFrags& f, KP p, int cid, int s, int rt, int ct, int l15, int lq) {
  const bf16_t* wb = (const bf16_t*)(p->ws + WS_WB) + (size_t)cid * 8192;
  const bf16_t* qt = (const bf16_t*)(p->ws + WS_QT) + (size_t)cid * 8192;
  const bf16_t* kt = (const bf16_t*)(p->ws + WS_KT) + (size_t)cid * 8192;
  const bf16_t* qk = (const bf16_t*)(p->ws + WS_QK) + (size_t)cid * 4096;
  const bf16_t* ut = (const bf16_t*)(p->ws + WS_UT) + (size_t)cid * 8192;
  const int ln = lq * 16 + l15;
#pragma unroll
  for (int kk = 0; kk < 4; ++kk) { f.wf[kk] = *(const u32x4*)(wb + ((rt * 4 + kk) * 64 + ln) * 8); f.qf[kk] = *(const u32x4*)(qt + ((rt * 4 + kk) * 64 + ln) * 8); }
#pragma unroll
  for (int kk = 0; kk < 2; ++kk) { f.qkf[kk] = *(const u32x4*)(qk + ((rt * 2 + kk) * 64 + ln) * 8);
#pragma unroll
    for (int d2 = 0; d2 < 2; ++d2) f.ktf[d2][kk] = *(const u32x4*)(kt + (((rt * 2 + d2) * 2 + kk) * 64 + ln) * 8); }
  f.uf = *(const u32x2*)(ut + (s * 32 + ct * 16 + l15) * 64 + rt * 16 + lq * 4);
  f.egl = ((const float*)(p->ws + WS_EGL))[cid];
}
DEVI void phase_gdnseq(KP p, int layer, unsigned char* lds) {
  const int tid = tidx_(), lane = tid & 63, wave = tid >> 6;
  const int j = layer >> 1, rt = wave >> 1, ct = wave & 1, l15 = lane & 15, lq = lane >> 4;
  bf16_t* ST = (bf16_t*)lds;
  bf16_t* VT = (bf16_t*)(lds + 8704);
  bf16_t* ybuf = (bf16_t*)(p->ws + WS_YBUF);
  unsigned dsum = 0u;
  for (int item = bidx_(); item < 256; item += gdim_()) {
    const int xcd = item & 7, idx = item >> 3, bh = xcd * 8 + (idx >> 2), s = idx & 3, b = bh >> 3, h = bh & 7;
    __syncthreads();
    for (int e = tid; e < 32 * 136 / 2; e += 512) ((unsigned*)ST)[e] = 0u;
    f32x4 sacc[2]; sacc[0] = (f32x4){0.f, 0.f, 0.f, 0.f}; sacc[1] = (f32x4){0.f, 0.f, 0.f, 0.f};
    GdnFrags nx; gdn_load(nx, p, bh * 32, s, rt, ct, l15, lq);
    __syncthreads();
    unsigned dprev = 0u; f32x4 oprev = (f32x4){0.f, 0.f, 0.f, 0.f};
    for (int c = 0; c < 32; ++c) {
      const GdnFrags cu = nx;
      if (c > 0) {
        bf16_t* yo = ybuf + (size_t)(b * 2048 + (c - 1) * 64 + rt * 16 + lq * 4) * 2048 + 1024 + h * 128 + s * 32 + ct * 16 + l15;
#pragma unroll
        for (int r = 0; r < 4; ++r) yo[(size_t)r * 2048] = f2bf(oprev[r]);
        asm volatile("" ::: "memory");
      }
      if (c + 1 < 32) gdn_load(nx, p, bh * 32 + c + 1, s, rt, ct, l15, lq);
      dsum += dprev;
      if (c + 3 < 32 && tid < 480) {
        const size_t cid3 = (size_t)(bh * 32 + c + 3); const unsigned char* src;
        if (tid < 128) src = p->ws + WS_WB + cid3 * 16384 + (size_t)tid * 128;
        else if (tid < 256) src = p->ws + WS_QT + cid3 * 16384 + (size_t)(tid - 128) * 128;
        else if (tid < 384) src = p->ws + WS_KT + cid3 * 16384 + (size_t)(tid - 256) * 128;
        else if (tid < 448) src = p->ws + WS_QK + cid3 * 8192 + (size_t)(tid - 384) * 128;
        else src = p->ws + WS_UT + cid3 * 16384 + (size_t)s * 4096 + (size_t)(tid - 448) * 128;
        dprev = *(const volatile unsigned*)src;
      }
      f32x4 wsa = (f32x4){0.f, 0.f, 0.f, 0.f}, oa = (f32x4){0.f, 0.f, 0.f, 0.f};
#pragma unroll
      for (int kk = 0; kk < 4; ++kk) { const bf16x8 sb = *(const bf16x8*)(ST + (ct * 16 + l15) * 136 + lq * 8 + kk * 32);
        wsa = mfma16(as_bf16x8(cu.wf[kk]), sb, wsa); oa = mfma16(as_bf16x8(cu.qf[kk]), sb, oa); }
      { const float u0 = bflo(cu.uf.x), u1 = bfhi(cu.uf.x), u2 = bflo(cu.uf.y), u3 = bfhi(cu.uf.y);
        u32x2 w; w.x = cvt_pk_bf16(u0 - wsa[0], u1 - wsa[1]); w.y = cvt_pk_bf16(u2 - wsa[2], u3 - wsa[3]);
        *(u32x2*)(VT + (ct * 16 + l15) * 72 + rt * 16 + lq * 4) = w; }
      lds_barrier();
      bf16x8 vb[2];
#pragma unroll
      for (int kk = 0; kk < 2; ++kk) vb[kk] = *(const bf16x8*)(VT + (ct * 16 + l15) * 72 + lq * 8 + kk * 32);
#pragma unroll
      for (int kk = 0; kk < 2; ++kk) oa = mfma16(as_bf16x8(cu.qkf[kk]), vb[kk], oa);
#pragma unroll
      for (int d2 = 0; d2 < 2; ++d2) { sacc[d2] = sacc[d2] * cu.egl;
#pragma unroll
        for (int kk = 0; kk < 2; ++kk) sacc[d2] = mfma16(as_bf16x8(cu.ktf[d2][kk]), vb[kk], sacc[d2]); }
      oprev = oa;
#pragma unroll
      for (int d2 = 0; d2 < 2; ++d2) { u32x2 w; w.x = cvt_pk_bf16(sacc[d2][0], sacc[d2][1]); w.y = cvt_pk_bf16(sacc[d2][2], sacc[d2][3]);
        *(u32x2*)(ST + (ct * 16 + l15) * 136 + (rt * 2 + d2) * 16 + lq * 4) = w; }
      lds_barrier();
    }
    { bf16_t* yo = ybuf + (size_t)(b * 2048 + 31 * 64 + rt * 16 + lq * 4) * 2048 + 1024 + h * 128 + s * 32 + ct * 16 + l15;
#pragma unroll
      for (int r = 0; r < 4; ++r) yo[(size_t)r * 2048] = f2bf(oprev[r]); }
    float* pd = p->out + O_PDEL + (size_t)((j * 8 + b) * 8 + h) * 16384;
#pragma unroll
    for (int d2 = 0; d2 < 2; ++d2)
#pragma unroll
      for (int r = 0; r < 4; ++r) pd[(size_t)((rt * 2 + d2) * 16 + lq * 4 + r) * 128 + s * 32 + ct * 16 + l15] = sacc[d2][r];
  }
  if (dsum == 0x9e3779b9u) ((unsigned*)(p->ws + WS_CTL))[5000] = dsum;
}

DEVI void phase_onorm(KP p, int layer) {
  const int tid = tidx_(), lane = tid & 63, wave = tid >> 6, j = layer >> 1;
  bf16_t* ybuf = (bf16_t*)(p->ws + WS_YBUF); const bf16_t* proj = (const bf16_t*)(p->ws + WS_PROJ);
  float gw[16];
#pragma unroll
  for (int e = 0; e < 16; ++e) gw[e] = p->in[I_GNW][j * 128 + ((lane * 16 + e) & 127)];
  for (int r = bidx_() * 8 + wave; r < NPR; r += gdim_() * 8) {
    bf16_t* yp = ybuf + (size_t)r * 2048 + 1024 + lane * 16; const bf16_t* zp = proj + (size_t)r * 6144 + 5120 + lane * 16;
    float o[16], z[16]; { float t[8]; unpack8(*(const u32x4*)yp, t);
#pragma unroll
      for (int e = 0; e < 8; ++e) o[e] = t[e];
      unpack8(*(const u32x4*)(yp + 8), t);
#pragma unroll
      for (int e = 0; e < 8; ++e) o[8 + e] = t[e];
      unpack8(*(const u32x4*)zp, t);
#pragma unroll
      for (int e = 0; e < 8; ++e) z[e] = t[e];
      unpack8(*(const u32x4*)(zp + 8), t);
#pragma unroll
      for (int e = 0; e < 8; ++e) z[8 + e] = t[e]; }
    float ss = 0.f;
#pragma unroll
    for (int e = 0; e < 16; ++e) ss += o[e] * o[e];
    ss += __shfl_xor(ss, 1); ss += __shfl_xor(ss, 2); ss += __shfl_xor(ss, 4);
    const float rinv = __builtin_amdgcn_rsqf(ss * (1.f / 128.f) + 1e-6f);
    float a[8], c[8];
#pragma unroll
    for (int e = 0; e < 8; ++e) { a[e] = o[e] * rinv * gw[e] * siluf_(z[e]); c[e] = o[8 + e] * rinv * gw[8 + e] * siluf_(z[8 + e]); }
    *(u32x4*)yp = pack8(a); *(u32x4*)(yp + 8) = pack8(c);
  }
}

struct S5C { bf16x8 Bf[8], Cf[4]; float abr, abi, dch; };
template <bool OUT, bool SAMPLE>
DEVI void s5_chunks(KP p, const S5C& c, int jc, int g, size_t rbase, int nch, int sgrp, float& xr, float& xi, float* BU, bf16_t* XB, int lane) {
  const int l15 = lane & 15, lq = lane >> 4;
  const bf16_t* proj = (const bf16_t*)(p->ws + WS_PROJ);
  bf16_t* y1 = (bf16_t*)(p->ws + WS_YBUF);
  u32x4 unx = (u32x4){0u, 0u, 0u, 0u}; bf16_t uenx[4] = {0, 0, 0, 0};
  if (lq < 2) unx = *(const u32x4*)(proj + (rbase + l15) * 2048 + g * 16 + lq * 8);
  if (OUT) {
#pragma unroll
    for (int r = 0; r < 4; ++r) uenx[r] = proj[(rbase + lq * 4 + r) * 2048 + g * 16 + l15]; }
  for (int ck = 0; ck < nch; ++ck) {
    const size_t row0 = rbase + (size_t)ck * 16;
    const u32x4 ucur = unx; bf16_t uec[4];
#pragma unroll
    for (int r = 0; r < 4; ++r) uec[r] = uenx[r];
    if (ck + 1 < nch) { if (lq < 2) unx = *(const u32x4*)(proj + (row0 + 16 + l15) * 2048 + g * 16 + lq * 8);
      if (OUT) {
#pragma unroll
        for (int r = 0; r < 4; ++r) uenx[r] = proj[(row0 + 16 + lq * 4 + r) * 2048 + g * 16 + l15]; } }
#pragma unroll
    for (int nt = 0; nt < 8; ++nt) { const f32x4 acc = mfma16(as_bf16x8(ucur), c.Bf[nt], (f32x4){0.f, 0.f, 0.f, 0.f});
      *(f32x4*)(BU + (nt * 16 + l15) * 20 + lq * 4) = acc; }
    asm volatile("s_waitcnt lgkmcnt(0)" ::: "memory");
    float br[16], bi[16];
#pragma unroll
    for (int t4 = 0; t4 < 4; ++t4) { const f32x4 a = *(const f32x4*)(BU + lane * 20 + t4 * 4), b = *(const f32x4*)(BU + (64 + lane) * 20 + t4 * 4);
#pragma unroll
      for (int e = 0; e < 4; ++e) { br[t4 * 4 + e] = a[e]; bi[t4 * 4 + e] = b[e]; } }
    if (!SAMPLE) {
#pragma unroll
      for (int t = 0; t < 16; ++t) { const float nr = c.abr * xr - c.abi * xi + br[t], ni = c.abr * xi + c.abi * xr + bi[t]; xr = nr; xi = ni;
        if (OUT) *(unsigned*)(XB + t * 136 + 2 * lane) = cvt_pk_bf16(xr, xi); }
    } else {
#pragma unroll
      for (int t = 0; t < 16; ++t) { const size_t si = ((size_t)(jc * 128 + sgrp * 16 + t) * 64 + g) * 64 + lane;
        const float x0r = p->in[I_SSR][si], x0i = p->in[I_SSI][si];
        const float nr = c.abr * x0r - c.abi * x0i + br[t], ni = c.abr * x0i + c.abi * x0r + bi[t];
        p->out[O_SSR + si] = nr; p->out[O_SSI + si] = ni;
        *(unsigned*)(XB + t * 136 + 2 * lane) = cvt_pk_bf16(nr, ni); }
    }
    if (OUT) {
      asm volatile("s_waitcnt lgkmcnt(0)" ::: "memory");
      f32x4 ya = (f32x4){0.f, 0.f, 0.f, 0.f};
#pragma unroll
      for (int kk = 0; kk < 4; ++kk) ya = mfma16(*(const bf16x8*)(XB + l15 * 136 + lq * 8 + kk * 32), c.Cf[kk], ya);
#pragma unroll
      for (int r = 0; r < 4; ++r) { const float y = ya[r] + c.dch * bf2f(uec[r]); y1[(row0 + lq * 4 + r) * 1024 + g * 16 + l15] = f2bf(geluf_(y)); }
    }
  }
}
DEVI void s5_setup(KP p, S5C& c, int jc, int g, int lane) {
  const int l15 = lane & 15, lq = lane >> 4, gi = jc * 64 + g;
  const float dt = __expf(p->in[I_LOGDT][gi]);
  { const float are = p->in[I_ARE][gi * 64 + lane], aim = p->in[I_AIM][gi * 64 + lane]; const float mag = __expf(are * dt); c.abr = mag * __cosf(aim * dt); c.abi = mag * __sinf(aim * dt); }
#pragma unroll
  for (int nt = 0; nt < 8; ++nt) {
    float v[8];
#pragma unroll
    for (int e = 0; e < 8; ++e) v[e] = 0.f;
    if (lq < 2) {
      const int pp = (nt & 3) * 16 + l15;
      const float are = p->in[I_ARE][gi * 64 + pp], aim = p->in[I_AIM][gi * 64 + pp]; const float mag = __expf(are * dt); const float sn = __sinf(aim * dt), cs = __cosf(aim * dt);
      const float nr = mag * cs - 1.f, ni = mag * sn, den = 1.f / (are * are + aim * aim);
      const float cr = (nr * are + ni * aim) * den, ci = (ni * are - nr * aim) * den;
      const float* br = p->in[I_BRE] + (size_t)(gi * 64 + pp) * 16 + lq * 8; const float* bi = p->in[I_BIM] + (size_t)(gi * 64 + pp) * 16 + lq * 8;
#pragma unroll
      for (int e = 0; e < 8; ++e) v[e] = (nt >= 4) ? (cr * bi[e] + ci * br[e]) : (cr * br[e] - ci * bi[e]);
    }
    c.Bf[nt] = as_bf16x8(pack8(v));
  }
#pragma unroll
  for (int kk = 0; kk < 4; ++kk) { const int p0 = lq * 4 + kk * 16;
    const float* sre = p->in[I_CRE] + (size_t)(gi * 16 + l15) * 64 + p0; const float* sim = p->in[I_CIM] + (size_t)(gi * 16 + l15) * 64 + p0; float v[8];
#pragma unroll
    for (int m = 0; m < 4; ++m) { v[2 * m] = sre[m]; v[2 * m + 1] = -sim[m]; }
    c.Cf[kk] = as_bf16x8(pack8(v)); }
  c.dch = p->in[I_S5D][jc * 1024 + g * 16 + l15];
}
DEVI void phase_s5(KP p, int layer, unsigned char* lds) {
  const int tid = tidx_(), lane = tid & 63, wave = tid >> 6, jc = layer >> 1;
  float* BU = (float*)(lds + wave * 14592);
  bf16_t* XB = (bf16_t*)(lds + wave * 14592 + 10240);
  float* EX = (float*)(lds + 116736);
  const int cb = wave >> 2, seg = wave & 3;
  for (int cp = bidx_(); cp < 256; cp += gdim_()) {
    const int q = cp * 2 + cb, b = q >> 6, g = q & 63;
    S5C c; s5_setup(p, c, jc, g, lane);
    float xr = 0.f, xi = 0.f;
    const size_t rbase = (size_t)b * 2048 + (size_t)seg * 512;
    if (seg < 3) {
      s5_chunks<false, false>(p, c, jc, g, rbase, 32, 0, xr, xi, BU, XB, lane);
      EX[wave * 128 + lane] = xr; EX[wave * 128 + 64 + lane] = xi;
    } else {
      const int qs = cp * 2 + cb, gs = qs & 63, sgrp = qs >> 6;
      S5C cs; s5_setup(p, cs, jc, gs, lane);
      float dr = 0.f, di = 0.f;
      s5_chunks<true, true>(p, cs, jc, gs, (size_t)(NPR + sgrp * 16), 1, sgrp, dr, di, BU, XB, lane);
    }
    __syncthreads();
    float pr = c.abr, pi = c.abi;
#pragma unroll
    for (int s = 0; s < 9; ++s) { const float nr = pr * pr - pi * pi, ni = 2.f * pr * pi; pr = nr; pi = ni; }
    xr = 0.f; xi = 0.f;
    for (int s = 0; s < seg; ++s) { const float er = EX[(cb * 4 + s) * 128 + lane], ei = EX[(cb * 4 + s) * 128 + 64 + lane];
      const float nr = pr * xr - pi * xi + er, ni = pr * xi + pi * xr + ei; xr = nr; xi = ni; }
    s5_chunks<true, false>(p, c, jc, g, rbase, 32, 0, xr, xi, BU, XB, lane);
    if (seg == 3) { const size_t si = ((size_t)(jc * 8 + b) * 64 + g) * 64 + lane; p->out[O_PSR + si] = xr; p->out[O_PSI + si] = xi; }
    __syncthreads();
  }
}

DEVI void phase_final(KP p) {
  const int tid = tidx_(), lane = tid & 63, wave = tid >> 6;
  const float* nw = p->in[I_FNW];
  float4 w4[4];
#pragma unroll
  for (int i = 0; i < 4; ++i) w4[i] = *(const float4*)(nw + i * 256 + lane * 4);
  for (int r = (bidx_() * 8 + wave) * 2; r < NRV; r += gdim_() * 16) {
    float* x0 = p->out + (size_t)r * 1024; float* x1 = x0 + 1024; float4 v0[4], v1[4]; float s0 = 0.f, s1 = 0.f;
#pragma unroll
    for (int i = 0; i < 4; ++i) { v0[i] = *(const float4*)(x0 + i * 256 + lane * 4); v1[i] = *(const float4*)(x1 + i * 256 + lane * 4); }
#pragma unroll
    for (int i = 0; i < 4; ++i) { s0 += v0[i].x * v0[i].x + v0[i].y * v0[i].y + v0[i].z * v0[i].z + v0[i].w * v0[i].w; s1 += v1[i].x * v1[i].x + v1[i].y * v1[i].y + v1[i].z * v1[i].z + v1[i].w * v1[i].w; }
#pragma unroll
    for (int o = 32; o >= 1; o >>= 1) { s0 += __shfl_xor(s0, o); s1 += __shfl_xor(s1, o); }
    const float r0 = __builtin_amdgcn_rsqf(s0 * (1.f / 1024.f) + 1e-6f), r1 = __builtin_amdgcn_rsqf(s1 * (1.f / 1024.f) + 1e-6f);
#pragma unroll
    for (int i = 0; i < 4; ++i) { float4 o; o.x = v0[i].x * r0 * w4[i].x; o.y = v0[i].y * r0 * w4[i].y; o.z = v0[i].z * r0 * w4[i].z; o.w = v0[i].w * r0 * w4[i].w; *(float4*)(x0 + i * 256 + lane * 4) = o;
      float4 q; q.x = v1[i].x * r1 * w4[i].x; q.y = v1[i].y * r1 * w4[i].y; q.z = v1[i].z * r1 * w4[i].z; q.w = v1[i].w * r1 * w4[i].w; *(float4*)(x1 + i * 256 + lane * 4) = q; }
  }
}

template <class F>
DEVI void sample_gemm(const bf16_t* __restrict__ A, int lda, const bf16_t* __restrict__ Bt, int N, int K, F&& epi, float* red) {
  const int tid = tidx_(), lane = tid & 63, wave = tid >> 6, l15 = lane & 15, lq = lane >> 4, rt2 = wave & 1, kq = wave >> 1;
  const int kq_len = K >> 2, nitems = (N / 16) * 4;
  for (int it = gdim_() - 1 - bidx_(); it < nitems; it += gdim_()) {
    const int s = it >> 2, rg = it & 3, row0 = rg * 32 + rt2 * 16;
    const bf16_t* ap = A + (size_t)(row0 + l15) * lda + lq * 8 + kq * kq_len;
    const bf16_t* bp = Bt + (size_t)(s * 16 + l15) * K + lq * 8 + kq * kq_len;
    f32x4 acc0 = (f32x4){0.f, 0.f, 0.f, 0.f}, acc1 = (f32x4){0.f, 0.f, 0.f, 0.f};
    for (int k0 = 0; k0 < kq_len; k0 += 256) {
      u32x4 a[8], b[8];
#pragma unroll
      for (int u = 0; u < 8; ++u) { a[u] = *(const u32x4*)(ap + k0 + u * 32); b[u] = *(const u32x4*)(bp + k0 + u * 32); }
#pragma unroll
      for (int u = 0; u < 8; u += 2) { acc0 = mfma16(as_bf16x8(a[u]), as_bf16x8(b[u]), acc0); acc1 = mfma16(as_bf16x8(a[u + 1]), as_bf16x8(b[u + 1]), acc1); }
    }
    acc0 = acc0 + acc1;
    __syncthreads();
    *(f32x4*)(red + ((kq * 2 + rt2) * 64 + lane) * 4) = acc0;
    __syncthreads();
    if (kq == 0) {
      f32x4 t = acc0;
#pragma unroll
      for (int q = 1; q < 4; ++q) t = t + *(const f32x4*)(red + ((q * 2 + rt2) * 64 + lane) * 4);
#pragma unroll
      for (int r = 0; r < 4; ++r) epi(row0 + lq * 4 + r, s * 16 + l15, t[r]);
    }
  }
}

constexpr int N_PHASES = 25;
#ifndef PROBE_SUB
#define PROBE_SUB 7
#endif
#ifndef ONLY_KIND
#define ONLY_KIND -1
#endif
#define KON(k) ((ONLY_KIND < 0 || ONLY_KIND == (k)) && kind == (k))
__global__ void __launch_bounds__(512, 2) mega(Params p_unused) {
  extern __shared__ __attribute__((aligned(16))) unsigned char shm[];
  cg::grid_group grid = cg::this_grid();
  PG8_LAS unsigned char* ldsg = (PG8_LAS unsigned char*)shm;
  KP p0 = (KP)__builtin_amdgcn_kernarg_segment_ptr();
  const int ph_lo = p0->ph_lo, ph_hi = p0->ph_hi;
  volatile LAS unsigned* xst = (volatile LAS unsigned*)(ldsg + LDS_MISC + 16);
  if (threadIdx.x == 0) { xst[0] = 0u; xst[1] = 0u; }
  __syncthreads();
  XcdBarrier xb = xcd_barrier_post((unsigned*)(p0->ws + WS_CTL), xst);
  int rep = 0;
  for (int ph = ph_lo; ph < ph_hi; ++ph) {
    KP p = p0; asm volatile("" : "+s"(p));
    int kind, layer = 0;
    if (ph == 0) kind = 0; else if (ph == 1) kind = 1; else if (ph == 24) kind = 12;
    else { const int q = ph - 2, pair = q / 11, rem = q % 11;
      if (rem < 6) { layer = 2 * pair; kind = (rem == 0) ? 2 : 2 + rem; }
      else { layer = 2 * pair + 1; const int s = rem - 6; kind = (s == 0) ? 2 : 7 + s; } }
    const int j = layer >> 1;
    if (KON(0)) phase_prep(p, (float*)shm);
    else if (KON(2)) phase_norm(p, layer, (float*)shm);
    else if (KON(4)) phase_mixprep(p, layer, shm, ph + 32 * rep, rep ? PROBE_SUB : 7);
    else if (KON(5)) phase_gdnseq(p, layer, shm);
    else if (KON(6)) phase_onorm(p, layer);
    else if (KON(9)) phase_s5(p, layer, shm);
    else if (KON(12)) phase_final(p);
    else if (KON(1)) {
      pg8::Gemm g{(const bf16_t*)(p->ws + WS_SILUC), (const bf16_t*)(p->ws + WS_WT_MOD), 256, 12288, 1024};
      pg8::StaticOrder S; S.init(256, 12288, gdim_(), bidx_());
      pg8::EpiF32 E{(float*)(p->ws + WS_MOD), 12288, p->in[I_MODB]};
      pg8::gemm_phase<pg8::EpiF32, pg8::StaticOrder, false>(ldsg, g, S, E, nullptr);
    } else if (KON(3) || KON(8)) {
      const bool ab = kind == 3; const int N = ab ? 6144 : 2048;
      const bf16_t* Bt = ab ? (const bf16_t*)(p->ws + WS_WT_INAB) + (size_t)j * 6144 * 1024 : (const bf16_t*)(p->ws + WS_WT_CIN) + (size_t)j * 2048 * 1024;
      pg8::Gemm g{(const bf16_t*)(p->ws + WS_YBUF), Bt, NPR, N, 1024};
      pg8::StaticOrder S; S.init(NPR, N, gdim_(), bidx_());
      pg8::EpiBf16<0> E{(bf16_t*)(p->ws + WS_PROJ), N, nullptr, 0, 0};
      pg8::gemm_phase<pg8::EpiBf16<0>, pg8::StaticOrder, false>(ldsg, g, S, E, nullptr);
      bf16_t* po = (bf16_t*)(p->ws + WS_PROJ) + (size_t)NPR * N;
      sample_gemm((const bf16_t*)(p->ws + WS_YBUF) + (size_t)NPR * 1024, 1024, Bt, N, 1024, [&](int r, int c, float v) { po[(size_t)r * N + c] = f2bf(v); }, (float*)shm);
      if (ab) tail_gemm(p, j);
    } else if (KON(7) || KON(11)) {
      const bool ab = kind == 7; const int K = ab ? 2048 : 1024;
      const bf16_t* Ab = ab ? (const bf16_t*)(p->ws + WS_YBUF) : (const bf16_t*)(p->ws + WS_Y2);
      const bf16_t* Bt = ab ? (const bf16_t*)(p->ws + WS_WT_OUTAB) + (size_t)j * 1024 * 2048 : (const bf16_t*)(p->ws + WS_WT_COUT) + (size_t)j * 1024 * 1024;
      pg8::Gemm g{Ab, Bt, NPR, 1024, K};
      pg8::StaticOrder S; S.init(NPR, 1024, gdim_(), bidx_());
      const float* gatep = (const float*)(p->ws + WS_MOD) + layer * 3072 + 2048;
      EpiRes E{layer == 0 ? p->in[I_XP] : p->out, layer == 0 ? p->in[I_XS] : p->out + (size_t)NPR * 1024, p->out, gatep};
      pg8::gemm_phase<EpiRes, pg8::StaticOrder, false>(ldsg, g, S, E, nullptr);
      const float* xsi = layer == 0 ? p->in[I_XS] : p->out + (size_t)NPR * 1024; float* xso = p->out + (size_t)NPR * 1024;
      sample_gemm(Ab + (size_t)NPR * K, K, Bt, 1024, K, [&](int r, int c, float v) { xso[(size_t)r * 1024 + c] = xsi[(size_t)r * 1024 + c] + gatep[(size_t)(8 + r) * 12288 + c] * v; }, (float*)shm);
    } else if (KON(10)) {
      const bf16_t* Bt = (const bf16_t*)(p->ws + WS_WT_GLU) + (size_t)j * 1024 * 1024;
      pg8::Gemm g{(const bf16_t*)(p->ws + WS_YBUF), Bt, NPR, 1024, 1024};
      pg8::StaticOrder S; S.init(NPR, 1024, gdim_(), bidx_());
      const float* gb = p->in[I_GLUB] + j * 1024;
      EpiGlu E{(const bf16_t*)(p->ws + WS_YBUF), (const bf16_t*)(p->ws + WS_PROJ) + 1024, (bf16_t*)(p->ws + WS_Y2), gb};
      pg8::gemm_phase<EpiGlu, pg8::StaticOrder, false>(ldsg, g, S, E, nullptr);
      const bf16_t* y1s = (const bf16_t*)(p->ws + WS_YBUF) + (size_t)NPR * 1024; const bf16_t* zs = (const bf16_t*)(p->ws + WS_PROJ) + (size_t)NPR * 2048 + 1024; bf16_t* y2s = (bf16_t*)(p->ws + WS_Y2) + (size_t)NPR * 1024;
      sample_gemm(y1s, 1024, Bt, 1024, 1024, [&](int r, int c, float v) { y2s[(size_t)r * 1024 + c] = f2bf(bf2f(y1s[(size_t)r * 1024 + c]) * sigmoidf_(v + gb[c]) * siluf_(bf2f(zs[(size_t)r * 2048 + c]))); }, (float*)shm);
    }
#ifdef REPEAT_KIND
    if (kind == REPEAT_KIND && rep == 0) { rep = 1; --ph; } else rep = 0;
#endif
    if (ph + 1 < ph_hi) { if (ph_hi > 100000) grid.sync();
      xcd_barrier(xb); }
  }
}

#ifndef MK_MULTI
#define MK_MULTI 0
#endif
#ifndef PH_HI
#define PH_HI N_PHASES
#endif
extern "C" void kernel_launch(void* const* d_in, const int* in_sizes, int n_in, void* d_out, int out_size, void* d_ws, size_t ws_size, hipStream_t stream) {
  static int grid = 0;
  if (grid == 0) {
    if (n_in != N_IN || (size_t)out_size != O_END || ws_size < WS_END) { fprintf(stderr, "kernel_launch: unexpected shapes: n_in %d out %d ws %zu (need %zu)\n", n_in, out_size, ws_size, (size_t)WS_END); grid = -1; return; }
    int dev = 0, cus = 0, per_cu = 0;
    if (hipGetDevice(&dev) != hipSuccess || hipDeviceGetAttribute(&cus, hipDeviceAttributeMultiprocessorCount, dev) != hipSuccess) { grid = -1; return; }
    if (hipFuncSetAttribute((const void*)mega, hipFuncAttributeMaxDynamicSharedMemorySize, LDS_BYTES) != hipSuccess) { fprintf(stderr, "kernel_launch: hipFuncSetAttribute failed\n"); grid = -1; return; }
    if (hipOccupancyMaxActiveBlocksPerMultiprocessor(&per_cu, (const void*)mega, 512, LDS_BYTES) != hipSuccess || per_cu < 1) { fprintf(stderr, "kernel_launch: occupancy query says %d\n", per_cu); per_cu = 1; }
    (void)hipGetLastError();
    grid = cus;
  }
  if (grid < 0) return;
  if (hipMemsetAsync((char*)d_ws + WS_CTL, 0, 32768, stream) != hipSuccess) { fprintf(stderr, "kernel_launch: memset failed\n"); return; }
  Params p{};
  for (int i = 0; i < N_IN; ++i) p.in[i] = (const float*)d_in[i];
  p.out = (float*)d_out; p.ws = (unsigned char*)d_ws;
#if MK_MULTI
  for (int ph = 0; ph < N_PHASES; ++ph) { p.ph_lo = ph; p.ph_hi = ph + 1; hipLaunchKernelGGL(mega, dim3(grid), dim3(512), LDS_BYTES, stream, p); }
#else
  p.ph_lo = 0; p.ph_hi = PH_HI;
  void* args[] = {&p};
  hipError_t e = hipLaunchCooperativeKernel((void*)mega, dim3(grid), dim3(512), args, LDS_BYTES, stream);
  if (e != hipSuccess) fprintf(stderr, "kernel_launch: cooperative launch failed: %s (grid %d)\n", hipGetErrorString(e), grid);
#endif
}
```

```cpp
#include <hip/hip_runtime.h>
#include <hip/hip_cooperative_groups.h>
#include <cstdio>
namespace cg = cooperative_groups;
__device__ __forceinline__ int tidx_() { int t = threadIdx.x; asm volatile("" : "+v"(t)); return t; }
__device__ __forceinline__ int bidx_() { int t = blockIdx.x; asm volatile("" : "+s"(t)); return t; }
__device__ __forceinline__ int gdim_() { int t = gridDim.x; asm volatile("" : "+s"(t)); return t; }
namespace pg8 {
#define PG8_LAS __attribute__((address_space(3)))
typedef unsigned short bf16_t;
typedef short bf16x8 __attribute__((ext_vector_type(8)));
typedef float f32x4 __attribute__((ext_vector_type(4)));
typedef unsigned u32x4 __attribute__((ext_vector_type(4)));
constexpr int BM = 256, BK = 64, HALF = 128, HTB = HALF * BK * 2  , STAGE_BYTES = 8 * HTB, NXCD = 8, WGM = 8;

__host__ __device__ __forceinline__ int lds_byte(int r, int c) { const int st = (r >> 4) * 2 + (c >> 5), rr = r & 15, cc = c & 31, ob = rr * 64 + cc * 2; return st * 1024 + (ob ^ (((ob >> 9) & 1) << 5)); }
__host__ __device__ __forceinline__ void stage_rc(int b, int& R, int& C) { const int st = b / 1024, sb = b % 1024, swz = sb ^ (((sb >> 9) & 1) << 5); R = (st >> 1) * 16 + swz / 64; C = (st & 1) * 32 + (swz % 64) / 2; }
__host__ __device__ __forceinline__ int perm32(int rho) { const int n = rho >> 4, i = rho & 15; return 8 * (i >> 2) + 4 * n + (i & 3); }

struct Unit { int pm, pn; };
struct Gemm { const bf16_t* A; const bf16_t* Bt; int M, N, K; };

struct StaticOrder {
    int nM, nN, nwg, G, c;
    __host__ __device__ void init(int M, int N, int G_, int c_) { nM = M / BM; nN = N / BM; nwg = nM * nN; G = G_; c = c_; }
    __host__ __device__ bool next(int i, Unit& u) const {
        const long L = (long)i * G + c; if (L >= nwg) return false;
        int wgid = (int)L; { const int q = nwg / NXCD, r = nwg % NXCD, xcd = wgid % NXCD, off = wgid / NXCD; wgid = (xcd < r ? xcd * (q + 1) : r * (q + 1) + (xcd - r) * q) + off; }
        const int nig = WGM * nN, gid = wgid / nig, fm = gid * WGM, gsz = (nM - fm) < WGM ? (nM - fm) : WGM;
        u.pm = fm + ((wgid % nig) % gsz); u.pn = (wgid % nig) / gsz; return true;
    }
    __device__ __forceinline__ void a_ready(const Unit&) const {}
    __device__ __forceinline__ void done(const Unit&) const {}
};
typedef float f32x2cv __attribute__((ext_vector_type(2)));
typedef __bf16 bf16x2cv __attribute__((ext_vector_type(2)));
__device__ __forceinline__ unsigned cvt_pk_bf16(float lo, float hi) { f32x2cv v = {lo, hi}; bf16x2cv b = __builtin_convertvector(v, bf16x2cv); return __builtin_bit_cast(unsigned, b); }
typedef float f32x2 __attribute__((ext_vector_type(2)));
__device__ __forceinline__ f32x2 gelu_pk(f32x2 v) {
    const f32x2 av = __builtin_elementwise_abs(v), d = av * 0.2316418882f + 1.0f;
    f32x2 t; t.x = __builtin_amdgcn_rcpf(d.x); t.y = __builtin_amdgcn_rcpf(d.y);
    f32x2 q = t * 0.5307027145f + (-0.7265760135f); q = q * t + 0.7107068705f; q = q * t + (-0.142248368f); q = q * t + 0.127414796f; q = q * t;
    const f32x2 s = (v * v) * (-0.72134752044f);
    f32x2 e; e.x = __builtin_amdgcn_exp2f(s.x); e.y = __builtin_amdgcn_exp2f(s.y);
    const f32x2 m = v * (q * e), r = v - m;
    f32x2 o; o.x = v.x < 0.f ? m.x : r.x; o.y = v.y < 0.f ? m.y : r.y; return o;
}

struct EpiF32 {
    static constexpr bool PERM = false, AFTER_DRAIN = false;
    float* C; int ldc; const float* bias;
    __device__ __forceinline__ void operator()(const f32x4 (&acc)[2][2][4][2], const Unit& u, int wr, int wc, int fr, int fq) const {
        const int row0 = u.pm * BM + wr * 64 + fr, col0 = u.pn * BM + wc * 32 + 4 * fq;
        f32x4 bv[2][2];
#pragma unroll
        for (int bj = 0; bj < 2; ++bj)
#pragma unroll
            for (int n = 0; n < 2; ++n) bv[bj][n] = bias ? *(const f32x4*)(bias + col0 + bj * HALF + n * 16) : (f32x4){0.f, 0.f, 0.f, 0.f};
#pragma unroll
        for (int ai = 0; ai < 2; ++ai)
#pragma unroll
            for (int m = 0; m < 4; ++m) { float* rowp = C + (size_t)(row0 + ai * HALF + m * 16) * ldc + col0;
#pragma unroll
                for (int bj = 0; bj < 2; ++bj)
#pragma unroll
                    for (int n = 0; n < 2; ++n) *(f32x4*)(rowp + bj * HALF + n * 16) = acc[ai][bj][m][n] + bv[bj][n]; }
    }
};
template <int ACT  > struct EpiBf16 {
    static constexpr bool PERM = true, AFTER_DRAIN = false;
    bf16_t* O; int ldc; const float* bias; int split_cols; size_t split_stride;
    __device__ __forceinline__ void operator()(const f32x4 (&acc)[2][2][4][2], const Unit& u, int wr, int wc, int fr, int fq) const {
        const int row0 = u.pm * BM + wr * 64 + fr; int colt = u.pn * BM; bf16_t* base = O;
        if (split_cols) { const int t = colt / split_cols; base += (size_t)t * split_stride; colt -= t * split_cols; }
        const int col0 = colt + wc * 32 + 8 * fq, bcol0 = u.pn * BM + wc * 32 + 8 * fq;
        f32x4 bv[2][2];
#pragma unroll
        for (int bj = 0; bj < 2; ++bj)
#pragma unroll
            for (int n = 0; n < 2; ++n) bv[bj][n] = bias ? *(const f32x4*)(bias + bcol0 + bj * HALF + 4 * n) : (f32x4){0.f, 0.f, 0.f, 0.f};
#pragma unroll
        for (int ai = 0; ai < 2; ++ai)
#pragma unroll
            for (int m = 0; m < 4; ++m) { bf16_t* rowp = base + (size_t)(row0 + ai * HALF + m * 16) * ldc + col0;
#pragma unroll
                for (int bj = 0; bj < 2; ++bj) { f32x4 v0 = acc[ai][bj][m][0] + bv[bj][0], v1 = acc[ai][bj][m][1] + bv[bj][1];
                    if (ACT == 1) { f32x2 a = gelu_pk((f32x2){v0[0], v0[1]}), b = gelu_pk((f32x2){v0[2], v0[3]}), c = gelu_pk((f32x2){v1[0], v1[1]}), d = gelu_pk((f32x2){v1[2], v1[3]});
                        v0 = (f32x4){a.x, a.y, b.x, b.y}; v1 = (f32x4){c.x, c.y, d.x, d.y}; }
                    if (ACT == 2) {
#pragma unroll
                        for (int j = 0; j < 4; ++j) { v0[j] = 0.5f * v0[j] * (1.0f + erff(v0[j] * 0.70710678f)); v1[j] = 0.5f * v1[j] * (1.0f + erff(v1[j] * 0.70710678f)); } }
                    u32x4 w; w.x = cvt_pk_bf16(v0[0], v0[1]); w.y = cvt_pk_bf16(v0[2], v0[3]); w.z = cvt_pk_bf16(v1[0], v1[1]); w.w = cvt_pk_bf16(v1[2], v1[3]);
                    *(u32x4*)(rowp + bj * HALF) = w; } }
    }
};
template <class Epi, class Sched, bool STAMP = false>
__device__ __forceinline__ void gemm_phase(PG8_LAS unsigned char* lds, const Gemm g, const Sched& S, const Epi& E, unsigned long long* stamps) {
    const int tid = tidx_(), wid = __builtin_amdgcn_readfirstlane(tid >> 6), lane = tid & 63, wr = wid >> 2, wc = wid & 3, fr = lane & 15, fq = lane >> 4;
    const int K = g.K, nt = K / BK;
    int ts_lo = 0, ts_hi = 0, nts = 0; const unsigned long long rt_entry = STAMP ? (unsigned long long)wall_clock64() : 0ull;
#define PG8_STAMP() do { if (STAMP && wid == 0 && nts < 64) { const unsigned long long _c = (unsigned long long)clock64(); \
        ts_lo = (lane == nts) ? (int)(unsigned)_c : ts_lo; ts_hi = (lane == nts) ? (int)(unsigned)(_c >> 32) : ts_hi; ++nts; } } while (0)
    PG8_STAMP();
    unsigned voffA[2], voffB[2];
#pragma unroll
    for (int i = 0; i < 2; ++i) { int R, C; stage_rc(tid * 16 + i * 8192, R, C); const int Rb = Epi::PERM ? ((R & ~31) + perm32(R & 31)) : R;
        voffA[i] = (unsigned)(R * K + C) * 2u; voffB[i] = (unsigned)(Rb * K + C) * 2u; }
    const size_t kstep = (size_t)(BK * 2);
    const size_t hstep = (size_t)HALF * K * 2;
    const size_t tstep = 2 * hstep;
    const unsigned ldsw = (unsigned)wid * 1024u;
    const int aoff = lds_byte(wr * 64 + fr, fq * 8), boff = lds_byte(wc * 32 + fr, fq * 8);
#define PG8_SA(b, h) (((b) * 2 + (h)) * HTB)
#define PG8_SB(b, h) ((4 + (b) * 2 + (h)) * HTB)
#define PG8_STAGE(bufoff, gbase, voff) do { _Pragma("unroll") for (int _i = 0; _i < 2; ++_i) \
        __builtin_amdgcn_global_load_lds((const unsigned*)((const char*)(gbase) + (voff)[_i]), (PG8_LAS unsigned*)(lds + (bufoff) + ldsw + _i * 8192), 16, 0, 0); } while (0)
#define PG8_LDA(dst, b, h) do { _Pragma("unroll") for (int m = 0; m < 4; ++m) _Pragma("unroll") for (int k = 0; k < 2; ++k) dst[m][k] = *(const PG8_LAS bf16x8*)(lds + PG8_SA(b, h) + aoff + m * 2048 + k * 1024); } while (0)
#define PG8_LDB(dst, b, h) do { _Pragma("unroll") for (int n = 0; n < 2; ++n) _Pragma("unroll") for (int k = 0; k < 2; ++k) dst[n][k] = *(const PG8_LAS bf16x8*)(lds + PG8_SB(b, h) + boff + n * 2048 + k * 1024); } while (0)
#define PG8_MMA(ai, bj, At, Bt) do { __builtin_amdgcn_s_setprio(1); _Pragma("unroll") for (int m = 0; m < 4; ++m) _Pragma("unroll") for (int n = 0; n < 2; ++n) _Pragma("unroll") for (int k = 0; k < 2; ++k) \
        acc[ai][bj][m][n] = __builtin_amdgcn_mfma_f32_16x16x32_bf16(Bt[n][k], At[m][k], acc[ai][bj][m][n], 0, 0, 0); __builtin_amdgcn_s_setprio(0); } while (0)
#define PG8_WAIT_V(n) asm volatile("s_waitcnt vmcnt(" #n ")" ::: "memory")
#define PG8_WAIT_L(n) asm volatile("s_waitcnt lgkmcnt(" #n ")" ::: "memory")
#define PG8_BAR __builtin_amdgcn_s_barrier()
#define PG8_SCHED __builtin_amdgcn_sched_barrier(0)
    Unit cur, nxt; int ui = 0;
    if (!S.next(0, cur)) return;
    f32x4 acc[2][2][4][2];
#pragma unroll
    for (int a = 0; a < 2; ++a)
#pragma unroll
        for (int b = 0; b < 2; ++b)
#pragma unroll
            for (int m = 0; m < 4; ++m)
#pragma unroll
                for (int n = 0; n < 2; ++n) acc[a][b][m][n] = (f32x4){0.f, 0.f, 0.f, 0.f};
    bf16x8 At[4][2], B0[2][2], B1[2][2];
    const char* cA = (const char*)g.A + (size_t)cur.pm * tstep; const char* cB = (const char*)g.Bt + (size_t)cur.pn * tstep;
    S.a_ready(cur);
    PG8_STAGE(PG8_SB(0, 0), cB, voffB); PG8_STAGE(PG8_SA(0, 0), cA, voffA); PG8_STAGE(PG8_SB(0, 1), cB + hstep, voffB); PG8_STAGE(PG8_SA(0, 1), cA + hstep, voffA);
    if (wr == 1) PG8_BAR;
    PG8_WAIT_V(4); PG8_BAR;
    PG8_STAGE(PG8_SB(1, 0), cB + kstep, voffB); PG8_STAGE(PG8_SA(1, 0), cA + kstep, voffA); PG8_STAGE(PG8_SB(1, 1), cB + hstep + kstep, voffB);
    PG8_WAIT_V(6); PG8_BAR;
    PG8_STAMP();
    for (;;) {
        const bool has_next = S.next(ui + 1, nxt);
        const char* nA = has_next ? (const char*)g.A + (size_t)nxt.pm * tstep : cA; const char* nB = has_next ? (const char*)g.Bt + (size_t)nxt.pn * tstep : cB;
        for (int t = 0; t < nt; t += 2) {
            const bool last = (t == nt - 2);
            const char* a1 = cA + (size_t)(t + 1) * kstep;
            const char* a2 = last ? nA : cA + (size_t)(t + 2) * kstep; const char* b2 = last ? nB : cB + (size_t)(t + 2) * kstep;
            const char* a3 = a2 + kstep; const char* b3 = b2 + kstep;
            if (last && has_next) S.a_ready(nxt);
            PG8_LDB(B0, 0, 0); PG8_SCHED; PG8_LDA(At, 0, 0); PG8_STAGE(PG8_SA(1, 1), a1 + hstep, voffA);
            PG8_WAIT_L(8); PG8_BAR; PG8_WAIT_L(0); PG8_MMA(0, 0, At, B0); PG8_BAR; PG8_SCHED;
            PG8_LDB(B1, 0, 1); PG8_STAGE(PG8_SB(0, 0), b2, voffB);
            PG8_BAR; PG8_WAIT_L(0); PG8_MMA(0, 1, At, B1); PG8_BAR;
            PG8_LDA(At, 0, 1); PG8_STAGE(PG8_SA(0, 0), a2, voffA);
            PG8_BAR; PG8_WAIT_L(0); PG8_MMA(1, 0, At, B0); PG8_BAR; PG8_SCHED;
            PG8_STAGE(PG8_SB(0, 1), b2 + hstep, voffB);
            PG8_WAIT_V(6); PG8_BAR; PG8_MMA(1, 1, At, B1); PG8_BAR;
            PG8_LDB(B0, 1, 0); PG8_SCHED; PG8_LDA(At, 1, 0); PG8_STAGE(PG8_SA(0, 1), a2 + hstep, voffA);
            PG8_WAIT_L(8); PG8_BAR; PG8_WAIT_L(0); PG8_MMA(0, 0, At, B0); PG8_BAR; PG8_SCHED;
            PG8_LDB(B1, 1, 1); PG8_STAGE(PG8_SB(1, 0), b3, voffB);
            PG8_BAR; PG8_WAIT_L(0); PG8_MMA(0, 1, At, B1); PG8_BAR;
            PG8_LDA(At, 1, 1); PG8_STAGE(PG8_SA(1, 0), a3, voffA);
            PG8_BAR; PG8_WAIT_L(0); PG8_MMA(1, 0, At, B0); PG8_BAR; PG8_SCHED;
            PG8_STAGE(PG8_SB(1, 1), b3 + hstep, voffB);
            PG8_WAIT_V(6); PG8_BAR; PG8_MMA(1, 1, At, B1); PG8_BAR;
        }
        PG8_STAMP();
        if constexpr (!Epi::AFTER_DRAIN) { E(acc, cur, wr, wc, fr, fq); S.done(cur); }
        PG8_STAMP();
        if (!has_next) break;
#pragma unroll
        for (int a = 0; a < 2; ++a)
#pragma unroll
            for (int b = 0; b < 2; ++b)
#pragma unroll
                for (int m = 0; m < 4; ++m)
#pragma unroll
                    for (int n = 0; n < 2; ++n) acc[a][b][m][n] = (f32x4){0.f, 0.f, 0.f, 0.f};
        cur = nxt; cA = nA; cB = nB; ++ui;
    }
    PG8_WAIT_V(0);
    if (wr == 0) PG8_BAR;
    PG8_BAR;
    if constexpr (Epi::AFTER_DRAIN) { E.fused(acc, cur, wr, wc, fr, fq, lds, wid, lane); S.done(cur); }
    PG8_STAMP();
    if (STAMP && wid == 0) { stamps[lane] = lane < nts ? (((unsigned long long)(unsigned)ts_hi << 32) | (unsigned)ts_lo) : 0ull;
        if (lane == 62) stamps[62] = rt_entry; if (lane == 63) stamps[63] = (unsigned long long)wall_clock64(); }
#undef PG8_STAMP
#undef PG8_SA
#undef PG8_SB
#undef PG8_STAGE
#undef PG8_LDA
#undef PG8_LDB
#undef PG8_MMA
#undef PG8_WAIT_V
#undef PG8_WAIT_L
#undef PG8_BAR
#undef PG8_SCHED
}
}
#define LAS __attribute__((address_space(3)))
#define XB_TMO      128
#define XB_XCNT(j)  (256  + 64 * (j))
#define XB_XSUB(j)  (1280 + 64 * (j))
#define XB_XGEN(j)  (2304 + 64 * (j))
#define XB_TOP      3328
#define XB_TOPGEN   3392
#define XCD_BAR_WORDS 3456
#define XB_SPIN_CAP (1u << 18)

__device__ __forceinline__ unsigned xb_ld(unsigned* p)              { return __hip_atomic_load(p, __ATOMIC_RELAXED, __HIP_MEMORY_SCOPE_AGENT); }
__device__ __forceinline__ unsigned xb_add(unsigned* p, unsigned v) { return __hip_atomic_fetch_add(p, v, __ATOMIC_RELAXED, __HIP_MEMORY_SCOPE_AGENT); }
__device__ __forceinline__ unsigned xb_xcc_id() { return (unsigned)__builtin_amdgcn_s_getreg((3 << 11) | 20) & 0xFu; }
#define XB_SPIN(cond, bar) do { unsigned _sp = 0; while (cond) { __builtin_amdgcn_s_sleep(1); \
    if ((++_sp & 255u) == 0u) { if (xb_ld(&(bar)[XB_TMO])) break; if (_sp > XB_SPIN_CAP) { atomicAdd(&(bar)[XB_TMO], 1u); break; } } } } while (0)

struct XcdBarrier {
    unsigned* bar; unsigned x;
    volatile LAS unsigned* st;
};

__device__ __forceinline__ XcdBarrier xcd_barrier_post(unsigned* bar, volatile LAS unsigned* st) {
    XcdBarrier b; b.bar = bar; b.x = xb_xcc_id(); b.st = st;
    if (threadIdx.x == 0) (void)xb_add(&bar[XB_XCNT(b.x)], 1u);
    return b;
}
__device__ __forceinline__ void xcd_barrier_complete(unsigned* bar, unsigned x, unsigned& nloc, unsigned& nx) {
    const unsigned G = gridDim.x * gridDim.y * gridDim.z;
    unsigned sum, cnt, mine, sp = 0u;
    for (;;) {
        sum = 0u; cnt = 0u; mine = 0u;
#pragma unroll
        for (unsigned j = 0; j < 16; ++j) { const unsigned c = xb_ld(&bar[XB_XCNT(j)]); sum += c; cnt += (c > 0u) ? 1u : 0u; mine = (j == x) ? c : mine; }
        if (sum == G) break;
        __builtin_amdgcn_s_sleep(1);
        if ((++sp & 255u) == 0u) { if (xb_ld(&bar[XB_TMO])) break; if (sp > XB_SPIN_CAP) { atomicAdd(&bar[XB_TMO], 1u); break; } }
    }
    nloc = mine > 0u ? mine : 1u; nx = cnt > 0u ? cnt : 1u;
}

__device__ __forceinline__ void xcd_barrier(const XcdBarrier& b) {
    asm volatile("s_waitcnt vmcnt(0)" ::: "memory");
    __syncthreads();
    if (threadIdx.x == 0) {
        unsigned* bar = b.bar;
        __builtin_amdgcn_s_waitcnt(0);
        unsigned nloc = b.st[0], nx = b.st[1];
        if (nloc == 0u) { xcd_barrier_complete(bar, b.x, nloc, nx); b.st[0] = nloc; b.st[1] = nx; }
        const unsigned old = xb_add(&bar[XB_XSUB(b.x)], 1u);
        const unsigned gen = old / nloc;
        if (old + 1u == (gen + 1u) * nloc) {
            __builtin_amdgcn_fence(__ATOMIC_RELEASE, "agent");
            asm volatile("s_waitcnt vmcnt(0)" ::: "memory");
            __builtin_amdgcn_s_sleep(127); __builtin_amdgcn_s_sleep(127);
            const unsigned og = xb_add(&bar[XB_TOP], 1u);
            const unsigned tg = og / nx;
            if (og + 1u == (tg + 1u) * nx) xb_add(&bar[XB_TOPGEN], 1u);
            else XB_SPIN(xb_ld(&bar[XB_TOPGEN]) == tg, bar);
            __builtin_amdgcn_fence(__ATOMIC_ACQUIRE, "agent");
            xb_add(&bar[XB_XGEN(b.x)], 1u);
            asm volatile("s_waitcnt vmcnt(0)" ::: "memory");
        } else {
            XB_SPIN(xb_ld(&bar[XB_XGEN(b.x)]) == gen, bar);
            __builtin_amdgcn_fence(__ATOMIC_ACQUIRE, "agent");
            asm volatile("s_waitcnt vmcnt(0)" ::: "memory");
        }
    }
    __syncthreads();
}


using pg8::bf16_t; using pg8::bf16x8; using pg8::f32x4; using pg8::u32x4; using pg8::cvt_pk_bf16;
typedef unsigned u32x2 __attribute__((ext_vector_type(2)));
#define DEVI __device__ __forceinline__

constexpr int NPR = 16384, NRV = 16512, NRP = 16640;
constexpr int LDS_BYTES = 135168;
constexpr int LDS_MISC = 131072;

constexpr size_t WS_CTL = 0;
constexpr size_t WS_WT_MOD = 32768;
constexpr size_t WS_WT_INAB = WS_WT_MOD + 25165824;
constexpr size_t WS_WT_OUTAB = WS_WT_INAB + 25165824;
constexpr size_t WS_WT_CIN = WS_WT_OUTAB + 8388608;
constexpr size_t WS_WT_GLU = WS_WT_CIN + 8388608;
constexpr size_t WS_WT_COUT = WS_WT_GLU + 4194304;
constexpr size_t WS_WT_LRU = WS_WT_COUT + 4194304;
constexpr size_t WS_SILUC = WS_WT_LRU + 1048576;
constexpr size_t WS_MOD = WS_SILUC + 524288;
constexpr size_t WS_TAIL = WS_MOD + 12582912;
constexpr size_t WS_YBUF = WS_TAIL + 1064960;
constexpr size_t WS_PROJ = WS_YBUF + 68157440;
constexpr size_t WS_UT = WS_PROJ + 204472320;
constexpr size_t WS_WB = WS_UT + 33554432;
constexpr size_t WS_QT = WS_WB + 33554432;
constexpr size_t WS_KT = WS_QT + 33554432;
constexpr size_t WS_EGL = WS_KT + 33554432;
constexpr size_t WS_WT_TAIL = WS_EGL + 8192;
constexpr size_t WS_END = WS_WT_TAIL + 65536;
constexpr size_t WS_QK = WS_WT_MOD;
constexpr size_t WS_Y2 = WS_YBUF + 34078720;

constexpr size_t O_YP = 0, O_YS = 16777216, O_PCA = O_YS + 131072, O_PLRU = O_PCA + 49152, O_PCB = O_PLRU + 16384, O_PDEL = O_PCB + 147456,
                 O_PSR = O_PDEL + 2097152, O_PSI = O_PSR + 65536, O_SCA = O_PSI + 65536, O_SLRU = O_SCA + 786432, O_SCB = O_SLRU + 262144,
                 O_SDEL = O_SCB + 2359296, O_SSR = O_SDEL + 33554432, O_SSI = O_SSR + 1048576, O_END = O_SSI + 1048576;

enum { I_XP = 0, I_XS, I_CP, I_CS, I_SCA, I_SLRU, I_SCB, I_SDEL, I_SSR, I_SSI, I_NORMW, I_MODW, I_MODB, I_ABIN, I_ABOUT, I_CAW, I_CAB, I_GXW, I_GXB, I_GAW, I_GAB, I_APAR,
       I_CBW, I_ALOG, I_DTB, I_GNW, I_CIN, I_COUT, I_ARE, I_AIM, I_BRE, I_BIM, I_CRE, I_CIM, I_S5D, I_LOGDT, I_GLUW, I_GLUB, I_FNW, N_IN };

struct Params {
  const float* in[N_IN];
  float* out;
  unsigned char* ws;
  int ph_lo, ph_hi;
};

typedef const Params __attribute__((address_space(4)))* KP;
DEVI float bf2f(unsigned v16) { return __uint_as_float(v16 << 16); }
DEVI float bflo(unsigned w) { return __uint_as_float(w << 16); }
DEVI float bfhi(unsigned w) { return __uint_as_float(w & 0xffff0000u); }
DEVI bf16_t f2bf(float f) { return (bf16_t)(cvt_pk_bf16(f, 0.f) & 0xffffu); }
DEVI float fexp_(float x) { return __builtin_amdgcn_exp2f(x * 1.4426950408889634f); }
DEVI float sigmoidf_(float x) { return __builtin_amdgcn_rcpf(1.f + fexp_(-x)); }
DEVI float siluf_(float x) { return x * __builtin_amdgcn_rcpf(1.f + fexp_(-x)); }
DEVI float softplusf_(float x) { return x > 20.f ? x : log1pf(__expf(x)); }
DEVI float geluf_(float x) { const float z = 0.7978845608028654f * (x + 0.044715f * x * x * x); const float e = fexp_(2.f * z); return x - x * __builtin_amdgcn_rcpf(1.f + e); }
DEVI void lds_barrier() { asm volatile("s_waitcnt lgkmcnt(0)" ::: "memory"); __builtin_amdgcn_s_barrier(); asm volatile("" ::: "memory"); }
DEVI float wave_sum(float v) {
#pragma unroll
  for (int o = 32; o >= 1; o >>= 1) v += __shfl_xor(v, o);
  return v;
}
DEVI void unpack8(const u32x4 w, float (&f)[8]) { f[0] = bflo(w.x); f[1] = bfhi(w.x); f[2] = bflo(w.y); f[3] = bfhi(w.y); f[4] = bflo(w.z); f[5] = bfhi(w.z); f[6] = bflo(w.w); f[7] = bfhi(w.w); }
DEVI u32x4 pack8(const float (&f)[8]) { u32x4 w; w.x = cvt_pk_bf16(f[0], f[1]); w.y = cvt_pk_bf16(f[2], f[3]); w.z = cvt_pk_bf16(f[4], f[5]); w.w = cvt_pk_bf16(f[6], f[7]); return w; }
DEVI bf16x8 as_bf16x8(const u32x4 w) { union { u32x4 u; bf16x8 b; } c; c.u = w; return c.b; }
DEVI f32x4 mfma16(bf16x8 a, bf16x8 b, f32x4 c) { return __builtin_amdgcn_mfma_f32_16x16x32_bf16(a, b, c, 0, 0, 0); }

struct EpiRes {
  static constexpr bool PERM = false, AFTER_DRAIN = false;
  const float* xp; const float* xs; float* xo; const float* gate;
  __device__ __forceinline__ void operator()(const f32x4 (&acc)[2][2][4][2], const pg8::Unit& u, int wr, int wc, int fr, int fq) const {
    const int row0 = u.pm * 256 + wr * 64 + fr, col0 = u.pn * 256 + wc * 32 + 4 * fq;
#pragma unroll
    for (int ai = 0; ai < 2; ++ai)
#pragma unroll
      for (int m = 0; m < 4; ++m) {
        const int row = row0 + ai * 128 + m * 16;
        if (row < NRV) {
          const float* xi = (row < NPR ? xp + (size_t)row * 1024 : xs + (size_t)(row - NPR) * 1024) + col0;
          const int mrow = row < NPR ? (row >> 11) : 8 + (row - NPR);
          const float* gp = gate + (size_t)mrow * 12288 + col0;
          float* op = xo + (size_t)row * 1024 + col0;
#pragma unroll
          for (int bj = 0; bj < 2; ++bj)
#pragma unroll
            for (int n = 0; n < 2; ++n) {
              const f32x4 xv = *(const f32x4*)(xi + bj * 128 + n * 16), gv = *(const f32x4*)(gp + bj * 128 + n * 16);
              *(f32x4*)(op + bj * 128 + n * 16) = xv + gv * acc[ai][bj][m][n];
            }
        }
      }
  }
};
struct EpiGlu {
  static constexpr bool PERM = true, AFTER_DRAIN = false;
  const bf16_t* y1; const bf16_t* z; bf16_t* y2; const float* bias;
  __device__ __forceinline__ void operator()(const f32x4 (&acc)[2][2][4][2], const pg8::Unit& u, int wr, int wc, int fr, int fq) const {
    const int row0 = u.pm * 256 + wr * 64 + fr, col0 = u.pn * 256 + wc * 32 + 8 * fq;
#pragma unroll
    for (int ai = 0; ai < 2; ++ai)
#pragma unroll
      for (int m = 0; m < 4; ++m) {
        const int row = row0 + ai * 128 + m * 16;
#pragma unroll
        for (int bj = 0; bj < 2; ++bj) {
          const int col = col0 + bj * 128;
          const f32x4 b0 = *(const f32x4*)(bias + col), b1 = *(const f32x4*)(bias + col + 4);
          const u32x4 yw = *(const u32x4*)(y1 + (size_t)row * 1024 + col), zw = *(const u32x4*)(z + (size_t)row * 2048 + col);
          float yf[8], zf[8], o[8]; unpack8(yw, yf); unpack8(zw, zf);
          const f32x4 a0 = acc[ai][bj][m][0] + b0, a1 = acc[ai][bj][m][1] + b1;
#pragma unroll
          for (int e = 0; e < 4; ++e) { o[e] = yf[e] * sigmoidf_(a0[e]) * siluf_(zf[e]); o[4 + e] = yf[4 + e] * sigmoidf_(a1[e]) * siluf_(zf[4 + e]); }
          *(u32x4*)(y2 + (size_t)row * 1024 + col) = pack8(o);
        }
      }
  }
};

struct TileDesc { const float* src; bf16_t* dst; int ldsrc, lddst, k0, n0; };
DEVI TileDesc prep_tile(KP p, int t) {
  TileDesc d; int tt = t;
  if (tt < 3072) { const int mat = tt / 768, r = tt % 768; d.k0 = (r / 48) * 64; d.n0 = (r % 48) * 64; d.src = p->in[I_MODW] + (size_t)mat * 1024 * 3072; d.ldsrc = 3072; d.dst = (bf16_t*)(p->ws + WS_WT_MOD) + (size_t)mat * 3072 * 1024; d.lddst = 1024; }
  else if ((tt -= 3072) < 3072) { const int mat = tt / 1536, r = tt % 1536; d.k0 = (r / 96) * 64; d.n0 = (r % 96) * 64; d.src = p->in[I_ABIN] + (size_t)mat * 1024 * 6160; d.ldsrc = 6160; d.dst = (bf16_t*)(p->ws + WS_WT_INAB) + (size_t)mat * 6144 * 1024; d.lddst = 1024; }
  else if ((tt -= 3072) < 1024) { const int mat = tt / 512, r = tt % 512; d.k0 = (r / 16) * 64; d.n0 = (r % 16) * 64; d.src = p->in[I_ABOUT] + (size_t)mat * 2048 * 1024; d.ldsrc = 1024; d.dst = (bf16_t*)(p->ws + WS_WT_OUTAB) + (size_t)mat * 1024 * 2048; d.lddst = 2048; }
  else if ((tt -= 1024) < 1024) { const int mat = tt / 512, r = tt % 512; d.k0 = (r / 32) * 64; d.n0 = (r % 32) * 64; d.src = p->in[I_CIN] + (size_t)mat * 1024 * 2048; d.ldsrc = 2048; d.dst = (bf16_t*)(p->ws + WS_WT_CIN) + (size_t)mat * 2048 * 1024; d.lddst = 1024; }
  else if ((tt -= 1024) < 512) { const int mat = tt / 256, r = tt % 256; d.k0 = (r / 16) * 64; d.n0 = (r % 16) * 64; d.src = p->in[I_COUT] + (size_t)mat * 1024 * 1024; d.ldsrc = 1024; d.dst = (bf16_t*)(p->ws + WS_WT_COUT) + (size_t)mat * 1024 * 1024; d.lddst = 1024; }
  else if ((tt -= 512) < 512) { const int mat = tt / 256, r = tt % 256; d.k0 = (r / 16) * 64; d.n0 = (r % 16) * 64; d.src = p->in[I_GLUW] + (size_t)mat * 1024 * 1024; d.ldsrc = 1024; d.dst = (bf16_t*)(p->ws + WS_WT_GLU) + (size_t)mat * 1024 * 1024; d.lddst = 1024; }
  else { tt -= 512; const int gate = tt / 64; const int r2 = tt % 64; const int mat = r2 / 4, r = r2 % 4;
    d.k0 = (r / 2) * 64; d.n0 = (r % 2) * 64; d.src = p->in[gate ? I_GAW : I_GXW] + (size_t)mat * 16384; d.ldsrc = 128;
    d.dst = (bf16_t*)(p->ws + WS_WT_LRU) + (size_t)(((mat >> 3) * 2 + gate) * 8 + (mat & 7)) * 16384; d.lddst = 128; }
  return d;
}
DEVI void phase_prep(KP p, float* lds) {
  const int tid = tidx_(), tx = tid & 15, ty = tid >> 4, nn = tid >> 3, ks = (tid & 7) * 8;
  for (int t0 = bidx_(); t0 < 9344; t0 += 4 * gdim_()) {
    float4 v[4][2];
#pragma unroll
    for (int q = 0; q < 4; ++q) { const int t = t0 + q * gdim_();
      if (t < 9344) { const TileDesc d = prep_tile(p, t);
#pragma unroll
        for (int pp = 0; pp < 2; ++pp) v[q][pp] = *(const float4*)(d.src + (size_t)(d.k0 + ty + pp * 32) * d.ldsrc + d.n0 + tx * 4); } }
#pragma unroll
    for (int q = 0; q < 4; ++q) { float* tile = lds + q * 4160;
#pragma unroll
      for (int pp = 0; pp < 2; ++pp) { const int k = ty + pp * 32; tile[k * 65 + tx * 4 + 0] = v[q][pp].x; tile[k * 65 + tx * 4 + 1] = v[q][pp].y; tile[k * 65 + tx * 4 + 2] = v[q][pp].z; tile[k * 65 + tx * 4 + 3] = v[q][pp].w; } }
    __syncthreads();
#pragma unroll
    for (int q = 0; q < 4; ++q) { const int t = t0 + q * gdim_();
      if (t < 9344) { const TileDesc d = prep_tile(p, t); const float* tile = lds + q * 4160; float f[8];
#pragma unroll
        for (int jx = 0; jx < 8; ++jx) f[jx] = tile[(ks + jx) * 65 + nn];
        *(u32x4*)(d.dst + (size_t)(d.n0 + nn) * d.lddst + d.k0 + ks) = pack8(f); } }
    __syncthreads();
  }
  { bf16_t* wtt = (bf16_t*)(p->ws + WS_WT_TAIL);
    for (int e = bidx_() * 512 + tidx_(); e < 32768; e += gdim_() * 512) { const int jj = e >> 14, cc = (e >> 10) & 15, k = e & 1023;
      wtt[e] = f2bf(p->in[I_ABIN][(size_t)jj * 1024 * 6160 + (size_t)k * 6160 + 6144 + cc]); } }
  bf16_t* sc = (bf16_t*)(p->ws + WS_SILUC);
  for (int e = bidx_() * 512 + tidx_(); e < 256 * 1024 / 4; e += gdim_() * 512) {
    const int row = e >> 8, c4 = (e & 255) * 4; float4 v = make_float4(0.f, 0.f, 0.f, 0.f);
    if (row < 8) v = *(const float4*)(p->in[I_CP] + row * 1024 + c4); else if (row < 136) v = *(const float4*)(p->in[I_CS] + (row - 8) * 1024 + c4);
    u32x2 w; w.x = cvt_pk_bf16(row < 136 ? siluf_(v.x) : 0.f, row < 136 ? siluf_(v.y) : 0.f); w.y = cvt_pk_bf16(row < 136 ? siluf_(v.z) : 0.f, row < 136 ? siluf_(v.w) : 0.f);
    *(u32x2*)(sc + row * 1024 + c4) = w;
  }
}

DEVI void norm_row2(const float* x0, const float* x1, bool two, const float (&wm)[16], const float (&sh)[16], bf16_t* h0, bf16_t* h1, int lane) {
  float4 v0[4], v1[4]; float s0 = 0.f, s1 = 0.f;
#pragma unroll
  for (int i = 0; i < 4; ++i) { v0[i] = *(const float4*)(x0 + i * 256 + lane * 4); v1[i] = two ? *(const float4*)(x1 + i * 256 + lane * 4) : make_float4(0.f, 0.f, 0.f, 0.f); }
#pragma unroll
  for (int i = 0; i < 4; ++i) { s0 += v0[i].x * v0[i].x + v0[i].y * v0[i].y + v0[i].z * v0[i].z + v0[i].w * v0[i].w; s1 += v1[i].x * v1[i].x + v1[i].y * v1[i].y + v1[i].z * v1[i].z + v1[i].w * v1[i].w; }
#pragma unroll
  for (int o = 32; o >= 1; o >>= 1) { s0 += __shfl_xor(s0, o); s1 += __shfl_xor(s1, o); }
  const float r0 = __builtin_amdgcn_rsqf(s0 * (1.f / 1024.f) + 1e-6f), r1 = __builtin_amdgcn_rsqf(s1 * (1.f / 1024.f) + 1e-6f);
#pragma unroll
  for (int i = 0; i < 4; ++i) { const int k = i * 256 + lane * 4;
    u32x2 w; w.x = cvt_pk_bf16(v0[i].x * r0 * wm[i * 4 + 0] + sh[i * 4 + 0], v0[i].y * r0 * wm[i * 4 + 1] + sh[i * 4 + 1]); w.y = cvt_pk_bf16(v0[i].z * r0 * wm[i * 4 + 2] + sh[i * 4 + 2], v0[i].w * r0 * wm[i * 4 + 3] + sh[i * 4 + 3]);
    *(u32x2*)(h0 + k) = w;
    if (two) { u32x2 w2; w2.x = cvt_pk_bf16(v1[i].x * r1 * wm[i * 4 + 0] + sh[i * 4 + 0], v1[i].y * r1 * wm[i * 4 + 1] + sh[i * 4 + 1]); w2.y = cvt_pk_bf16(v1[i].z * r1 * wm[i * 4 + 2] + sh[i * 4 + 2], v1[i].w * r1 * wm[i * 4 + 3] + sh[i * 4 + 3]);
      *(u32x2*)(h1 + k) = w2; } }
}
DEVI void norm_coefs(KP p, int layer, int mrow, int lane, float (&wm)[16], float (&sh)[16]) {
  const float* nw = p->in[I_NORMW] + layer * 1024;
  const float* md = (const float*)(p->ws + WS_MOD) + (size_t)mrow * 12288 + layer * 3072;
#pragma unroll
  for (int i = 0; i < 4; ++i) { const int k = i * 256 + lane * 4; const float4 w4 = *(const float4*)(nw + k), s4 = *(const float4*)(md + k), c4 = *(const float4*)(md + 1024 + k);
    wm[i * 4 + 0] = w4.x * (1.f + c4.x); wm[i * 4 + 1] = w4.y * (1.f + c4.y); wm[i * 4 + 2] = w4.z * (1.f + c4.z); wm[i * 4 + 3] = w4.w * (1.f + c4.w);
    sh[i * 4 + 0] = s4.x; sh[i * 4 + 1] = s4.y; sh[i * 4 + 2] = s4.z; sh[i * 4 + 3] = s4.w; }
}
DEVI void phase_norm(KP p, int layer, float* lds) {
  const int tid = tidx_(), lane = tid & 63, wave = tid >> 6;
  bf16_t* hb = (bf16_t*)(p->ws + WS_YBUF);
  float wm[16], sh[16];
  for (int gw = bidx_() * 8 + wave; gw < 2048; gw += gdim_() * 8) {
    const int r0 = gw * 8;
    norm_coefs(p, layer, r0 >> 11, lane, wm, sh);
    const float* xb = (layer == 0) ? p->in[I_XP] : p->out;
#pragma unroll 2
    for (int i = 0; i < 8; i += 2) norm_row2(xb + (size_t)(r0 + i) * 1024, xb + (size_t)(r0 + i + 1) * 1024, true, wm, sh, hb + (size_t)(r0 + i) * 1024, hb + (size_t)(r0 + i + 1) * 1024, lane);
    if (gw < 128) {
      norm_coefs(p, layer, 8 + gw, lane, wm, sh);
      const float* xs = (layer == 0) ? p->in[I_XS] + (size_t)gw * 1024 : p->out + (size_t)(NPR + gw) * 1024;
      norm_row2(xs, xs, false, wm, sh, hb + (size_t)(NPR + gw) * 1024, hb, lane);
    }
  }
}
DEVI void tail_gemm(KP p, int j) {
  const int tid = tidx_(), lane = tid & 63, wave = tid >> 6, l15 = lane & 15, lq = lane >> 4;
  const bf16_t* hb = (const bf16_t*)(p->ws + WS_YBUF);
  const bf16_t* bp = (const bf16_t*)(p->ws + WS_WT_TAIL) + (size_t)j * 16384 + l15 * 1024 + lq * 8;
  float* tl = (float*)(p->ws + WS_TAIL);
  for (int t = bidx_() * 8 + wave; t < 1032; t += gdim_() * 8) {
    const bf16_t* ap = hb + (size_t)(t * 16 + l15) * 1024 + lq * 8;
    f32x4 acc0 = (f32x4){0.f, 0.f, 0.f, 0.f}, acc1 = (f32x4){0.f, 0.f, 0.f, 0.f};
#pragma unroll 1
    for (int k0 = 0; k0 < 1024; k0 += 256) {
      u32x4 a[8], b[8];
#pragma unroll
      for (int u = 0; u < 8; ++u) { a[u] = *(const u32x4*)(ap + k0 + u * 32); b[u] = *(const u32x4*)(bp + k0 + u * 32); }
#pragma unroll
      for (int u = 0; u < 8; u += 2) { acc0 = mfma16(as_bf16x8(a[u]), as_bf16x8(b[u]), acc0); acc1 = mfma16(as_bf16x8(a[u + 1]), as_bf16x8(b[u + 1]), acc1); }
    }
    acc0 = acc0 + acc1;
#pragma unroll
    for (int r = 0; r < 4; ++r) tl[(size_t)(t * 16 + lq * 4 + r) * 16 + l15] = acc0[r];
  }
}

DEVI void lru_item(KP p, int j, int item, unsigned char* lds) {
  const int tid = tidx_(), lane = tid & 63, wave = tid >> 6;
  const bool prompt = item < 128;
  const int b = prompt ? (item >> 4) : 0, hd = prompt ? ((item >> 1) & 7) : ((item - 128) >> 1), half = item & 1;
  bf16_t* WX = (bf16_t*)lds;
  bf16_t* XA = (bf16_t*)(lds + 34816);
  float* AA = (float*)(lds + 52224);
  float* BB = (float*)(lds + 69632);
  bf16_t* RAW = (bf16_t*)(lds + 87040);
  float* CAR = (float*)(lds + 105472);
  const bf16_t* proj = (const bf16_t*)(p->ws + WS_PROJ);
  bf16_t* ybuf = (bf16_t*)(p->ws + WS_YBUF);
  { const bf16_t* wt = (const bf16_t*)(p->ws + WS_WT_LRU);
#pragma unroll
    for (int q = 0; q < 4; ++q) { const int e = tid + q * 512, gate = e >> 10, o = (e & 1023) >> 4, c8 = e & 15;
      *(u32x4*)(WX + (gate * 64 + o) * 136 + c8 * 8) = *(const u32x4*)(wt + ((size_t)((j * 2 + gate) * 8 + hd) * 128 + half * 64 + o) * 128 + c8 * 8); } }
  const int ch8 = tid & 15, rsub = tid >> 4, chb = hd * 128 + ch8 * 8;
  float cw[4][8], cb[8];
#pragma unroll
  for (int t = 0; t < 4; ++t)
#pragma unroll
    for (int e = 0; e < 8; ++e) cw[t][e] = p->in[I_CAW][(size_t)(j * 4 + t) * 1024 + chb + e];
#pragma unroll
  for (int e = 0; e < 8; ++e) cb[e] = p->in[I_CAB][j * 1024 + chb + e];
  const int rt = wave >> 1, chh = wave & 1, l15 = lane & 15, lq = lane >> 4;
  float gxb[2], gab[2], spv[2];
#pragma unroll
  for (int c2 = 0; c2 < 2; ++c2) { const int gch = hd * 128 + half * 64 + chh * 32 + c2 * 16 + l15;
    gxb[c2] = p->in[I_GXB][j * 1024 + gch]; gab[c2] = p->in[I_GAB][j * 1024 + gch]; spv[c2] = softplusf_(-p->in[I_APAR][j * 1024 + gch]); }
  const int sch = hd * 128 + half * 64 + lane;
  float hcar = 0.f;
  const int ntiles = prompt ? 32 : 2;
  u32x4 pre[3];
  if (prompt) {
#pragma unroll
    for (int q = 0; q < 3; ++q) { const int e = tid + q * 512, row = e >> 4, c8 = e & 15, t = row - 3; pre[q] = (u32x4){0u, 0u, 0u, 0u};
      if (e < 1072 && t >= 0) pre[q] = *(const u32x4*)(proj + (size_t)(b * 2048 + t) * 6144 + hd * 128 + c8 * 8); }
  }
  for (int tile = 0; tile < ntiles; ++tile) {
    bf16_t zav[8];
#pragma unroll
    for (int i = 0; i < 8; ++i) { const size_t grow = prompt ? (size_t)(b * 2048 + tile * 64 + wave * 8 + i) : (size_t)(NPR + tile * 64 + wave * 8 + i); zav[i] = proj[grow * 6144 + 1024 + sch]; }
    if (prompt) {
#pragma unroll
      for (int q = 0; q < 3; ++q) { const int e = tid + q * 512; if (e < 1072) *(u32x4*)(RAW + (e >> 4) * 136 + (e & 15) * 8) = pre[q]; }
      if (tile + 1 < ntiles) {
#pragma unroll
        for (int q = 0; q < 3; ++q) { const int e = tid + q * 512, row = e >> 4, c8 = e & 15, t = (tile + 1) * 64 + row - 3;
          if (e < 1072) pre[q] = *(const u32x4*)(proj + (size_t)(b * 2048 + t) * 6144 + hd * 128 + c8 * 8); }
      }
      lds_barrier();
#pragma unroll
      for (int pp = 0; pp < 2; ++pp) {
        const int i = rsub + pp * 32; float acc[8];
#pragma unroll
        for (int e = 0; e < 8; ++e) acc[e] = cb[e];
#pragma unroll
        for (int tap = 0; tap < 4; ++tap) { float xf[8]; unpack8(*(const u32x4*)(RAW + (i + tap) * 136 + ch8 * 8), xf);
#pragma unroll
          for (int e = 0; e < 8; ++e) acc[e] += cw[tap][e] * xf[e]; }
        *(u32x4*)(XA + i * 136 + ch8 * 8) = pack8(acc);
      }
      if (tile == 31 && half == 0 && tid < 48) { const int r3 = tid >> 4, c8 = tid & 15; float xf[8]; unpack8(*(const u32x4*)(RAW + (64 + r3) * 136 + c8 * 8), xf);
        float* o = p->out + O_PCA + (size_t)((j * 8 + b) * 3 + r3) * 1024 + hd * 128 + c8 * 8;
        *(float4*)o = make_float4(xf[0], xf[1], xf[2], xf[3]); *(float4*)(o + 4) = make_float4(xf[4], xf[5], xf[6], xf[7]); }
    } else {
#pragma unroll
      for (int pp = 0; pp < 2; ++pp) {
        const int i = rsub + pp * 32; float acc[8], x3[8];
#pragma unroll
        for (int e = 0; e < 8; ++e) acc[e] = cb[e];
        const int brow = tile * 64 + i;
        const float* st = p->in[I_SCA] + (size_t)((j * 128 + brow) * 3) * 1024 + chb;
        float* so = p->out + O_SCA + (size_t)((j * 128 + brow) * 3) * 1024 + chb;
#pragma unroll
        for (int tap = 0; tap < 3; ++tap) { const float4 s0 = *(const float4*)(st + tap * 1024), s1 = *(const float4*)(st + tap * 1024 + 4);
          const float xf[8] = {s0.x, s0.y, s0.z, s0.w, s1.x, s1.y, s1.z, s1.w};
#pragma unroll
          for (int e = 0; e < 8; ++e) acc[e] += cw[tap][e] * xf[e];
          if (tap >= 1 && half == 0) { *(float4*)(so + (tap - 1) * 1024) = s0; *(float4*)(so + (tap - 1) * 1024 + 4) = s1; } }
        const u32x4 w = *(const u32x4*)(proj + (size_t)(NPR + brow) * 6144 + chb); unpack8(w, x3);
#pragma unroll
        for (int e = 0; e < 8; ++e) acc[e] += cw[3][e] * x3[e];
        if (half == 0) { *(float4*)(so + 2 * 1024) = make_float4(x3[0], x3[1], x3[2], x3[3]); *(float4*)(so + 2 * 1024 + 4) = make_float4(x3[4], x3[5], x3[6], x3[7]); }
        *(u32x4*)(XA + i * 136 + ch8 * 8) = pack8(acc);
      }
    }
    lds_barrier();
    f32x4 accx[2], acca[2];
#pragma unroll
    for (int c2 = 0; c2 < 2; ++c2) { accx[c2] = (f32x4){0.f, 0.f, 0.f, 0.f}; acca[c2] = (f32x4){0.f, 0.f, 0.f, 0.f}; }
#pragma unroll
    for (int kk = 0; kk < 4; ++kk) {
      const bf16x8 a = *(const bf16x8*)(XA + (rt * 16 + l15) * 136 + lq * 8 + kk * 32);
#pragma unroll
      for (int c2 = 0; c2 < 2; ++c2) {
        const bf16x8 bx = *(const bf16x8*)(WX + (chh * 32 + c2 * 16 + l15) * 136 + lq * 8 + kk * 32);
        const bf16x8 ba = *(const bf16x8*)(WX + (64 + chh * 32 + c2 * 16 + l15) * 136 + lq * 8 + kk * 32);
        accx[c2] = mfma16(a, bx, accx[c2]); acca[c2] = mfma16(a, ba, acca[c2]);
      }
    }
#pragma unroll
    for (int c2 = 0; c2 < 2; ++c2)
#pragma unroll
      for (int r = 0; r < 4; ++r) {
        const int row = rt * 16 + lq * 4 + r, oc = chh * 32 + c2 * 16 + l15;
        const float gx = sigmoidf_(accx[c2][r] + gxb[c2]), ga = sigmoidf_(acca[c2][r] + gab[c2]);
        const float log_a = -8.f * ga * spv[c2];
        const float a = fexp_(log_a);
        float mult = __builtin_amdgcn_sqrtf(fmaxf(1.f - a * a, 0.f));
        if (prompt && tile == 0 && row == 0) mult = 1.f;
        const float xv = bf2f(XA[row * 136 + half * 64 + oc]);
        AA[row * 68 + oc] = a; BB[row * 68 + oc] = mult * gx * xv;
      }
    lds_barrier();
    float hl[8], pc[8];
    { float h = 0.f, P = 1.f;
#pragma unroll
      for (int i = 0; i < 8; ++i) { const float a = AA[(wave * 8 + i) * 68 + lane], bv = BB[(wave * 8 + i) * 68 + lane];
        if (prompt) { h = a * h + bv; P *= a; hl[i] = h; pc[i] = P; } else { hl[i] = bv; pc[i] = a; } }
      CAR[(wave * 64 + lane) * 2] = P; CAR[(wave * 64 + lane) * 2 + 1] = h; }
    lds_barrier();
    float cin = 0.f;
    if (prompt) { float c = hcar;
#pragma unroll
      for (int s = 0; s < 8; ++s) { const float Ps = CAR[(s * 64 + lane) * 2], Es = CAR[(s * 64 + lane) * 2 + 1]; if (s == wave) cin = c; c = Ps * c + Es; }
      hcar = c; }
#pragma unroll
    for (int i = 0; i < 8; ++i) {
      const int rowl = tile * 64 + wave * 8 + i;
      float hv;
      if (prompt) hv = hl[i] + pc[i] * cin;
      else { const float h0 = p->in[I_SLRU][(size_t)(j * 128 + rowl) * 1024 + sch]; hv = pc[i] * h0 + hl[i]; p->out[O_SLRU + (size_t)(j * 128 + rowl) * 1024 + sch] = hv; }
      const size_t grow = prompt ? (size_t)(b * 2048 + rowl) : (size_t)(NPR + rowl);
      ybuf[grow * 2048 + sch] = f2bf(hv * siluf_(bf2f(zav[i])));
    }
  }
  if (prompt && wave == 0) p->out[O_PLRU + (size_t)(j * 8 + b) * 1024 + sch] = hcar;
}

DEVI void gdn_prep_item(KP p, int j, int cid, unsigned char* lds) {
  const int tid = tidx_(), lane = tid & 63, wave = tid >> 6;
  const int b = cid >> 8, h = (cid >> 5) & 7, c = cid & 31;
  const int row0 = b * 2048 + c * 64;
  bf16_t* QN = (bf16_t*)lds; bf16_t* KN = (bf16_t*)(lds + 17408); bf16_t* VN = (bf16_t*)(lds + 34816);
  float* AM = (float*)(lds + 52224); float* GC = (float*)(lds + 69632); float* BETA = (float*)(lds + 69888); float* BEG = (float*)(lds + 70144);
  const bf16_t* proj = (const bf16_t*)(p->ws + WS_PROJ);
  const float* tl = (const float*)(p->ws + WS_TAIL);
  if (wave == 0) {
    const float* t = tl + (size_t)(row0 + lane) * 16;
    float g = -fexp_(p->in[I_ALOG][j * 8 + h]) * softplusf_(t[8 + h] + p->in[I_DTB][j * 8 + h]);
    const float beta = sigmoidf_(t[h]);
#pragma unroll
    for (int o = 1; o < 64; o <<= 1) { const float v = __shfl_up(g, o); if (lane >= o) g += v; }
    GC[lane] = g; BETA[lane] = beta; BEG[lane] = beta * fexp_(g);
  }
  bf16_t* RAWB = (bf16_t*)(lds + 70656);
  bf16_t* AMB = (bf16_t*)(lds + 70656);
  bf16_t* XT = (bf16_t*)(lds + 79872);
  float* CORR = (float*)lds;
  float* CW = (float*)(lds + 123184);
  {
    u32x4 rv[7];
#pragma unroll
    for (int q = 0; q < 7; ++q) { const int e = tid + 512 * q, row = e / 48, c16 = e - row * 48, tt = c * 64 + row - 3; rv[q] = (u32x4){0u, 0u, 0u, 0u};
      if (e < 3216 && tt >= 0) rv[q] = *(const u32x4*)(proj + (size_t)(b * 2048 + tt) * 6144 + 2048 + (c16 >> 4) * 1024 + h * 128 + (c16 & 15) * 8); }
    float4 wv = make_float4(0.f, 0.f, 0.f, 0.f);
    if (tid < 384) { const int tap = tid / 96, lc = (tid - tap * 96) * 4; wv = *(const float4*)(p->in[I_CBW] + (size_t)(j * 4 + tap) * 3072 + (lc >> 7) * 1024 + h * 128 + (lc & 127)); }
#pragma unroll
    for (int q = 0; q < 7; ++q) { const int e = tid + 512 * q, row = e / 48, c16 = e - row * 48; if (e < 3216) *(u32x4*)(RAWB + row * 392 + c16 * 8) = rv[q]; }
    if (tid < 384) { const int tap = tid / 96, lc = (tid - tap * 96) * 4; *(float4*)(CW + tap * 384 + lc) = wv; }
  }
  lds_barrier();
  if (c == 31 && tid < 144) { const int r3 = tid / 48, c16 = tid - r3 * 48; float xf[8]; unpack8(*(const u32x4*)(RAWB + (64 + r3) * 392 + c16 * 8), xf);
    float* o = p->out + O_PCB + (size_t)((j * 8 + b) * 3 + r3) * 3072 + (c16 >> 4) * 1024 + h * 128 + (c16 & 15) * 8;
    *(float4*)o = make_float4(xf[0], xf[1], xf[2], xf[3]); *(float4*)(o + 4) = make_float4(xf[4], xf[5], xf[6], xf[7]); }
#pragma unroll 2
  for (int pi = 0; pi < 6; ++pi) {
    const int pair = tid + 512 * pi, part = pair >> 10, rem = pair & 1023, i = rem >> 4, cgp = rem & 15;
    float acc[8];
#pragma unroll
    for (int e = 0; e < 8; ++e) acc[e] = 0.f;
#pragma unroll
    for (int tap = 0; tap < 4; ++tap) { float xf[8]; unpack8(*(const u32x4*)(RAWB + (i + tap) * 392 + part * 128 + cgp * 8), xf);
      const float4 w0 = *(const float4*)(CW + tap * 384 + part * 128 + cgp * 8), w1 = *(const float4*)(CW + tap * 384 + part * 128 + cgp * 8 + 4);
      acc[0] += w0.x * xf[0]; acc[1] += w0.y * xf[1]; acc[2] += w0.z * xf[2]; acc[3] += w0.w * xf[3];
      acc[4] += w1.x * xf[4]; acc[5] += w1.y * xf[5]; acc[6] += w1.z * xf[6]; acc[7] += w1.w * xf[7]; }
    float ss = 0.f;
#pragma unroll
    for (int e = 0; e < 8; ++e) { acc[e] = siluf_(acc[e]); ss += acc[e] * acc[e]; }
    ss += __shfl_xor(ss, 1); ss += __shfl_xor(ss, 2); ss += __shfl_xor(ss, 4); ss += __shfl_xor(ss, 8);
    float scl = 1.f;
    if (part == 0) scl = __builtin_amdgcn_rsqf(ss + 1e-6f) * 0.08838834764831845f; else if (part == 1) scl = __builtin_amdgcn_rsqf(ss + 1e-6f);
#pragma unroll
    for (int e = 0; e < 8; ++e) acc[e] *= scl;
    bf16_t* dstp = part == 0 ? QN : (part == 1 ? KN : VN);
    *(u32x4*)(dstp + i * 136 + cgp * 8) = pack8(acc);
  }
  lds_barrier();
  {
    const int rt = wave >> 1, ctp = (wave & 1) * 2, l15 = lane & 15, lq = lane >> 4;
    f32x4 kka[2], qka[2];
#pragma unroll
    for (int c2 = 0; c2 < 2; ++c2) { kka[c2] = (f32x4){0.f, 0.f, 0.f, 0.f}; qka[c2] = (f32x4){0.f, 0.f, 0.f, 0.f}; }
#pragma unroll
    for (int kk = 0; kk < 4; ++kk) {
      const bf16x8 ak = *(const bf16x8*)(KN + (rt * 16 + l15) * 136 + lq * 8 + kk * 32);
      const bf16x8 aq = *(const bf16x8*)(QN + (rt * 16 + l15) * 136 + lq * 8 + kk * 32);
#pragma unroll
      for (int c2 = 0; c2 < 2; ++c2) { const bf16x8 bk = *(const bf16x8*)(KN + ((ctp + c2) * 16 + l15) * 136 + lq * 8 + kk * 32);
        kka[c2] = mfma16(ak, bk, kka[c2]); qka[c2] = mfma16(aq, bk, qka[c2]); }
    }
    bf16_t* qkg = (bf16_t*)(p->ws + WS_QK) + (size_t)cid * 4096;
#pragma unroll
    for (int c2 = 0; c2 < 2; ++c2)
#pragma unroll
      for (int r = 0; r < 4; ++r) {
        const int i = rt * 16 + lq * 4 + r, jj = (ctp + c2) * 16 + l15;
        const float dec = fexp_(fminf(GC[i] - GC[jj], 0.f));
        const float aval = (i > jj) ? BETA[i] * kka[c2][r] * dec : 0.f;
        AM[i * 68 + jj] = aval; AMB[i * 72 + jj] = f2bf(aval);
        qkg[(((i >> 4) * 2 + (jj >> 5)) * 64 + ((jj & 31) >> 3) * 16 + (i & 15)) * 8 + (jj & 7)] = f2bf((i >= jj) ? qka[c2][r] * dec : 0.f);
      }
  }
  lds_barrier();
  const int cc = tid & 255;
  const bf16_t* rsrc = (cc < 128) ? (VN + cc) : (KN + (cc - 128));
  const float* rfac = (cc < 128) ? BETA : BEG;
#pragma unroll
  for (int bi = 0; bi < 4; ++bi) {
    if (bi > 0) {
      const int l15 = lane & 15, lq = lane >> 4;
#pragma unroll
      for (int n2 = 0; n2 < 2; ++n2) { const int nt = wave * 2 + n2; f32x4 acc = (f32x4){0.f, 0.f, 0.f, 0.f};
#pragma unroll
        for (int kk = 0; kk < (bi * 16 + 31) / 32; ++kk) { const int k0 = lq * 8 + kk * 32; const bool valid = k0 < bi * 16;
          u32x4 av = *(const u32x4*)(AMB + (bi * 16 + l15) * 72 + k0), bv = *(const u32x4*)(XT + (nt * 16 + l15) * 72 + k0);
          if (!valid) { av = (u32x4){0u, 0u, 0u, 0u}; bv = (u32x4){0u, 0u, 0u, 0u}; }
          acc = mfma16(as_bf16x8(av), as_bf16x8(bv), acc); }
#pragma unroll
        for (int r = 0; r < 4; ++r) CORR[(lq * 4 + r) * 260 + nt * 16 + l15] = acc[r]; }
      lds_barrier();
    }
    if (tid < 256) {
      float xb[16], rh[16];
#pragma unroll
      for (int ii = 0; ii < 16; ++ii) { const int i = bi * 16 + ii; rh[ii] = bf2f(rsrc[i * 136]) * rfac[i]; if (bi > 0) rh[ii] -= CORR[ii * 260 + cc]; }
#pragma unroll
      for (int rg = 0; rg < 4; ++rg) {
        f32x4 a[4][4];
#pragma unroll
        for (int q = 0; q < 4; ++q)
#pragma unroll
          for (int g4 = 0; g4 <= rg; ++g4) a[q][g4] = *(const f32x4*)(AM + (bi * 16 + rg * 4 + q) * 68 + bi * 16 + g4 * 4);
#pragma unroll
        for (int q = 0; q < 4; ++q) { const int ii = rg * 4 + q; float s = rh[ii];
#pragma unroll
          for (int jj = 0; jj < ii; ++jj) s -= a[q][jj >> 2][jj & 3] * xb[jj];
          xb[ii] = s; }
        asm volatile("" : "+v"(xb[rg * 4 + 3]) :: "memory");
      }
      u32x4 w0, w1;
      w0.x = cvt_pk_bf16(xb[0], xb[1]); w0.y = cvt_pk_bf16(xb[2], xb[3]); w0.z = cvt_pk_bf16(xb[4], xb[5]); w0.w = cvt_pk_bf16(xb[6], xb[7]);
      w1.x = cvt_pk_bf16(xb[8], xb[9]); w1.y = cvt_pk_bf16(xb[10], xb[11]); w1.z = cvt_pk_bf16(xb[12], xb[13]); w1.w = cvt_pk_bf16(xb[14], xb[15]);
      if (bi < 3) { *(u32x4*)(XT + cc * 72 + bi * 16) = w0; *(u32x4*)(XT + cc * 72 + bi * 16 + 8) = w1; }
      if (cc < 128) {
        bf16_t* ut = (bf16_t*)(p->ws + WS_UT) + (size_t)cid * 8192 + cc * 64 + bi * 16;
        *(u32x4*)ut = w0; *(u32x4*)(ut + 8) = w1;
      } else {
        const int dk = cc - 128;
        bf16_t* wb = (bf16_t*)(p->ws + WS_WB) + (size_t)cid * 8192 + ((bi * 4 + (dk >> 5)) * 64 + ((dk & 31) >> 3) * 16) * 8 + (dk & 7);
#pragma unroll
        for (int ii = 0; ii < 16; ++ii) wb[ii * 8] = f2bf(xb[ii]);
      }
    } else if (bi == 0) {
      const int t2 = tid - 256;
      { const int i = t2 >> 2, dseg = (t2 & 3) * 32; const float eg = fexp_(GC[i]);
        bf16_t* qt = (bf16_t*)(p->ws + WS_QT) + (size_t)cid * 8192 + (((i >> 4) * 4 + (t2 & 3)) * 64 + (i & 15)) * 8;
#pragma unroll
        for (int s = 0; s < 4; ++s) { float f[8]; unpack8(*(const u32x4*)(QN + i * 136 + dseg + s * 8), f);
#pragma unroll
          for (int e = 0; e < 8; ++e) f[e] *= eg;
          *(u32x4*)(qt + s * 128) = pack8(f); } }
      { const int d = t2 >> 1, iseg = (t2 & 1) * 32; const float gl = GC[63];
        bf16_t* kt = (bf16_t*)(p->ws + WS_KT) + (size_t)cid * 8192 + (((d >> 4) * 2 + (t2 & 1)) * 64 + (d & 15)) * 8;
#pragma unroll
        for (int s = 0; s < 4; ++s) { float f[8];
#pragma unroll
          for (int e = 0; e < 8; ++e) { const int i = iseg + s * 8 + e; f[e] = bf2f(KN[i * 136 + d]) * fexp_(gl - GC[i]); }
          *(u32x4*)(kt + s * 128) = pack8(f); } }
      if (t2 == 0) ((float*)(p->ws + WS_EGL))[cid] = fexp_(GC[63]);
    }
    if (bi < 3) lds_barrier();
  }
}

DEVI void gdn_decode_item(KP p, int j, int item, unsigned char* lds) {
  const int tid = tidx_(), lane = tid & 63, wave = tid >> 6;
  const int b = item >> 3, h = item & 7;
  const size_t row = NPR + b;
  float* QKV = (float*)lds; float* RED = (float*)(lds + 1536); float* PART = (float*)(lds + 2048);
  const bf16_t* proj = (const bf16_t*)(p->ws + WS_PROJ);
  const int dv4 = tid & 31, dkq = tid >> 5;
  const float* S0 = p->in[I_SDEL] + (size_t)((j * 128 + b) * 8 + h) * 16384;
  float4 s[8];
#pragma unroll
  for (int r = 0; r < 8; ++r) s[r] = *(const float4*)(S0 + (dkq * 8 + r) * 128 + dv4 * 4);
  const float* t = (const float*)(p->ws + WS_TAIL) + row * 16;
  const float traw_a = t[8 + h], traw_b = t[h], alog = p->in[I_ALOG][j * 8 + h], dtb = p->in[I_DTB][j * 8 + h];
  if (tid < 384) {
    const int part = tid >> 7, ch = tid & 127, col = part * 1024 + h * 128 + ch;
    const float* st = p->in[I_SCB] + (size_t)((j * 128 + b) * 3) * 3072 + col;
    const float x0 = st[0], x1 = st[3072], x2 = st[6144], x3 = bf2f(proj[row * 6144 + 2048 + col]);
    const float* cw = p->in[I_CBW] + (size_t)(j * 4) * 3072 + col;
    const float val = siluf_(cw[0] * x0 + cw[3072] * x1 + cw[6144] * x2 + cw[9216] * x3);
    float* so = p->out + O_SCB + (size_t)((j * 128 + b) * 3) * 3072 + col;
    so[0] = x1; so[3072] = x2; so[6144] = x3;
    QKV[tid] = val;
    const float ss = wave_sum(val * val);
    if (lane == 0) RED[wave] = ss;
  }
  lds_barrier();
  const float rq = __builtin_amdgcn_rsqf(RED[0] + RED[1] + 1e-6f) * 0.08838834764831845f, rk = __builtin_amdgcn_rsqf(RED[2] + RED[3] + 1e-6f);
  const float g = -fexp_(alog) * softplusf_(traw_a + dtb);
  const float beta = sigmoidf_(traw_b), eg = fexp_(g);
  float* S1 = p->out + O_SDEL + (size_t)((j * 128 + b) * 8 + h) * 16384;
  float4 pt = make_float4(0.f, 0.f, 0.f, 0.f);
#pragma unroll
  for (int r = 0; r < 8; ++r) { const int dk = dkq * 8 + r; const float kd = QKV[128 + dk] * rk;
    pt.x += s[r].x * kd; pt.y += s[r].y * kd; pt.z += s[r].z * kd; pt.w += s[r].w * kd; }
  *(float4*)(PART + dkq * 128 + dv4 * 4) = pt;
  lds_barrier();
  float4 kv = make_float4(0.f, 0.f, 0.f, 0.f);
#pragma unroll
  for (int q = 0; q < 16; ++q) { const float4 v = *(const float4*)(PART + q * 128 + dv4 * 4); kv.x += v.x; kv.y += v.y; kv.z += v.z; kv.w += v.w; }
  const float4 vv = *(const float4*)(QKV + 256 + dv4 * 4);
  float4 vn; vn.x = beta * (vv.x - eg * kv.x); vn.y = beta * (vv.y - eg * kv.y); vn.z = beta * (vv.z - eg * kv.z); vn.w = beta * (vv.w - eg * kv.w);
  lds_barrier();
  float4 po = make_float4(0.f, 0.f, 0.f, 0.f);
#pragma unroll
  for (int r = 0; r < 8; ++r) { const int dk = dkq * 8 + r; const float kd = QKV[128 + dk] * rk, qd = QKV[dk] * rq;
    float4 n; n.x = eg * s[r].x + kd * vn.x; n.y = eg * s[r].y + kd * vn.y; n.z = eg * s[r].z + kd * vn.z; n.w = eg * s[r].w + kd * vn.w;
    *(float4*)(S1 + dk * 128 + dv4 * 4) = n;
    po.x += n.x * qd; po.y += n.y * qd; po.z += n.z * qd; po.w += n.w * qd; }
  *(float4*)(PART + dkq * 128 + dv4 * 4) = po;
  lds_barrier();
  float o = 0.f;
  if (tid < 128) {
#pragma unroll
    for (int q = 0; q < 16; ++q) o += PART[q * 128 + tid];
    const float ss = wave_sum(o * o);
    if (lane == 0) RED[8 + wave] = ss;
  }
  lds_barrier();
  if (tid < 128) {
    const float rinv = __builtin_amdgcn_rsqf((RED[8] + RED[9]) * (1.f / 128.f) + 1e-6f);
    const float zb = bf2f(proj[row * 6144 + 5120 + h * 128 + tid]);
    ((bf16_t*)(p->ws + WS_YBUF))[row * 2048 + 1024 + h * 128 + tid] = f2bf(o * rinv * p->in[I_GNW][j * 128 + tid] * siluf_(zb));
  }
}

DEVI void phase_mixprep(KP p, int layer, unsigned char* lds, int ph, int submask) {
  const int j = layer >> 1;
  unsigned* ctr = (unsigned*)(p->ws + WS_CTL) + 4096 + ph;
  int* slot = (int*)(lds + LDS_MISC);
  const bool lead = tidx_() == 0;
  int nxt = 0; if (lead) nxt = (int)atomicAdd(ctr, 1u);
  for (;;) {
    if (lead) *slot = nxt;
    lds_barrier();
    const int it = *slot;
    lds_barrier();
    if (it >= 3216) break;
    if (lead) nxt = (int)atomicAdd(ctr, 1u);
    if (it < 144) { if (submask & 1) lru_item(p, j, it, lds); }
    else if (it < 2192) { if (submask & 2) gdn_prep_item(p, j, it - 144, lds); }
    else { if (submask & 4) gdn_decode_item(p, j, it - 2192, lds); }
  }
}

struct GdnFrags { u32x4 wf[4], qf[4], qkf[2], ktf[2][2]; u32x2 uf; float egl; };
DEVI void gdn_load(GdnFrags& f, KP p, int cid, int s, int rt, int ct, int l15, int lq) {
  const bf16_t* wb = (const bf16_t*)(p->ws + WS_WB) + (size_t)cid * 8192;
  const bf16_t* qt = (const bf16_t*)(p->ws + WS_QT) + (size_t)cid * 8192;
  const bf16_t* kt = (const bf16_t*)(p->ws + WS_KT) + (size_t)cid * 8192;
  const bf16_t* qk = (const bf16_t*)(p->ws + WS_QK) + (size_t)cid * 4096;
  const bf16_t* ut = (const bf16_t*)(p->ws + WS_UT) + (size_t)cid * 8192;
  const int ln = lq * 16 + l15;
#pragma unroll
  for (int kk = 0; kk < 4; ++kk) { f.wf[kk] = *(const u32x4*)(wb + ((rt * 4 + kk) * 64 + ln) * 8); f.qf[kk] = *(const u32x4*)(qt + ((rt * 4 + kk) * 64 + ln) * 8); }
#pragma unroll
  for (int kk = 0; kk < 2; ++kk) { f.qkf[kk] = *(const u32x4*)(qk + ((rt * 2 + kk) * 64 + ln) * 8);
#pragma unroll
    for (int d2 = 0; d2 < 2; ++d2) f.ktf[d2][kk] = *(const u32x4*)(kt + (((rt * 2 + d2) * 2 + kk) * 64 + ln) * 8); }
  f.uf = *(const u32x2*)(ut + (s * 32 + ct * 16 + l15) * 64 + rt * 16 + lq * 4);
  f.egl = ((const float*)(p->ws + WS_EGL))[cid];
}
DEVI void phase_gdnseq(KP p, int layer, unsigned char* lds) {
  const int tid = tidx_(), lane = tid & 63, wave = tid >> 6;
  const int j = layer >> 1, rt = wave >> 1, ct = wave & 1, l15 = lane & 15, lq = lane >> 4;
  bf16_t* ST = (bf16_t*)lds;
  bf16_t* VT = (bf16_t*)(lds + 8704);
  bf16_t* ybuf = (bf16_t*)(p->ws + WS_YBUF);
  unsigned dsum = 0u;
  for (int item = bidx_(); item < 256; item += gdim_()) {
    const int xcd = item & 7, idx = item >> 3, bh = xcd * 8 + (idx >> 2), s = idx & 3, b = bh >> 3, h = bh & 7;
    __syncthreads();
    for (int e = tid; e < 32 * 136 / 2; e += 512) ((unsigned*)ST)[e] = 0u;
    f32x4 sacc[2]; sacc[0] = (f32x4){0.f, 0.f, 0.f, 0.f}; sacc[1] = (f32x4){0.f, 0.f, 0.f, 0.f};
    GdnFrags nx; gdn_load(nx, p, bh * 32, s, rt, ct, l15, lq);
    __syncthreads();
    unsigned dprev = 0u; f32x4 oprev = (f32x4){0.f, 0.f, 0.f, 0.f};
    for (int c = 0; c < 32; ++c) {
      const GdnFrags cu = nx;
      if (c > 0) {
        bf16_t* yo = ybuf + (size_t)(b * 2048 + (c - 1) * 64 + rt * 16 + lq * 4) * 2048 + 1024 + h * 128 + s * 32 + ct * 16 + l15;
#pragma unroll
        for (int r = 0; r < 4; ++r) yo[(size_t)r * 2048] = f2bf(oprev[r]);
        asm volatile("" ::: "memory");
      }
      if (c + 1 < 32) gdn_load(nx, p, bh * 32 + c + 1, s, rt, ct, l15, lq);
      dsum += dprev;
      if (c + 3 < 32 && tid < 480) {
        const size_t cid3 = (size_t)(bh * 32 + c + 3); const unsigned char* src;
        if (tid < 128) src = p->ws + WS_WB + cid3 * 16384 + (size_t)tid * 128;
        else if (tid < 256) src = p->ws + WS_QT + cid3 * 16384 + (size_t)(tid - 128) * 128;
        else if (tid < 384) src = p->ws + WS_KT + cid3 * 16384 + (size_t)(tid - 256) * 128;
        else if (tid < 448) src = p->ws + WS_QK + cid3 * 8192 + (size_t)(tid - 384) * 128;
        else src = p->ws + WS_UT + cid3 * 16384 + (size_t)s * 4096 + (size_t)(tid - 448) * 128;
        dprev = *(const volatile unsigned*)src;
      }
      f32x4 wsa = (f32x4){0.f, 0.f, 0.f, 0.f}, oa = (f32x4){0.f, 0.f, 0.f, 0.f};
#pragma unroll
      for (int kk = 0; kk < 4; ++kk) { const bf16x8 sb = *(const bf16x8*)(ST + (ct * 16 + l15) * 136 + lq * 8 + kk * 32);
        wsa = mfma16(as_bf16x8(cu.wf[kk]), sb, wsa); oa = mfma16(as_bf16x8(cu.qf[kk]), sb, oa); }
      { const float u0 = bflo(cu.uf.x), u1 = bfhi(cu.uf.x), u2 = bflo(cu.uf.y), u3 = bfhi(cu.uf.y);
        u32x2 w; w.x = cvt_pk_bf16(u0 - wsa[0], u1 - wsa[1]); w.y = cvt_pk_bf16(u2 - wsa[2], u3 - wsa[3]);
        *(u32x2*)(VT + (ct * 16 + l15) * 72 + rt * 16 + lq * 4) = w; }
      lds_barrier();
      bf16x8 vb[2];
#pragma unroll
      for (int kk = 0; kk < 2; ++kk) vb[kk] = *(const bf16x8*)(VT + (ct * 16 + l15) * 72 + lq * 8 + kk * 32);
#pragma unroll
      for (int kk = 0; kk < 2; ++kk) oa = mfma16(as_bf16x8(cu.qkf[kk]), vb[kk], oa);
#pragma unroll
      for (int d2 = 0; d2 < 2; ++d2) { sacc[d2] = sacc[d2] * cu.egl;
#pragma unroll
        for (int kk = 0; kk < 2; ++kk) sacc[d2] = mfma16(as_bf16x8(cu.ktf[d2][kk]), vb[kk], sacc[d2]); }
      oprev = oa;
#pragma unroll
      for (int d2 = 0; d2 < 2; ++d2) { u32x2 w; w.x = cvt_pk_bf16(sacc[d2][0], sacc[d2][1]); w.y = cvt_pk_bf16(sacc[d2][2], sacc[d2][3]);
        *(u32x2*)(ST + (ct * 16 + l15) * 136 + (rt * 2 + d2) * 16 + lq * 4) = w; }
      lds_barrier();
    }
    { bf16_t* yo = ybuf + (size_t)(b * 2048 + 31 * 64 + rt * 16 + lq * 4) * 2048 + 1024 + h * 128 + s * 32 + ct * 16 + l15;
#pragma unroll
      for (int r = 0; r < 4; ++r) yo[(size_t)r * 2048] = f2bf(oprev[r]); }
    float* pd = p->out + O_PDEL + (size_t)((j * 8 + b) * 8 + h) * 16384;
#pragma unroll
    for (int d2 = 0; d2 < 2; ++d2)
#pragma unroll
      for (int r = 0; r < 4; ++r) pd[(size_t)((rt * 2 + d2) * 16 + lq * 4 + r) * 128 + s * 32 + ct * 16 + l15] = sacc[d2][r];
  }
  if (dsum == 0x9e3779b9u) ((unsigned*)(p->ws + WS_CTL))[5000] = dsum;
}

DEVI void phase_onorm(KP p, int layer) {
  const int tid = tidx_(), lane = tid & 63, wave = tid >> 6, j = layer >> 1;
  bf16_t* ybuf = (bf16_t*)(p->ws + WS_YBUF); const bf16_t* proj = (const bf16_t*)(p->ws + WS_PROJ);
  float gw[16];
#pragma unroll
  for (int e = 0; e < 16; ++e) gw[e] = p->in[I_GNW][j * 128 + ((lane * 16 + e) & 127)];
  const int rstep = gdim_() * 8;
  for (int r = bidx_() * 8 + wave; r < NPR; r += 2 * rstep) {
    const bool two = r + rstep < NPR;
    bf16_t* yp[2]; u32x4 yv[2][2], zv[2][2];
#pragma unroll
    for (int q = 0; q < 2; ++q) { const int rr = (q == 0 || two) ? r + q * rstep : r;
      yp[q] = ybuf + (size_t)rr * 2048 + 1024 + lane * 16; const bf16_t* zp = proj + (size_t)rr * 6144 + 5120 + lane * 16;
      yv[q][0] = *(const u32x4*)yp[q]; yv[q][1] = *(const u32x4*)(yp[q] + 8); zv[q][0] = *(const u32x4*)zp; zv[q][1] = *(const u32x4*)(zp + 8); }
#pragma unroll
    for (int q = 0; q < 2; ++q) {
      float o[16], z[16]; { float t[8]; unpack8(yv[q][0], t);
#pragma unroll
        for (int e = 0; e < 8; ++e) o[e] = t[e];
        unpack8(yv[q][1], t);
#pragma unroll
        for (int e = 0; e < 8; ++e) o[8 + e] = t[e];
        unpack8(zv[q][0], t);
#pragma unroll
        for (int e = 0; e < 8; ++e) z[e] = t[e];
        unpack8(zv[q][1], t);
#pragma unroll
        for (int e = 0; e < 8; ++e) z[8 + e] = t[e]; }
      float ss = 0.f;
#pragma unroll
      for (int e = 0; e < 16; ++e) ss += o[e] * o[e];
      ss += __shfl_xor(ss, 1); ss += __shfl_xor(ss, 2); ss += __shfl_xor(ss, 4);
      const float rinv = __builtin_amdgcn_rsqf(ss * (1.f / 128.f) + 1e-6f);
      float a[8], cq[8];
#pragma unroll
      for (int e = 0; e < 8; ++e) { a[e] = o[e] * rinv * gw[e] * siluf_(z[e]); cq[e] = o[8 + e] * rinv * gw[8 + e] * siluf_(z[8 + e]); }
      if (q == 0 || two) { *(u32x4*)yp[q] = pack8(a); *(u32x4*)(yp[q] + 8) = pack8(cq); }
    }
  }
}

struct S5C { bf16x8 Bf[8], Cf[4]; float abr, abi, dch; };
template <bool OUT, bool SAMPLE>
DEVI void s5_chunks(KP p, const S5C& c, int jc, int g, size_t rbase, int nch, int sgrp, float& xr, float& xi, float* BU, bf16_t* XB, int lane) {
  const int l15 = lane & 15, lq = lane >> 4;
  const bf16_t* proj = (const bf16_t*)(p->ws + WS_PROJ);
  bf16_t* y1 = (bf16_t*)(p->ws + WS_YBUF);
  u32x4 unx = (u32x4){0u, 0u, 0u, 0u}; bf16_t uenx[4] = {0, 0, 0, 0};
  if (lq < 2) unx = *(const u32x4*)(proj + (rbase + l15) * 2048 + g * 16 + lq * 8);
  if (OUT) {
#pragma unroll
    for (int r = 0; r < 4; ++r) uenx[r] = proj[(rbase + lq * 4 + r) * 2048 + g * 16 + l15]; }
  for (int ck = 0; ck < nch; ++ck) {
    const size_t row0 = rbase + (size_t)ck * 16;
    const u32x4 ucur = unx; bf16_t uec[4];
#pragma unroll
    for (int r = 0; r < 4; ++r) uec[r] = uenx[r];
    if (ck + 1 < nch) { if (lq < 2) unx = *(const u32x4*)(proj + (row0 + 16 + l15) * 2048 + g * 16 + lq * 8);
      if (OUT) {
#pragma unroll
        for (int r = 0; r < 4; ++r) uenx[r] = proj[(row0 + 16 + lq * 4 + r) * 2048 + g * 16 + l15]; } }
#pragma unroll
    for (int nt = 0; nt < 8; ++nt) { const f32x4 acc = mfma16(as_bf16x8(ucur), c.Bf[nt], (f32x4){0.f, 0.f, 0.f, 0.f});
      *(f32x4*)(BU + (nt * 16 + l15) * 20 + lq * 4) = acc; }
    asm volatile("s_waitcnt lgkmcnt(0)" ::: "memory");
    float br[16], bi[16];
#pragma unroll
    for (int t4 = 0; t4 < 4; ++t4) { const f32x4 a = *(const f32x4*)(BU + lane * 20 + t4 * 4), b = *(const f32x4*)(BU + (64 + lane) * 20 + t4 * 4);
#pragma unroll
      for (int e = 0; e < 4; ++e) { br[t4 * 4 + e] = a[e]; bi[t4 * 4 + e] = b[e]; } }
    if (!SAMPLE) {
#pragma unroll
      for (int t = 0; t < 16; ++t) { const float nr = c.abr * xr - c.abi * xi + br[t], ni = c.abr * xi + c.abi * xr + bi[t]; xr = nr; xi = ni;
        if (OUT) *(unsigned*)(XB + t * 136 + 2 * lane) = cvt_pk_bf16(xr, xi); }
    } else {
#pragma unroll
      for (int t = 0; t < 16; ++t) { const size_t si = ((size_t)(jc * 128 + sgrp * 16 + t) * 64 + g) * 64 + lane;
        const float x0r = p->in[I_SSR][si], x0i = p->in[I_SSI][si];
        const float nr = c.abr * x0r - c.abi * x0i + br[t], ni = c.abr * x0i + c.abi * x0r + bi[t];
        p->out[O_SSR + si] = nr; p->out[O_SSI + si] = ni;
        *(unsigned*)(XB + t * 136 + 2 * lane) = cvt_pk_bf16(nr, ni); }
    }
    if (OUT) {
      asm volatile("s_waitcnt lgkmcnt(0)" ::: "memory");
      f32x4 ya = (f32x4){0.f, 0.f, 0.f, 0.f};
#pragma unroll
      for (int kk = 0; kk < 4; ++kk) ya = mfma16(*(const bf16x8*)(XB + l15 * 136 + lq * 8 + kk * 32), c.Cf[kk], ya);
#pragma unroll
      for (int r = 0; r < 4; ++r) { const float y = ya[r] + c.dch * bf2f(uec[r]); y1[(row0 + lq * 4 + r) * 1024 + g * 16 + l15] = f2bf(geluf_(y)); }
    }
  }
}
DEVI void s5_setup(KP p, S5C& c, int jc, int g, int lane) {
  const int l15 = lane & 15, lq = lane >> 4, gi = jc * 64 + g;
  const float dt = __expf(p->in[I_LOGDT][gi]);
  { const float are = p->in[I_ARE][gi * 64 + lane], aim = p->in[I_AIM][gi * 64 + lane]; const float mag = __expf(are * dt); c.abr = mag * __cosf(aim * dt); c.abi = mag * __sinf(aim * dt); }
#pragma unroll
  for (int nt = 0; nt < 8; ++nt) {
    float v[8];
#pragma unroll
    for (int e = 0; e < 8; ++e) v[e] = 0.f;
    if (lq < 2) {
      const int pp = (nt & 3) * 16 + l15;
      const float are = p->in[I_ARE][gi * 64 + pp], aim = p->in[I_AIM][gi * 64 + pp]; const float mag = __expf(are * dt); const float sn = __sinf(aim * dt), cs = __cosf(aim * dt);
      const float nr = mag * cs - 1.f, ni = mag * sn, den = 1.f / (are * are + aim * aim);
      const float cr = (nr * are + ni * aim) * den, ci = (ni * are - nr * aim) * den;
      const float* br = p->in[I_BRE] + (size_t)(gi * 64 + pp) * 16 + lq * 8; const float* bi = p->in[I_BIM] + (size_t)(gi * 64 + pp) * 16 + lq * 8;
#pragma unroll
      for (int e = 0; e < 8; ++e) v[e] = (nt >= 4) ? (cr * bi[e] + ci * br[e]) : (cr * br[e] - ci * bi[e]);
    }
    c.Bf[nt] = as_bf16x8(pack8(v));
  }
#pragma unroll
  for (int kk = 0; kk < 4; ++kk) { const int p0 = lq * 4 + kk * 16;
    const float* sre = p->in[I_CRE] + (size_t)(gi * 16 + l15) * 64 + p0; const float* sim = p->in[I_CIM] + (size_t)(gi * 16 + l15) * 64 + p0; float v[8];
#pragma unroll
    for (int m = 0; m < 4; ++m) { v[2 * m] = sre[m]; v[2 * m + 1] = -sim[m]; }
    c.Cf[kk] = as_bf16x8(pack8(v)); }
  c.dch = p->in[I_S5D][jc * 1024 + g * 16 + l15];
}
DEVI void phase_s5(KP p, int layer, unsigned char* lds) {
  const int tid = tidx_(), lane = tid & 63, wave = tid >> 6, jc = layer >> 1;
  float* BU = (float*)(lds + wave * 14592);
  bf16_t* XB = (bf16_t*)(lds + wave * 14592 + 10240);
  float* EX = (float*)(lds + 116736);
  const int cb = wave >> 2, seg = wave & 3;
  for (int cp = bidx_(); cp < 256; cp += gdim_()) {
    const int q = cp * 2 + cb, b = q >> 6, g = q & 63;
    S5C c; s5_setup(p, c, jc, g, lane);
    float xr = 0.f, xi = 0.f;
    const size_t rbase = (size_t)b * 2048 + (size_t)seg * 512;
    const int nch2 = 32;
    if (seg < 3) {
      s5_chunks<false, false>(p, c, jc, g, rbase, 32, 0, xr, xi, BU, XB, lane);
      EX[wave * 128 + lane] = xr; EX[wave * 128 + 64 + lane] = xi;
    } else {
      const int qs = cp * 2 + cb, gs = qs & 63, sgrp = qs >> 6;
      S5C cs; s5_setup(p, cs, jc, gs, lane);
      float dr = 0.f, di = 0.f;
      s5_chunks<true, true>(p, cs, jc, gs, (size_t)(NPR + sgrp * 16), 1, sgrp, dr, di, BU, XB, lane);
    }
    __syncthreads();
    float pr = c.abr, pi = c.abi;
#pragma unroll
    for (int s = 0; s < 9; ++s) { const float nr = pr * pr - pi * pi, ni = 2.f * pr * pi; pr = nr; pi = ni; }
    xr = 0.f; xi = 0.f;
    for (int s = 0; s < seg; ++s) { const float er = EX[(cb * 4 + s) * 128 + lane], ei = EX[(cb * 4 + s) * 128 + 64 + lane];
      const float nr = pr * xr - pi * xi + er, ni = pr * xi + pi * xr + ei; xr = nr; xi = ni; }
    s5_chunks<true, false>(p, c, jc, g, rbase, nch2, 0, xr, xi, BU, XB, lane);
    if (seg == 3) { const size_t si = ((size_t)(jc * 8 + b) * 64 + g) * 64 + lane; p->out[O_PSR + si] = xr; p->out[O_PSI + si] = xi; }
    __syncthreads();
  }
}

DEVI void phase_final(KP p) {
  const int tid = tidx_(), lane = tid & 63, wave = tid >> 6;
  const float* nw = p->in[I_FNW];
  float4 w4[4];
#pragma unroll
  for (int i = 0; i < 4; ++i) w4[i] = *(const float4*)(nw + i * 256 + lane * 4);
  for (int r = (bidx_() * 8 + wave) * 2; r < NRV; r += gdim_() * 16) {
    float* x0 = p->out + (size_t)r * 1024; float* x1 = x0 + 1024; float4 v0[4], v1[4]; float s0 = 0.f, s1 = 0.f;
#pragma unroll
    for (int i = 0; i < 4; ++i) { v0[i] = *(const float4*)(x0 + i * 256 + lane * 4); v1[i] = *(const float4*)(x1 + i * 256 + lane * 4); }
#pragma unroll
    for (int i = 0; i < 4; ++i) { s0 += v0[i].x * v0[i].x + v0[i].y * v0[i].y + v0[i].z * v0[i].z + v0[i].w * v0[i].w; s1 += v1[i].x * v1[i].x + v1[i].y * v1[i].y + v1[i].z * v1[i].z + v1[i].w * v1[i].w; }
#pragma unroll
    for (int o = 32; o >= 1; o >>= 1) { s0 += __shfl_xor(s0, o); s1 += __shfl_xor(s1, o); }
    const float r0 = __builtin_amdgcn_rsqf(s0 * (1.f / 1024.f) + 1e-6f), r1 = __builtin_amdgcn_rsqf(s1 * (1.f / 1024.f) + 1e-6f);
#pragma unroll
    for (int i = 0; i < 4; ++i) { float4 o; o.x = v0[i].x * r0 * w4[i].x; o.y = v0[i].y * r0 * w4[i].y; o.z = v0[i].z * r0 * w4[i].z; o.w = v0[i].w * r0 * w4[i].w; *(float4*)(x0 + i * 256 + lane * 4) = o;
      float4 q; q.x = v1[i].x * r1 * w4[i].x; q.y = v1[i].y * r1 * w4[i].y; q.z = v1[i].z * r1 * w4[i].z; q.w = v1[i].w * r1 * w4[i].w; *(float4*)(x1 + i * 256 + lane * 4) = q; }
  }
}

template <class F>
DEVI void sample_gemm(const bf16_t* __restrict__ A, int lda, const bf16_t* __restrict__ Bt, int N, int K, F&& epi, float* red) {
  const int tid = tidx_(), lane = tid & 63, wave = tid >> 6, l15 = lane & 15, lq = lane >> 4, rt2 = wave & 1, kq = wave >> 1;
  const int kq_len = K >> 2, nitems = (N / 16) * 4;
  for (int it = gdim_() - 1 - bidx_(); it < nitems; it += gdim_()) {
    const int s = it >> 2, rg = it & 3, row0 = rg * 32 + rt2 * 16;
    const bf16_t* ap = A + (size_t)(row0 + l15) * lda + lq * 8 + kq * kq_len;
    const bf16_t* bp = Bt + (size_t)(s * 16 + l15) * K + lq * 8 + kq * kq_len;
    f32x4 acc0 = (f32x4){0.f, 0.f, 0.f, 0.f}, acc1 = (f32x4){0.f, 0.f, 0.f, 0.f};
    for (int k0 = 0; k0 < kq_len; k0 += 256) {
      u32x4 a[8], b[8];
#pragma unroll
      for (int u = 0; u < 8; ++u) { a[u] = *(const u32x4*)(ap + k0 + u * 32); b[u] = *(const u32x4*)(bp + k0 + u * 32); }
#pragma unroll
      for (int u = 0; u < 8; u += 2) { acc0 = mfma16(as_bf16x8(a[u]), as_bf16x8(b[u]), acc0); acc1 = mfma16(as_bf16x8(a[u + 1]), as_bf16x8(b[u + 1]), acc1); }
    }
    acc0 = acc0 + acc1;
    __syncthreads();
    *(f32x4*)(red + ((kq * 2 + rt2) * 64 + lane) * 4) = acc0;
    __syncthreads();
    if (kq == 0) {
      f32x4 t = acc0;
#pragma unroll
      for (int q = 1; q < 4; ++q) t = t + *(const f32x4*)(red + ((q * 2 + rt2) * 64 + lane) * 4);
#pragma unroll
      for (int r = 0; r < 4; ++r) epi(row0 + lq * 4 + r, s * 16 + l15, t[r]);
    }
  }
}

constexpr int N_PHASES = 25;
#ifndef PROBE_SUB
#define PROBE_SUB 7
#endif
#ifndef ONLY_KIND
#define ONLY_KIND -1
#endif
#define KON(k) ((ONLY_KIND < 0 || ONLY_KIND == (k)) && kind == (k))
__global__ void __launch_bounds__(512, 2) mega(Params p_unused) {
  extern __shared__ __attribute__((aligned(16))) unsigned char shm[];
  cg::grid_group grid = cg::this_grid();
  PG8_LAS unsigned char* ldsg = (PG8_LAS unsigned char*)shm;
  KP p0 = (KP)__builtin_amdgcn_kernarg_segment_ptr();
  const int ph_lo = p0->ph_lo, ph_hi = p0->ph_hi;
  volatile LAS unsigned* xst = (volatile LAS unsigned*)(ldsg + LDS_MISC + 16);
  if (threadIdx.x == 0) { xst[0] = 0u; xst[1] = 0u; }
  __syncthreads();
  XcdBarrier xb = xcd_barrier_post((unsigned*)(p0->ws + WS_CTL), xst);
  int rep = 0;
  for (int ph = ph_lo; ph < ph_hi; ++ph) {
    KP p = p0; asm volatile("" : "+s"(p));
    int kind, layer = 0;
    if (ph == 0) kind = 0; else if (ph == 1) kind = 1; else if (ph == 24) kind = 12;
    else { const int q = ph - 2, pair = q / 11, rem = q % 11;
      if (rem < 6) { layer = 2 * pair; kind = (rem == 0) ? 2 : 2 + rem; }
      else { layer = 2 * pair + 1; const int s = rem - 6; kind = (s == 0) ? 2 : 7 + s; } }
    const int j = layer >> 1;
    if (KON(0)) phase_prep(p, (float*)shm);
    else if (KON(2)) phase_norm(p, layer, (float*)shm);
    else if (KON(4)) phase_mixprep(p, layer, shm, ph + 32 * rep, rep ? PROBE_SUB : 7);
    else if (KON(5)) phase_gdnseq(p, layer, shm);
    else if (KON(6)) phase_onorm(p, layer);
    else if (KON(9)) phase_s5(p, layer, shm);
    else if (KON(12)) phase_final(p);
    else if (KON(1)) {
      pg8::Gemm g{(const bf16_t*)(p->ws + WS_SILUC), (const bf16_t*)(p->ws + WS_WT_MOD), 256, 12288, 1024};
      pg8::StaticOrder S; S.init(256, 12288, gdim_(), bidx_());
      pg8::EpiF32 E{(float*)(p->ws + WS_MOD), 12288, p->in[I_MODB]};
      pg8::gemm_phase<pg8::EpiF32, pg8::StaticOrder, false>(ldsg, g, S, E, nullptr);
    } else if (KON(3) || KON(8)) {
      const bool ab = kind == 3; const int N = ab ? 6144 : 2048;
      const bf16_t* Bt = ab ? (const bf16_t*)(p->ws + WS_WT_INAB) + (size_t)j * 6144 * 1024 : (const bf16_t*)(p->ws + WS_WT_CIN) + (size_t)j * 2048 * 1024;
      pg8::Gemm g{(const bf16_t*)(p->ws + WS_YBUF), Bt, NPR, N, 1024};
      pg8::StaticOrder S; S.init(NPR, N, gdim_(), bidx_());
      pg8::EpiBf16<0> E{(bf16_t*)(p->ws + WS_PROJ), N, nullptr, 0, 0};
      pg8::gemm_phase<pg8::EpiBf16<0>, pg8::StaticOrder, false>(ldsg, g, S, E, nullptr);
      bf16_t* po = (bf16_t*)(p->ws + WS_PROJ) + (size_t)NPR * N;
      sample_gemm((const bf16_t*)(p->ws + WS_YBUF) + (size_t)NPR * 1024, 1024, Bt, N, 1024, [&](int r, int c, float v) { po[(size_t)r * N + c] = f2bf(v); }, (float*)shm);
      if (ab) tail_gemm(p, j);
    } else if (KON(7) || KON(11)) {
      const bool ab = kind == 7; const int K = ab ? 2048 : 1024;
      const bf16_t* Ab = ab ? (const bf16_t*)(p->ws + WS_YBUF) : (const bf16_t*)(p->ws + WS_Y2);
      const bf16_t* Bt = ab ? (const bf16_t*)(p->ws + WS_WT_OUTAB) + (size_t)j * 1024 * 2048 : (const bf16_t*)(p->ws + WS_WT_COUT) + (size_t)j * 1024 * 1024;
      pg8::Gemm g{Ab, Bt, NPR, 1024, K};
      pg8::StaticOrder S; S.init(NPR, 1024, gdim_(), bidx_());
      const float* gatep = (const float*)(p->ws + WS_MOD) + layer * 3072 + 2048;
      EpiRes E{layer == 0 ? p->in[I_XP] : p->out, layer == 0 ? p->in[I_XS] : p->out + (size_t)NPR * 1024, p->out, gatep};
      pg8::gemm_phase<EpiRes, pg8::StaticOrder, false>(ldsg, g, S, E, nullptr);
      const float* xsi = layer == 0 ? p->in[I_XS] : p->out + (size_t)NPR * 1024; float* xso = p->out + (size_t)NPR * 1024;
      sample_gemm(Ab + (size_t)NPR * K, K, Bt, 1024, K, [&](int r, int c, float v) { xso[(size_t)r * 1024 + c] = xsi[(size_t)r * 1024 + c] + gatep[(size_t)(8 + r) * 12288 + c] * v; }, (float*)shm);
    } else if (KON(10)) {
      const bf16_t* Bt = (const bf16_t*)(p->ws + WS_WT_GLU) + (size_t)j * 1024 * 1024;
      pg8::Gemm g{(const bf16_t*)(p->ws + WS_YBUF), Bt, NPR, 1024, 1024};
      pg8::StaticOrder S; S.init(NPR, 1024, gdim_(), bidx_());
      const float* gb = p->in[I_GLUB] + j * 1024;
      EpiGlu E{(const bf16_t*)(p->ws + WS_YBUF), (const bf16_t*)(p->ws + WS_PROJ) + 1024, (bf16_t*)(p->ws + WS_Y2), gb};
      pg8::gemm_phase<EpiGlu, pg8::StaticOrder, false>(ldsg, g, S, E, nullptr);
      const bf16_t* y1s = (const bf16_t*)(p->ws + WS_YBUF) + (size_t)NPR * 1024; const bf16_t* zs = (const bf16_t*)(p->ws + WS_PROJ) + (size_t)NPR * 2048 + 1024; bf16_t* y2s = (bf16_t*)(p->ws + WS_Y2) + (size_t)NPR * 1024;
      sample_gemm(y1s, 1024, Bt, 1024, 1024, [&](int r, int c, float v) { y2s[(size_t)r * 1024 + c] = f2bf(bf2f(y1s[(size_t)r * 1024 + c]) * sigmoidf_(v + gb[c]) * siluf_(bf2f(zs[(size_t)r * 2048 + c]))); }, (float*)shm);
    }
#ifdef REPEAT_KIND
    if (kind == REPEAT_KIND && rep == 0) { rep = 1; --ph; } else rep = 0;
#endif
    if (ph + 1 < ph_hi) { if (ph_hi > 100000) grid.sync();
      xcd_barrier(xb); }
  }
}

#ifndef MK_MULTI
#define MK_MULTI 0
#endif
#ifndef PH_HI
#define PH_HI N_PHASES
#endif
extern "C" void kernel_launch(void* const* d_in, const int* in_sizes, int n_in, void* d_out, int out_size, void* d_ws, size_t ws_size, hipStream_t stream) {
  static int grid = 0;
  if (grid == 0) {
    if (n_in != N_IN || (size_t)out_size != O_END || ws_size < WS_END) { fprintf(stderr, "kernel_launch: unexpected shapes: n_in %d out %d ws %zu (need %zu)\n", n_in, out_size, ws_size, (size_t)WS_END); grid = -1; return; }
    int dev = 0, cus = 0, per_cu = 0;
    if (hipGetDevice(&dev) != hipSuccess || hipDeviceGetAttribute(&cus, hipDeviceAttributeMultiprocessorCount, dev) != hipSuccess) { grid = -1; return; }
    if (hipFuncSetAttribute((const void*)mega, hipFuncAttributeMaxDynamicSharedMemorySize, LDS_BYTES) != hipSuccess) { fprintf(stderr, "kernel_launch: hipFuncSetAttribute failed\n"); grid = -1; return; }
    if (hipOccupancyMaxActiveBlocksPerMultiprocessor(&per_cu, (const void*)mega, 512, LDS_BYTES) != hipSuccess || per_cu < 1) { fprintf(stderr, "kernel_launch: occupancy query says %d\n", per_cu); per_cu = 1; }
    (void)hipGetLastError();
    grid = cus;
  }
  if (grid < 0) return;
  if (hipMemsetAsync((char*)d_ws + WS_CTL, 0, 32768, stream) != hipSuccess) { fprintf(stderr, "kernel_launch: memset failed\n"); return; }
  Params p{};
  for (int i = 0; i < N_IN; ++i) p.in[i] = (const float*)d_in[i];
  p.out = (float*)d_out; p.ws = (unsigned char*)d_ws;
#if MK_MULTI
  for (int ph = 0; ph < N_PHASES; ++ph) { p.ph_lo = ph; p.ph_hi = ph + 1; hipLaunchKernelGGL(mega, dim3(grid), dim3(512), LDS_BYTES, stream, p); }
#else
  p.ph_lo = 0; p.ph_hi = PH_HI;
  void* args[] = {&p};
  hipError_t e = hipLaunchCooperativeKernel((void*)mega, dim3(grid), dim3(512), args, LDS_BYTES, stream);
  if (e != hipSuccess) fprintf(stderr, "kernel_launch: cooperative launch failed: %s (grid %d)\n", hipGetErrorString(e), grid);
#endif
}
```

```cpp
#include <hip/hip_runtime.h>
#include <hip/hip_cooperative_groups.h>
#include <cstdio>
namespace cg = cooperative_groups;
__device__ __forceinline__ int tidx_() { int t = threadIdx.x; asm volatile("" : "+v"(t)); return t; }
__device__ __forceinline__ int bidx_() { int t = blockIdx.x; asm volatile("" : "+s"(t)); return t; }
__device__ __forceinline__ int gdim_() { int t = gridDim.x; asm volatile("" : "+s"(t)); return t; }
namespace pg8 {
#define PG8_LAS __attribute__((address_space(3)))
typedef unsigned short bf16_t;
typedef short bf16x8 __attribute__((ext_vector_type(8)));
typedef float f32x4 __attribute__((ext_vector_type(4)));
typedef unsigned u32x4 __attribute__((ext_vector_type(4)));
constexpr int BM = 256, BK = 64, HALF = 128, HTB = HALF * BK * 2  , STAGE_BYTES = 8 * HTB, NXCD = 8, WGM = 8;

__host__ __device__ __forceinline__ int lds_byte(int r, int c) { const int st = (r >> 4) * 2 + (c >> 5), rr = r & 15, cc = c & 31, ob = rr * 64 + cc * 2; return st * 1024 + (ob ^ (((ob >> 9) & 1) << 5)); }
__host__ __device__ __forceinline__ void stage_rc(int b, int& R, int& C) { const int st = b / 1024, sb = b % 1024, swz = sb ^ (((sb >> 9) & 1) << 5); R = (st >> 1) * 16 + swz / 64; C = (st & 1) * 32 + (swz % 64) / 2; }
__host__ __device__ __forceinline__ int perm32(int rho) { const int n = rho >> 4, i = rho & 15; return 8 * (i >> 2) + 4 * n + (i & 3); }

struct Unit { int pm, pn; };
struct Gemm { const bf16_t* A; const bf16_t* Bt; int M, N, K; };

struct StaticOrder {
    int nM, nN, nwg, G, c;
    __host__ __device__ void init(int M, int N, int G_, int c_) { nM = M / BM; nN = N / BM; nwg = nM * nN; G = G_; c = c_; }
    __host__ __device__ bool next(int i, Unit& u) const {
        const long L = (long)i * G + c; if (L >= nwg) return false;
        int wgid = (int)L; { const int q = nwg / NXCD, r = nwg % NXCD, xcd = wgid % NXCD, off = wgid / NXCD; wgid = (xcd < r ? xcd * (q + 1) : r * (q + 1) + (xcd - r) * q) + off; }
        const int nig = WGM * nN, gid = wgid / nig, fm = gid * WGM, gsz = (nM - fm) < WGM ? (nM - fm) : WGM;
        u.pm = fm + ((wgid % nig) % gsz); u.pn = (wgid % nig) / gsz; return true;
    }
    __device__ __forceinline__ void a_ready(const Unit&) const {}
    __device__ __forceinline__ void done(const Unit&) const {}
};
typedef float f32x2cv __attribute__((ext_vector_type(2)));
typedef __bf16 bf16x2cv __attribute__((ext_vector_type(2)));
__device__ __forceinline__ unsigned cvt_pk_bf16(float lo, float hi) { f32x2cv v = {lo, hi}; bf16x2cv b = __builtin_convertvector(v, bf16x2cv); return __builtin_bit_cast(unsigned, b); }
typedef float f32x2 __attribute__((ext_vector_type(2)));
__device__ __forceinline__ f32x2 gelu_pk(f32x2 v) {
    const f32x2 av = __builtin_elementwise_abs(v), d = av * 0.2316418882f + 1.0f;
    f32x2 t; t.x = __builtin_amdgcn_rcpf(d.x); t.y = __builtin_amdgcn_rcpf(d.y);
    f32x2 q = t * 0.5307027145f + (-0.7265760135f); q = q * t + 0.7107068705f; q = q * t + (-0.142248368f); q = q * t + 0.127414796f; q = q * t;
    const f32x2 s = (v * v) * (-0.72134752044f);
    f32x2 e; e.x = __builtin_amdgcn_exp2f(s.x); e.y = __builtin_amdgcn_exp2f(s.y);
    const f32x2 m = v * (q * e), r = v - m;
    f32x2 o; o.x = v.x < 0.f ? m.x : r.x; o.y = v.y < 0.f ? m.y : r.y; return o;
}

struct EpiF32 {
    static constexpr bool PERM = false, AFTER_DRAIN = false;
    float* C; int ldc; const float* bias;
    __device__ __forceinline__ void operator()(const f32x4 (&acc)[2][2][4][2], const Unit& u, int wr, int wc, int fr, int fq) const {
        const int row0 = u.pm * BM + wr * 64 + fr, col0 = u.pn * BM + wc * 32 + 4 * fq;
        f32x4 bv[2][2];
#pragma unroll
        for (int bj = 0; bj < 2; ++bj)
#pragma unroll
            for (int n = 0; n < 2; ++n) bv[bj][n] = bias ? *(const f32x4*)(bias + col0 + bj * HALF + n * 16) : (f32x4){0.f, 0.f, 0.f, 0.f};
#pragma unroll
        for (int ai = 0; ai < 2; ++ai)
#pragma unroll
            for (int m = 0; m < 4; ++m) { float* rowp = C + (size_t)(row0 + ai * HALF + m * 16) * ldc + col0;
#pragma unroll
                for (int bj = 0; bj < 2; ++bj)
#pragma unroll
                    for (int n = 0; n < 2; ++n) *(f32x4*)(rowp + bj * HALF + n * 16) = acc[ai][bj][m][n] + bv[bj][n]; }
    }
};
template <int ACT  > struct EpiBf16 {
    static constexpr bool PERM = true, AFTER_DRAIN = false;
    bf16_t* O; int ldc; const float* bias; int split_cols; size_t split_stride;
    __device__ __forceinline__ void operator()(const f32x4 (&acc)[2][2][4][2], const Unit& u, int wr, int wc, int fr, int fq) const {
        const int row0 = u.pm * BM + wr * 64 + fr; int colt = u.pn * BM; bf16_t* base = O;
        if (split_cols) { const int t = colt / split_cols; base += (size_t)t * split_stride; colt -= t * split_cols; }
        const int col0 = colt + wc * 32 + 8 * fq, bcol0 = u.pn * BM + wc * 32 + 8 * fq;
        f32x4 bv[2][2];
#pragma unroll
        for (int bj = 0; bj < 2; ++bj)
#pragma unroll
            for (int n = 0; n < 2; ++n) bv[bj][n] = bias ? *(const f32x4*)(bias + bcol0 + bj * HALF + 4 * n) : (f32x4){0.f, 0.f, 0.f, 0.f};
#pragma unroll
        for (int ai = 0; ai < 2; ++ai)
#pragma unroll
            for (int m = 0; m < 4; ++m) { bf16_t* rowp = base + (size_t)(row0 + ai * HALF + m * 16) * ldc + col0;
#pragma unroll
                for (int bj = 0; bj < 2; ++bj) { f32x4 v0 = acc[ai][bj][m][0] + bv[bj][0], v1 = acc[ai][bj][m][1] + bv[bj][1];
                    if (ACT == 1) { f32x2 a = gelu_pk((f32x2){v0[0], v0[1]}), b = gelu_pk((f32x2){v0[2], v0[3]}), c = gelu_pk((f32x2){v1[0], v1[1]}), d = gelu_pk((f32x2){v1[2], v1[3]});
                        v0 = (f32x4){a.x, a.y, b.x, b.y}; v1 = (f32x4){c.x, c.y, d.x, d.y}; }
                    if (ACT == 2) {
#pragma unroll
                        for (int j = 0; j < 4; ++j) { v0[j] = 0.5f * v0[j] * (1.0f + erff(v0[j] * 0.70710678f)); v1[j] = 0.5f * v1[j] * (1.0f + erff(v1[j] * 0.70710678f)); } }
                    u32x4 w; w.x = cvt_pk_bf16(v0[0], v0[1]); w.y = cvt_pk_bf16(v0[2], v0[3]); w.z = cvt_pk_bf16(v1[0], v1[1]); w.w = cvt_pk_bf16(v1[2], v1[3]);
                    *(u32x4*)(rowp + bj * HALF) = w; } }
    }
};
template <class Epi, class Sched, bool STAMP = false>
__device__ __forceinline__ void gemm_phase(PG8_LAS unsigned char* lds, const Gemm g, const Sched& S, const Epi& E, unsigned long long* stamps) {
    const int tid = tidx_(), wid = __builtin_amdgcn_readfirstlane(tid >> 6), lane = tid & 63, wr = wid >> 2, wc = wid & 3, fr = lane & 15, fq = lane >> 4;
    const int K = g.K, nt = K / BK;
    int ts_lo = 0, ts_hi = 0, nts = 0; const unsigned long long rt_entry = STAMP ? (unsigned long long)wall_clock64() : 0ull;
#define PG8_STAMP() do { if (STAMP && wid == 0 && nts < 64) { const unsigned long long _c = (unsigned long long)clock64(); \
        ts_lo = (lane == nts) ? (int)(unsigned)_c : ts_lo; ts_hi = (lane == nts) ? (int)(unsigned)(_c >> 32) : ts_hi; ++nts; } } while (0)
    PG8_STAMP();
    unsigned voffA[2], voffB[2];
#pragma unroll
    for (int i = 0; i < 2; ++i) { int R, C; stage_rc(tid * 16 + i * 8192, R, C); const int Rb = Epi::PERM ? ((R & ~31) + perm32(R & 31)) : R;
        voffA[i] = (unsigned)(R * K + C) * 2u; voffB[i] = (unsigned)(Rb * K + C) * 2u; }
    const size_t kstep = (size_t)(BK * 2);
    const size_t hstep = (size_t)HALF * K * 2;
    const size_t tstep = 2 * hstep;
    const unsigned ldsw = (unsigned)wid * 1024u;
    const int aoff = lds_byte(wr * 64 + fr, fq * 8), boff = lds_byte(wc * 32 + fr, fq * 8);
#define PG8_SA(b, h) (((b) * 2 + (h)) * HTB)
#define PG8_SB(b, h) ((4 + (b) * 2 + (h)) * HTB)
#define PG8_STAGE(bufoff, gbase, voff) do { _Pragma("unroll") for (int _i = 0; _i < 2; ++_i) \
        __builtin_amdgcn_global_load_lds((const unsigned*)((const char*)(gbase) + (voff)[_i]), (PG8_LAS unsigned*)(lds + (bufoff) + ldsw + _i * 8192), 16, 0, 0); } while (0)
#define PG8_LDA(dst, b, h) do { _Pragma("unroll") for (int m = 0; m < 4; ++m) _Pragma("unroll") for (int k = 0; k < 2; ++k) dst[m][k] = *(const PG8_LAS bf16x8*)(lds + PG8_SA(b, h) + aoff + m * 2048 + k * 1024); } while (0)
#define PG8_LDB(dst, b, h) do { _Pragma("unroll") for (int n = 0; n < 2; ++n) _Pragma("unroll") for (int k = 0; k < 2; ++k) dst[n][k] = *(const PG8_LAS bf16x8*)(lds + PG8_SB(b, h) + boff + n * 2048 + k * 1024); } while (0)
#define PG8_MMA(ai, bj, At, Bt) do { __builtin_amdgcn_s_setprio(1); _Pragma("unroll") for (int m = 0; m < 4; ++m) _Pragma("unroll") for (int n = 0; n < 2; ++n) _Pragma("unroll") for (int k = 0; k < 2; ++k) \
        acc[ai][bj][m][n] = __builtin_amdgcn_mfma_f32_16x16x32_bf16(Bt[n][k], At[m][k], acc[ai][bj][m][n], 0, 0, 0); __builtin_amdgcn_s_setprio(0); } while (0)
#define PG8_WAIT_V(n) asm volatile("s_waitcnt vmcnt(" #n ")" ::: "memory")
#define PG8_WAIT_L(n) asm volatile("s_waitcnt lgkmcnt(" #n ")" ::: "memory")
#define PG8_BAR __builtin_amdgcn_s_barrier()
#define PG8_SCHED __builtin_amdgcn_sched_barrier(0)
    Unit cur, nxt; int ui = 0;
    if (!S.next(0, cur)) return;
    f32x4 acc[2][2][4][2];
#pragma unroll
    for (int a = 0; a < 2; ++a)
#pragma unroll
        for (int b = 0; b < 2; ++b)
#pragma unroll
            for (int m = 0; m < 4; ++m)
#pragma unroll
                for (int n = 0; n < 2; ++n) acc[a][b][m][n] = (f32x4){0.f, 0.f, 0.f, 0.f};
    bf16x8 At[4][2], B0[2][2], B1[2][2];
    const char* cA = (const char*)g.A + (size_t)cur.pm * tstep; const char* cB = (const char*)g.Bt + (size_t)cur.pn * tstep;
    S.a_ready(cur);
    PG8_STAGE(PG8_SB(0, 0), cB, voffB); PG8_STAGE(PG8_SA(0, 0), cA, voffA); PG8_STAGE(PG8_SB(0, 1), cB + hstep, voffB); PG8_STAGE(PG8_SA(0, 1), cA + hstep, voffA);
    if (wr == 1) PG8_BAR;
    PG8_WAIT_V(4); PG8_BAR;
    PG8_STAGE(PG8_SB(1, 0), cB + kstep, voffB); PG8_STAGE(PG8_SA(1, 0), cA + kstep, voffA); PG8_STAGE(PG8_SB(1, 1), cB + hstep + kstep, voffB);
    PG8_WAIT_V(6); PG8_BAR;
    PG8_STAMP();
    for (;;) {
        const bool has_next = S.next(ui + 1, nxt);
        const char* nA = has_next ? (const char*)g.A + (size_t)nxt.pm * tstep : cA; const char* nB = has_next ? (const char*)g.Bt + (size_t)nxt.pn * tstep : cB;
        for (int t = 0; t < nt; t += 2) {
            const bool last = (t == nt - 2);
            const char* a1 = cA + (size_t)(t + 1) * kstep;
            const char* a2 = last ? nA : cA + (size_t)(t + 2) * kstep; const char* b2 = last ? nB : cB + (size_t)(t + 2) * kstep;
            const char* a3 = a2 + kstep; const char* b3 = b2 + kstep;
            if (last && has_next) S.a_ready(nxt);
            PG8_LDB(B0, 0, 0); PG8_SCHED; PG8_LDA(At, 0, 0); PG8_STAGE(PG8_SA(1, 1), a1 + hstep, voffA);
            PG8_WAIT_L(8); PG8_BAR; PG8_WAIT_L(0); PG8_MMA(0, 0, At, B0); PG8_BAR; PG8_SCHED;
            PG8_LDB(B1, 0, 1); PG8_STAGE(PG8_SB(0, 0), b2, voffB);
            PG8_BAR; PG8_WAIT_L(0); PG8_MMA(0, 1, At, B1); PG8_BAR;
            PG8_LDA(At, 0, 1); PG8_STAGE(PG8_SA(0, 0), a2, voffA);
            PG8_BAR; PG8_WAIT_L(0); PG8_MMA(1, 0, At, B0); PG8_BAR; PG8_SCHED;
            PG8_STAGE(PG8_SB(0, 1), b2 + hstep, voffB);
            PG8_WAIT_V(6); PG8_BAR; PG8_MMA(1, 1, At, B1); PG8_BAR;
            PG8_LDB(B0, 1, 0); PG8_SCHED; PG8_LDA(At, 1, 0); PG8_STAGE(PG8_SA(0, 1), a2 + hstep, voffA);
            PG8_WAIT_L(8); PG8_BAR; PG8_WAIT_L(0); PG8_MMA(0, 0, At, B0); PG8_BAR; PG8_SCHED;
            PG8_LDB(B1, 1, 1); PG8_STAGE(PG8_SB(1, 0), b3, voffB);
            PG8_BAR; PG8_WAIT_L(0); PG8_MMA(0, 1, At, B1); PG8_BAR;
            PG8_LDA(At, 1, 1); PG8_STAGE(PG8_SA(1, 0), a3, voffA);
            PG8_BAR; PG8_WAIT_L(0); PG8_MMA(1, 0, At, B0); PG8_BAR; PG8_SCHED;
            PG8_STAGE(PG8_SB(1, 1), b3 + hstep, voffB);
            PG8_WAIT_V(6); PG8_BAR; PG8_MMA(1, 1, At, B1); PG8_BAR;
        }
        PG8_STAMP();
        if constexpr (!Epi::AFTER_DRAIN) { E(acc, cur, wr, wc, fr, fq); S.done(cur); }
        PG8_STAMP();
        if (!has_next) break;
#pragma unroll
        for (int a = 0; a < 2; ++a)
#pragma unroll
            for (int b = 0; b < 2; ++b)
#pragma unroll
                for (int m = 0; m < 4; ++m)
#pragma unroll
                    for (int n = 0; n < 2; ++n) acc[a][b][m][n] = (f32x4){0.f, 0.f, 0.f, 0.f};
        cur = nxt; cA = nA; cB = nB; ++ui;
    }
    PG8_WAIT_V(0);
    if (wr == 0) PG8_BAR;
    PG8_BAR;
    if constexpr (Epi::AFTER_DRAIN) { E.fused(acc, cur, wr, wc, fr, fq, lds, wid, lane); S.done(cur); }
    PG8_STAMP();
    if (STAMP && wid == 0) { stamps[lane] = lane < nts ? (((unsigned long long)(unsigned)ts_hi << 32) | (unsigned)ts_lo) : 0ull;
        if (lane == 62) stamps[62] = rt_entry; if (lane == 63) stamps[63] = (unsigned long long)wall_clock64(); }
#undef PG8_STAMP
#undef PG8_SA
#undef PG8_SB
#undef PG8_STAGE
#undef PG8_LDA
#undef PG8_LDB
#undef PG8_MMA
#undef PG8_WAIT_V
#undef PG8_WAIT_L
#undef PG8_BAR
#undef PG8_SCHED
}
}
#define LAS __attribute__((address_space(3)))
#define XB_TMO      128
#define XB_XCNT(j)  (256  + 64 * (j))
#define XB_XSUB(j)  (1280 + 64 * (j))
#define XB_XGEN(j)  (2304 + 64 * (j))
#define XB_TOP      3328
#define XB_TOPGEN   3392
#define XCD_BAR_WORDS 3456
#define XB_SPIN_CAP (1u << 18)

__device__ __forceinline__ unsigned xb_ld(unsigned* p)              { return __hip_atomic_load(p, __ATOMIC_RELAXED, __HIP_MEMORY_SCOPE_AGENT); }
__device__ __forceinline__ unsigned xb_add(unsigned* p, unsigned v) { return __hip_atomic_fetch_add(p, v, __ATOMIC_RELAXED, __HIP_MEMORY_SCOPE_AGENT); }
__device__ __forceinline__ unsigned xb_xcc_id() { return (unsigned)__builtin_amdgcn_s_getreg((3 << 11) | 20) & 0xFu; }
#define XB_SPIN(cond, bar) do { unsigned _sp = 0; while (cond) { __builtin_amdgcn_s_sleep(1); \
    if ((++_sp & 255u) == 0u) { if (xb_ld(&(bar)[XB_TMO])) break; if (_sp > XB_SPIN_CAP) { atomicAdd(&(bar)[XB_TMO], 1u); break; } } } } while (0)

struct XcdBarrier {
    unsigned* bar; unsigned x;
    volatile LAS unsigned* st;
};

__device__ __forceinline__ XcdBarrier xcd_barrier_post(unsigned* bar, volatile LAS unsigned* st) {
    XcdBarrier b; b.bar = bar; b.x = xb_xcc_id(); b.st = st;
    if (threadIdx.x == 0) (void)xb_add(&bar[XB_XCNT(b.x)], 1u);
    return b;
}
__device__ __forceinline__ void xcd_barrier_complete(unsigned* bar, unsigned x, unsigned& nloc, unsigned& nx) {
    const unsigned G = gridDim.x * gridDim.y * gridDim.z;
    unsigned sum, cnt, mine, sp = 0u;
    for (;;) {
        sum = 0u; cnt = 0u; mine = 0u;
#pragma unroll
        for (unsigned j = 0; j < 16; ++j) { const unsigned c = xb_ld(&bar[XB_XCNT(j)]); sum += c; cnt += (c > 0u) ? 1u : 0u; mine = (j == x) ? c : mine; }
        if (sum == G) break;
        __builtin_amdgcn_s_sleep(1);
        if ((++sp & 255u) == 0u) { if (xb_ld(&bar[XB_TMO])) break; if (sp > XB_SPIN_CAP) { atomicAdd(&bar[XB_TMO], 1u); break; } }
    }
    nloc = mine > 0u ? mine : 1u; nx = cnt > 0u ? cnt : 1u;
}

__device__ __forceinline__ void xcd_barrier(const XcdBarrier& b) {
    asm volatile("s_waitcnt vmcnt(0)" ::: "memory");
    __syncthreads();
    if (threadIdx.x == 0) {
        unsigned* bar = b.bar;
        __builtin_amdgcn_s_waitcnt(0);
        unsigned nloc = b.st[0], nx = b.st[1];
        if (nloc == 0u) { xcd_barrier_complete(bar, b.x, nloc, nx); b.st[0] = nloc; b.st[1] = nx; }
        const unsigned old = xb_add(&bar[XB_XSUB(b.x)], 1u);
        const unsigned gen = old / nloc;
        if (old + 1u == (gen + 1u) * nloc) {
            __builtin_amdgcn_fence(__ATOMIC_RELEASE, "agent");
            asm volatile("s_waitcnt vmcnt(0)" ::: "memory");
            __builtin_amdgcn_s_sleep(127); __builtin_amdgcn_s_sleep(127);
            const unsigned og = xb_add(&bar[XB_TOP], 1u);
            const unsigned tg = og / nx;
            if (og + 1u == (tg + 1u) * nx) xb_add(&bar[XB_TOPGEN], 1u);
            else XB_SPIN(xb_ld(&bar[XB_TOPGEN]) == tg, bar);
            __builtin_amdgcn_fence(__ATOMIC_ACQUIRE, "agent");
            xb_add(&bar[XB_XGEN(b.x)], 1u);
            asm volatile("s_waitcnt vmcnt(0)" ::: "memory");
        } else {
            XB_SPIN(xb_ld(&bar[XB_XGEN(b.x)]) == gen, bar);
            __builtin_amdgcn_fence(__ATOMIC_ACQUIRE, "agent");
            asm volatile("s_waitcnt vmcnt(0)" ::: "memory");
        }
    }
    __syncthreads();
}


using pg8::bf16_t; using pg8::bf16x8; using pg8::f32x4; using pg8::u32x4; using pg8::cvt_pk_bf16;
typedef unsigned u32x2 __attribute__((ext_vector_type(2)));
#define DEVI __device__ __forceinline__

constexpr int NPR = 16384, NRV = 16512, NRP = 16640;
constexpr int LDS_BYTES = 135168;
constexpr int LDS_MISC = 131072;

constexpr size_t WS_CTL = 0;
constexpr size_t WS_WT_MOD = 32768;
constexpr size_t WS_WT_INAB = WS_WT_MOD + 25165824;
constexpr size_t WS_WT_OUTAB = WS_WT_INAB + 25165824;
constexpr size_t WS_WT_CIN = WS_WT_OUTAB + 8388608;
constexpr size_t WS_WT_GLU = WS_WT_CIN + 8388608;
constexpr size_t WS_WT_COUT = WS_WT_GLU + 4194304;
constexpr size_t WS_WT_LRU = WS_WT_COUT + 4194304;
constexpr size_t WS_SILUC = WS_WT_LRU + 1048576;
constexpr size_t WS_MOD = WS_SILUC + 524288;
constexpr size_t WS_TAIL = WS_MOD + 12582912;
constexpr size_t WS_YBUF = WS_TAIL + 1064960;
constexpr size_t WS_PROJ = WS_YBUF + 68157440;
constexpr size_t WS_UT = WS_PROJ + 204472320;
constexpr size_t WS_WB = WS_UT + 33554432;
constexpr size_t WS_QT = WS_WB + 33554432;
constexpr size_t WS_KT = WS_QT + 33554432;
constexpr size_t WS_EGL = WS_KT + 33554432;
constexpr size_t WS_WT_TAIL = WS_EGL + 8192;
constexpr size_t WS_END = WS_WT_TAIL + 65536;
constexpr size_t WS_QK = WS_WT_MOD;
constexpr size_t WS_Y2 = WS_YBUF + 34078720;

constexpr size_t O_YP = 0, O_YS = 16777216, O_PCA = O_YS + 131072, O_PLRU = O_PCA + 49152, O_PCB = O_PLRU + 16384, O_PDEL = O_PCB + 147456,
                 O_PSR = O_PDEL + 2097152, O_PSI = O_PSR + 65536, O_SCA = O_PSI + 65536, O_SLRU = O_SCA + 786432, O_SCB = O_SLRU + 262144,
                 O_SDEL = O_SCB + 2359296, O_SSR = O_SDEL + 33554432, O_SSI = O_SSR + 1048576, O_END = O_SSI + 1048576;

enum { I_XP = 0, I_XS, I_CP, I_CS, I_SCA, I_SLRU, I_SCB, I_SDEL, I_SSR, I_SSI, I_NORMW, I_MODW, I_MODB, I_ABIN, I_ABOUT, I_CAW, I_CAB, I_GXW, I_GXB, I_GAW, I_GAB, I_APAR,
       I_CBW, I_ALOG, I_DTB, I_GNW, I_CIN, I_COUT, I_ARE, I_AIM, I_BRE, I_BIM, I_CRE, I_CIM, I_S5D, I_LOGDT, I_GLUW, I_GLUB, I_FNW, N_IN };

struct Params {
  const float* in[N_IN];
  float* out;
  unsigned char* ws;
  int ph_lo, ph_hi;
};

typedef const Params __attribute__((address_space(4)))* KP;
DEVI float bf2f(unsigned v16) { return __uint_as_float(v16 << 16); }
DEVI float bflo(unsigned w) { return __uint_as_float(w << 16); }
DEVI float bfhi(unsigned w) { return __uint_as_float(w & 0xffff0000u); }
DEVI bf16_t f2bf(float f) { return (bf16_t)(cvt_pk_bf16(f, 0.f) & 0xffffu); }
DEVI float fexp_(float x) { return __builtin_amdgcn_exp2f(x * 1.4426950408889634f); }
DEVI float sigmoidf_(float x) { return __builtin_amdgcn_rcpf(1.f + fexp_(-x)); }
DEVI float siluf_(float x) { return x * __builtin_amdgcn_rcpf(1.f + fexp_(-x)); }
DEVI float softplusf_(float x) { return x > 20.f ? x : log1pf(__expf(x)); }
DEVI float geluf_(float x) { const float z = 0.7978845608028654f * (x + 0.044715f * x * x * x); const float e = fexp_(2.f * z); return x - x * __builtin_amdgcn_rcpf(1.f + e); }
DEVI void lds_barrier() { asm volatile("s_waitcnt lgkmcnt(0)" ::: "memory"); __builtin_amdgcn_s_barrier(); asm volatile("" ::: "memory"); }
DEVI float wave_sum(float v) {
#pragma unroll
  for (int o = 32; o >= 1; o >>= 1) v += __shfl_xor(v, o);
  return v;
}
DEVI void unpack8(const u32x4 w, float (&f)[8]) { f[0] = bflo(w.x); f[1] = bfhi(w.x); f[2] = bflo(w.y); f[3] = bfhi(w.y); f[4] = bflo(w.z); f[5] = bfhi(w.z); f[6] = bflo(w.w); f[7] = bfhi(w.w); }
DEVI u32x4 pack8(const float (&f)[8]) { u32x4 w; w.x = cvt_pk_bf16(f[0], f[1]); w.y = cvt_pk_bf16(f[2], f[3]); w.z = cvt_pk_bf16(f[4], f[5]); w.w = cvt_pk_bf16(f[6], f[7]); return w; }
DEVI bf16x8 as_bf16x8(const u32x4 w) { union { u32x4 u; bf16x8 b; } c; c.u = w; return c.b; }
DEVI f32x4 mfma16(bf16x8 a, bf16x8 b, f32x4 c) { return __builtin_amdgcn_mfma_f32_16x16x32_bf16(a, b, c, 0, 0, 0); }

struct EpiRes {
  static constexpr bool PERM = false, AFTER_DRAIN = false;
  const float* xp; const float* xs; float* xo; const float* gate;
  __device__ __forceinline__ void operator()(const f32x4 (&acc)[2][2][4][2], const pg8::Unit& u, int wr, int wc, int fr, int fq) const {
    const int row0 = u.pm * 256 + wr * 64 + fr, col0 = u.pn * 256 + wc * 32 + 4 * fq;
#pragma unroll
    for (int ai = 0; ai < 2; ++ai)
#pragma unroll
      for (int m = 0; m < 4; ++m) {
        const int row = row0 + ai * 128 + m * 16;
        if (row < NRV) {
          const float* xi = (row < NPR ? xp + (size_t)row * 1024 : xs + (size_t)(row - NPR) * 1024) + col0;
          const int mrow = row < NPR ? (row >> 11) : 8 + (row - NPR);
          const float* gp = gate + (size_t)mrow * 12288 + col0;
          float* op = xo + (size_t)row * 1024 + col0;
#pragma unroll
          for (int bj = 0; bj < 2; ++bj)
#pragma unroll
            for (int n = 0; n < 2; ++n) {
              const f32x4 xv = *(const f32x4*)(xi + bj * 128 + n * 16), gv = *(const f32x4*)(gp + bj * 128 + n * 16);
              *(f32x4*)(op + bj * 128 + n * 16) = xv + gv * acc[ai][bj][m][n];
            }
        }
      }
  }
};
struct EpiGlu {
  static constexpr bool PERM = true, AFTER_DRAIN = false;
  const bf16_t* y1; const bf16_t* z; bf16_t* y2; const float* bias;
  __device__ __forceinline__ void operator()(const f32x4 (&acc)[2][2][4][2], const pg8::Unit& u, int wr, int wc, int fr, int fq) const {
    const int row0 = u.pm * 256 + wr * 64 + fr, col0 = u.pn * 256 + wc * 32 + 8 * fq;
#pragma unroll
    for (int ai = 0; ai < 2; ++ai)
#pragma unroll
      for (int m = 0; m < 4; ++m) {
        const int row = row0 + ai * 128 + m * 16;
#pragma unroll
        for (int bj = 0; bj < 2; ++bj) {
          const int col = col0 + bj * 128;
          const f32x4 b0 = *(const f32x4*)(bias + col), b1 = *(const f32x4*)(bias + col + 4);
          const u32x4 yw = *(const u32x4*)(y1 + (size_t)row * 1024 + col), zw = *(const u32x4*)(z + (size_t)row * 2048 + col);
          float yf[8], zf[8], o[8]; unpack8(yw, yf); unpack8(zw, zf);
          const f32x4 a0 = acc[ai][bj][m][0] + b0, a1 = acc[ai][bj][m][1] + b1;
#pragma unroll
          for (int e = 0; e < 4; ++e) { o[e] = yf[e] * sigmoidf_(a0[e]) * siluf_(zf[e]); o[4 + e] = yf[4 + e] * sigmoidf_(a1[e]) * siluf_(zf[4 + e]); }
          *(u32x4*)(y2 + (size_t)row * 1024 + col) = pack8(o);
        }
      }
  }
};

struct TileDesc { const float* src; bf16_t* dst; int ldsrc, lddst, k0, n0; };
DEVI TileDesc prep_tile(KP p, int t) {
  TileDesc d; int tt = t;
  if (tt < 3072) { const int mat = tt / 768, r = tt % 768; d.k0 = (r / 48) * 64; d.n0 = (r % 48) * 64; d.src = p->in[I_MODW] + (size_t)mat * 1024 * 3072; d.ldsrc = 3072; d.dst = (bf16_t*)(p->ws + WS_WT_MOD) + (size_t)mat * 3072 * 1024; d.lddst = 1024; }
  else if ((tt -= 3072) < 3072) { const int mat = tt / 1536, r = tt % 1536; d.k0 = (r / 96) * 64; d.n0 = (r % 96) * 64; d.src = p->in[I_ABIN] + (size_t)mat * 1024 * 6160; d.ldsrc = 6160; d.dst = (bf16_t*)(p->ws + WS_WT_INAB) + (size_t)mat * 6144 * 1024; d.lddst = 1024; }
  else if ((tt -= 3072) < 1024) { const int mat = tt / 512, r = tt % 512; d.k0 = (r / 16) * 64; d.n0 = (r % 16) * 64; d.src = p->in[I_ABOUT] + (size_t)mat * 2048 * 1024; d.ldsrc = 1024; d.dst = (bf16_t*)(p->ws + WS_WT_OUTAB) + (size_t)mat * 1024 * 2048; d.lddst = 2048; }
  else if ((tt -= 1024) < 1024) { const int mat = tt / 512, r = tt % 512; d.k0 = (r / 32) * 64; d.n0 = (r % 32) * 64; d.src = p->in[I_CIN] + (size_t)mat * 1024 * 2048; d.ldsrc = 2048; d.dst = (bf16_t*)(p->ws + WS_WT_CIN) + (size_t)mat * 2048 * 1024; d.lddst = 1024; }
  else if ((tt -= 1024) < 512) { const int mat = tt / 256, r = tt % 256; d.k0 = (r / 16) * 64; d.n0 = (r % 16) * 64; d.src = p->in[I_COUT] + (size_t)mat * 1024 * 1024; d.ldsrc = 1024; d.dst = (bf16_t*)(p->ws + WS_WT_COUT) + (size_t)mat * 1024 * 1024; d.lddst = 1024; }
  else if ((tt -= 512) < 512) { const int mat = tt / 256, r = tt % 256; d.k0 = (r / 16) * 64; d.n0 = (r % 16) * 64; d.src = p->in[I_GLUW] + (size_t)mat * 1024 * 1024; d.ldsrc = 1024; d.dst = (bf16_t*)(p->ws + WS_WT_GLU) + (size_t)mat * 1024 * 1024; d.lddst = 1024; }
  else { tt -= 512; const int gate = tt / 64; const int r2 = tt % 64; const int mat = r2 / 4, r = r2 % 4;
    d.k0 = (r / 2) * 64; d.n0 = (r % 2) * 64; d.src = p->in[gate ? I_GAW : I_GXW] + (size_t)mat * 16384; d.ldsrc = 128;
    d.dst = (bf16_t*)(p->ws + WS_WT_LRU) + (size_t)(((mat >> 3) * 2 + gate) * 8 + (mat & 7)) * 16384; d.lddst = 128; }
  return d;
}
DEVI void phase_prep(KP p, float* lds) {
  const int tid = tidx_(), tx = tid & 15, ty = tid >> 4, nn = tid >> 3, ks = (tid & 7) * 8;
  for (int t0 = bidx_(); t0 < 9344; t0 += 4 * gdim_()) {
    float4 v[4][2];
#pragma unroll
    for (int q = 0; q < 4; ++q) { const int t = t0 + q * gdim_();
      if (t < 9344) { const TileDesc d = prep_tile(p, t);
#pragma unroll
        for (int pp = 0; pp < 2; ++pp) v[q][pp] = *(const float4*)(d.src + (size_t)(d.k0 + ty + pp * 32) * d.ldsrc + d.n0 + tx * 4); } }
#pragma unroll
    for (int q = 0; q < 4; ++q) { float* tile = lds + q * 4160;
#pragma unroll
      for (int pp = 0; pp < 2; ++pp) { const int k = ty + pp * 32; tile[k * 65 + tx * 4 + 0] = v[q][pp].x; tile[k * 65 + tx * 4 + 1] = v[q][pp].y; tile[k * 65 + tx * 4 + 2] = v[q][pp].z; tile[k * 65 + tx * 4 + 3] = v[q][pp].w; } }
    __syncthreads();
#pragma unroll
    for (int q = 0; q < 4; ++q) { const int t = t0 + q * gdim_();
      if (t < 9344) { const TileDesc d = prep_tile(p, t); const float* tile = lds + q * 4160; float f[8];
#pragma unroll
        for (int jx = 0; jx < 8; ++jx) f[jx] = tile[(ks + jx) * 65 + nn];
        *(u32x4*)(d.dst + (size_t)(d.n0 + nn) * d.lddst + d.k0 + ks) = pack8(f); } }
    __syncthreads();
  }
  { bf16_t* wtt = (bf16_t*)(p->ws + WS_WT_TAIL);
    for (int e = bidx_() * 512 + tidx_(); e < 32768; e += gdim_() * 512) { const int jj = e >> 14, cc = (e >> 10) & 15, k = e & 1023;
      wtt[e] = f2bf(p->in[I_ABIN][(size_t)jj * 1024 * 6160 + (size_t)k * 6160 + 6144 + cc]); } }
  bf16_t* sc = (bf16_t*)(p->ws + WS_SILUC);
  for (int e = bidx_() * 512 + tidx_(); e < 256 * 1024 / 4; e += gdim_() * 512) {
    const int row = e >> 8, c4 = (e & 255) * 4; float4 v = make_float4(0.f, 0.f, 0.f, 0.f);
    if (row < 8) v = *(const float4*)(p->in[I_CP] + row * 1024 + c4); else if (row < 136) v = *(const float4*)(p->in[I_CS] + (row - 8) * 1024 + c4);
    u32x2 w; w.x = cvt_pk_bf16(row < 136 ? siluf_(v.x) : 0.f, row < 136 ? siluf_(v.y) : 0.f); w.y = cvt_pk_bf16(row < 136 ? siluf_(v.z) : 0.f, row < 136 ? siluf_(v.w) : 0.f);
    *(u32x2*)(sc + row * 1024 + c4) = w;
  }
}

DEVI void norm_row2(const float* x0, const float* x1, bool two, const float (&wm)[16], const float (&sh)[16], bf16_t* h0, bf16_t* h1, int lane) {
  float4 v0[4], v1[4]; float s0 = 0.f, s1 = 0.f;
#pragma unroll
  for (int i = 0; i < 4; ++i) { v0[i] = *(const float4*)(x0 + i * 256 + lane * 4); v1[i] = two ? *(const float4*)(x1 + i * 256 + lane * 4) : make_float4(0.f, 0.f, 0.f, 0.f); }
#pragma unroll
  for (int i = 0; i < 4; ++i) { s0 += v0[i].x * v0[i].x + v0[i].y * v0[i].y + v0[i].z * v0[i].z + v0[i].w * v0[i].w; s1 += v1[i].x * v1[i].x + v1[i].y * v1[i].y + v1[i].z * v1[i].z + v1[i].w * v1[i].w; }
#pragma unroll
  for (int o = 32; o >= 1; o >>= 1) { s0 += __shfl_xor(s0, o); s1 += __shfl_xor(s1, o); }
  const float r0 = __builtin_amdgcn_rsqf(s0 * (1.f / 1024.f) + 1e-6f), r1 = __builtin_amdgcn_rsqf(s1 * (1.f / 1024.f) + 1e-6f);
#pragma unroll
  for (int i = 0; i < 4; ++i) { const int k = i * 256 + lane * 4;
    u32x2 w; w.x = cvt_pk_bf16(v0[i].x * r0 * wm[i * 4 + 0] + sh[i * 4 + 0], v0[i].y * r0 * wm[i * 4 + 1] + sh[i * 4 + 1]); w.y = cvt_pk_bf16(v0[i].z * r0 * wm[i * 4 + 2] + sh[i * 4 + 2], v0[i].w * r0 * wm[i * 4 + 3] + sh[i * 4 + 3]);
    *(u32x2*)(h0 + k) = w;
    if (two) { u32x2 w2; w2.x = cvt_pk_bf16(v1[i].x * r1 * wm[i * 4 + 0] + sh[i * 4 + 0], v1[i].y * r1 * wm[i * 4 + 1] + sh[i * 4 + 1]); w2.y = cvt_pk_bf16(v1[i].z * r1 * wm[i * 4 + 2] + sh[i * 4 + 2], v1[i].w * r1 * wm[i * 4 + 3] + sh[i * 4 + 3]);
      *(u32x2*)(h1 + k) = w2; } }
}
DEVI void norm_coefs(KP p, int layer, int mrow, int lane, float (&wm)[16], float (&sh)[16]) {
  const float* nw = p->in[I_NORMW] + layer * 1024;
  const float* md = (const float*)(p->ws + WS_MOD) + (size_t)mrow * 12288 + layer * 3072;
#pragma unroll
  for (int i = 0; i < 4; ++i) { const int k = i * 256 + lane * 4; const float4 w4 = *(const float4*)(nw + k), s4 = *(const float4*)(md + k), c4 = *(const float4*)(md + 1024 + k);
    wm[i * 4 + 0] = w4.x * (1.f + c4.x); wm[i * 4 + 1] = w4.y * (1.f + c4.y); wm[i * 4 + 2] = w4.z * (1.f + c4.z); wm[i * 4 + 3] = w4.w * (1.f + c4.w);
    sh[i * 4 + 0] = s4.x; sh[i * 4 + 1] = s4.y; sh[i * 4 + 2] = s4.z; sh[i * 4 + 3] = s4.w; }
}
DEVI void phase_norm(KP p, int layer, float* lds) {
  const int tid = tidx_(), lane = tid & 63, wave = tid >> 6;
  bf16_t* hb = (bf16_t*)(p->ws + WS_YBUF);
  float wm[16], sh[16];
  for (int gw = bidx_() * 8 + wave; gw < 2048; gw += gdim_() * 8) {
    const int r0 = gw * 8;
    norm_coefs(p, layer, r0 >> 11, lane, wm, sh);
    const float* xb = (layer == 0) ? p->in[I_XP] : p->out;
#pragma unroll 2
    for (int i = 0; i < 8; i += 2) norm_row2(xb + (size_t)(r0 + i) * 1024, xb + (size_t)(r0 + i + 1) * 1024, true, wm, sh, hb + (size_t)(r0 + i) * 1024, hb + (size_t)(r0 + i + 1) * 1024, lane);
    if (gw < 128) {
      norm_coefs(p, layer, 8 + gw, lane, wm, sh);
      const float* xs = (layer == 0) ? p->in[I_XS] + (size_t)gw * 1024 : p->out + (size_t)(NPR + gw) * 1024;
      norm_row2(xs, xs, false, wm, sh, hb + (size_t)(NPR + gw) * 1024, hb, lane);
    }
  }
}
DEVI void tail_gemm(KP p, int j) {
  const int tid = tidx_(), lane = tid & 63, wave = tid >> 6, l15 = lane & 15, lq = lane >> 4;
  const bf16_t* hb = (const bf16_t*)(p->ws + WS_YBUF);
  const bf16_t* bp = (const bf16_t*)(p->ws + WS_WT_TAIL) + (size_t)j * 16384 + l15 * 1024 + lq * 8;
  float* tl = (float*)(p->ws + WS_TAIL);
  for (int t = bidx_() * 8 + wave; t < 1032; t += gdim_() * 8) {
    const bf16_t* ap = hb + (size_t)(t * 16 + l15) * 1024 + lq * 8;
    f32x4 acc0 = (f32x4){0.f, 0.f, 0.f, 0.f}, acc1 = (f32x4){0.f, 0.f, 0.f, 0.f};
#pragma unroll 1
    for (int k0 = 0; k0 < 1024; k0 += 256) {
      u32x4 a[8], b[8];
#pragma unroll
      for (int u = 0; u < 8; ++u) { a[u] = *(const u32x4*)(ap + k0 + u * 32); b[u] = *(const u32x4*)(bp + k0 + u * 32); }
#pragma unroll
      for (int u = 0; u < 8; u += 2) { acc0 = mfma16(as_bf16x8(a[u]), as_bf16x8(b[u]), acc0); acc1 = mfma16(as_bf16x8(a[u + 1]), as_bf16x8(b[u + 1]), acc1); }
    }
    acc0 = acc0 + acc1;
#pragma unroll
    for (int r = 0; r < 4; ++r) tl[(size_t)(t * 16 + lq * 4 + r) * 16 + l15] = acc0[r];
  }
}

DEVI void lru_item(KP p, int j, int item, unsigned char* lds) {
  const int tid = tidx_(), lane = tid & 63, wave = tid >> 6;
  const bool prompt = item < 128;
  const int b = prompt ? (item >> 4) : 0, hd = prompt ? ((item >> 1) & 7) : ((item - 128) >> 1), half = item & 1;
  bf16_t* WX = (bf16_t*)lds;
  bf16_t* XA = (bf16_t*)(lds + 34816);
  float* AA = (float*)(lds + 52224);
  float* BB = (float*)(lds + 69632);
  bf16_t* RAW = (bf16_t*)(lds + 87040);
  float* CAR = (float*)(lds + 105472);
  const bf16_t* proj = (const bf16_t*)(p->ws + WS_PROJ);
  bf16_t* ybuf = (bf16_t*)(p->ws + WS_YBUF);
  { const bf16_t* wt = (const bf16_t*)(p->ws + WS_WT_LRU);
#pragma unroll
    for (int q = 0; q < 4; ++q) { const int e = tid + q * 512, gate = e >> 10, o = (e & 1023) >> 4, c8 = e & 15;
      *(u32x4*)(WX + (gate * 64 + o) * 136 + c8 * 8) = *(const u32x4*)(wt + ((size_t)((j * 2 + gate) * 8 + hd) * 128 + half * 64 + o) * 128 + c8 * 8); } }
  const int ch8 = tid & 15, rsub = tid >> 4, chb = hd * 128 + ch8 * 8;
  float cw[4][8], cb[8];
#pragma unroll
  for (int t = 0; t < 4; ++t)
#pragma unroll
    for (int e = 0; e < 8; ++e) cw[t][e] = p->in[I_CAW][(size_t)(j * 4 + t) * 1024 + chb + e];
#pragma unroll
  for (int e = 0; e < 8; ++e) cb[e] = p->in[I_CAB][j * 1024 + chb + e];
  const int rt = wave >> 1, chh = wave & 1, l15 = lane & 15, lq = lane >> 4;
  float gxb[2], gab[2], spv[2];
#pragma unroll
  for (int c2 = 0; c2 < 2; ++c2) { const int gch = hd * 128 + half * 64 + chh * 32 + c2 * 16 + l15;
    gxb[c2] = p->in[I_GXB][j * 1024 + gch]; gab[c2] = p->in[I_GAB][j * 1024 + gch]; spv[c2] = softplusf_(-p->in[I_APAR][j * 1024 + gch]); }
  const int sch = hd * 128 + half * 64 + lane;
  float hcar = 0.f;
  const int ntiles = prompt ? 32 : 2;
  u32x4 pre[3];
  if (prompt) {
#pragma unroll
    for (int q = 0; q < 3; ++q) { const int e = tid + q * 512, row = e >> 4, c8 = e & 15, t = row - 3; pre[q] = (u32x4){0u, 0u, 0u, 0u};
      if (e < 1072 && t >= 0) pre[q] = *(const u32x4*)(proj + (size_t)(b * 2048 + t) * 6144 + hd * 128 + c8 * 8); }
  }
  for (int tile = 0; tile < ntiles; ++tile) {
    bf16_t zav[8];
#pragma unroll
    for (int i = 0; i < 8; ++i) { const size_t grow = prompt ? (size_t)(b * 2048 + tile * 64 + wave * 8 + i) : (size_t)(NPR + tile * 64 + wave * 8 + i); zav[i] = proj[grow * 6144 + 1024 + sch]; }
    if (prompt) {
#pragma unroll
      for (int q = 0; q < 3; ++q) { const int e = tid + q * 512; if (e < 1072) *(u32x4*)(RAW + (e >> 4) * 136 + (e & 15) * 8) = pre[q]; }
      if (tile + 1 < ntiles) {
#pragma unroll
        for (int q = 0; q < 3; ++q) { const int e = tid + q * 512, row = e >> 4, c8 = e & 15, t = (tile + 1) * 64 + row - 3;
          if (e < 1072) pre[q] = *(const u32x4*)(proj + (size_t)(b * 2048 + t) * 6144 + hd * 128 + c8 * 8); }
      }
      lds_barrier();
#pragma unroll
      for (int pp = 0; pp < 2; ++pp) {
        const int i = rsub + pp * 32; float acc[8];
#pragma unroll
        for (int e = 0; e < 8; ++e) acc[e] = cb[e];
#pragma unroll
        for (int tap = 0; tap < 4; ++tap) { float xf[8]; unpack8(*(const u32x4*)(RAW + (i + tap) * 136 + ch8 * 8), xf);
#pragma unroll
          for (int e = 0; e < 8; ++e) acc[e] += cw[tap][e] * xf[e]; }
        *(u32x4*)(XA + i * 136 + ch8 * 8) = pack8(acc);
      }
      if (tile == 31 && half == 0 && tid < 48) { const int r3 = tid >> 4, c8 = tid & 15; float xf[8]; unpack8(*(const u32x4*)(RAW + (64 + r3) * 136 + c8 * 8), xf);
        float* o = p->out + O_PCA + (size_t)((j * 8 + b) * 3 + r3) * 1024 + hd * 128 + c8 * 8;
        *(float4*)o = make_float4(xf[0], xf[1], xf[2], xf[3]); *(float4*)(o + 4) = make_float4(xf[4], xf[5], xf[6], xf[7]); }
    } else {
#pragma unroll
      for (int pp = 0; pp < 2; ++pp) {
        const int i = rsub + pp * 32; float acc[8], x3[8];
#pragma unroll
        for (int e = 0; e < 8; ++e) acc[e] = cb[e];
        const int brow = tile * 64 + i;
        const float* st = p->in[I_SCA] + (size_t)((j * 128 + brow) * 3) * 1024 + chb;
        float* so = p->out + O_SCA + (size_t)((j * 128 + brow) * 3) * 1024 + chb;
#pragma unroll
        for (int tap = 0; tap < 3; ++tap) { const float4 s0 = *(const float4*)(st + tap * 1024), s1 = *(const float4*)(st + tap * 1024 + 4);
          const float xf[8] = {s0.x, s0.y, s0.z, s0.w, s1.x, s1.y, s1.z, s1.w};
#pragma unroll
          for (int e = 0; e < 8; ++e) acc[e] += cw[tap][e] * xf[e];
          if (tap >= 1 && half == 0) { *(float4*)(so + (tap - 1) * 1024) = s0; *(float4*)(so + (tap - 1) * 1024 + 4) = s1; } }
        const u32x4 w = *(const u32x4*)(proj + (size_t)(NPR + brow) * 6144 + chb); unpack8(w, x3);
#pragma unroll
        for (int e = 0; e < 8; ++e) acc[e] += cw[3][e] * x3[e];
        if (half == 0) { *(float4*)(so + 2 * 1024) = make_float4(x3[0], x3[1], x3[2], x3[3]); *(float4*)(so + 2 * 1024 + 4) = make_float4(x3[4], x3[5], x3[6], x3[7]); }
        *(u32x4*)(XA + i * 136 + ch8 * 8) = pack8(acc);
      }
    }
    lds_barrier();
    f32x4 accx[2], acca[2];
#pragma unroll
    for (int c2 = 0; c2 < 2; ++c2) { accx[c2] = (f32x4){0.f, 0.f, 0.f, 0.f}; acca[c2] = (f32x4){0.f, 0.f, 0.f, 0.f}; }
#pragma unroll
    for (int kk = 0; kk < 4; ++kk) {
      const bf16x8 a = *(const bf16x8*)(XA + (rt * 16 + l15) * 136 + lq * 8 + kk * 32);
#pragma unroll
      for (int c2 = 0; c2 < 2; ++c2) {
        const bf16x8 bx = *(const bf16x8*)(WX + (chh * 32 + c2 * 16 + l15) * 136 + lq * 8 + kk * 32);
        const bf16x8 ba = *(const bf16x8*)(WX + (64 + chh * 32 + c2 * 16 + l15) * 136 + lq * 8 + kk * 32);
        accx[c2] = mfma16(a, bx, accx[c2]); acca[c2] = mfma16(a, ba, acca[c2]);
      }
    }
#pragma unroll
    for (int c2 = 0; c2 < 2; ++c2)
#pragma unroll
      for (int r = 0; r < 4; ++r) {
        const int row = rt * 16 + lq * 4 + r, oc = chh * 32 + c2 * 16 + l15;
        const float gx = sigmoidf_(accx[c2][r] + gxb[c2]), ga = sigmoidf_(acca[c2][r] + gab[c2]);
        const float log_a = -8.f * ga * spv[c2];
        const float a = fexp_(log_a);
        float mult = __builtin_amdgcn_sqrtf(fmaxf(1.f - a * a, 0.f));
        if (prompt && tile == 0 && row == 0) mult = 1.f;
        const float xv = bf2f(XA[row * 136 + half * 64 + oc]);
        AA[row * 68 + oc] = a; BB[row * 68 + oc] = mult * gx * xv;
      }
    lds_barrier();
    float hl[8], pc[8];
    { float h = 0.f, P = 1.f;
#pragma unroll
      for (int i = 0; i < 8; ++i) { const float a = AA[(wave * 8 + i) * 68 + lane], bv = BB[(wave * 8 + i) * 68 + lane];
        if (prompt) { h = a * h + bv; P *= a; hl[i] = h; pc[i] = P; } else { hl[i] = bv; pc[i] = a; } }
      CAR[(wave * 64 + lane) * 2] = P; CAR[(wave * 64 + lane) * 2 + 1] = h; }
    lds_barrier();
    float cin = 0.f;
    if (prompt) { float c = hcar;
#pragma unroll
      for (int s = 0; s < 8; ++s) { const float Ps = CAR[(s * 64 + lane) * 2], Es = CAR[(s * 64 + lane) * 2 + 1]; if (s == wave) cin = c; c = Ps * c + Es; }
      hcar = c; }
#pragma unroll
    for (int i = 0; i < 8; ++i) {
      const int rowl = tile * 64 + wave * 8 + i;
      float hv;
      if (prompt) hv = hl[i] + pc[i] * cin;
      else { const float h0 = p->in[I_SLRU][(size_t)(j * 128 + rowl) * 1024 + sch]; hv = pc[i] * h0 + hl[i]; p->out[O_SLRU + (size_t)(j * 128 + rowl) * 1024 + sch] = hv; }
      const size_t grow = prompt ? (size_t)(b * 2048 + rowl) : (size_t)(NPR + rowl);
      ybuf[grow * 2048 + sch] = f2bf(hv * siluf_(bf2f(zav[i])));
    }
  }
  if (prompt && wave == 0) p->out[O_PLRU + (size_t)(j * 8 + b) * 1024 + sch] = hcar;
}

DEVI void gdn_prep_item(KP p, int j, int cid, unsigned char* lds) {
  const int tid = tidx_(), lane = tid & 63, wave = tid >> 6;
  const int b = cid >> 8, h = (cid >> 5) & 7, c = cid & 31;
  const int row0 = b * 2048 + c * 64;
  bf16_t* QN = (bf16_t*)lds; bf16_t* KN = (bf16_t*)(lds + 17408); bf16_t* VN = (bf16_t*)(lds + 34816);
  float* AM = (float*)(lds + 52224); float* GC = (float*)(lds + 69632); float* BETA = (float*)(lds + 69888); float* BEG = (float*)(lds + 70144);
  const bf16_t* proj = (const bf16_t*)(p->ws + WS_PROJ);
  const float* tl = (const float*)(p->ws + WS_TAIL);
  if (wave == 0) {
    const float* t = tl + (size_t)(row0 + lane) * 16;
    float g = -fexp_(p->in[I_ALOG][j * 8 + h]) * softplusf_(t[8 + h] + p->in[I_DTB][j * 8 + h]);
    const float beta = sigmoidf_(t[h]);
#pragma unroll
    for (int o = 1; o < 64; o <<= 1) { const float v = __shfl_up(g, o); if (lane >= o) g += v; }
    GC[lane] = g; BETA[lane] = beta; BEG[lane] = beta * fexp_(g);
  }
  bf16_t* RAWB = (bf16_t*)(lds + 70656);
  bf16_t* AMB = (bf16_t*)(lds + 70656);
  bf16_t* XT = (bf16_t*)(lds + 79872);
  float* CORR = (float*)lds;
  float* CW = (float*)(lds + 123184);
  {
    u32x4 rv[7];
#pragma unroll
    for (int q = 0; q < 7; ++q) { const int e = tid + 512 * q, row = e / 48, c16 = e - row * 48, tt = c * 64 + row - 3; rv[q] = (u32x4){0u, 0u, 0u, 0u};
      if (e < 3216 && tt >= 0) rv[q] = *(const u32x4*)(proj + (size_t)(b * 2048 + tt) * 6144 + 2048 + (c16 >> 4) * 1024 + h * 128 + (c16 & 15) * 8); }
    float4 wv = make_float4(0.f, 0.f, 0.f, 0.f);
    if (tid < 384) { const int tap = tid / 96, lc = (tid - tap * 96) * 4; wv = *(const float4*)(p->in[I_CBW] + (size_t)(j * 4 + tap) * 3072 + (lc >> 7) * 1024 + h * 128 + (lc & 127)); }
#pragma unroll
    for (int q = 0; q < 7; ++q) { const int e = tid + 512 * q, row = e / 48, c16 = e - row * 48; if (e < 3216) *(u32x4*)(RAWB + row * 392 + c16 * 8) = rv[q]; }
    if (tid < 384) { const int tap = tid / 96, lc = (tid - tap * 96) * 4; *(float4*)(CW + tap * 384 + lc) = wv; }
  }
  lds_barrier();
  if (c == 31 && tid < 144) { const int r3 = tid / 48, c16 = tid - r3 * 48; float xf[8]; unpack8(*(const u32x4*)(RAWB + (64 + r3) * 392 + c16 * 8), xf);
    float* o = p->out + O_PCB + (size_t)((j * 8 + b) * 3 + r3) * 3072 + (c16 >> 4) * 1024 + h * 128 + (c16 & 15) * 8;
    *(float4*)o = make_float4(xf[0], xf[1], xf[2], xf[3]); *(float4*)(o + 4) = make_float4(xf[4], xf[5], xf[6], xf[7]); }
#pragma unroll 2
  for (int pi = 0; pi < 6; ++pi) {
    const int pair = tid + 512 * pi, part = pair >> 10, rem = pair & 1023, i = rem >> 4, cgp = rem & 15;
    float acc[8];
#pragma unroll
    for (int e = 0; e < 8; ++e) acc[e] = 0.f;
#pragma unroll
    for (int tap = 0; tap < 4; ++tap) { float xf[8]; unpack8(*(const u32x4*)(RAWB + (i + tap) * 392 + part * 128 + cgp * 8), xf);
      const float4 w0 = *(const float4*)(CW + tap * 384 + part * 128 + cgp * 8), w1 = *(const float4*)(CW + tap * 384 + part * 128 + cgp * 8 + 4);
      acc[0] += w0.x * xf[0]; acc[1] += w0.y * xf[1]; acc[2] += w0.z * xf[2]; acc[3] += w0.w * xf[3];
      acc[4] += w1.x * xf[4]; acc[5] += w1.y * xf[5]; acc[6] += w1.z * xf[6]; acc[7] += w1.w * xf[7]; }
    float ss = 0.f;
#pragma unroll
    for (int e = 0; e < 8; ++e) { acc[e] = siluf_(acc[e]); ss += acc[e] * acc[e]; }
    ss += __shfl_xor(ss, 1); ss += __shfl_xor(ss, 2); ss += __shfl_xor(ss, 4); ss += __shfl_xor(ss, 8);
    float scl = 1.f;
    if (part == 0) scl = __builtin_amdgcn_rsqf(ss + 1e-6f) * 0.08838834764831845f; else if (part == 1) scl = __builtin_amdgcn_rsqf(ss + 1e-6f);
#pragma unroll
    for (int e = 0; e < 8; ++e) acc[e] *= scl;
    bf16_t* dstp = part == 0 ? QN : (part == 1 ? KN : VN);
    *(u32x4*)(dstp + i * 136 + cgp * 8) = pack8(acc);
  }
  lds_barrier();
  {
    const int rt = wave >> 1, ctp = (wave & 1) * 2, l15 = lane & 15, lq = lane >> 4;
    f32x4 kka[2], qka[2];
#pragma unroll
    for (int c2 = 0; c2 < 2; ++c2) { kka[c2] = (f32x4){0.f, 0.f, 0.f, 0.f}; qka[c2] = (f32x4){0.f, 0.f, 0.f, 0.f}; }
#pragma unroll
    for (int kk = 0; kk < 4; ++kk) {
      const bf16x8 ak = *(const bf16x8*)(KN + (rt * 16 + l15) * 136 + lq * 8 + kk * 32);
      const bf16x8 aq = *(const bf16x8*)(QN + (rt * 16 + l15) * 136 + lq * 8 + kk * 32);
#pragma unroll
      for (int c2 = 0; c2 < 2; ++c2) { const bf16x8 bk = *(const bf16x8*)(KN + ((ctp + c2) * 16 + l15) * 136 + lq * 8 + kk * 32);
        kka[c2] = mfma16(ak, bk, kka[c2]); qka[c2] = mfma16(aq, bk, qka[c2]); }
    }
    bf16_t* qkg = (bf16_t*)(p->ws + WS_QK) + (size_t)cid * 4096;
#pragma unroll
    for (int c2 = 0; c2 < 2; ++c2)
#pragma unroll
      for (int r = 0; r < 4; ++r) {
        const int i = rt * 16 + lq * 4 + r, jj = (ctp + c2) * 16 + l15;
        const float dec = fexp_(fminf(GC[i] - GC[jj], 0.f));
        const float aval = (i > jj) ? BETA[i] * kka[c2][r] * dec : 0.f;
        AM[i * 68 + jj] = aval; AMB[i * 72 + jj] = f2bf(aval);
        qkg[(((i >> 4) * 2 + (jj >> 5)) * 64 + ((jj & 31) >> 3) * 16 + (i & 15)) * 8 + (jj & 7)] = f2bf((i >= jj) ? qka[c2][r] * dec : 0.f);
      }
  }
  lds_barrier();
  const int cc = tid & 255;
  const bf16_t* rsrc = (cc < 128) ? (VN + cc) : (KN + (cc - 128));
  const float* rfac = (cc < 128) ? BETA : BEG;
#pragma unroll
  for (int bi = 0; bi < 4; ++bi) {
    if (bi > 0) {
      const int l15 = lane & 15, lq = lane >> 4;
#pragma unroll
      for (int n2 = 0; n2 < 2; ++n2) { const int nt = wave * 2 + n2; f32x4 acc = (f32x4){0.f, 0.f, 0.f, 0.f};
#pragma unroll
        for (int kk = 0; kk < (bi * 16 + 31) / 32; ++kk) { const int k0 = lq * 8 + kk * 32; const bool valid = k0 < bi * 16;
          u32x4 av = *(const u32x4*)(AMB + (bi * 16 + l15) * 72 + k0), bv = *(const u32x4*)(XT + (nt * 16 + l15) * 72 + k0);
          if (!valid) { av = (u32x4){0u, 0u, 0u, 0u}; bv = (u32x4){0u, 0u, 0u, 0u}; }
          acc = mfma16(as_bf16x8(av), as_bf16x8(bv), acc); }
#pragma unroll
        for (int r = 0; r < 4; ++r) CORR[(lq * 4 + r) * 260 + nt * 16 + l15] = acc[r]; }
      lds_barrier();
    }
    if (tid < 256) {
      float xb[16], rh[16];
#pragma unroll
      for (int ii = 0; ii < 16; ++ii) { const int i = bi * 16 + ii; rh[ii] = bf2f(rsrc[i * 136]) * rfac[i]; if (bi > 0) rh[ii] -= CORR[ii * 260 + cc]; }
#pragma unroll
      for (int rg = 0; rg < 4; ++rg) {
        f32x4 a[4][4];
#pragma unroll
        for (int q = 0; q < 4; ++q)
#pragma unroll
          for (int g4 = 0; g4 <= rg; ++g4) a[q][g4] = *(const f32x4*)(AM + (bi * 16 + rg * 4 + q) * 68 + bi * 16 + g4 * 4);
#pragma unroll
        for (int q = 0; q < 4; ++q) { const int ii = rg * 4 + q; float s = rh[ii];
#pragma unroll
          for (int jj = 0; jj < ii; ++jj) s -= a[q][jj >> 2][jj & 3] * xb[jj];
          xb[ii] = s; }
        asm volatile("" : "+v"(xb[rg * 4 + 3]) :: "memory");
      }
      u32x4 w0, w1;
      w0.x = cvt_pk_bf16(xb[0], xb[1]); w0.y = cvt_pk_bf16(xb[2], xb[3]); w0.z = cvt_pk_bf16(xb[4], xb[5]); w0.w = cvt_pk_bf16(xb[6], xb[7]);
      w1.x = cvt_pk_bf16(xb[8], xb[9]); w1.y = cvt_pk_bf16(xb[10], xb[11]); w1.z = cvt_pk_bf16(xb[12], xb[13]); w1.w = cvt_pk_bf16(xb[14], xb[15]);
      if (bi < 3) { *(u32x4*)(XT + cc * 72 + bi * 16) = w0; *(u32x4*)(XT + cc * 72 + bi * 16 + 8) = w1; }
      if (cc < 128) {
        bf16_t* ut = (bf16_t*)(p->ws + WS_UT) + (size_t)cid * 8192 + cc * 64 + bi * 16;
        *(u32x4*)ut = w0; *(u32x4*)(ut + 8) = w1;
      } else {
        const int dk = cc - 128;
        bf16_t* wb = (bf16_t*)(p->ws + WS_WB) + (size_t)cid * 8192 + ((bi * 4 + (dk >> 5)) * 64 + ((dk & 31) >> 3) * 16) * 8 + (dk & 7);
#pragma unroll
        for (int ii = 0; ii < 16; ++ii) wb[ii * 8] = f2bf(xb[ii]);
      }
    } else if (bi == 0) {
      const int t2 = tid - 256;
      { const int i = t2 >> 2, dseg = (t2 & 3) * 32; const float eg = fexp_(GC[i]);
        bf16_t* qt = (bf16_t*)(p->ws + WS_QT) + (size_t)cid * 8192 + (((i >> 4) * 4 + (t2 & 3)) * 64 + (i & 15)) * 8;
#pragma unroll
        for (int s = 0; s < 4; ++s) { float f[8]; unpack8(*(const u32x4*)(QN + i * 136 + dseg + s * 8), f);
#pragma unroll
          for (int e = 0; e < 8; ++e) f[e] *= eg;
          *(u32x4*)(qt + s * 128) = pack8(f); } }
      { const int d = t2 >> 1, iseg = (t2 & 1) * 32; const float gl = GC[63];
        bf16_t* kt = (bf16_t*)(p->ws + WS_KT) + (size_t)cid * 8192 + (((d >> 4) * 2 + (t2 & 1)) * 64 + (d & 15)) * 8;
#pragma unroll
        for (int s = 0; s < 4; ++s) { float f[8];
#pragma unroll
          for (int e = 0; e < 8; ++e) { const int i = iseg + s * 8 + e; f[e] = bf2f(KN[i * 136 + d]) * fexp_(gl - GC[i]); }
          *(u32x4*)(kt + s * 128) = pack8(f); } }
      if (t2 == 0) ((float*)(p->ws + WS_EGL))[cid] = fexp_(GC[63]);
    }
    if (bi < 3) lds_barrier();
  }
}

DEVI void gdn_decode_item(KP p, int j, int item, unsigned char* lds) {
  const int tid = tidx_(), lane = tid & 63, wave = tid >> 6;
  const int b = item >> 3, h = item & 7;
  const size_t row = NPR + b;
  float* QKV = (float*)lds; float* RED = (float*)(lds + 1536); float* PART = (float*)(lds + 2048);
  const bf16_t* proj = (const bf16_t*)(p->ws + WS_PROJ);
  const int dv4 = tid & 31, dkq = tid >> 5;
  const float* S0 = p->in[I_SDEL] + (size_t)((j * 128 + b) * 8 + h) * 16384;
  float4 s[8];
#pragma unroll
  for (int r = 0; r < 8; ++r) s[r] = *(const float4*)(S0 + (dkq * 8 + r) * 128 + dv4 * 4);
  const float* t = (const float*)(p->ws + WS_TAIL) + row * 16;
  const float traw_a = t[8 + h], traw_b = t[h], alog = p->in[I_ALOG][j * 8 + h], dtb = p->in[I_DTB][j * 8 + h];
  if (tid < 384) {
    const int part = tid >> 7, ch = tid & 127, col = part * 1024 + h * 128 + ch;
    const float* st = p->in[I_SCB] + (size_t)((j * 128 + b) * 3) * 3072 + col;
    const float x0 = st[0], x1 = st[3072], x2 = st[6144], x3 = bf2f(proj[row * 6144 + 2048 + col]);
    const float* cw = p->in[I_CBW] + (size_t)(j * 4) * 3072 + col;
    const float val = siluf_(cw[0] * x0 + cw[3072] * x1 + cw[6144] * x2 + cw[9216] * x3);
    float* so = p->out + O_SCB + (size_t)((j * 128 + b) * 3) * 3072 + col;
    so[0] = x1; so[3072] = x2; so[6144] = x3;
    QKV[tid] = val;
    const float ss = wave_sum(val * val);
    if (lane == 0) RED[wave] = ss;
  }
  lds_barrier();
  const float rq = __builtin_amdgcn_rsqf(RED[0] + RED[1] + 1e-6f) * 0.08838834764831845f, rk = __builtin_amdgcn_rsqf(RED[2] + RED[3] + 1e-6f);
  const float g = -fexp_(alog) * softplusf_(traw_a + dtb);
  const float beta = sigmoidf_(traw_b), eg = fexp_(g);
  float* S1 = p->out + O_SDEL + (size_t)((j * 128 + b) * 8 + h) * 16384;
  float4 pt = make_float4(0.f, 0.f, 0.f, 0.f);
#pragma unroll
  for (int r = 0; r < 8; ++r) { const int dk = dkq * 8 + r; const float kd = QKV[128 + dk] * rk;
    pt.x += s[r].x * kd; pt.y += s[r].y * kd; pt.z += s[r].z * kd; pt.w += s[r].w * kd; }
  *(float4*)(PART + dkq * 128 + dv4 * 4) = pt;
  lds_barrier();
  float4 kv = make_float4(0.f, 0.f, 0.f, 0.f);
#pragma unroll
  for (int q = 0; q < 16; ++q) { const float4 v = *(const float4*)(PART + q * 128 + dv4 * 4); kv.x += v.x; kv.y += v.y; kv.z += v.z; kv.w += v.w; }
  const float4 vv = *(const float4*)(QKV + 256 + dv4 * 4);
  float4 vn; vn.x = beta * (vv.x - eg * kv.x); vn.y = beta * (vv.y - eg * kv.y); vn.z = beta * (vv.z - eg * kv.z); vn.w = beta * (vv.w - eg * kv.w);
  lds_barrier();
  float4 po = make_float4(0.f, 0.f, 0.f, 0.f);
#pragma unroll
  for (int r = 0; r < 8; ++r) { const int dk = dkq * 8 + r; const float kd = QKV[128 + dk] * rk, qd = QKV[dk] * rq;
    float4 n; n.x = eg * s[r].x + kd * vn.x; n.y = eg * s[r].y + kd * vn.y; n.z = eg * s[r].z + kd * vn.z; n.w = eg * s[r].w + kd * vn.w;
    *(float4*)(S1 + dk * 128 + dv4 * 4) = n;
    po.x += n.x * qd; po.y += n.y * qd; po.z += n.z * qd; po.w += n.w * qd; }
  *(float4*)(PART + dkq * 128 + dv4 * 4) = po;
  lds_barrier();
  float o = 0.f;
  if (tid < 128) {
#pragma unroll
    for (int q = 0; q < 16; ++q) o += PART[q * 128 + tid];
    const float ss = wave_sum(o * o);
    if (lane == 0) RED[8 + wave] = ss;
  }
  lds_barrier();
  if (tid < 128) {
    const float rinv = __builtin_amdgcn_rsqf((RED[8] + RED[9]) * (1.f / 128.f) + 1e-6f);
    const float zb = bf2f(proj[row * 6144 + 5120 + h * 128 + tid]);
    ((bf16_t*)(p->ws + WS_YBUF))[row * 2048 + 1024 + h * 128 + tid] = f2bf(o * rinv * p->in[I_GNW][j * 128 + tid] * siluf_(zb));
  }
}

DEVI void phase_mixprep(KP p, int layer, unsigned char* lds, int ph, int submask) {
  const int j = layer >> 1;
  unsigned* ctr = (unsigned*)(p->ws + WS_CTL) + 4096 + ph;
  int* slot = (int*)(lds + LDS_MISC);
  const bool lead = tidx_() == 0;
  int nxt = 0; if (lead) nxt = (int)atomicAdd(ctr, 1u);
  for (;;) {
    if (lead) *slot = nxt;
    lds_barrier();
    const int it = *slot;
    lds_barrier();
    if (it >= 3216) break;
    if (lead) nxt = (int)atomicAdd(ctr, 1u);
    if (it < 144) { if (submask & 1) lru_item(p, j, it, lds); }
    else if (it < 2192) { if (submask & 2) gdn_prep_item(p, j, it - 144, lds); }
    else { if (submask & 4) gdn_decode_item(p, j, it - 2192, lds); }
  }
}

struct GdnFrags { u32x4 wf[4], qf[4], qkf[2], ktf[2][2]; u32x2 uf; float egl; };
DEVI void gdn_load(GdnFrags& f, KP p, int cid, int s, int rt, int ct, int l15, int lq) {
  const bf16_t* wb = (const bf16_t*)(p->ws + WS_WB) + (size_t)cid * 8192;
  const bf16_t* qt = (const bf16_t*)(p->ws + WS_QT) + (size_t)cid * 8192;
  const bf16_t* kt = (const bf16_t*)(p->ws + WS_KT) + (size_t)cid * 8192;
  const bf16_t* qk = (const bf16_t*)(p->ws + WS_QK) + (size_t)cid * 4096;
  const bf16_t* ut = (const bf16_t*)(p->ws + WS_UT) + (size_t)cid * 8192;
  const int ln = lq * 16 + l15;
#pragma unroll
  for (int kk = 0; kk < 4; ++kk) { f.wf[kk] = *(const u32x4*)(wb + ((rt * 4 + kk) * 64 + ln) * 8); f.qf[kk] = *(const u32x4*)(qt + ((rt * 4 + kk) * 64 + ln) * 8); }
#pragma unroll
  for (int kk = 0; kk < 2; ++kk) { f.qkf[kk] = *(const u32x4*)(qk + ((rt * 2 + kk) * 64 + ln) * 8);
#pragma unroll
    for (int d2 = 0; d2 < 2; ++d2) f.ktf[d2][kk] = *(const u32x4*)(kt + (((rt * 2 + d2) * 2 + kk) * 64 + ln) * 8); }
  f.uf = *(const u32x2*)(ut + (s * 32 + ct * 16 + l15) * 64 + rt * 16 + lq * 4);
  f.egl = ((const float*)(p->ws + WS_EGL))[cid];
}
DEVI void phase_gdnseq(KP p, int layer, unsigned char* lds) {
  const int tid = tidx_(), lane = tid & 63, wave = tid >> 6;
  const int j = layer >> 1, rt = wave >> 1, ct = wave & 1, l15 = lane & 15, lq = lane >> 4;
  bf16_t* ST = (bf16_t*)lds;
  bf16_t* VT = (bf16_t*)(lds + 8704);
  bf16_t* ybuf = (bf16_t*)(p->ws + WS_YBUF);
  unsigned dsum = 0u;
  for (int item = bidx_(); item < 256; item += gdim_()) {
    const int xcd = item & 7, idx = item >> 3, bh = xcd * 8 + (idx >> 2), s = idx & 3, b = bh >> 3, h = bh & 7;
    __syncthreads();
    for (int e = tid; e < 32 * 136 / 2; e += 512) ((unsigned*)ST)[e] = 0u;
    f32x4 sacc[2]; sacc[0] = (f32x4){0.f, 0.f, 0.f, 0.f}; sacc[1] = (f32x4){0.f, 0.f, 0.f, 0.f};
    GdnFrags nx; gdn_load(nx, p, bh * 32, s, rt, ct, l15, lq);
    __syncthreads();
    unsigned dprev = 0u; f32x4 oprev = (f32x4){0.f, 0.f, 0.f, 0.f};
    for (int c = 0; c < 32; ++c) {
      const GdnFrags cu = nx;
      if (c > 0) {
        bf16_t* yo = ybuf + (size_t)(b * 2048 + (c - 1) * 64 + rt * 16 + lq * 4) * 2048 + 1024 + h * 128 + s * 32 + ct * 16 + l15;
#pragma unroll
        for (int r = 0; r < 4; ++r) yo[(size_t)r * 2048] = f2bf(oprev[r]);
        asm volatile("" ::: "memory");
      }
      if (c + 1 < 32) gdn_load(nx, p, bh * 32 + c + 1, s, rt, ct, l15, lq);
      f32x4 wsa = (f32x4){0.f, 0.f, 0.f, 0.f}, oa = (f32x4){0.f, 0.f, 0.f, 0.f};
#pragma unroll
      for (int kk = 0; kk < 4; ++kk) { const bf16x8 sb = *(const bf16x8*)(ST + (ct * 16 + l15) * 136 + lq * 8 + kk * 32);
        wsa = mfma16(as_bf16x8(cu.wf[kk]), sb, wsa); oa = mfma16(as_bf16x8(cu.qf[kk]), sb, oa); }
      { const float u0 = bflo(cu.uf.x), u1 = bfhi(cu.uf.x), u2 = bflo(cu.uf.y), u3 = bfhi(cu.uf.y);
        u32x2 w; w.x = cvt_pk_bf16(u0 - wsa[0], u1 - wsa[1]); w.y = cvt_pk_bf16(u2 - wsa[2], u3 - wsa[3]);
        *(u32x2*)(VT + (ct * 16 + l15) * 72 + rt * 16 + lq * 4) = w; }
      lds_barrier();
      bf16x8 vb[2];
#pragma unroll
      for (int kk = 0; kk < 2; ++kk) vb[kk] = *(const bf16x8*)(VT + (ct * 16 + l15) * 72 + lq * 8 + kk * 32);
#pragma unroll
      for (int kk = 0; kk < 2; ++kk) oa = mfma16(as_bf16x8(cu.qkf[kk]), vb[kk], oa);
#pragma unroll
      for (int d2 = 0; d2 < 2; ++d2) { sacc[d2] = sacc[d2] * cu.egl;
#pragma unroll
        for (int kk = 0; kk < 2; ++kk) sacc[d2] = mfma16(as_bf16x8(cu.ktf[d2][kk]), vb[kk], sacc[d2]); }
      oprev = oa;
#pragma unroll
      for (int d2 = 0; d2 < 2; ++d2) { u32x2 w; w.x = cvt_pk_bf16(sacc[d2][0], sacc[d2][1]); w.y = cvt_pk_bf16(sacc[d2][2], sacc[d2][3]);
        *(u32x2*)(ST + (ct * 16 + l15) * 136 + (rt * 2 + d2) * 16 + lq * 4) = w; }
      lds_barrier();
    }
    { bf16_t* yo = ybuf + (size_t)(b * 2048 + 31 * 64 + rt * 16 + lq * 4) * 2048 + 1024 + h * 128 + s * 32 + ct * 16 + l15;
#pragma unroll
      for (int r = 0; r < 4; ++r) yo[(size_t)r * 2048] = f2bf(oprev[r]); }
    float* pd = p->out + O_PDEL + (size_t)((j * 8 + b) * 8 + h) * 16384;
#pragma unroll
    for (int d2 = 0; d2 < 2; ++d2)
#pragma unroll
      for (int r = 0; r < 4; ++r) pd[(size_t)((rt * 2 + d2) * 16 + lq * 4 + r) * 128 + s * 32 + ct * 16 + l15] = sacc[d2][r];
  }
  if (dsum == 0x9e3779b9u) ((unsigned*)(p->ws + WS_CTL))[5000] = dsum;
}

DEVI void phase_onorm(KP p, int layer) {
  const int tid = tidx_(), lane = tid & 63, wave = tid >> 6, j = layer >> 1;
  bf16_t* ybuf = (bf16_t*)(p->ws + WS_YBUF); const bf16_t* proj = (const bf16_t*)(p->ws + WS_PROJ);
  float gw[16];
#pragma unroll
  for (int e = 0; e < 16; ++e) gw[e] = p->in[I_GNW][j * 128 + ((lane * 16 + e) & 127)];
  const int rstep = gdim_() * 8;
  for (int r = bidx_() * 8 + wave; r < NPR; r += 2 * rstep) {
    const bool two = r + rstep < NPR;
    bf16_t* yp[2]; u32x4 yv[2][2], zv[2][2];
#pragma unroll
    for (int q = 0; q < 2; ++q) { const int rr = (q == 0 || two) ? r + q * rstep : r;
      yp[q] = ybuf + (size_t)rr * 2048 + 1024 + lane * 16; const bf16_t* zp = proj + (size_t)rr * 6144 + 5120 + lane * 16;
      yv[q][0] = *(const u32x4*)yp[q]; yv[q][1] = *(const u32x4*)(yp[q] + 8); zv[q][0] = *(const u32x4*)zp; zv[q][1] = *(const u32x4*)(zp + 8); }
#pragma unroll
    for (int q = 0; q < 2; ++q) {
      float o[16], z[16]; { float t[8]; unpack8(yv[q][0], t);
#pragma unroll
        for (int e = 0; e < 8; ++e) o[e] = t[e];
        unpack8(yv[q][1], t);
#pragma unroll
        for (int e = 0; e < 8; ++e) o[8 + e] = t[e];
        unpack8(zv[q][0], t);
#pragma unroll
        for (int e = 0; e < 8; ++e) z[e] = t[e];
        unpack8(zv[q][1], t);
#pragma unroll
        for (int e = 0; e < 8; ++e) z[8 + e] = t[e]; }
      float ss = 0.f;
#pragma unroll
      for (int e = 0; e < 16; ++e) ss += o[e] * o[e];
      ss += __shfl_xor(ss, 1); ss += __shfl_xor(ss, 2); ss += __shfl_xor(ss, 4);
      const float rinv = __builtin_amdgcn_rsqf(ss * (1.f / 128.f) + 1e-6f);
      float a[8], cq[8];
#pragma unroll
      for (int e = 0; e < 8; ++e) { a[e] = o[e] * rinv * gw[e] * siluf_(z[e]); cq[e] = o[8 + e] * rinv * gw[8 + e] * siluf_(z[8 + e]); }
      if (q == 0 || two) { *(u32x4*)yp[q] = pack8(a); *(u32x4*)(yp[q] + 8) = pack8(cq); }
    }
  }
}

struct S5C { bf16x8 Bf[8], Cf[4]; float abr, abi, dch; };
template <bool OUT, bool SAMPLE>
DEVI void s5_chunks(KP p, const S5C& c, int jc, int g, size_t rbase, int nch, int sgrp, float& xr, float& xi, float* BU, bf16_t* XB, int lane) {
  const int l15 = lane & 15, lq = lane >> 4;
  const bf16_t* proj = (const bf16_t*)(p->ws + WS_PROJ);
  bf16_t* y1 = (bf16_t*)(p->ws + WS_YBUF);
  u32x4 unx = (u32x4){0u, 0u, 0u, 0u}; bf16_t uenx[4] = {0, 0, 0, 0};
  if (lq < 2) unx = *(const u32x4*)(proj + (rbase + l15) * 2048 + g * 16 + lq * 8);
  if (OUT) {
#pragma unroll
    for (int r = 0; r < 4; ++r) uenx[r] = proj[(rbase + lq * 4 + r) * 2048 + g * 16 + l15]; }
  for (int ck = 0; ck < nch; ++ck) {
    const size_t row0 = rbase + (size_t)ck * 16;
    const u32x4 ucur = unx; bf16_t uec[4];
#pragma unroll
    for (int r = 0; r < 4; ++r) uec[r] = uenx[r];
    if (ck + 1 < nch) { if (lq < 2) unx = *(const u32x4*)(proj + (row0 + 16 + l15) * 2048 + g * 16 + lq * 8);
      if (OUT) {
#pragma unroll
        for (int r = 0; r < 4; ++r) uenx[r] = proj[(row0 + 16 + lq * 4 + r) * 2048 + g * 16 + l15]; } }
#pragma unroll
    for (int nt = 0; nt < 8; ++nt) { const f32x4 acc = mfma16(as_bf16x8(ucur), c.Bf[nt], (f32x4){0.f, 0.f, 0.f, 0.f});
      *(f32x4*)(BU + (nt * 16 + l15) * 20 + lq * 4) = acc; }
    asm volatile("s_waitcnt lgkmcnt(0)" ::: "memory");
    float br[16], bi[16];
#pragma unroll
    for (int t4 = 0; t4 < 4; ++t4) { const f32x4 a = *(const f32x4*)(BU + lane * 20 + t4 * 4), b = *(const f32x4*)(BU + (64 + lane) * 20 + t4 * 4);
#pragma unroll
      for (int e = 0; e < 4; ++e) { br[t4 * 4 + e] = a[e]; bi[t4 * 4 + e] = b[e]; } }
    if (!SAMPLE) {
#pragma unroll
      for (int t = 0; t < 16; ++t) { const float nr = c.abr * xr - c.abi * xi + br[t], ni = c.abr * xi + c.abi * xr + bi[t]; xr = nr; xi = ni;
        if (OUT) *(unsigned*)(XB + t * 136 + 2 * lane) = cvt_pk_bf16(xr, xi); }
    } else {
#pragma unroll
      for (int t = 0; t < 16; ++t) { const size_t si = ((size_t)(jc * 128 + sgrp * 16 + t) * 64 + g) * 64 + lane;
        const float x0r = p->in[I_SSR][si], x0i = p->in[I_SSI][si];
        const float nr = c.abr * x0r - c.abi * x0i + br[t], ni = c.abr * x0i + c.abi * x0r + bi[t];
        p->out[O_SSR + si] = nr; p->out[O_SSI + si] = ni;
        *(unsigned*)(XB + t * 136 + 2 * lane) = cvt_pk_bf16(nr, ni); }
    }
    if (OUT) {
      asm volatile("s_waitcnt lgkmcnt(0)" ::: "memory");
      f32x4 ya = (f32x4){0.f, 0.f, 0.f, 0.f};
#pragma unroll
      for (int kk = 0; kk < 4; ++kk) ya = mfma16(*(const bf16x8*)(XB + l15 * 136 + lq * 8 + kk * 32), c.Cf[kk], ya);
#pragma unroll
      for (int r = 0; r < 4; ++r) { const float y = ya[r] + c.dch * bf2f(uec[r]); y1[(row0 + lq * 4 + r) * 1024 + g * 16 + l15] = f2bf(geluf_(y)); }
    }
  }
}
DEVI void s5_setup(KP p, S5C& c, int jc, int g, int lane) {
  const int l15 = lane & 15, lq = lane >> 4, gi = jc * 64 + g;
  const float dt = __expf(p->in[I_LOGDT][gi]);
  { const float are = p->in[I_ARE][gi * 64 + lane], aim = p->in[I_AIM][gi * 64 + lane]; const float mag = __expf(are * dt); c.abr = mag * __cosf(aim * dt); c.abi = mag * __sinf(aim * dt); }
#pragma unroll
  for (int nt = 0; nt < 8; ++nt) {
    float v[8];
#pragma unroll
    for (int e = 0; e < 8; ++e) v[e] = 0.f;
    if (lq < 2) {
      const int pp = (nt & 3) * 16 + l15;
      const float are = p->in[I_ARE][gi * 64 + pp], aim = p->in[I_AIM][gi * 64 + pp]; const float mag = __expf(are * dt); const float sn = __sinf(aim * dt), cs = __cosf(aim * dt);
      const float nr = mag * cs - 1.f, ni = mag * sn, den = 1.f / (are * are + aim * aim);
      const float cr = (nr * are + ni * aim) * den, ci = (ni * are - nr * aim) * den;
      const float* br = p->in[I_BRE] + (size_t)(gi * 64 + pp) * 16 + lq * 8; const float* bi = p->in[I_BIM] + (size_t)(gi * 64 + pp) * 16 + lq * 8;
#pragma unroll
      for (int e = 0; e < 8; ++e) v[e] = (nt >= 4) ? (cr * bi[e] + ci * br[e]) : (cr * br[e] - ci * bi[e]);
    }
    c.Bf[nt] = as_bf16x8(pack8(v));
  }
#pragma unroll
  for (int kk = 0; kk < 4; ++kk) { const int p0 = lq * 4 + kk * 16;
    const float* sre = p->in[I_CRE] + (size_t)(gi * 16 + l15) * 64 + p0; const float* sim = p->in[I_CIM] + (size_t)(gi * 16 + l15) * 64 + p0; float v[8];
#pragma unroll
    for (int m = 0; m < 4; ++m) { v[2 * m] = sre[m]; v[2 * m + 1] = -sim[m]; }
    c.Cf[kk] = as_bf16x8(pack8(v)); }
  c.dch = p->in[I_S5D][jc * 1024 + g * 16 + l15];
}
DEVI void phase_s5(KP p, int layer, unsigned char* lds) {
  const int tid = tidx_(), lane = tid & 63, wave = tid >> 6, jc = layer >> 1;
  float* BU = (float*)(lds + wave * 14592);
  bf16_t* XB = (bf16_t*)(lds + wave * 14592 + 10240);
  float* EX = (float*)(lds + 116736);
  const int cb = wave >> 2, seg = wave & 3;
  for (int cp = bidx_(); cp < 256; cp += gdim_()) {
    const int q = cp * 2 + cb, b = q >> 6, g = q & 63;
    S5C c; s5_setup(p, c, jc, g, lane);
    float xr = 0.f, xi = 0.f;
    const size_t rbase = (size_t)b * 2048 + (size_t)seg * 512;
    const int nch2 = 32;
    if (seg < 3) {
      s5_chunks<false, false>(p, c, jc, g, rbase, 32, 0, xr, xi, BU, XB, lane);
      EX[wave * 128 + lane] = xr; EX[wave * 128 + 64 + lane] = xi;
    } else {
      const int qs = cp * 2 + cb, gs = qs & 63, sgrp = qs >> 6;
      S5C cs; s5_setup(p, cs, jc, gs, lane);
      float dr = 0.f, di = 0.f;
      s5_chunks<true, true>(p, cs, jc, gs, (size_t)(NPR + sgrp * 16), 1, sgrp, dr, di, BU, XB, lane);
    }
    __syncthreads();
    float pr = c.abr, pi = c.abi;
#pragma unroll
    for (int s = 0; s < 9; ++s) { const float nr = pr * pr - pi * pi, ni = 2.f * pr * pi; pr = nr; pi = ni; }
    xr = 0.f; xi = 0.f;
    for (int s = 0; s < seg; ++s) { const float er = EX[(cb * 4 + s) * 128 + lane], ei = EX[(cb * 4 + s) * 128 + 64 + lane];
      const float nr = pr * xr - pi * xi + er, ni = pr * xi + pi * xr + ei; xr = nr; xi = ni; }
    s5_chunks<true, false>(p, c, jc, g, rbase, nch2, 0, xr, xi, BU, XB, lane);
    if (seg == 3) { const size_t si = ((size_t)(jc * 8 + b) * 64 + g) * 64 + lane; p->out[O_PSR + si] = xr; p->out[O_PSI + si] = xi; }
    __syncthreads();
  }
}

DEVI void phase_final(KP p) {
  const int tid = tidx_(), lane = tid & 63, wave = tid >> 6;
  const float* nw = p->in[I_FNW];
  float4 w4[4];
#pragma unroll
  for (int i = 0; i < 4; ++i) w4[i] = *(const float4*)(nw + i * 256 + lane * 4);
  for (int r = (bidx_() * 8 + wave) * 2; r < NRV; r += gdim_() * 16) {
    float* x0 = p->out + (size_t)r * 1024; float* x1 = x0 + 1024; float4 v0[4], v1[4]; float s0 = 0.f, s1 = 0.f;
#pragma unroll
    for (int i = 0; i < 4; ++i) { v0[i] = *(const float4*)(x0 + i * 256 + lane * 4); v1[i] = *(const float4*)(x1 + i * 256 + lane * 4); }
#pragma unroll
    for (int i = 0; i < 4; ++i) { s0 += v0[i].x * v0[i].x + v0[i].y * v0[i].y + v0[i].z * v0[i].z + v0[i].w * v0[i].w; s1 += v1[i].x * v1[i].x + v1[i].y * v1[i].y + v1[i].z * v1[i].z + v1[i].w * v1[i].w; }
#pragma unroll
    for (int o = 32; o >= 1; o >>= 1) { s0 += __shfl_xor(s0, o); s1 += __shfl_xor(s1, o); }
    const float r0 = __builtin_amdgcn_rsqf(s0 * (1.f / 1024.f) + 1e-6f), r1 = __builtin_amdgcn_rsqf(s1 * (1.f / 1024.f) + 1e-6f);
#pragma unroll
    for (int i = 0; i < 4; ++i) { float4 o; o.x = v0[i].x * r0 * w4[i].x; o.y = v0[i].y * r0 * w4[i].y; o.z = v0[i].z * r0 * w4[i].z; o.w = v0[i].w * r0 * w4[i].w; *(float4*)(x0 + i * 256 + lane * 4) = o;
      float4 q; q.x = v1[i].x * r1 * w4[i].x; q.y = v1[i].y * r1 * w4[i].y; q.z = v1[i].z * r1 * w4[i].z; q.w = v1[i].w * r1 * w4[i].w; *(float4*)(x1 + i * 256 + lane * 4) = q; }
  }
}

template <class F>
DEVI void sample_gemm(const bf16_t* __restrict__ A, int lda, const bf16_t* __restrict__ Bt, int N, int K, F&& epi, float* red) {
  const int tid = tidx_(), lane = tid & 63, wave = tid >> 6, l15 = lane & 15, lq = lane >> 4, rt2 = wave & 1, kq = wave >> 1;
  const int kq_len = K >> 2, nitems = (N / 16) * 4;
  for (int it = gdim_() - 1 - bidx_(); it < nitems; it += gdim_()) {
    const int s = it >> 2, rg = it & 3, row0 = rg * 32 + rt2 * 16;
    const bf16_t* ap = A + (size_t)(row0 + l15) * lda + lq * 8 + kq * kq_len;
    const bf16_t* bp = Bt + (size_t)(s * 16 + l15) * K + lq * 8 + kq * kq_len;
    f32x4 acc0 = (f32x4){0.f, 0.f, 0.f, 0.f}, acc1 = (f32x4){0.f, 0.f, 0.f, 0.f};
    for (int k0 = 0; k0 < kq_len; k0 += 256) {
      u32x4 a[8], b[8];
#pragma unroll
      for (int u = 0; u < 8; ++u) { a[u] = *(const u32x4*)(ap + k0 + u * 32); b[u] = *(const u32x4*)(bp + k0 + u * 32); }
#pragma unroll
      for (int u = 0; u < 8; u += 2) { acc0 = mfma16(as_bf16x8(a[u]), as_bf16x8(b[u]), acc0); acc1 = mfma16(as_bf16x8(a[u + 1]), as_bf16x8(b[u + 1]), acc1); }
    }
    acc0 = acc0 + acc1;
    __syncthreads();
    *(f32x4*)(red + ((kq * 2 + rt2) * 64 + lane) * 4) = acc0;
    __syncthreads();
    if (kq == 0) {
      f32x4 t = acc0;
#pragma unroll
      for (int q = 1; q < 4; ++q) t = t + *(const f32x4*)(red + ((q * 2 + rt2) * 64 + lane) * 4);
#pragma unroll
      for (int r = 0; r < 4; ++r) epi(row0 + lq * 4 + r, s * 16 + l15, t[r]);
    }
  }
}

constexpr int N_PHASES = 25;
#ifndef PROBE_SUB
#define PROBE_SUB 7
#endif
#ifndef ONLY_KIND
#define ONLY_KIND -1
#endif
#define KON(k) ((ONLY_KIND < 0 || ONLY_KIND == (k)) && kind == (k))
__global__ void __launch_bounds__(512, 2) mega(Params p_unused) {
  extern __shared__ __attribute__((aligned(16))) unsigned char shm[];
  cg::grid_group grid = cg::this_grid();
  PG8_LAS unsigned char* ldsg = (PG8_LAS unsigned char*)shm;
  KP p0 = (KP)__builtin_amdgcn_kernarg_segment_ptr();
  const int ph_lo = p0->ph_lo, ph_hi = p0->ph_hi;
  volatile LAS unsigned* xst = (volatile LAS unsigned*)(ldsg + LDS_MISC + 16);
  if (threadIdx.x == 0) { xst[0] = 0u; xst[1] = 0u; }
  __syncthreads();
  XcdBarrier xb = xcd_barrier_post((unsigned*)(p0->ws + WS_CTL), xst);
  int rep = 0;
  for (int ph = ph_lo; ph < ph_hi; ++ph) {
    KP p = p0; asm volatile("" : "+s"(p));
    int kind, layer = 0;
    if (ph == 0) kind = 0; else if (ph == 1) kind = 1; else if (ph == 24) kind = 12;
    else { const int q = ph - 2, pair = q / 11, rem = q % 11;
      if (rem < 6) { layer = 2 * pair; kind = (rem == 0) ? 2 : 2 + rem; }
      else { layer = 2 * pair + 1; const int s = rem - 6; kind = (s == 0) ? 2 : 7 + s; } }
    const int j = layer >> 1;
    if (KON(0)) phase_prep(p, (float*)shm);
    else if (KON(2)) phase_norm(p, layer, (float*)shm);
    else if (KON(4)) phase_mixprep(p, layer, shm, ph + 32 * rep, rep ? PROBE_SUB : 7);
    else if (KON(5)) phase_gdnseq(p, layer, shm);
    else if (KON(6)) phase_onorm(p, layer);
    else if (KON(9)) phase_s5(p, layer, shm);
    else if (KON(12)) phase_final(p);
    else if (KON(1)) {
      pg8::Gemm g{(const bf16_t*)(p->ws + WS_SILUC), (const bf16_t*)(p->ws + WS_WT_MOD), 256, 12288, 1024};
      pg8::StaticOrder S; S.init(256, 12288, gdim_(), bidx_());
      pg8::EpiF32 E{(float*)(p->ws + WS_MOD), 12288, p->in[I_MODB]};
      pg8::gemm_phase<pg8::EpiF32, pg8::StaticOrder, false>(ldsg, g, S, E, nullptr);
    } else if (KON(3) || KON(8)) {
      const bool ab = kind == 3; const int N = ab ? 6144 : 2048;
      const bf16_t* Bt = ab ? (const bf16_t*)(p->ws + WS_WT_INAB) + (size_t)j * 6144 * 1024 : (const bf16_t*)(p->ws + WS_WT_CIN) + (size_t)j * 2048 * 1024;
      pg8::Gemm g{(const bf16_t*)(p->ws + WS_YBUF), Bt, NPR, N, 1024};
      pg8::StaticOrder S; S.init(NPR, N, gdim_(), bidx_());
      pg8::EpiBf16<0> E{(bf16_t*)(p->ws + WS_PROJ), N, nullptr, 0, 0};
      pg8::gemm_phase<pg8::EpiBf16<0>, pg8::StaticOrder, false>(ldsg, g, S, E, nullptr);
      bf16_t* po = (bf16_t*)(p->ws + WS_PROJ) + (size_t)NPR * N;
      sample_gemm((const bf16_t*)(p->ws + WS_YBUF) + (size_t)NPR * 1024, 1024, Bt, N, 1024, [&](int r, int c, float v) { po[(size_t)r * N + c] = f2bf(v); }, (float*)shm);
      if (ab) tail_gemm(p, j);
    } else if (KON(7) || KON(11)) {
      const bool ab = kind == 7; const int K = ab ? 2048 : 1024;
      const bf16_t* Ab = ab ? (const bf16_t*)(p->ws + WS_YBUF) : (const bf16_t*)(p->ws + WS_Y2);
      const bf16_t* Bt = ab ? (const bf16_t*)(p->ws + WS_WT_OUTAB) + (size_t)j * 1024 * 2048 : (const bf16_t*)(p->ws + WS_WT_COUT) + (size_t)j * 1024 * 1024;
      pg8::Gemm g{Ab, Bt, NPR, 1024, K};
      pg8::StaticOrder S; S.init(NPR, 1024, gdim_(), bidx_());
      const float* gatep = (const float*)(p->ws + WS_MOD) + layer * 3072 + 2048;
      EpiRes E{layer == 0 ? p->in[I_XP] : p->out, layer == 0 ? p->in[I_XS] : p->out + (size_t)NPR * 1024, p->out, gatep};
      pg8::gemm_phase<EpiRes, pg8::StaticOrder, false>(ldsg, g, S, E, nullptr);
      const float* xsi = layer == 0 ? p->in[I_XS] : p->out + (size_t)NPR * 1024; float* xso = p->out + (size_t)NPR * 1024;
      sample_gemm(Ab + (size_t)NPR * K, K, Bt, 1024, K, [&](int r, int c, float v) { xso[(size_t)r * 1024 + c] = xsi[(size_t)r * 1024 + c] + gatep[(size_t)(8 + r) * 12288 + c] * v; }, (float*)shm);
    } else if (KON(10)) {
      const bf16_t* Bt = (const bf16_t*)(p->ws + WS_WT_GLU) + (size_t)j * 1024 * 1024;
      pg8::Gemm g{(const bf16_t*)(p->ws + WS_YBUF), Bt, NPR, 1024, 1024};
      pg8::StaticOrder S; S.init(NPR, 1024, gdim_(), bidx_());
      const float* gb = p->in[I_GLUB] + j * 1024;
      EpiGlu E{(const bf16_t*)(p->ws + WS_YBUF), (const bf16_t*)(p->ws + WS_PROJ) + 1024, (bf16_t*)(p->ws + WS_Y2), gb};
      pg8::gemm_phase<EpiGlu, pg8::StaticOrder, false>(ldsg, g, S, E, nullptr);
      const bf16_t* y1s = (const bf16_t*)(p->ws + WS_YBUF) + (size_t)NPR * 1024; const bf16_t* zs = (const bf16_t*)(p->ws + WS_PROJ) + (size_t)NPR * 2048 + 1024; bf16_t* y2s = (bf16_t*)(p->ws + WS_Y2) + (size_t)NPR * 1024;
      sample_gemm(y1s, 1024, Bt, 1024, 1024, [&](int r, int c, float v) { y2s[(size_t)r * 1024 + c] = f2bf(bf2f(y1s[(size_t)r * 1024 + c]) * sigmoidf_(v + gb[c]) * siluf_(bf2f(zs[(size_t)r * 2048 + c]))); }, (float*)shm);
    }
#ifdef REPEAT_KIND
    if (kind == REPEAT_KIND && rep == 0) { rep = 1; --ph; } else rep = 0;
#endif
    if (ph + 1 < ph_hi) { if (ph_hi > 100000) grid.sync();
      xcd_barrier(xb); }
  }
}

#ifndef MK_MULTI
#define MK_MULTI 0
#endif
#ifndef PH_HI
#define PH_HI N_PHASES
#endif
extern "C" void kernel_launch(void* const* d_in, const int* in_sizes, int n_in, void* d_out, int out_size, void* d_ws, size_t ws_size, hipStream_t stream) {
  static int grid = 0;
  if (grid == 0) {
    if (n_in != N_IN || (size_t)out_size != O_END || ws_size < WS_END) { fprintf(stderr, "kernel_launch: unexpected shapes: n_in %d out %d ws %zu (need %zu)\n", n_in, out_size, ws_size, (size_t)WS_END); grid = -1; return; }
    int dev = 0, cus = 0, per_cu = 0;
    if (hipGetDevice(&dev) != hipSuccess || hipDeviceGetAttribute(&cus, hipDeviceAttributeMultiprocessorCount, dev) != hipSuccess) { grid = -1; return; }
    if (hipFuncSetAttribute((const void*)mega, hipFuncAttributeMaxDynamicSharedMemorySize, LDS_BYTES) != hipSuccess) { fprintf(stderr, "kernel_launch: hipFuncSetAttribute failed\n"); grid = -1; return; }
    if (hipOccupancyMaxActiveBlocksPerMultiprocessor(&per_cu, (const void*)mega, 512, LDS_BYTES) != hipSuccess || per_cu < 1) { fprintf(stderr, "kernel_launch: occupancy query says %d\n", per_cu); per_cu = 1; }
    (void)hipGetLastError();
    grid = cus;
  }
  if (grid < 0) return;
  if (hipMemsetAsync((char*)d_ws + WS_CTL, 0, 32768, stream) != hipSuccess) { fprintf(stderr, "kernel_launch: memset failed\n"); return; }
  Params p{};
  for (int i = 0; i < N_IN; ++i) p.in[i] = (const float*)d_in[i];
  p.out = (float*)d_out; p.ws = (unsigned char*)d_ws;
#if MK_MULTI
  for (int ph = 0; ph < N_PHASES; ++ph) { p.ph_lo = ph; p.ph_hi = ph + 1; hipLaunchKernelGGL(mega, dim3(grid), dim3(512), LDS_BYTES, stream, p); }
#else
  p.ph_lo = 0; p.ph_hi = PH_HI;
  void* args[] = {&p};
  hipError_t e = hipLaunchCooperativeKernel((void*)mega, dim3(grid), dim3(512), args, LDS_BYTES, stream);
  if (e != hipSuccess) fprintf(stderr, "kernel_launch: cooperative launch failed: %s (grid %d)\n", hipGetErrorString(e), grid);
#endif
}
```

```cpp
#include <hip/hip_runtime.h>
#include <hip/hip_cooperative_groups.h>
#include <cstdio>
namespace cg = cooperative_groups;
__device__ __forceinline__ int tidx_() { int t = threadIdx.x; asm volatile("" : "+v"(t)); return t; }
__device__ __forceinline__ int bidx_() { int t = blockIdx.x; asm volatile("" : "+s"(t)); return t; }
__device__ __forceinline__ int gdim_() { int t = gridDim.x; asm volatile("" : "+s"(t)); return t; }
namespace pg8 {
#define PG8_LAS __attribute__((address_space(3)))
typedef unsigned short bf16_t;
typedef short bf16x8 __attribute__((ext_vector_type(8)));
typedef float f32x4 __attribute__((ext_vector_type(4)));
typedef unsigned u32x4 __attribute__((ext_vector_type(4)));
constexpr int BM = 256, BK = 64, HALF = 128, HTB = HALF * BK * 2  , STAGE_BYTES = 8 * HTB, NXCD = 8, WGM = 8;

__host__ __device__ __forceinline__ int lds_byte(int r, int c) { const int st = (r >> 4) * 2 + (c >> 5), rr = r & 15, cc = c & 31, ob = rr * 64 + cc * 2; return st * 1024 + (ob ^ (((ob >> 9) & 1) << 5)); }
__host__ __device__ __forceinline__ void stage_rc(int b, int& R, int& C) { const int st = b / 1024, sb = b % 1024, swz = sb ^ (((sb >> 9) & 1) << 5); R = (st >> 1) * 16 + swz / 64; C = (st & 1) * 32 + (swz % 64) / 2; }
__host__ __device__ __forceinline__ int perm32(int rho) { const int n = rho >> 4, i = rho & 15; return 8 * (i >> 2) + 4 * n + (i & 3); }

struct Unit { int pm, pn; };
struct Gemm { const bf16_t* A; const bf16_t* Bt; int M, N, K; };

struct StaticOrder {
    int nM, nN, nwg, G, c;
    __host__ __device__ void init(int M, int N, int G_, int c_) { nM = M / BM; nN = N / BM; nwg = nM * nN; G = G_; c = c_; }
    __host__ __device__ bool next(int i, Unit& u) const {
        const long L = (long)i * G + c; if (L >= nwg) return false;
        int wgid = (int)L; { const int q = nwg / NXCD, r = nwg % NXCD, xcd = wgid % NXCD, off = wgid / NXCD; wgid = (xcd < r ? xcd * (q + 1) : r * (q + 1) + (xcd - r) * q) + off; }
        const int nig = WGM * nN, gid = wgid / nig, fm = gid * WGM, gsz = (nM - fm) < WGM ? (nM - fm) : WGM;
        u.pm = fm + ((wgid % nig) % gsz); u.pn = (wgid % nig) / gsz; return true;
    }
    __device__ __forceinline__ void a_ready(const Unit&) const {}
    __device__ __forceinline__ void done(const Unit&) const {}
};
typedef float f32x2cv __attribute__((ext_vector_type(2)));
typedef __bf16 bf16x2cv __attribute__((ext_vector_type(2)));
__device__ __forceinline__ unsigned cvt_pk_bf16(float lo, float hi) { f32x2cv v = {lo, hi}; bf16x2cv b = __builtin_convertvector(v, bf16x2cv); return __builtin_bit_cast(unsigned, b); }
typedef float f32x2 __attribute__((ext_vector_type(2)));
__device__ __forceinline__ f32x2 gelu_pk(f32x2 v) {
    const f32x2 av = __builtin_elementwise_abs(v), d = av * 0.2316418882f + 1.0f;
    f32x2 t; t.x = __builtin_amdgcn_rcpf(d.x); t.y = __builtin_amdgcn_rcpf(d.y);
    f32x2 q = t * 0.5307027145f + (-0.7265760135f); q = q * t + 0.7107068705f; q = q * t + (-0.142248368f); q = q * t + 0.127414796f; q = q * t;
    const f32x2 s = (v * v) * (-0.72134752044f);
    f32x2 e; e.x = __builtin_amdgcn_exp2f(s.x); e.y = __builtin_amdgcn_exp2f(s.y);
    const f32x2 m = v * (q * e), r = v - m;
    f32x2 o; o.x = v.x < 0.f ? m.x : r.x; o.y = v.y < 0.f ? m.y : r.y; return o;
}

struct EpiF32 {
    static constexpr bool PERM = false, AFTER_DRAIN = false;
    float* C; int ldc; const float* bias;
    __device__ __forceinline__ void operator()(const f32x4 (&acc)[2][2][4][2], const Unit& u, int wr, int wc, int fr, int fq) const {
        const int row0 = u.pm * BM + wr * 64 + fr, col0 = u.pn * BM + wc * 32 + 4 * fq;
        f32x4 bv[2][2];
#pragma unroll
        for (int bj = 0; bj < 2; ++bj)
#pragma unroll
            for (int n = 0; n < 2; ++n) bv[bj][n] = bias ? *(const f32x4*)(bias + col0 + bj * HALF + n * 16) : (f32x4){0.f, 0.f, 0.f, 0.f};
#pragma unroll
        for (int ai = 0; ai < 2; ++ai)
#pragma unroll
            for (int m = 0; m < 4; ++m) { float* rowp = C + (size_t)(row0 + ai * HALF + m * 16) * ldc + col0;
#pragma unroll
                for (int bj = 0; bj < 2; ++bj)
#pragma unroll
                    for (int n = 0; n < 2; ++n) *(f32x4*)(rowp + bj * HALF + n * 16) = acc[ai][bj][m][n] + bv[bj][n]; }
    }
};
template <int ACT  > struct EpiBf16 {
    static constexpr bool PERM = true, AFTER_DRAIN = false;
    bf16_t* O; int ldc; const float* bias; int split_cols; size_t split_stride;
    __device__ __forceinline__ void operator()(const f32x4 (&acc)[2][2][4][2], const Unit& u, int wr, int wc, int fr, int fq) const {
        const int row0 = u.pm * BM + wr * 64 + fr; int colt = u.pn * BM; bf16_t* base = O;
        if (split_cols) { const int t = colt / split_cols; base += (size_t)t * split_stride; colt -= t * split_cols; }
        const int col0 = colt + wc * 32 + 8 * fq, bcol0 = u.pn * BM + wc * 32 + 8 * fq;
        f32x4 bv[2][2];
#pragma unroll
        for (int bj = 0; bj < 2; ++bj)
#pragma unroll
            for (int n = 0; n < 2; ++n) bv[bj][n] = bias ? *(const f32x4*)(bias + bcol0 + bj * HALF + 4 * n) : (f32x4){0.f, 0.f, 0.f, 0.f};
#pragma unroll
        for (int ai = 0; ai < 2; ++ai)
#pragma unroll
            for (int m = 0; m < 4; ++m) { bf16_t* rowp = base + (size_t)(row0 + ai * HALF + m * 16) * ldc + col0;
#pragma unroll
                for (int bj = 0; bj < 2; ++bj) { f32x4 v0 = acc[ai][bj][m][0] + bv[bj][0], v1 = acc[ai][bj][m][1] + bv[bj][1];
                    if (ACT == 1) { f32x2 a = gelu_pk((f32x2){v0[0], v0[1]}), b = gelu_pk((f32x2){v0[2], v0[3]}), c = gelu_pk((f32x2){v1[0], v1[1]}), d = gelu_pk((f32x2){v1[2], v1[3]});
                        v0 = (f32x4){a.x, a.y, b.x, b.y}; v1 = (f32x4){c.x, c.y, d.x, d.y}; }
                    if (ACT == 2) {
#pragma unroll
                        for (int j = 0; j < 4; ++j) { v0[j] = 0.5f * v0[j] * (1.0f + erff(v0[j] * 0.70710678f)); v1[j] = 0.5f * v1[j] * (1.0f + erff(v1[j] * 0.70710678f)); } }
                    u32x4 w; w.x = cvt_pk_bf16(v0[0], v0[1]); w.y = cvt_pk_bf16(v0[2], v0[3]); w.z = cvt_pk_bf16(v1[0], v1[1]); w.w = cvt_pk_bf16(v1[2], v1[3]);
                    *(u32x4*)(rowp + bj * HALF) = w; } }
    }
};
template <class Epi, class Sched, bool STAMP = false>
__device__ __forceinline__ void gemm_phase(PG8_LAS unsigned char* lds, const Gemm g, const Sched& S, const Epi& E, unsigned long long* stamps) {
    const int tid = tidx_(), wid = __builtin_amdgcn_readfirstlane(tid >> 6), lane = tid & 63, wr = wid >> 2, wc = wid & 3, fr = lane & 15, fq = lane >> 4;
    const int K = g.K, nt = K / BK;
    int ts_lo = 0, ts_hi = 0, nts = 0; const unsigned long long rt_entry = STAMP ? (unsigned long long)wall_clock64() : 0ull;
#define PG8_STAMP() do { if (STAMP && wid == 0 && nts < 64) { const unsigned long long _c = (unsigned long long)clock64(); \
        ts_lo = (lane == nts) ? (int)(unsigned)_c : ts_lo; ts_hi = (lane == nts) ? (int)(unsigned)(_c >> 32) : ts_hi; ++nts; } } while (0)
    PG8_STAMP();
    unsigned voffA[2], voffB[2];
#pragma unroll
    for (int i = 0; i < 2; ++i) { int R, C; stage_rc(tid * 16 + i * 8192, R, C); const int Rb = Epi::PERM ? ((R & ~31) + perm32(R & 31)) : R;
        voffA[i] = (unsigned)(R * K + C) * 2u; voffB[i] = (unsigned)(Rb * K + C) * 2u; }
    const size_t kstep = (size_t)(BK * 2);
    const size_t hstep = (size_t)HALF * K * 2;
    const size_t tstep = 2 * hstep;
    const unsigned ldsw = (unsigned)wid * 1024u;
    const int aoff = lds_byte(wr * 64 + fr, fq * 8), boff = lds_byte(wc * 32 + fr, fq * 8);
#define PG8_SA(b, h) (((b) * 2 + (h)) * HTB)
#define PG8_SB(b, h) ((4 + (b) * 2 + (h)) * HTB)
#define PG8_STAGE(bufoff, gbase, voff) do { _Pragma("unroll") for (int _i = 0; _i < 2; ++_i) \
        __builtin_amdgcn_global_load_lds((const unsigned*)((const char*)(gbase) + (voff)[_i]), (PG8_LAS unsigned*)(lds + (bufoff) + ldsw + _i * 8192), 16, 0, 0); } while (0)
#define PG8_LDA(dst, b, h) do { _Pragma("unroll") for (int m = 0; m < 4; ++m) _Pragma("unroll") for (int k = 0; k < 2; ++k) dst[m][k] = *(const PG8_LAS bf16x8*)(lds + PG8_SA(b, h) + aoff + m * 2048 + k * 1024); } while (0)
#define PG8_LDB(dst, b, h) do { _Pragma("unroll") for (int n = 0; n < 2; ++n) _Pragma("unroll") for (int k = 0; k < 2; ++k) dst[n][k] = *(const PG8_LAS bf16x8*)(lds + PG8_SB(b, h) + boff + n * 2048 + k * 1024); } while (0)
#define PG8_MMA(ai, bj, At, Bt) do { __builtin_amdgcn_s_setprio(1); _Pragma("unroll") for (int m = 0; m < 4; ++m) _Pragma("unroll") for (int n = 0; n < 2; ++n) _Pragma("unroll") for (int k = 0; k < 2; ++k) \
        acc[ai][bj][m][n] = __builtin_amdgcn_mfma_f32_16x16x32_bf16(Bt[n][k], At[m][k], acc[ai][bj][m][n], 0, 0, 0); __builtin_amdgcn_s_setprio(0); } while (0)
#define PG8_WAIT_V(n) asm volatile("s_waitcnt vmcnt(" #n ")" ::: "memory")
#define PG8_WAIT_L(n) asm volatile("s_waitcnt lgkmcnt(" #n ")" ::: "memory")
#define PG8_BAR __builtin_amdgcn_s_barrier()
#define PG8_SCHED __builtin_amdgcn_sched_barrier(0)
    Unit cur, nxt; int ui = 0;
    if (!S.next(0, cur)) return;
    f32x4 acc[2][2][4][2];
#pragma unroll
    for (int a = 0; a < 2; ++a)
#pragma unroll
        for (int b = 0; b < 2; ++b)
#pragma unroll
            for (int m = 0; m < 4; ++m)
#pragma unroll
                for (int n = 0; n < 2; ++n) acc[a][b][m][n] = (f32x4){0.f, 0.f, 0.f, 0.f};
    bf16x8 At[4][2], B0[2][2], B1[2][2];
    const char* cA = (const char*)g.A + (size_t)cur.pm * tstep; const char* cB = (const char*)g.Bt + (size_t)cur.pn * tstep;
    S.a_ready(cur);
    PG8_STAGE(PG8_SB(0, 0), cB, voffB); PG8_STAGE(PG8_SA(0, 0), cA, voffA); PG8_STAGE(PG8_SB(0, 1), cB + hstep, voffB); PG8_STAGE(PG8_SA(0, 1), cA + hstep, voffA);
    if (wr == 1) PG8_BAR;
    PG8_WAIT_V(4); PG8_BAR;
    PG8_STAGE(PG8_SB(1, 0), cB + kstep, voffB); PG8_STAGE(PG8_SA(1, 0), cA + kstep, voffA); PG8_STAGE(PG8_SB(1, 1), cB + hstep + kstep, voffB);
    PG8_WAIT_V(6); PG8_BAR;
    PG8_STAMP();
    for (;;) {
        const bool has_next = S.next(ui + 1, nxt);
        const char* nA = has_next ? (const char*)g.A + (size_t)nxt.pm * tstep : cA; const char* nB = has_next ? (const char*)g.Bt + (size_t)nxt.pn * tstep : cB;
        for (int t = 0; t < nt; t += 2) {
            const bool last = (t == nt - 2);
            const char* a1 = cA + (size_t)(t + 1) * kstep;
            const char* a2 = last ? nA : cA + (size_t)(t + 2) * kstep; const char* b2 = last ? nB : cB + (size_t)(t + 2) * kstep;
            const char* a3 = a2 + kstep; const char* b3 = b2 + kstep;
            if (last && has_next) S.a_ready(nxt);
            PG8_LDB(B0, 0, 0); PG8_SCHED; PG8_LDA(At, 0, 0); PG8_STAGE(PG8_SA(1, 1), a1 + hstep, voffA);
            PG8_WAIT_L(8); PG8_BAR; PG8_WAIT_L(0); PG8_MMA(0, 0, At, B0); PG8_BAR; PG8_SCHED;
            PG8_LDB(B1, 0, 1); PG8_STAGE(PG8_SB(0, 0), b2, voffB);
            PG8_BAR; PG8_WAIT_L(0); PG8_MMA(0, 1, At, B1); PG8_BAR;
            PG8_LDA(At, 0, 1); PG8_STAGE(PG8_SA(0, 0), a2, voffA);
            PG8_BAR; PG8_WAIT_L(0); PG8_MMA(1, 0, At, B0); PG8_BAR; PG8_SCHED;
            PG8_STAGE(PG8_SB(0, 1), b2 + hstep, voffB);
            PG8_WAIT_V(6); PG8_BAR; PG8_MMA(1, 1, At, B1); PG8_BAR;
            PG8_LDB(B0, 1, 0); PG8_SCHED; PG8_LDA(At, 1, 0); PG8_STAGE(PG8_SA(0, 1), a2 + hstep, voffA);
            PG8_WAIT_L(8); PG8_BAR; PG8_WAIT_L(0); PG8_MMA(0, 0, At, B0); PG8_BAR; PG8_SCHED;
            PG8_LDB(B1, 1, 1); PG8_STAGE(PG8_SB(1, 0), b3, voffB);
            PG8_BAR; PG8_WAIT_L(0); PG8_MMA(0, 1, At, B1); PG8_BAR;
            PG8_LDA(At, 1, 1); PG8_STAGE(PG8_SA(1, 0), a3, voffA);
            PG8_BAR; PG8_WAIT_L(0); PG8_MMA(1, 0, At, B0); PG8_BAR; PG8_SCHED;
            PG8_STAGE(PG8_SB(1, 1), b3 + hstep, voffB);
            PG8_WAIT_V(6); PG8_BAR; PG8_MMA(1, 1, At, B1); PG8_BAR;
        }
        PG8_STAMP();
        if constexpr (!Epi::AFTER_DRAIN) { E(acc, cur, wr, wc, fr, fq); S.done(cur); }
        PG8_STAMP();
        if (!has_next) break;
#pragma unroll
        for (int a = 0; a < 2; ++a)
#pragma unroll
            for (int b = 0; b < 2; ++b)
#pragma unroll
                for (int m = 0; m < 4; ++m)
#pragma unroll
                    for (int n = 0; n < 2; ++n) acc[a][b][m][n] = (f32x4){0.f, 0.f, 0.f, 0.f};
        cur = nxt; cA = nA; cB = nB; ++ui;
    }
    PG8_WAIT_V(0);
    if (wr == 0) PG8_BAR;
    PG8_BAR;
    if constexpr (Epi::AFTER_DRAIN) { E.fused(acc, cur, wr, wc, fr, fq, lds, wid, lane); S.done(cur); }
    PG8_STAMP();
    if (STAMP && wid == 0) { stamps[lane] = lane < nts ? (((unsigned long long)(unsigned)ts_hi << 32) | (unsigned)ts_lo) : 0ull;
        if (lane == 62) stamps[62] = rt_entry; if (lane == 63) stamps[63] = (unsigned long long)wall_clock64(); }
#undef PG8_STAMP
#undef PG8_SA
#undef PG8_SB
#undef PG8_STAGE
#undef PG8_LDA
#undef PG8_LDB
#undef PG8_MMA
#undef PG8_WAIT_V
#undef PG8_WAIT_L
#undef PG8_BAR
#undef PG8_SCHED
}
}
#define LAS __attribute__((address_space(3)))
#define XB_TMO      128
#define XB_XCNT(j)  (256  + 64 * (j))
#define XB_XSUB(j)  (1280 + 64 * (j))
#define XB_XGEN(j)  (2304 + 64 * (j))
#define XB_TOP      3328
#define XB_TOPGEN   3392
#define XCD_BAR_WORDS 3456
#define XB_SPIN_CAP (1u << 18)

__device__ __forceinline__ unsigned xb_ld(unsigned* p)              { return __hip_atomic_load(p, __ATOMIC_RELAXED, __HIP_MEMORY_SCOPE_AGENT); }
__device__ __forceinline__ unsigned xb_add(unsigned* p, unsigned v) { return __hip_atomic_fetch_add(p, v, __ATOMIC_RELAXED, __HIP_MEMORY_SCOPE_AGENT); }
__device__ __forceinline__ unsigned xb_xcc_id() { return (unsigned)__builtin_amdgcn_s_getreg((3 << 11) | 20) & 0xFu; }
#define XB_SPIN(cond, bar) do { unsigned _sp = 0; while (cond) { __builtin_amdgcn_s_sleep(1); \
    if ((++_sp & 255u) == 0u) { if (xb_ld(&(bar)[XB_TMO])) break; if (_sp > XB_SPIN_CAP) { atomicAdd(&(bar)[XB_TMO], 1u); break; } } } } while (0)

struct XcdBarrier {
    unsigned* bar; unsigned x;
    volatile LAS unsigned* st;
};

__device__ __forceinline__ XcdBarrier xcd_barrier_post(unsigned* bar, volatile LAS unsigned* st) {
    XcdBarrier b; b.bar = bar; b.x = xb_xcc_id(); b.st = st;
    if (threadIdx.x == 0) (void)xb_add(&bar[XB_XCNT(b.x)], 1u);
    return b;
}
__device__ __forceinline__ void xcd_barrier_complete(unsigned* bar, unsigned x, unsigned& nloc, unsigned& nx) {
    const unsigned G = gridDim.x * gridDim.y * gridDim.z;
    unsigned sum, cnt, mine, sp = 0u;
    for (;;) {
        sum = 0u; cnt = 0u; mine = 0u;
#pragma unroll
        for (unsigned j = 0; j < 16; ++j) { const unsigned c = xb_ld(&bar[XB_XCNT(j)]); sum += c; cnt += (c > 0u) ? 1u : 0u; mine = (j == x) ? c : mine; }
        if (sum == G) break;
        __builtin_amdgcn_s_sleep(1);
        if ((++sp & 255u) == 0u) { if (xb_ld(&bar[XB_TMO])) break; if (sp > XB_SPIN_CAP) { atomicAdd(&bar[XB_TMO], 1u); break; } }
    }
    nloc = mine > 0u ? mine : 1u; nx = cnt > 0u ? cnt : 1u;
}

__device__ __forceinline__ void xcd_barrier(const XcdBarrier& b) {
    asm volatile("s_waitcnt vmcnt(0)" ::: "memory");
    __syncthreads();
    if (threadIdx.x == 0) {
        unsigned* bar = b.bar;
        __builtin_amdgcn_s_waitcnt(0);
        unsigned nloc = b.st[0], nx = b.st[1];
        if (nloc == 0u) { xcd_barrier_complete(bar, b.x, nloc, nx); b.st[0] = nloc; b.st[1] = nx; }
        const unsigned old = xb_add(&bar[XB_XSUB(b.x)], 1u);
        const unsigned gen = old / nloc;
        if (old + 1u == (gen + 1u) * nloc) {
            __builtin_amdgcn_fence(__ATOMIC_RELEASE, "agent");
            asm volatile("s_waitcnt vmcnt(0)" ::: "memory");
            const unsigned og = xb_add(&bar[XB_TOP], 1u);
            const unsigned tg = og / nx;
            if (og + 1u == (tg + 1u) * nx) xb_add(&bar[XB_TOPGEN], 1u);
            else XB_SPIN(xb_ld(&bar[XB_TOPGEN]) == tg, bar);
            __builtin_amdgcn_fence(__ATOMIC_ACQUIRE, "agent");
            xb_add(&bar[XB_XGEN(b.x)], 1u);
            asm volatile("s_waitcnt vmcnt(0)" ::: "memory");
        } else {
            XB_SPIN(xb_ld(&bar[XB_XGEN(b.x)]) == gen, bar);
            __builtin_amdgcn_fence(__ATOMIC_ACQUIRE, "agent");
            asm volatile("s_waitcnt vmcnt(0)" ::: "memory");
        }
    }
    __syncthreads();
}


using pg8::bf16_t; using pg8::bf16x8; using pg8::f32x4; using pg8::u32x4; using pg8::cvt_pk_bf16;
typedef unsigned u32x2 __attribute__((ext_vector_type(2)));
#define DEVI __device__ __forceinline__

constexpr int NPR = 16384, NRV = 16512, NRP = 16640;
constexpr int LDS_BYTES = 135168;
constexpr int LDS_MISC = 131072;

constexpr size_t WS_CTL = 0;
constexpr size_t WS_WT_MOD = 32768;
constexpr size_t WS_WT_INAB = WS_WT_MOD + 25165824;
constexpr size_t WS_WT_OUTAB = WS_WT_INAB + 25165824;
constexpr size_t WS_WT_CIN = WS_WT_OUTAB + 8388608;
constexpr size_t WS_WT_GLU = WS_WT_CIN + 8388608;
constexpr size_t WS_WT_COUT = WS_WT_GLU + 4194304;
constexpr size_t WS_WT_LRU = WS_WT_COUT + 4194304;
constexpr size_t WS_SILUC = WS_WT_LRU + 1048576;
constexpr size_t WS_MOD = WS_SILUC + 524288;
constexpr size_t WS_TAIL = WS_MOD + 12582912;
constexpr size_t WS_YBUF = WS_TAIL + 1064960;
constexpr size_t WS_PROJ = WS_YBUF + 68157440;
constexpr size_t WS_UT = WS_PROJ + 204472320;
constexpr size_t WS_WB = WS_UT + 33554432;
constexpr size_t WS_QT = WS_WB + 33554432;
constexpr size_t WS_KT = WS_QT + 33554432;
constexpr size_t WS_EGL = WS_KT + 33554432;
constexpr size_t WS_WT_TAIL = WS_EGL + 8192;
constexpr size_t WS_END = WS_WT_TAIL + 65536;
constexpr size_t WS_QK = WS_WT_MOD;
constexpr size_t WS_Y2 = WS_YBUF + 34078720;

constexpr size_t O_YP = 0, O_YS = 16777216, O_PCA = O_YS + 131072, O_PLRU = O_PCA + 49152, O_PCB = O_PLRU + 16384, O_PDEL = O_PCB + 147456,
                 O_PSR = O_PDEL + 2097152, O_PSI = O_PSR + 65536, O_SCA = O_PSI + 65536, O_SLRU = O_SCA + 786432, O_SCB = O_SLRU + 262144,
                 O_SDEL = O_SCB + 2359296, O_SSR = O_SDEL + 33554432, O_SSI = O_SSR + 1048576, O_END = O_SSI + 1048576;

enum { I_XP = 0, I_XS, I_CP, I_CS, I_SCA, I_SLRU, I_SCB, I_SDEL, I_SSR, I_SSI, I_NORMW, I_MODW, I_MODB, I_ABIN, I_ABOUT, I_CAW, I_CAB, I_GXW, I_GXB, I_GAW, I_GAB, I_APAR,
       I_CBW, I_ALOG, I_DTB, I_GNW, I_CIN, I_COUT, I_ARE, I_AIM, I_BRE, I_BIM, I_CRE, I_CIM, I_S5D, I_LOGDT, I_GLUW, I_GLUB, I_FNW, N_IN };

struct Params {
  const float* in[N_IN];
  float* out;
  unsigned char* ws;
  int ph_lo, ph_hi;
};

typedef const Params __attribute__((address_space(4)))* KP;
DEVI float bf2f(unsigned v16) { return __uint_as_float(v16 << 16); }
DEVI float bflo(unsigned w) { return __uint_as_float(w << 16); }
DEVI float bfhi(unsigned w) { return __uint_as_float(w & 0xffff0000u); }
DEVI bf16_t f2bf(float f) { return (bf16_t)(cvt_pk_bf16(f, 0.f) & 0xffffu); }
DEVI float fexp_(float x) { return __builtin_amdgcn_exp2f(x * 1.4426950408889634f); }
DEVI float sigmoidf_(float x) { return __builtin_amdgcn_rcpf(1.f + fexp_(-x)); }
DEVI float siluf_(float x) { return x * __builtin_amdgcn_rcpf(1.f + fexp_(-x)); }
DEVI float softplusf_(float x) { return x > 20.f ? x : log1pf(__expf(x)); }
DEVI float geluf_(float x) { const float z = 0.7978845608028654f * (x + 0.044715f * x * x * x); const float e = fexp_(2.f * z); return x - x * __builtin_amdgcn_rcpf(1.f + e); }
DEVI void lds_barrier() { asm volatile("s_waitcnt lgkmcnt(0)" ::: "memory"); __builtin_amdgcn_s_barrier(); asm volatile("" ::: "memory"); }
DEVI float wave_sum(float v) {
#pragma unroll
  for (int o = 32; o >= 1; o >>= 1) v += __shfl_xor(v, o);
  return v;
}
DEVI void unpack8(const u32x4 w, float (&f)[8]) { f[0] = bflo(w.x); f[1] = bfhi(w.x); f[2] = bflo(w.y); f[3] = bfhi(w.y); f[4] = bflo(w.z); f[5] = bfhi(w.z); f[6] = bflo(w.w); f[7] = bfhi(w.w); }
DEVI u32x4 pack8(const float (&f)[8]) { u32x4 w; w.x = cvt_pk_bf16(f[0], f[1]); w.y = cvt_pk_bf16(f[2], f[3]); w.z = cvt_pk_bf16(f[4], f[5]); w.w = cvt_pk_bf16(f[6], f[7]); return w; }
DEVI bf16x8 as_bf16x8(const u32x4 w) { union { u32x4 u; bf16x8 b; } c; c.u = w; return c.b; }
DEVI f32x4 mfma16(bf16x8 a, bf16x8 b, f32x4 c) { return __builtin_amdgcn_mfma_f32_16x16x32_bf16(a, b, c, 0, 0, 0); }

struct EpiRes {
  static constexpr bool PERM = false, AFTER_DRAIN = false;
  const float* xp; const float* xs; float* xo; const float* gate;
  __device__ __forceinline__ void operator()(const f32x4 (&acc)[2][2][4][2], const pg8::Unit& u, int wr, int wc, int fr, int fq) const {
    const int row0 = u.pm * 256 + wr * 64 + fr, col0 = u.pn * 256 + wc * 32 + 4 * fq;
#pragma unroll
    for (int ai = 0; ai < 2; ++ai)
#pragma unroll
      for (int m = 0; m < 4; ++m) {
        const int row = row0 + ai * 128 + m * 16;
        if (row < NRV) {
          const float* xi = (row < NPR ? xp + (size_t)row * 1024 : xs + (size_t)(row - NPR) * 1024) + col0;
          const int mrow = row < NPR ? (row >> 11) : 8 + (row - NPR);
          const float* gp = gate + (size_t)mrow * 12288 + col0;
          float* op = xo + (size_t)row * 1024 + col0;
#pragma unroll
          for (int bj = 0; bj < 2; ++bj)
#pragma unroll
            for (int n = 0; n < 2; ++n) {
              const f32x4 xv = *(const f32x4*)(xi + bj * 128 + n * 16), gv = *(const f32x4*)(gp + bj * 128 + n * 16);
              *(f32x4*)(op + bj * 128 + n * 16) = xv + gv * acc[ai][bj][m][n];
            }
        }
      }
  }
};
struct EpiGlu {
  static constexpr bool PERM = true, AFTER_DRAIN = false;
  const bf16_t* y1; const bf16_t* z; bf16_t* y2; const float* bias;
  __device__ __forceinline__ void operator()(const f32x4 (&acc)[2][2][4][2], const pg8::Unit& u, int wr, int wc, int fr, int fq) const {
    const int row0 = u.pm * 256 + wr * 64 + fr, col0 = u.pn * 256 + wc * 32 + 8 * fq;
#pragma unroll
    for (int ai = 0; ai < 2; ++ai)
#pragma unroll
      for (int m = 0; m < 4; ++m) {
        const int row = row0 + ai * 128 + m * 16;
#pragma unroll
        for (int bj = 0; bj < 2; ++bj) {
          const int col = col0 + bj * 128;
          const f32x4 b0 = *(const f32x4*)(bias + col), b1 = *(const f32x4*)(bias + col + 4);
          const u32x4 yw = *(const u32x4*)(y1 + (size_t)row * 1024 + col), zw = *(const u32x4*)(z + (size_t)row * 2048 + col);
          float yf[8], zf[8], o[8]; unpack8(yw, yf); unpack8(zw, zf);
          const f32x4 a0 = acc[ai][bj][m][0] + b0, a1 = acc[ai][bj][m][1] + b1;
#pragma unroll
          for (int e = 0; e < 4; ++e) { o[e] = yf[e] * sigmoidf_(a0[e]) * siluf_(zf[e]); o[4 + e] = yf[4 + e] * sigmoidf_(a1[e]) * siluf_(zf[4 + e]); }
          *(u32x4*)(y2 + (size_t)row * 1024 + col) = pack8(o);
        }
      }
  }
};

struct TileDesc { const float* src; bf16_t* dst; int ldsrc, lddst, k0, n0; };
DEVI TileDesc prep_tile(KP p, int t) {
  TileDesc d; int tt = t;
  if (tt < 3072) { const int mat = tt / 768, r = tt % 768; d.k0 = (r / 48) * 64; d.n0 = (r % 48) * 64; d.src = p->in[I_MODW] + (size_t)mat * 1024 * 3072; d.ldsrc = 3072; d.dst = (bf16_t*)(p->ws + WS_WT_MOD) + (size_t)mat * 3072 * 1024; d.lddst = 1024; }
  else if ((tt -= 3072) < 3072) { const int mat = tt / 1536, r = tt % 1536; d.k0 = (r / 96) * 64; d.n0 = (r % 96) * 64; d.src = p->in[I_ABIN] + (size_t)mat * 1024 * 6160; d.ldsrc = 6160; d.dst = (bf16_t*)(p->ws + WS_WT_INAB) + (size_t)mat * 6144 * 1024; d.lddst = 1024; }
  else if ((tt -= 3072) < 1024) { const int mat = tt / 512, r = tt % 512; d.k0 = (r / 16) * 64; d.n0 = (r % 16) * 64; d.src = p->in[I_ABOUT] + (size_t)mat * 2048 * 1024; d.ldsrc = 1024; d.dst = (bf16_t*)(p->ws + WS_WT_OUTAB) + (size_t)mat * 1024 * 2048; d.lddst = 2048; }
  else if ((tt -= 1024) < 1024) { const int mat = tt / 512, r = tt % 512; d.k0 = (r / 32) * 64; d.n0 = (r % 32) * 64; d.src = p->in[I_CIN] + (size_t)mat * 1024 * 2048; d.ldsrc = 2048; d.dst = (bf16_t*)(p->ws + WS_WT_CIN) + (size_t)mat * 2048 * 1024; d.lddst = 1024; }
  else if ((tt -= 1024) < 512) { const int mat = tt / 256, r = tt % 256; d.k0 = (r / 16) * 64; d.n0 = (r % 16) * 64; d.src = p->in[I_COUT] + (size_t)mat * 1024 * 1024; d.ldsrc = 1024; d.dst = (bf16_t*)(p->ws + WS_WT_COUT) + (size_t)mat * 1024 * 1024; d.lddst = 1024; }
  else if ((tt -= 512) < 512) { const int mat = tt / 256, r = tt % 256; d.k0 = (r / 16) * 64; d.n0 = (r % 16) * 64; d.src = p->in[I_GLUW] + (size_t)mat * 1024 * 1024; d.ldsrc = 1024; d.dst = (bf16_t*)(p->ws + WS_WT_GLU) + (size_t)mat * 1024 * 1024; d.lddst = 1024; }
  else { tt -= 512; const int gate = tt / 64; const int r2 = tt % 64; const int mat = r2 / 4, r = r2 % 4;
    d.k0 = (r / 2) * 64; d.n0 = (r % 2) * 64; d.src = p->in[gate ? I_GAW : I_GXW] + (size_t)mat * 16384; d.ldsrc = 128;
    d.dst = (bf16_t*)(p->ws + WS_WT_LRU) + (size_t)(((mat >> 3) * 2 + gate) * 8 + (mat & 7)) * 16384; d.lddst = 128; }
  return d;
}
DEVI void phase_prep(KP p, float* lds) {
  const int tid = tidx_(), tx = tid & 15, ty = tid >> 4, nn = tid >> 3, ks = (tid & 7) * 8;
  for (int t0 = bidx_(); t0 < 9344; t0 += 4 * gdim_()) {
    float4 v[4][2];
#pragma unroll
    for (int q = 0; q < 4; ++q) { const int t = t0 + q * gdim_();
      if (t < 9344) { const TileDesc d = prep_tile(p, t);
#pragma unroll
        for (int pp = 0; pp < 2; ++pp) v[q][pp] = *(const float4*)(d.src + (size_t)(d.k0 + ty + pp * 32) * d.ldsrc + d.n0 + tx * 4); } }
#pragma unroll
    for (int q = 0; q < 4; ++q) { float* tile = lds + q * 4160;
#pragma unroll
      for (int pp = 0; pp < 2; ++pp) { const int k = ty + pp * 32; tile[k * 65 + tx * 4 + 0] = v[q][pp].x; tile[k * 65 + tx * 4 + 1] = v[q][pp].y; tile[k * 65 + tx * 4 + 2] = v[q][pp].z; tile[k * 65 + tx * 4 + 3] = v[q][pp].w; } }
    __syncthreads();
#pragma unroll
    for (int q = 0; q < 4; ++q) { const int t = t0 + q * gdim_();
      if (t < 9344) { const TileDesc d = prep_tile(p, t); const float* tile = lds + q * 4160; float f[8];
#pragma unroll
        for (int jx = 0; jx < 8; ++jx) f[jx] = tile[(ks + jx) * 65 + nn];
        *(u32x4*)(d.dst + (size_t)(d.n0 + nn) * d.lddst + d.k0 + ks) = pack8(f); } }
    __syncthreads();
  }
  { bf16_t* wtt = (bf16_t*)(p->ws + WS_WT_TAIL);
    for (int e = bidx_() * 512 + tidx_(); e < 32768; e += gdim_() * 512) { const int jj = e >> 14, cc = (e >> 10) & 15, k = e & 1023;
      wtt[e] = f2bf(p->in[I_ABIN][(size_t)jj * 1024 * 6160 + (size_t)k * 6160 + 6144 + cc]); } }
  bf16_t* sc = (bf16_t*)(p->ws + WS_SILUC);
  for (int e = bidx_() * 512 + tidx_(); e < 256 * 1024 / 4; e += gdim_() * 512) {
    const int row = e >> 8, c4 = (e & 255) * 4; float4 v = make_float4(0.f, 0.f, 0.f, 0.f);
    if (row < 8) v = *(const float4*)(p->in[I_CP] + row * 1024 + c4); else if (row < 136) v = *(const float4*)(p->in[I_CS] + (row - 8) * 1024 + c4);
    u32x2 w; w.x = cvt_pk_bf16(row < 136 ? siluf_(v.x) : 0.f, row < 136 ? siluf_(v.y) : 0.f); w.y = cvt_pk_bf16(row < 136 ? siluf_(v.z) : 0.f, row < 136 ? siluf_(v.w) : 0.f);
    *(u32x2*)(sc + row * 1024 + c4) = w;
  }
}

DEVI void norm_row2(const float* x0, const float* x1, bool two, const float (&wm)[16], const float (&sh)[16], bf16_t* h0, bf16_t* h1, int lane) {
  float4 v0[4], v1[4]; float s0 = 0.f, s1 = 0.f;
#pragma unroll
  for (int i = 0; i < 4; ++i) { v0[i] = *(const float4*)(x0 + i * 256 + lane * 4); v1[i] = two ? *(const float4*)(x1 + i * 256 + lane * 4) : make_float4(0.f, 0.f, 0.f, 0.f); }
#pragma unroll
  for (int i = 0; i < 4; ++i) { s0 += v0[i].x * v0[i].x + v0[i].y * v0[i].y + v0[i].z * v0[i].z + v0[i].w * v0[i].w; s1 += v1[i].x * v1[i].x + v1[i].y * v1[i].y + v1[i].z * v1[i].z + v1[i].w * v1[i].w; }
#pragma unroll
  for (int o = 32; o >= 1; o >>= 1) { s0 += __shfl_xor(s0, o); s1 += __shfl_xor(s1, o); }
  const float r0 = __builtin_amdgcn_rsqf(s0 * (1.f / 1024.f) + 1e-6f), r1 = __builtin_amdgcn_rsqf(s1 * (1.f / 1024.f) + 1e-6f);
#pragma unroll
  for (int i = 0; i < 4; ++i) { const int k = i * 256 + lane * 4;
    u32x2 w; w.x = cvt_pk_bf16(v0[i].x * r0 * wm[i * 4 + 0] + sh[i * 4 + 0], v0[i].y * r0 * wm[i * 4 + 1] + sh[i * 4 + 1]); w.y = cvt_pk_bf16(v0[i].z * r0 * wm[i * 4 + 2] + sh[i * 4 + 2], v0[i].w * r0 * wm[i * 4 + 3] + sh[i * 4 + 3]);
    *(u32x2*)(h0 + k) = w;
    if (two) { u32x2 w2; w2.x = cvt_pk_bf16(v1[i].x * r1 * wm[i * 4 + 0] + sh[i * 4 + 0], v1[i].y * r1 * wm[i * 4 + 1] + sh[i * 4 + 1]); w2.y = cvt_pk_bf16(v1[i].z * r1 * wm[i * 4 + 2] + sh[i * 4 + 2], v1[i].w * r1 * wm[i * 4 + 3] + sh[i * 4 + 3]);
      *(u32x2*)(h1 + k) = w2; } }
}
DEVI void norm_coefs(KP p, int layer, int mrow, int lane, float (&wm)[16], float (&sh)[16]) {
  const float* nw = p->in[I_NORMW] + layer * 1024;
  const float* md = (const float*)(p->ws + WS_MOD) + (size_t)mrow * 12288 + layer * 3072;
#pragma unroll
  for (int i = 0; i < 4; ++i) { const int k = i * 256 + lane * 4; const float4 w4 = *(const float4*)(nw + k), s4 = *(const float4*)(md + k), c4 = *(const float4*)(md + 1024 + k);
    wm[i * 4 + 0] = w4.x * (1.f + c4.x); wm[i * 4 + 1] = w4.y * (1.f + c4.y); wm[i * 4 + 2] = w4.z * (1.f + c4.z); wm[i * 4 + 3] = w4.w * (1.f + c4.w);
    sh[i * 4 + 0] = s4.x; sh[i * 4 + 1] = s4.y; sh[i * 4 + 2] = s4.z; sh[i * 4 + 3] = s4.w; }
}
DEVI void phase_norm(KP p, int layer, float* lds) {
  const int tid = tidx_(), lane = tid & 63, wave = tid >> 6;
  bf16_t* hb = (bf16_t*)(p->ws + WS_YBUF);
  float wm[16], sh[16];
  for (int gw = bidx_() * 8 + wave; gw < 2048; gw += gdim_() * 8) {
    const int r0 = gw * 8;
    norm_coefs(p, layer, r0 >> 11, lane, wm, sh);
    const float* xb = (layer == 0) ? p->in[I_XP] : p->out;
#pragma unroll 2
    for (int i = 0; i < 8; i += 2) norm_row2(xb + (size_t)(r0 + i) * 1024, xb + (size_t)(r0 + i + 1) * 1024, true, wm, sh, hb + (size_t)(r0 + i) * 1024, hb + (size_t)(r0 + i + 1) * 1024, lane);
    if (gw < 128) {
      norm_coefs(p, layer, 8 + gw, lane, wm, sh);
      const float* xs = (layer == 0) ? p->in[I_XS] + (size_t)gw * 1024 : p->out + (size_t)(NPR + gw) * 1024;
      norm_row2(xs, xs, false, wm, sh, hb + (size_t)(NPR + gw) * 1024, hb, lane);
    }
  }
}
DEVI void tail_gemm(KP p, int j) {
  const int tid = tidx_(), lane = tid & 63, wave = tid >> 6, l15 = lane & 15, lq = lane >> 4;
  const bf16_t* hb = (const bf16_t*)(p->ws + WS_YBUF);
  const bf16_t* bp = (const bf16_t*)(p->ws + WS_WT_TAIL) + (size_t)j * 16384 + l15 * 1024 + lq * 8;
  float* tl = (float*)(p->ws + WS_TAIL);
  for (int t = bidx_() * 8 + wave; t < 1032; t += gdim_() * 8) {
    const bf16_t* ap = hb + (size_t)(t * 16 + l15) * 1024 + lq * 8;
    f32x4 acc0 = (f32x4){0.f, 0.f, 0.f, 0.f}, acc1 = (f32x4){0.f, 0.f, 0.f, 0.f};
#pragma unroll 1
    for (int k0 = 0; k0 < 1024; k0 += 256) {
      u32x4 a[8], b[8];
#pragma unroll
      for (int u = 0; u < 8; ++u) { a[u] = *(const u32x4*)(ap + k0 + u * 32); b[u] = *(const u32x4*)(bp + k0 + u * 32); }
#pragma unroll
      for (int u = 0; u < 8; u += 2) { acc0 = mfma16(as_bf16x8(a[u]), as_bf16x8(b[u]), acc0); acc1 = mfma16(as_bf16x8(a[u + 1]), as_bf16x8(b[u + 1]), acc1); }
    }
    acc0 = acc0 + acc1;
#pragma unroll
    for (int r = 0; r < 4; ++r) tl[(size_t)(t * 16 + lq * 4 + r) * 16 + l15] = acc0[r];
  }
}

DEVI void lru_item(KP p, int j, int item, unsigned char* lds) {
  const int tid = tidx_(), lane = tid & 63, wave = tid >> 6;
  const bool prompt = item < 128;
  const int b = prompt ? (item >> 4) : 0, hd = prompt ? ((item >> 1) & 7) : ((item - 128) >> 1), half = item & 1;
  bf16_t* WX = (bf16_t*)lds;
  bf16_t* XA = (bf16_t*)(lds + 34816);
  float* AA = (float*)(lds + 52224);
  float* BB = (float*)(lds + 69632);
  bf16_t* RAW = (bf16_t*)(lds + 87040);
  float* CAR = (float*)(lds + 105472);
  const bf16_t* proj = (const bf16_t*)(p->ws + WS_PROJ);
  bf16_t* ybuf = (bf16_t*)(p->ws + WS_YBUF);
  { const bf16_t* wt = (const bf16_t*)(p->ws + WS_WT_LRU);
#pragma unroll
    for (int q = 0; q < 4; ++q) { const int e = tid + q * 512, gate = e >> 10, o = (e & 1023) >> 4, c8 = e & 15;
      *(u32x4*)(WX + (gate * 64 + o) * 136 + c8 * 8) = *(const u32x4*)(wt + ((size_t)((j * 2 + gate) * 8 + hd) * 128 + half * 64 + o) * 128 + c8 * 8); } }
  const int ch8 = tid & 15, rsub = tid >> 4, chb = hd * 128 + ch8 * 8;
  float cw[4][8], cb[8];
#pragma unroll
  for (int t = 0; t < 4; ++t)
#pragma unroll
    for (int e = 0; e < 8; ++e) cw[t][e] = p->in[I_CAW][(size_t)(j * 4 + t) * 1024 + chb + e];
#pragma unroll
  for (int e = 0; e < 8; ++e) cb[e] = p->in[I_CAB][j * 1024 + chb + e];
  const int rt = wave >> 1, chh = wave & 1, l15 = lane & 15, lq = lane >> 4;
  float gxb[2], gab[2], spv[2];
#pragma unroll
  for (int c2 = 0; c2 < 2; ++c2) { const int gch = hd * 128 + half * 64 + chh * 32 + c2 * 16 + l15;
    gxb[c2] = p->in[I_GXB][j * 1024 + gch]; gab[c2] = p->in[I_GAB][j * 1024 + gch]; spv[c2] = softplusf_(-p->in[I_APAR][j * 1024 + gch]); }
  const int sch = hd * 128 + half * 64 + lane;
  float hcar = 0.f;
  const int ntiles = prompt ? 32 : 2;
  u32x4 pre[3];
  if (prompt) {
#pragma unroll
    for (int q = 0; q < 3; ++q) { const int e = tid + q * 512, row = e >> 4, c8 = e & 15, t = row - 3; pre[q] = (u32x4){0u, 0u, 0u, 0u};
      if (e < 1072 && t >= 0) pre[q] = *(const u32x4*)(proj + (size_t)(b * 2048 + t) * 6144 + hd * 128 + c8 * 8); }
  }
  for (int tile = 0; tile < ntiles; ++tile) {
    bf16_t zav[8];
#pragma unroll
    for (int i = 0; i < 8; ++i) { const size_t grow = prompt ? (size_t)(b * 2048 + tile * 64 + wave * 8 + i) : (size_t)(NPR + tile * 64 + wave * 8 + i); zav[i] = proj[grow * 6144 + 1024 + sch]; }
    if (prompt) {
#pragma unroll
      for (int q = 0; q < 3; ++q) { const int e = tid + q * 512; if (e < 1072) *(u32x4*)(RAW + (e >> 4) * 136 + (e & 15) * 8) = pre[q]; }
      if (tile + 1 < ntiles) {
#pragma unroll
        for (int q = 0; q < 3; ++q) { const int e = tid + q * 512, row = e >> 4, c8 = e & 15, t = (tile + 1) * 64 + row - 3;
          if (e < 1072) pre[q] = *(const u32x4*)(proj + (size_t)(b * 2048 + t) * 6144 + hd * 128 + c8 * 8); }
      }
      lds_barrier();
#pragma unroll
      for (int pp = 0; pp < 2; ++pp) {
        const int i = rsub + pp * 32; float acc[8];
#pragma unroll
        for (int e = 0; e < 8; ++e) acc[e] = cb[e];
#pragma unroll
        for (int tap = 0; tap < 4; ++tap) { float xf[8]; unpack8(*(const u32x4*)(RAW + (i + tap) * 136 + ch8 * 8), xf);
#pragma unroll
          for (int e = 0; e < 8; ++e) acc[e] += cw[tap][e] * xf[e]; }
        *(u32x4*)(XA + i * 136 + ch8 * 8) = pack8(acc);
      }
      if (tile == 31 && half == 0 && tid < 48) { const int r3 = tid >> 4, c8 = tid & 15; float xf[8]; unpack8(*(const u32x4*)(RAW + (64 + r3) * 136 + c8 * 8), xf);
        float* o = p->out + O_PCA + (size_t)((j * 8 + b) * 3 + r3) * 1024 + hd * 128 + c8 * 8;
        *(float4*)o = make_float4(xf[0], xf[1], xf[2], xf[3]); *(float4*)(o + 4) = make_float4(xf[4], xf[5], xf[6], xf[7]); }
    } else {
#pragma unroll
      for (int pp = 0; pp < 2; ++pp) {
        const int i = rsub + pp * 32; float acc[8], x3[8];
#pragma unroll
        for (int e = 0; e < 8; ++e) acc[e] = cb[e];
        const int brow = tile * 64 + i;
        const float* st = p->in[I_SCA] + (size_t)((j * 128 + brow) * 3) * 1024 + chb;
        float* so = p->out + O_SCA + (size_t)((j * 128 + brow) * 3) * 1024 + chb;
#pragma unroll
        for (int tap = 0; tap < 3; ++tap) { const float4 s0 = *(const float4*)(st + tap * 1024), s1 = *(const float4*)(st + tap * 1024 + 4);
          const float xf[8] = {s0.x, s0.y, s0.z, s0.w, s1.x, s1.y, s1.z, s1.w};
#pragma unroll
          for (int e = 0; e < 8; ++e) acc[e] += cw[tap][e] * xf[e];
          if (tap >= 1 && half == 0) { *(float4*)(so + (tap - 1) * 1024) = s0; *(float4*)(so + (tap - 1) * 1024 + 4) = s1; } }
        const u32x4 w = *(const u32x4*)(proj + (size_t)(NPR + brow) * 6144 + chb); unpack8(w, x3);
#pragma unroll
        for (int e = 0; e < 8; ++e) acc[e] += cw[3][e] * x3[e];
        if (half == 0) { *(float4*)(so + 2 * 1024) = make_float4(x3[0], x3[1], x3[2], x3[3]); *(float4*)(so + 2 * 1024 + 4) = make_float4(x3[4], x3[5], x3[6], x3[7]); }
        *(u32x4*)(XA + i * 136 + ch8 * 8) = pack8(acc);
      }
    }
    lds_barrier();
    f32x4 accx[2], acca[2];
#pragma unroll
    for (int c2 = 0; c2 < 2; ++c2) { accx[c2] = (f32x4){0.f, 0.f, 0.f, 0.f}; acca[c2] = (f32x4){0.f, 0.f, 0.f, 0.f}; }
#pragma unroll
    for (int kk = 0; kk < 4; ++kk) {
      const bf16x8 a = *(const bf16x8*)(XA + (rt * 16 + l15) * 136 + lq * 8 + kk * 32);
#pragma unroll
      for (int c2 = 0; c2 < 2; ++c2) {
        const bf16x8 bx = *(const bf16x8*)(WX + (chh * 32 + c2 * 16 + l15) * 136 + lq * 8 + kk * 32);
        const bf16x8 ba = *(const bf16x8*)(WX + (64 + chh * 32 + c2 * 16 + l15) * 136 + lq * 8 + kk * 32);
        accx[c2] = mfma16(a, bx, accx[c2]); acca[c2] = mfma16(a, ba, acca[c2]);
      }
    }
#pragma unroll
    for (int c2 = 0; c2 < 2; ++c2)
#pragma unroll
      for (int r = 0; r < 4; ++r) {
        const int row = rt * 16 + lq * 4 + r, oc = chh * 32 + c2 * 16 + l15;
        const float gx = sigmoidf_(accx[c2][r] + gxb[c2]), ga = sigmoidf_(acca[c2][r] + gab[c2]);
        const float log_a = -8.f * ga * spv[c2];
        const float a = fexp_(log_a);
        float mult = __builtin_amdgcn_sqrtf(fmaxf(1.f - a * a, 0.f));
        if (prompt && tile == 0 && row == 0) mult = 1.f;
        const float xv = bf2f(XA[row * 136 + half * 64 + oc]);
        AA[row * 68 + oc] = a; BB[row * 68 + oc] = mult * gx * xv;
      }
    lds_barrier();
    float hl[8], pc[8];
    { float h = 0.f, P = 1.f;
#pragma unroll
      for (int i = 0; i < 8; ++i) { const float a = AA[(wave * 8 + i) * 68 + lane], bv = BB[(wave * 8 + i) * 68 + lane];
        if (prompt) { h = a * h + bv; P *= a; hl[i] = h; pc[i] = P; } else { hl[i] = bv; pc[i] = a; } }
      CAR[(wave * 64 + lane) * 2] = P; CAR[(wave * 64 + lane) * 2 + 1] = h; }
    lds_barrier();
    float cin = 0.f;
    if (prompt) { float c = hcar;
#pragma unroll
      for (int s = 0; s < 8; ++s) { const float Ps = CAR[(s * 64 + lane) * 2], Es = CAR[(s * 64 + lane) * 2 + 1]; if (s == wave) cin = c; c = Ps * c + Es; }
      hcar = c; }
#pragma unroll
    for (int i = 0; i < 8; ++i) {
      const int rowl = tile * 64 + wave * 8 + i;
      float hv;
      if (prompt) hv = hl[i] + pc[i] * cin;
      else { const float h0 = p->in[I_SLRU][(size_t)(j * 128 + rowl) * 1024 + sch]; hv = pc[i] * h0 + hl[i]; p->out[O_SLRU + (size_t)(j * 128 + rowl) * 1024 + sch] = hv; }
      const size_t grow = prompt ? (size_t)(b * 2048 + rowl) : (size_t)(NPR + rowl);
      ybuf[grow * 2048 + sch] = f2bf(hv * siluf_(bf2f(zav[i])));
    }
  }
  if (prompt && wave == 0) p->out[O_PLRU + (size_t)(j * 8 + b) * 1024 + sch] = hcar;
}

DEVI void gdn_prep_item(KP p, int j, int cid, unsigned char* lds) {
  const int tid = tidx_(), lane = tid & 63, wave = tid >> 6;
  const int b = cid >> 8, h = (cid >> 5) & 7, c = cid & 31;
  const int row0 = b * 2048 + c * 64;
  bf16_t* QN = (bf16_t*)lds; bf16_t* KN = (bf16_t*)(lds + 17408); bf16_t* VN = (bf16_t*)(lds + 34816);
  float* AM = (float*)(lds + 52224); float* GC = (float*)(lds + 69632); float* BETA = (float*)(lds + 69888); float* BEG = (float*)(lds + 70144);
  const bf16_t* proj = (const bf16_t*)(p->ws + WS_PROJ);
  const float* tl = (const float*)(p->ws + WS_TAIL);
  if (wave == 0) {
    const float* t = tl + (size_t)(row0 + lane) * 16;
    float g = -fexp_(p->in[I_ALOG][j * 8 + h]) * softplusf_(t[8 + h] + p->in[I_DTB][j * 8 + h]);
    const float beta = sigmoidf_(t[h]);
#pragma unroll
    for (int o = 1; o < 64; o <<= 1) { const float v = __shfl_up(g, o); if (lane >= o) g += v; }
    GC[lane] = g; BETA[lane] = beta; BEG[lane] = beta * fexp_(g);
  }
  bf16_t* RAWB = (bf16_t*)(lds + 70656);
  bf16_t* AMB = (bf16_t*)(lds + 70656);
  bf16_t* XT = (bf16_t*)(lds + 79872);
  float* CORR = (float*)lds;
  float* CW = (float*)(lds + 123184);
  {
    u32x4 rv[7];
#pragma unroll
    for (int q = 0; q < 7; ++q) { const int e = tid + 512 * q, row = e / 48, c16 = e - row * 48, tt = c * 64 + row - 3; rv[q] = (u32x4){0u, 0u, 0u, 0u};
      if (e < 3216 && tt >= 0) rv[q] = *(const u32x4*)(proj + (size_t)(b * 2048 + tt) * 6144 + 2048 + (c16 >> 4) * 1024 + h * 128 + (c16 & 15) * 8); }
    float4 wv = make_float4(0.f, 0.f, 0.f, 0.f);
    if (tid < 384) { const int tap = tid / 96, lc = (tid - tap * 96) * 4; wv = *(const float4*)(p->in[I_CBW] + (size_t)(j * 4 + tap) * 3072 + (lc >> 7) * 1024 + h * 128 + (lc & 127)); }
#pragma unroll
    for (int q = 0; q < 7; ++q) { const int e = tid + 512 * q, row = e / 48, c16 = e - row * 48; if (e < 3216) *(u32x4*)(RAWB + row * 392 + c16 * 8) = rv[q]; }
    if (tid < 384) { const int tap = tid / 96, lc = (tid - tap * 96) * 4; *(float4*)(CW + tap * 384 + lc) = wv; }
  }
  lds_barrier();
  if (c == 31 && tid < 144) { const int r3 = tid / 48, c16 = tid - r3 * 48; float xf[8]; unpack8(*(const u32x4*)(RAWB + (64 + r3) * 392 + c16 * 8), xf);
    float* o = p->out + O_PCB + (size_t)((j * 8 + b) * 3 + r3) * 3072 + (c16 >> 4) * 1024 + h * 128 + (c16 & 15) * 8;
    *(float4*)o = make_float4(xf[0], xf[1], xf[2], xf[3]); *(float4*)(o + 4) = make_float4(xf[4], xf[5], xf[6], xf[7]); }
#pragma unroll 2
  for (int pi = 0; pi < 6; ++pi) {
    const int pair = tid + 512 * pi, part = pair >> 10, rem = pair & 1023, i = rem >> 4, cgp = rem & 15;
    float acc[8];
#pragma unroll
    for (int e = 0; e < 8; ++e) acc[e] = 0.f;
#pragma unroll
    for (int tap = 0; tap < 4; ++tap) { float xf[8]; unpack8(*(const u32x4*)(RAWB + (i + tap) * 392 + part * 128 + cgp * 8), xf);
      const float4 w0 = *(const float4*)(CW + tap * 384 + part * 128 + cgp * 8), w1 = *(const float4*)(CW + tap * 384 + part * 128 + cgp * 8 + 4);
      acc[0] += w0.x * xf[0]; acc[1] += w0.y * xf[1]; acc[2] += w0.z * xf[2]; acc[3] += w0.w * xf[3];
      acc[4] += w1.x * xf[4]; acc[5] += w1.y * xf[5]; acc[6] += w1.z * xf[6]; acc[7] += w1.w * xf[7]; }
    float ss = 0.f;
#pragma unroll
    for (int e = 0; e < 8; ++e) { acc[e] = siluf_(acc[e]); ss += acc[e] * acc[e]; }
    ss += __shfl_xor(ss, 1); ss += __shfl_xor(ss, 2); ss += __shfl_xor(ss, 4); ss += __shfl_xor(ss, 8);
    float scl = 1.f;
    if (part == 0) scl = __builtin_amdgcn_rsqf(ss + 1e-6f) * 0.08838834764831845f; else if (part == 1) scl = __builtin_amdgcn_rsqf(ss + 1e-6f);
#pragma unroll
    for (int e = 0; e < 8; ++e) acc[e] *= scl;
    bf16_t* dstp = part == 0 ? QN : (part == 1 ? KN : VN);
    *(u32x4*)(dstp + i * 136 + cgp * 8) = pack8(acc);
  }
  lds_barrier();
  {
    const int rt = wave >> 1, ctp = (wave & 1) * 2, l15 = lane & 15, lq = lane >> 4;
    f32x4 kka[2], qka[2];
#pragma unroll
    for (int c2 = 0; c2 < 2; ++c2) { kka[c2] = (f32x4){0.f, 0.f, 0.f, 0.f}; qka[c2] = (f32x4){0.f, 0.f, 0.f, 0.f}; }
#pragma unroll
    for (int kk = 0; kk < 4; ++kk) {
      const bf16x8 ak = *(const bf16x8*)(KN + (rt * 16 + l15) * 136 + lq * 8 + kk * 32);
      const bf16x8 aq = *(const bf16x8*)(QN + (rt * 16 + l15) * 136 + lq * 8 + kk * 32);
#pragma unroll
      for (int c2 = 0; c2 < 2; ++c2) { const bf16x8 bk = *(const bf16x8*)(KN + ((ctp + c2) * 16 + l15) * 136 + lq * 8 + kk * 32);
        kka[c2] = mfma16(ak, bk, kka[c2]); qka[c2] = mfma16(aq, bk, qka[c2]); }
    }
    bf16_t* qkg = (bf16_t*)(p->ws + WS_QK) + (size_t)cid * 4096;
#pragma unroll
    for (int c2 = 0; c2 < 2; ++c2)
#pragma unroll
      for (int r = 0; r < 4; ++r) {
        const int i = rt * 16 + lq * 4 + r, jj = (ctp + c2) * 16 + l15;
        const float dec = fexp_(fminf(GC[i] - GC[jj], 0.f));
        const float aval = (i > jj) ? BETA[i] * kka[c2][r] * dec : 0.f;
        AM[i * 68 + jj] = aval; AMB[i * 72 + jj] = f2bf(aval);
        qkg[(((i >> 4) * 2 + (jj >> 5)) * 64 + ((jj & 31) >> 3) * 16 + (i & 15)) * 8 + (jj & 7)] = f2bf((i >= jj) ? qka[c2][r] * dec : 0.f);
      }
  }
  lds_barrier();
  const int cc = tid & 255;
  const bf16_t* rsrc = (cc < 128) ? (VN + cc) : (KN + (cc - 128));
  const float* rfac = (cc < 128) ? BETA : BEG;
#pragma unroll
  for (int bi = 0; bi < 4; ++bi) {
    if (bi > 0) {
      const int l15 = lane & 15, lq = lane >> 4;
#pragma unroll
      for (int n2 = 0; n2 < 2; ++n2) { const int nt = wave * 2 + n2; f32x4 acc = (f32x4){0.f, 0.f, 0.f, 0.f};
#pragma unroll
        for (int kk = 0; kk < (bi * 16 + 31) / 32; ++kk) { const int k0 = lq * 8 + kk * 32; const bool valid = k0 < bi * 16;
          u32x4 av = *(const u32x4*)(AMB + (bi * 16 + l15) * 72 + k0), bv = *(const u32x4*)(XT + (nt * 16 + l15) * 72 + k0);
          if (!valid) { av = (u32x4){0u, 0u, 0u, 0u}; bv = (u32x4){0u, 0u, 0u, 0u}; }
          acc = mfma16(as_bf16x8(av), as_bf16x8(bv), acc); }
#pragma unroll
        for (int r = 0; r < 4; ++r) CORR[(lq * 4 + r) * 260 + nt * 16 + l15] = acc[r]; }
      lds_barrier();
    }
    if (tid < 256) {
      float xb[16], rh[16];
#pragma unroll
      for (int ii = 0; ii < 16; ++ii) { const int i = bi * 16 + ii; rh[ii] = bf2f(rsrc[i * 136]) * rfac[i]; if (bi > 0) rh[ii] -= CORR[ii * 260 + cc]; }
#pragma unroll
      for (int rg = 0; rg < 4; ++rg) {
        f32x4 a[4][4];
#pragma unroll
        for (int q = 0; q < 4; ++q)
#pragma unroll
          for (int g4 = 0; g4 <= rg; ++g4) a[q][g4] = *(const f32x4*)(AM + (bi * 16 + rg * 4 + q) * 68 + bi * 16 + g4 * 4);
#pragma unroll
        for (int q = 0; q < 4; ++q) { const int ii = rg * 4 + q; float s = rh[ii];
#pragma unroll
          for (int jj = 0; jj < ii; ++jj) s -= a[q][jj >> 2][jj & 3] * xb[jj];
          xb[ii] = s; }
        asm volatile("" : "+v"(xb[rg * 4 + 3]) :: "memory");
      }
      u32x4 w0, w1;
      w0.x = cvt_pk_bf16(xb[0], xb[1]); w0.y = cvt_pk_bf16(xb[2], xb[3]); w0.z = cvt_pk_bf16(xb[4], xb[5]); w0.w = cvt_pk_bf16(xb[6], xb[7]);
      w1.x = cvt_pk_bf16(xb[8], xb[9]); w1.y = cvt_pk_bf16(xb[10], xb[11]); w1.z = cvt_pk_bf16(xb[12], xb[13]); w1.w = cvt_pk_bf16(xb[14], xb[15]);
      if (bi < 3) { *(u32x4*)(XT + cc * 72 + bi * 16) = w0; *(u32x4*)(XT + cc * 72 + bi * 16 + 8) = w1; }
      if (cc < 128) {
        bf16_t* ut = (bf16_t*)(p->ws + WS_UT) + (size_t)cid * 8192 + cc * 64 + bi * 16;
        *(u32x4*)ut = w0; *(u32x4*)(ut + 8) = w1;
      } else {
        const int dk = cc - 128;
        bf16_t* wb = (bf16_t*)(p->ws + WS_WB) + (size_t)cid * 8192 + ((bi * 4 + (dk >> 5)) * 64 + ((dk & 31) >> 3) * 16) * 8 + (dk & 7);
#pragma unroll
        for (int ii = 0; ii < 16; ++ii) wb[ii * 8] = f2bf(xb[ii]);
      }
    } else if (bi == 0) {
      const int t2 = tid - 256;
      { const int i = t2 >> 2, dseg = (t2 & 3) * 32; const float eg = fexp_(GC[i]);
        bf16_t* qt = (bf16_t*)(p->ws + WS_QT) + (size_t)cid * 8192 + (((i >> 4) * 4 + (t2 & 3)) * 64 + (i & 15)) * 8;
#pragma unroll
        for (int s = 0; s < 4; ++s) { float f[8]; unpack8(*(const u32x4*)(QN + i * 136 + dseg + s * 8), f);
#pragma unroll
          for (int e = 0; e < 8; ++e) f[e] *= eg;
          *(u32x4*)(qt + s * 128) = pack8(f); } }
      { const int d = t2 >> 1, iseg = (t2 & 1) * 32; const float gl = GC[63];
        bf16_t* kt = (bf16_t*)(p->ws + WS_KT) + (size_t)cid * 8192 + (((d >> 4) * 2 + (t2 & 1)) * 64 + (d & 15)) * 8;
#pragma unroll
        for (int s = 0; s < 4; ++s) { float f[8];
#pragma unroll
          for (int e = 0; e < 8; ++e) { const int i = iseg + s * 8 + e; f[e] = bf2f(KN[i * 136 + d]) * fexp_(gl - GC[i]); }
          *(u32x4*)(kt + s * 128) = pack8(f); } }
      if (t2 == 0) ((float*)(p->ws + WS_EGL))[cid] = fexp_(GC[63]);
    }
    if (bi < 3) lds_barrier();
  }
}

DEVI void gdn_decode_item(KP p, int j, int item, unsigned char* lds) {
  const int tid = tidx_(), lane = tid & 63, wave = tid >> 6;
  const int b = item >> 3, h = item & 7;
  const size_t row = NPR + b;
  float* QKV = (float*)lds; float* RED = (float*)(lds + 1536); float* PART = (float*)(lds + 2048);
  const bf16_t* proj = (const bf16_t*)(p->ws + WS_PROJ);
  const int dv4 = tid & 31, dkq = tid >> 5;
  const float* S0 = p->in[I_SDEL] + (size_t)((j * 128 + b) * 8 + h) * 16384;
  float4 s[8];
#pragma unroll
  for (int r = 0; r < 8; ++r) s[r] = *(const float4*)(S0 + (dkq * 8 + r) * 128 + dv4 * 4);
  const float* t = (const float*)(p->ws + WS_TAIL) + row * 16;
  const float traw_a = t[8 + h], traw_b = t[h], alog = p->in[I_ALOG][j * 8 + h], dtb = p->in[I_DTB][j * 8 + h];
  if (tid < 384) {
    const int part = tid >> 7, ch = tid & 127, col = part * 1024 + h * 128 + ch;
    const float* st = p->in[I_SCB] + (size_t)((j * 128 + b) * 3) * 3072 + col;
    const float x0 = st[0], x1 = st[3072], x2 = st[6144], x3 = bf2f(proj[row * 6144 + 2048 + col]);
    const float* cw = p->in[I_CBW] + (size_t)(j * 4) * 3072 + col;
    const float val = siluf_(cw[0] * x0 + cw[3072] * x1 + cw[6144] * x2 + cw[9216] * x3);
    float* so = p->out + O_SCB + (size_t)((j * 128 + b) * 3) * 3072 + col;
    so[0] = x1; so[3072] = x2; so[6144] = x3;
    QKV[tid] = val;
    const float ss = wave_sum(val * val);
    if (lane == 0) RED[wave] = ss;
  }
  lds_barrier();
  const float rq = __builtin_amdgcn_rsqf(RED[0] + RED[1] + 1e-6f) * 0.08838834764831845f, rk = __builtin_amdgcn_rsqf(RED[2] + RED[3] + 1e-6f);
  const float g = -fexp_(alog) * softplusf_(traw_a + dtb);
  const float beta = sigmoidf_(traw_b), eg = fexp_(g);
  float* S1 = p->out + O_SDEL + (size_t)((j * 128 + b) * 8 + h) * 16384;
  float4 pt = make_float4(0.f, 0.f, 0.f, 0.f);
#pragma unroll
  for (int r = 0; r < 8; ++r) { const int dk = dkq * 8 + r; const float kd = QKV[128 + dk] * rk;
    pt.x += s[r].x * kd; pt.y += s[r].y * kd; pt.z += s[r].z * kd; pt.w += s[r].w * kd; }
  *(float4*)(PART + dkq * 128 + dv4 * 4) = pt;
  lds_barrier();
  float4 kv = make_float4(0.f, 0.f, 0.f, 0.f);
#pragma unroll
  for (int q = 0; q < 16; ++q) { const float4 v = *(const float4*)(PART + q * 128 + dv4 * 4); kv.x += v.x; kv.y += v.y; kv.z += v.z; kv.w += v.w; }
  const float4 vv = *(const float4*)(QKV + 256 + dv4 * 4);
  float4 vn; vn.x = beta * (vv.x - eg * kv.x); vn.y = beta * (vv.y - eg * kv.y); vn.z = beta * (vv.z - eg * kv.z); vn.w = beta * (vv.w - eg * kv.w);
  lds_barrier();
  float4 po = make_float4(0.f, 0.f, 0.f, 0.f);
#pragma unroll
  for (int r = 0; r < 8; ++r) { const int dk = dkq * 8 + r; const float kd = QKV[128 + dk] * rk, qd = QKV[dk] * rq;
    float4 n; n.x = eg * s[r].x + kd * vn.x; n.y = eg * s[r].y + kd * vn.y; n.z = eg * s[r].z + kd * vn.z; n.w = eg * s[r].w + kd * vn.w;
    *(float4*)(S1 + dk * 128 + dv4 * 4) = n;
    po.x += n.x * qd; po.y += n.y * qd; po.z += n.z * qd; po.w += n.w * qd; }
  *(float4*)(PART + dkq * 128 + dv4 * 4) = po;
  lds_barrier();
  float o = 0.f;
  if (tid < 128) {
#pragma unroll
    for (int q = 0; q < 16; ++q) o += PART[q * 128 + tid];
    const float ss = wave_sum(o * o);
    if (lane == 0) RED[8 + wave] = ss;
  }
  lds_barrier();
  if (tid < 128) {
    const float rinv = __builtin_amdgcn_rsqf((RED[8] + RED[9]) * (1.f / 128.f) + 1e-6f);
    const float zb = bf2f(proj[row * 6144 + 5120 + h * 128 + tid]);
    ((bf16_t*)(p->ws + WS_YBUF))[row * 2048 + 1024 + h * 128 + tid] = f2bf(o * rinv * p->in[I_GNW][j * 128 + tid] * siluf_(zb));
  }
}

DEVI void phase_mixprep(KP p, int layer, unsigned char* lds, int ph, int submask) {
  const int j = layer >> 1;
  unsigned* ctr = (unsigned*)(p->ws + WS_CTL) + 4096 + ph;
  int* slot = (int*)(lds + LDS_MISC);
  const bool lead = tidx_() == 0;
  int nxt = 0; if (lead) nxt = (int)atomicAdd(ctr, 1u);
  for (;;) {
    if (lead) *slot = nxt;
    lds_barrier();
    const int it = *slot;
    lds_barrier();
    if (it >= 3216) break;
    if (lead) nxt = (int)atomicAdd(ctr, 1u);
    if (it < 144) { if (submask & 1) lru_item(p, j, it, lds); }
    else if (it < 2192) { if (submask & 2) gdn_prep_item(p, j, it - 144, lds); }
    else { if (submask & 4) gdn_decode_item(p, j, it - 2192, lds); }
  }
}

struct GdnFrags { u32x4 wf[4], qf[4], qkf[2], ktf[2][2]; u32x2 uf; float egl; };
DEVI void gdn_load(GdnFrags& f, KP p, int cid, int s, int rt, int ct, int l15, int lq) {
  const bf16_t* wb = (const bf16_t*)(p->ws + WS_WB) + (size_t)cid * 8192;
  const bf16_t* qt = (const bf16_t*)(p->ws + WS_QT) + (size_t)cid * 8192;
  const bf16_t* kt = (const bf16_t*)(p->ws + WS_KT) + (size_t)cid * 8192;
  const bf16_t* qk = (const bf16_t*)(p->ws + WS_QK) + (size_t)cid * 4096;
  const bf16_t* ut = (const bf16_t*)(p->ws + WS_UT) + (size_t)cid * 8192;
  const int ln = lq * 16 + l15;
#pragma unroll
  for (int kk = 0; kk < 4; ++kk) { f.wf[kk] = *(const u32x4*)(wb + ((rt * 4 + kk) * 64 + ln) * 8); f.qf[kk] = *(const u32x4*)(qt + ((rt * 4 + kk) * 64 + ln) * 8); }
#pragma unroll
  for (int kk = 0; kk < 2; ++kk) { f.qkf[kk] = *(const u32x4*)(qk + ((rt * 2 + kk) * 64 + ln) * 8);
#pragma unroll
    for (int d2 = 0; d2 < 2; ++d2) f.ktf[d2][kk] = *(const u32x4*)(kt + (((rt * 2 + d2) * 2 + kk) * 64 + ln) * 8); }
  f.uf = *(const u32x2*)(ut + (s * 32 + ct * 16 + l15) * 64 + rt * 16 + lq * 4);
  f.egl = ((const float*)(p->ws + WS_EGL))[cid];
}
DEVI void phase_gdnseq(KP p, int layer, unsigned char* lds) {
  const int tid = tidx_(), lane = tid & 63, wave = tid >> 6;
  const int j = layer >> 1, rt = wave >> 1, ct = wave & 1, l15 = lane & 15, lq = lane >> 4;
  bf16_t* ST = (bf16_t*)lds;
  bf16_t* VT = (bf16_t*)(lds + 8704);
  bf16_t* ybuf = (bf16_t*)(p->ws + WS_YBUF);
  unsigned dsum = 0u;
  for (int item = bidx_(); item < 256; item += gdim_()) {
    const int xcd = item & 7, idx = item >> 3, bh = xcd * 8 + (idx >> 2), s = idx & 3, b = bh >> 3, h = bh & 7;
    __syncthreads();
    for (int e = tid; e < 32 * 136 / 2; e += 512) ((unsigned*)ST)[e] = 0u;
    f32x4 sacc[2]; sacc[0] = (f32x4){0.f, 0.f, 0.f, 0.f}; sacc[1] = (f32x4){0.f, 0.f, 0.f, 0.f};
    GdnFrags nx; gdn_load(nx, p, bh * 32, s, rt, ct, l15, lq);
    __syncthreads();
    unsigned dprev = 0u; f32x4 oprev = (f32x4){0.f, 0.f, 0.f, 0.f};
    for (int c = 0; c < 32; ++c) {
      const GdnFrags cu = nx;
      if (c > 0) {
        bf16_t* yo = ybuf + (size_t)(b * 2048 + (c - 1) * 64 + rt * 16 + lq * 4) * 2048 + 1024 + h * 128 + s * 32 + ct * 16 + l15;
#pragma unroll
        for (int r = 0; r < 4; ++r) yo[(size_t)r * 2048] = f2bf(oprev[r]);
        asm volatile("" ::: "memory");
      }
      if (c + 1 < 32) gdn_load(nx, p, bh * 32 + c + 1, s, rt, ct, l15, lq);
      f32x4 wsa = (f32x4){0.f, 0.f, 0.f, 0.f}, oa = (f32x4){0.f, 0.f, 0.f, 0.f};
#pragma unroll
      for (int kk = 0; kk < 4; ++kk) { const bf16x8 sb = *(const bf16x8*)(ST + (ct * 16 + l15) * 136 + lq * 8 + kk * 32);
        wsa = mfma16(as_bf16x8(cu.wf[kk]), sb, wsa); oa = mfma16(as_bf16x8(cu.qf[kk]), sb, oa); }
      { const float u0 = bflo(cu.uf.x), u1 = bfhi(cu.uf.x), u2 = bflo(cu.uf.y), u3 = bfhi(cu.uf.y);
        u32x2 w; w.x = cvt_pk_bf16(u0 - wsa[0], u1 - wsa[1]); w.y = cvt_pk_bf16(u2 - wsa[2], u3 - wsa[3]);
        *(u32x2*)(VT + (ct * 16 + l15) * 72 + rt * 16 + lq * 4) = w; }
      lds_barrier();
      bf16x8 vb[2];
#pragma unroll
      for (int kk = 0; kk < 2; ++kk) vb[kk] = *(const bf16x8*)(VT + (ct * 16 + l15) * 72 + lq * 8 + kk * 32);
#pragma unroll
      for (int kk = 0; kk < 2; ++kk) oa = mfma16(as_bf16x8(cu.qkf[kk]), vb[kk], oa);
#pragma unroll
      for (int d2 = 0; d2 < 2; ++d2) { sacc[d2] = sacc[d2] * cu.egl;
#pragma unroll
        for (int kk = 0; kk < 2; ++kk) sacc[d2] = mfma16(as_bf16x8(cu.ktf[d2][kk]), vb[kk], sacc[d2]); }
      oprev = oa;
#pragma unroll
      for (int d2 = 0; d2 < 2; ++d2) { u32x2 w; w.x = cvt_pk_bf16(sacc[d2][0], sacc[d2][1]); w.y = cvt_pk_bf16(sacc[d2][2], sacc[d2][3]);
        *(u32x2*)(ST + (ct * 16 + l15) * 136 + (rt * 2 + d2) * 16 + lq * 4) = w; }
      lds_barrier();
    }
    { bf16_t* yo = ybuf + (size_t)(b * 2048 + 31 * 64 + rt * 16 + lq * 4) * 2048 + 1024 + h * 128 + s * 32 + ct * 16 + l15;
#pragma unroll
      for (int r = 0; r < 4; ++r) yo[(size_t)r * 2048] = f2bf(oprev[r]); }
    float* pd = p->out + O_PDEL + (size_t)((j * 8 + b) * 8 + h) * 16384;
#pragma unroll
    for (int d2 = 0; d2 < 2; ++d2)
#pragma unroll
      for (int r = 0; r < 4; ++r) pd[(size_t)((rt * 2 + d2) * 16 + lq * 4 + r) * 128 + s * 32 + ct * 16 + l15] = sacc[d2][r];
  }
  if (dsum == 0x9e3779b9u) ((unsigned*)(p->ws + WS_CTL))[5000] = dsum;
}

DEVI void phase_onorm(KP p, int layer) {
  const int tid = tidx_(), lane = tid & 63, wave = tid >> 6, j = layer >> 1;
  bf16_t* ybuf = (bf16_t*)(p->ws + WS_YBUF); const bf16_t* proj = (const bf16_t*)(p->ws + WS_PROJ);
  float gw[16];
#pragma unroll
  for (int e = 0; e < 16; ++e) gw[e] = p->in[I_GNW][j * 128 + ((lane * 16 + e) & 127)];
  const int rstep = gdim_() * 8;
  for (int r = bidx_() * 8 + wave; r < NPR; r += 2 * rstep) {
    const bool two = r + rstep < NPR;
    bf16_t* yp[2]; u32x4 yv[2][2], zv[2][2];
#pragma unroll
    for (int q = 0; q < 2; ++q) { const int rr = (q == 0 || two) ? r + q * rstep : r;
      yp[q] = ybuf + (size_t)rr * 2048 + 1024 + lane * 16; const bf16_t* zp = proj + (size_t)rr * 6144 + 5120 + lane * 16;
      yv[q][0] = *(const u32x4*)yp[q]; yv[q][1] = *(const u32x4*)(yp[q] + 8); zv[q][0] = *(const u32x4*)zp; zv[q][1] = *(const u32x4*)(zp + 8); }
#pragma unroll
    for (int q = 0; q < 2; ++q) {
      float o[16], z[16]; { float t[8]; unpack8(yv[q][0], t);
#pragma unroll
        for (int e = 0; e < 8; ++e) o[e] = t[e];
        unpack8(yv[q][1], t);
#pragma unroll
        for (int e = 0; e < 8; ++e) o[8 + e] = t[e];
        unpack8(zv[q][0], t);
#pragma unroll
        for (int e = 0; e < 8; ++e) z[e] = t[e];
        unpack8(zv[q][1], t);
#pragma unroll
        for (int e = 0; e < 8; ++e) z[8 + e] = t[e]; }
      float ss = 0.f;
#pragma unroll
      for (int e = 0; e < 16; ++e) ss += o[e] * o[e];
      ss += __shfl_xor(ss, 1); ss += __shfl_xor(ss, 2); ss += __shfl_xor(ss, 4);
      const float rinv = __builtin_amdgcn_rsqf(ss * (1.f / 128.f) + 1e-6f);
      float a[8], cq[8];
#pragma unroll
      for (int e = 0; e < 8; ++e) { a[e] = o[e] * rinv * gw[e] * siluf_(z[e]); cq[e] = o[8 + e] * rinv * gw[8 + e] * siluf_(z[8 + e]); }
      if (q == 0 || two) { *(u32x4*)yp[q] = pack8(a); *(u32x4*)(yp[q] + 8) = pack8(cq); }
    }
  }
}

struct S5C { bf16x8 Bf[8], Cf[4]; float abr, abi, dch; };
template <bool OUT, bool SAMPLE>
DEVI void s5_chunks(KP p, const S5C& c, int jc, int g, size_t rbase, int nch, int sgrp, float& xr, float& xi, float* BU, bf16_t* XB, int lane) {
  const int l15 = lane & 15, lq = lane >> 4;
  const bf16_t* proj = (const bf16_t*)(p->ws + WS_PROJ);
  bf16_t* y1 = (bf16_t*)(p->ws + WS_YBUF);
  u32x4 unx = (u32x4){0u, 0u, 0u, 0u}; bf16_t uenx[4] = {0, 0, 0, 0};
  if (lq < 2) unx = *(const u32x4*)(proj + (rbase + l15) * 2048 + g * 16 + lq * 8);
  if (OUT) {
#pragma unroll
    for (int r = 0; r < 4; ++r) uenx[r] = proj[(rbase + lq * 4 + r) * 2048 + g * 16 + l15]; }
  for (int ck = 0; ck < nch; ++ck) {
    const size_t row0 = rbase + (size_t)ck * 16;
    const u32x4 ucur = unx; bf16_t uec[4];
#pragma unroll
    for (int r = 0; r < 4; ++r) uec[r] = uenx[r];
    if (ck + 1 < nch) { if (lq < 2) unx = *(const u32x4*)(proj + (row0 + 16 + l15) * 2048 + g * 16 + lq * 8);
      if (OUT) {
#pragma unroll
        for (int r = 0; r < 4; ++r) uenx[r] = proj[(row0 + 16 + lq * 4 + r) * 2048 + g * 16 + l15]; } }
#pragma unroll
    for (int nt = 0; nt < 8; ++nt) { const f32x4 acc = mfma16(as_bf16x8(ucur), c.Bf[nt], (f32x4){0.f, 0.f, 0.f, 0.f});
      *(f32x4*)(BU + (nt * 16 + l15) * 20 + lq * 4) = acc; }
    asm volatile("s_waitcnt lgkmcnt(0)" ::: "memory");
    float br[16], bi[16];
#pragma unroll
    for (int t4 = 0; t4 < 4; ++t4) { const f32x4 a = *(const f32x4*)(BU + lane * 20 + t4 * 4), b = *(const f32x4*)(BU + (64 + lane) * 20 + t4 * 4);
#pragma unroll
      for (int e = 0; e < 4; ++e) { br[t4 * 4 + e] = a[e]; bi[t4 * 4 + e] = b[e]; } }
    if (!SAMPLE) {
#pragma unroll
      for (int t = 0; t < 16; ++t) { const float nr = c.abr * xr - c.abi * xi + br[t], ni = c.abr * xi + c.abi * xr + bi[t]; xr = nr; xi = ni;
        if (OUT) *(unsigned*)(XB + t * 136 + 2 * lane) = cvt_pk_bf16(xr, xi); }
    } else {
#pragma unroll
      for (int t = 0; t < 16; ++t) { const size_t si = ((size_t)(jc * 128 + sgrp * 16 + t) * 64 + g) * 64 + lane;
        const float x0r = p->in[I_SSR][si], x0i = p->in[I_SSI][si];
        const float nr = c.abr * x0r - c.abi * x0i + br[t], ni = c.abr * x0i + c.abi * x0r + bi[t];
        p->out[O_SSR + si] = nr; p->out[O_SSI + si] = ni;
        *(unsigned*)(XB + t * 136 + 2 * lane) = cvt_pk_bf16(nr, ni); }
    }
    if (OUT) {
      asm volatile("s_waitcnt lgkmcnt(0)" ::: "memory");
      f32x4 ya = (f32x4){0.f, 0.f, 0.f, 0.f};
#pragma unroll
      for (int kk = 0; kk < 4; ++kk) ya = mfma16(*(const bf16x8*)(XB + l15 * 136 + lq * 8 + kk * 32), c.Cf[kk], ya);
#pragma unroll
      for (int r = 0; r < 4; ++r) { const float y = ya[r] + c.dch * bf2f(uec[r]); y1[(row0 + lq * 4 + r) * 1024 + g * 16 + l15] = f2bf(geluf_(y)); }
    }
  }
}
DEVI void s5_setup(KP p, S5C& c, int jc, int g, int lane) {
  const int l15 = lane & 15, lq = lane >> 4, gi = jc * 64 + g;
  const float dt = __expf(p->in[I_LOGDT][gi]);
  { const float are = p->in[I_ARE][gi * 64 + lane], aim = p->in[I_AIM][gi * 64 + lane]; const float mag = __expf(are * dt); c.abr = mag * __cosf(aim * dt); c.abi = mag * __sinf(aim * dt); }
#pragma unroll
  for (int nt = 0; nt < 8; ++nt) {
    float v[8];
#pragma unroll
    for (int e = 0; e < 8; ++e) v[e] = 0.f;
    if (lq < 2) {
      const int pp = (nt & 3) * 16 + l15;
      const float are = p->in[I_ARE][gi * 64 + pp], aim = p->in[I_AIM][gi * 64 + pp]; const float mag = __expf(are * dt); const float sn = __sinf(aim * dt), cs = __cosf(aim * dt);
      const float nr = mag * cs - 1.f, ni = mag * sn, den = 1.f / (are * are + aim * aim);
      const float cr = (nr * are + ni * aim) * den, ci = (ni * are - nr * aim) * den;
      const float* br = p->in[I_BRE] + (size_t)(gi * 64 + pp) * 16 + lq * 8; const float* bi = p->in[I_BIM] + (size_t)(gi * 64 + pp) * 16 + lq * 8;
#pragma unroll
      for (int e = 0; e < 8; ++e) v[e] = (nt >= 4) ? (cr * bi[e] + ci * br[e]) : (cr * br[e] - ci * bi[e]);
    }
    c.Bf[nt] = as_bf16x8(pack8(v));
  }
#pragma unroll
  for (int kk = 0; kk < 4; ++kk) { const int p0 = lq * 4 + kk * 16;
    const float* sre = p->in[I_CRE] + (size_t)(gi * 16 + l15) * 64 + p0; const float* sim = p->in[I_CIM] + (size_t)(gi * 16 + l15) * 64 + p0; float v[8];
#pragma unroll
    for (int m = 0; m < 4; ++m) { v[2 * m] = sre[m]; v[2 * m + 1] = -sim[m]; }
    c.Cf[kk] = as_bf16x8(pack8(v)); }
  c.dch = p->in[I_S5D][jc * 1024 + g * 16 + l15];
}
DEVI void phase_s5(KP p, int layer, unsigned char* lds) {
  const int tid = tidx_(), lane = tid & 63, wave = tid >> 6, jc = layer >> 1;
  float* BU = (float*)(lds + wave * 14592);
  bf16_t* XB = (bf16_t*)(lds + wave * 14592 + 10240);
  float* EX = (float*)(lds + 116736);
  const int cb = wave >> 2, seg = wave & 3;
  for (int cp = bidx_(); cp < 256; cp += gdim_()) {
    const int q = cp * 2 + cb, b = q >> 6, g = q & 63;
    S5C c; s5_setup(p, c, jc, g, lane);
    float xr = 0.f, xi = 0.f;
    const size_t rbase = (size_t)b * 2048 + (size_t)seg * 512;
    const int nch2 = 32;
    if (seg < 3) {
      s5_chunks<false, false>(p, c, jc, g, rbase, 32, 0, xr, xi, BU, XB, lane);
      EX[wave * 128 + lane] = xr; EX[wave * 128 + 64 + lane] = xi;
    } else {
      const int qs = cp * 2 + cb, gs = qs & 63, sgrp = qs >> 6;
      S5C cs; s5_setup(p, cs, jc, gs, lane);
      float dr = 0.f, di = 0.f;
      s5_chunks<true, true>(p, cs, jc, gs, (size_t)(NPR + sgrp * 16), 1, sgrp, dr, di, BU, XB, lane);
    }
    __syncthreads();
    float pr = c.abr, pi = c.abi;
#pragma unroll
    for (int s = 0; s < 9; ++s) { const float nr = pr * pr - pi * pi, ni = 2.f * pr * pi; pr = nr; pi = ni; }
    xr = 0.f; xi = 0.f;
    for (int s = 0; s < seg; ++s) { const float er = EX[(cb * 4 + s) * 128 + lane], ei = EX[(cb * 4 + s) * 128 + 64 + lane];
      const float nr = pr * xr - pi * xi + er, ni = pr * xi + pi * xr + ei; xr = nr; xi = ni; }
    s5_chunks<true, false>(p, c, jc, g, rbase, nch2, 0, xr, xi, BU, XB, lane);
    if (seg == 3) { const size_t si = ((size_t)(jc * 8 + b) * 64 + g) * 64 + lane; p->out[O_PSR + si] = xr; p->out[O_PSI + si] = xi; }
    __syncthreads();
  }
}

DEVI void phase_final(KP p) {
  const int tid = tidx_(), lane = tid & 63, wave = tid >> 6;
  const float* nw = p->in[I_FNW];
  float4 w4[4];
#pragma unroll
  for (int i = 0; i < 4; ++i) w4[i] = *(const float4*)(nw + i * 256 + lane * 4);
  for (int r = (bidx_() * 8 + wave) * 2; r < NRV; r += gdim_() * 16) {
    float* x0 = p->out + (size_t)r * 1024; float* x1 = x0 + 1024; float4 v0[4], v1[4]; float s0 = 0.f, s1 = 0.f;
#pragma unroll
    for (int i = 0; i < 4; ++i) { v0[i] = *(const float4*)(x0 + i * 256 + lane * 4); v1[i] = *(const float4*)(x1 + i * 256 + lane * 4); }
#pragma unroll
    for (int i = 0; i < 4; ++i) { s0 += v0[i].x * v0[i].x + v0[i].y * v0[i].y + v0[i].z * v0[i].z + v0[i].w * v0[i].w; s1 += v1[i].x * v1[i].x + v1[i].y * v1[i].y + v1[i].z * v1[i].z + v1[i].w * v1[i].w; }
#pragma unroll
    for (int o = 32; o >= 1; o >>= 1) { s0 += __shfl_xor(s0, o); s1 += __shfl_xor(s1, o); }
    const float r0 = __builtin_amdgcn_rsqf(s0 * (1.f / 1024.f) + 1e-6f), r1 = __builtin_amdgcn_rsqf(s1 * (1.f / 1024.f) + 1e-6f);
#pragma unroll
    for (int i = 0; i < 4; ++i) { float4 o; o.x = v0[i].x * r0 * w4[i].x; o.y = v0[i].y * r0 * w4[i].y; o.z = v0[i].z * r0 * w4[i].z; o.w = v0[i].w * r0 * w4[i].w; *(float4*)(x0 + i * 256 + lane * 4) = o;
      float4 q; q.x = v1[i].x * r1 * w4[i].x; q.y = v1[i].y * r1 * w4[i].y; q.z = v1[i].z * r1 * w4[i].z; q.w = v1[i].w * r1 * w4[i].w; *(float4*)(x1 + i * 256 + lane * 4) = q; }
  }
}

template <class F>
DEVI void sample_gemm(const bf16_t* __restrict__ A, int lda, const bf16_t* __restrict__ Bt, int N, int K, F&& epi, float* red) {
  const int tid = tidx_(), lane = tid & 63, wave = tid >> 6, l15 = lane & 15, lq = lane >> 4, rt2 = wave & 1, kq = wave >> 1;
  const int kq_len = K >> 2, nitems = (N / 16) * 4;
  for (int it = gdim_() - 1 - bidx_(); it < nitems; it += gdim_()) {
    const int s = it >> 2, rg = it & 3, row0 = rg * 32 + rt2 * 16;
    const bf16_t* ap = A + (size_t)(row0 + l15) * lda + lq * 8 + kq * kq_len;
    const bf16_t* bp = Bt + (size_t)(s * 16 + l15) * K + lq * 8 + kq * kq_len;
    f32x4 acc0 = (f32x4){0.f, 0.f, 0.f, 0.f}, acc1 = (f32x4){0.f, 0.f, 0.f, 0.f};
    for (int k0 = 0; k0 < kq_len; k0 += 256) {
      u32x4 a[8], b[8];
#pragma unroll
      for (int u = 0; u < 8; ++u) { a[u] = *(const u32x4*)(ap + k0 + u * 32); b[u] = *(const u32x4*)(bp + k0 + u * 32); }
#pragma unroll
      for (int u = 0; u < 8; u += 2) { acc0 = mfma16(as_bf16x8(a[u]), as_bf16x8(b[u]), acc0); acc1 = mfma16(as_bf16x8(a[u + 1]), as_bf16x8(b[u + 1]), acc1); }
    }
    acc0 = acc0 + acc1;
    __syncthreads();
    *(f32x4*)(red + ((kq * 2 + rt2) * 64 + lane) * 4) = acc0;
    __syncthreads();
    if (kq == 0) {
      f32x4 t = acc0;
#pragma unroll
      for (int q = 1; q < 4; ++q) t = t + *(const f32x4*)(red + ((q * 2 + rt2) * 64 + lane) * 4);
#pragma unroll
      for (int r = 0; r < 4; ++r) epi(row0 + lq * 4 + r, s * 16 + l15, t[r]);
    }
  }
}

constexpr int N_PHASES = 25;
#ifndef PROBE_SUB
#define PROBE_SUB 7
#endif
#ifndef ONLY_KIND
#define ONLY_KIND -1
#endif
#define KON(k) ((ONLY_KIND < 0 || ONLY_KIND == (k)) && kind == (k))
__global__ void __launch_bounds__(512, 2) mega(Params p_unused) {
  extern __shared__ __attribute__((aligned(16))) unsigned char shm[];
  cg::grid_group grid = cg::this_grid();
  PG8_LAS unsigned char* ldsg = (PG8_LAS unsigned char*)shm;
  KP p0 = (KP)__builtin_amdgcn_kernarg_segment_ptr();
  const int ph_lo = p0->ph_lo, ph_hi = p0->ph_hi;
  volatile LAS unsigned* xst = (volatile LAS unsigned*)(ldsg + LDS_MISC + 16);
  if (threadIdx.x == 0) { xst[0] = 0u; xst[1] = 0u; }
  __syncthreads();
  XcdBarrier xb = xcd_barrier_post((unsigned*)(p0->ws + WS_CTL), xst);
  int rep = 0;
  for (int ph = ph_lo; ph < ph_hi; ++ph) {
    KP p = p0; asm volatile("" : "+s"(p));
    int kind, layer = 0;
    if (ph == 0) kind = 0; else if (ph == 1) kind = 1; else if (ph == 24) kind = 12;
    else { const int q = ph - 2, pair = q / 11, rem = q % 11;
      if (rem < 6) { layer = 2 * pair; kind = (rem == 0) ? 2 : 2 + rem; }
      else { layer = 2 * pair + 1; const int s = rem - 6; kind = (s == 0) ? 2 : 7 + s; } }
    const int j = layer >> 1;
    if (KON(0)) phase_prep(p, (float*)shm);
    else if (KON(2)) phase_norm(p, layer, (float*)shm);
    else if (KON(4)) phase_mixprep(p, layer, shm, ph + 32 * rep, rep ? PROBE_SUB : 7);
    else if (KON(5)) phase_gdnseq(p, layer, shm);
    else if (KON(6)) phase_onorm(p, layer);
    else if (KON(9)) phase_s5(p, layer, shm);
    else if (KON(12)) phase_final(p);
    else if (KON(1)) {
      pg8::Gemm g{(const bf16_t*)(p->ws + WS_SILUC), (const bf16_t*)(p->ws + WS_WT_MOD), 256, 12288, 1024};
      pg8::StaticOrder S; S.init(256, 12288, gdim_(), bidx_());
      pg8::EpiF32 E{(float*)(p->ws + WS_MOD), 12288, p->in[I_MODB]};
      pg8::gemm_phase<pg8::EpiF32, pg8::StaticOrder, false>(ldsg, g, S, E, nullptr);
    } else if (KON(3) || KON(8)) {
      const bool ab = kind == 3; const int N = ab ? 6144 : 2048;
      const bf16_t* Bt = ab ? (const bf16_t*)(p->ws + WS_WT_INAB) + (size_t)j * 6144 * 1024 : (const bf16_t*)(p->ws + WS_WT_CIN) + (size_t)j * 2048 * 1024;
      pg8::Gemm g{(const bf16_t*)(p->ws + WS_YBUF), Bt, NPR, N, 1024};
      pg8::StaticOrder S; S.init(NPR, N, gdim_(), bidx_());
      pg8::EpiBf16<0> E{(bf16_t*)(p->ws + WS_PROJ), N, nullptr, 0, 0};
      pg8::gemm_phase<pg8::EpiBf16<0>, pg8::StaticOrder, false>(ldsg, g, S, E, nullptr);
      bf16_t* po = (bf16_t*)(p->ws + WS_PROJ) + (size_t)NPR * N;
      sample_gemm((const bf16_t*)(p->ws + WS_YBUF) + (size_t)NPR * 1024, 1024, Bt, N, 1024, [&](int r, int c, float v) { po[(size_t)r * N + c] = f2bf(v); }, (float*)shm);
      if (ab) tail_gemm(p, j);
    } else if (KON(7) || KON(11)) {
      const bool ab = kind == 7; const int K = ab ? 2048 : 1024;
      const bf16_t* Ab = ab ? (const bf16_t*)(p->ws + WS_YBUF) : (const bf16_t*)(p->ws + WS_Y2);
      const bf16_t* Bt = ab ? (const bf16_t*)(p->ws + WS_WT_OUTAB) + (size_t)j * 1024 * 2048 : (const bf16_t*)(p->ws + WS_WT_COUT) + (size_t)j * 1024 * 1024;
      pg8::Gemm g{Ab, Bt, NPR, 1024, K};
      pg8::StaticOrder S; S.init(NPR, 1024, gdim_(), bidx_());
      const float* gatep = (const float*)(p->ws + WS_MOD) + layer * 3072 + 2048;
      EpiRes E{layer == 0 ? p->in[I_XP] : p->out, layer == 0 ? p->in[I_XS] : p->out + (size_t)NPR * 1024, p->out, gatep};
      pg8::gemm_phase<EpiRes, pg8::StaticOrder, false>(ldsg, g, S, E, nullptr);
      const float* xsi = layer == 0 ? p->in[I_XS] : p->out + (size_t)NPR * 1024; float* xso = p->out + (size_t)NPR * 1024;
      sample_gemm(Ab + (size_t)NPR * K, K, Bt, 1024, K, [&](int r, int c, float v) { xso[(size_t)r * 1024 + c] = xsi[(size_t)r * 1024 + c] + gatep[(size_t)(8 + r) * 12288 + c] * v; }, (float*)shm);
    } else if (KON(10)) {
      const bf16_t* Bt = (const bf16_t*)(p->ws + WS_WT_GLU) + (size_t)j * 1024 * 1024;
      pg8::Gemm g{(const bf16_t*)(p->ws + WS_YBUF), Bt, NPR, 1024, 1024};
      pg8::StaticOrder S; S.init(NPR, 1024, gdim_(), bidx_());
      const float* gb = p->in[I_GLUB] + j * 1024;
      EpiGlu E{(const bf16_t*)(p->ws + WS_YBUF), (const bf16_t*)(p->ws + WS_PROJ) + 1024, (bf16_t*)(p->ws + WS_Y2), gb};
      pg8::gemm_phase<EpiGlu, pg8::StaticOrder, false>(ldsg, g, S, E, nullptr);
      const bf16_t* y1s = (const bf16_t*)(p->ws + WS_YBUF) + (size_t)NPR * 1024; const bf16_t* zs = (const bf16_t*)(p->ws + WS_PROJ) + (size_t)NPR * 2048 + 1024; bf16_t* y2s = (bf16_t*)(p->ws + WS_Y2) + (size_t)NPR * 1024;
      sample_gemm(y1s, 1024, Bt, 1024, 1024, [&](int r, int c, float v) { y2s[(size_t)r * 1024 + c] = f2bf(bf2f(y1s[(size_t)r * 1024 + c]) * sigmoidf_(v + gb[c]) * siluf_(bf2f(zs[(size_t)r * 2048 + c]))); }, (float*)shm);
    }
#ifdef REPEAT_KIND
    if (kind == REPEAT_KIND && rep == 0) { rep = 1; --ph; } else rep = 0;
#endif
    if (ph + 1 < ph_hi) { if (ph_hi > 100000) grid.sync();
      xcd_barrier(xb); }
  }
}

#ifndef MK_MULTI
#define MK_MULTI 0
#endif
#ifndef PH_HI
#define PH_HI N_PHASES
#endif
extern "C" void kernel_launch(void* const* d_in, const int* in_sizes, int n_in, void* d_out, int out_size, void* d_ws, size_t ws_size, hipStream_t stream) {
  static int grid = 0;
  if (grid == 0) {
    if (n_in != N_IN || (size_t)out_size != O_END || ws_size < WS_END) { fprintf(stderr, "kernel_launch: unexpected shapes: n_in %d out %d ws %zu (need %zu)\n", n_in, out_size, ws_size, (size_t)WS_END); grid = -1; return; }
    int dev = 0, cus = 0, per_cu = 0;
    if (hipGetDevice(&dev) != hipSuccess || hipDeviceGetAttribute(&cus, hipDeviceAttributeMultiprocessorCount, dev) != hipSuccess) { grid = -1; return; }
    if (hipFuncSetAttribute((const void*)mega, hipFuncAttributeMaxDynamicSharedMemorySize, LDS_BYTES) != hipSuccess) { fprintf(stderr, "kernel_launch: hipFuncSetAttribute failed\n"); grid = -1; return; }
    if (hipOccupancyMaxActiveBlocksPerMultiprocessor(&per_cu, (const void*)mega, 512, LDS_BYTES) != hipSuccess || per_cu < 1) { fprintf(stderr, "kernel_launch: occupancy query says %d\n", per_cu); per_cu = 1; }
    (void)hipGetLastError();
    grid = cus;
  }
  if (grid < 0) return;
  if (hipMemsetAsync((char*)d_ws + WS_CTL, 0, 32768, stream) != hipSuccess) { fprintf(stderr, "kernel_launch: memset failed\n"); return; }
  Params p{};
  for (int i = 0; i < N_IN; ++i) p.in[i] = (const float*)d_in[i];
  p.out = (float*)d_out; p.ws = (unsigned char*)d_ws;
#if MK_MULTI
  for (int ph = 0; ph < N_PHASES; ++ph) { p.ph_lo = ph; p.ph_hi = ph + 1; hipLaunchKernelGGL(mega, dim3(grid), dim3(512), LDS_BYTES, stream, p); }
#else
  p.ph_lo = 0; p.ph_hi = PH_HI;
  void* args[] = {&p};
  hipError_t e = hipLaunchCooperativeKernel((void*)mega, dim3(grid), dim3(512), args, LDS_BYTES, stream);
  if (e != hipSuccess) fprintf(stderr, "kernel_launch: cooperative launch failed: %s (grid %d)\n", hipGetErrorString(e), grid);
#endif
}
```

```cpp
#include <hip/hip_runtime.h>
#include <hip/hip_cooperative_groups.h>
#include <cstdio>
namespace cg = cooperative_groups;
__device__ __forceinline__ int tidx_() { int t = threadIdx.x; asm volatile("" : "+v"(t)); return t; }
__device__ __forceinline__ int bidx_() { int t = blockIdx.x; asm volatile("" : "+s"(t)); return t; }
__device__ __forceinline__ int gdim_() { int t = gridDim.x; asm volatile("" : "+s"(t)); return t; }
namespace pg8 {
#define PG8_LAS __attribute__((address_space(3)))
typedef unsigned short bf16_t;
typedef short bf16x8 __attribute__((ext_vector_type(8)));
typedef float f32x4 __attribute__((ext_vector_type(4)));
typedef unsigned u32x4 __attribute__((ext_vector_type(4)));
constexpr int BM = 256, BK = 64, HALF = 128, HTB = HALF * BK * 2  , STAGE_BYTES = 8 * HTB, NXCD = 8, WGM = 8;

__host__ __device__ __forceinline__ int lds_byte(int r, int c) { const int st = (r >> 4) * 2 + (c >> 5), rr = r & 15, cc = c & 31, ob = rr * 64 + cc * 2; return st * 1024 + (ob ^ (((ob >> 9) & 1) << 5)); }
__host__ __device__ __forceinline__ void stage_rc(int b, int& R, int& C) { const int st = b / 1024, sb = b % 1024, swz = sb ^ (((sb >> 9) & 1) << 5); R = (st >> 1) * 16 + swz / 64; C = (st & 1) * 32 + (swz % 64) / 2; }
__host__ __device__ __forceinline__ int perm32(int rho) { const int n = rho >> 4, i = rho & 15; return 8 * (i >> 2) + 4 * n + (i & 3); }

struct Unit { int pm, pn; };
struct Gemm { const bf16_t* A; const bf16_t* Bt; int M, N, K; };

struct StaticOrder {
    int nM, nN, nwg, G, c;
    __host__ __device__ void init(int M, int N, int G_, int c_) { nM = M / BM; nN = N / BM; nwg = nM * nN; G = G_; c = c_; }
    __host__ __device__ bool next(int i, Unit& u) const {
        const long L = (long)i * G + c; if (L >= nwg) return false;
        int wgid = (int)L; { const int q = nwg / NXCD, r = nwg % NXCD, xcd = wgid % NXCD, off = wgid / NXCD; wgid = (xcd < r ? xcd * (q + 1) : r * (q + 1) + (xcd - r) * q) + off; }
        const int nig = WGM * nN, gid = wgid / nig, fm = gid * WGM, gsz = (nM - fm) < WGM ? (nM - fm) : WGM;
        u.pm = fm + ((wgid % nig) % gsz); u.pn = (wgid % nig) / gsz; return true;
    }
    __device__ __forceinline__ void a_ready(const Unit&) const {}
    __device__ __forceinline__ void done(const Unit&) const {}
};
typedef float f32x2cv __attribute__((ext_vector_type(2)));
typedef __bf16 bf16x2cv __attribute__((ext_vector_type(2)));
__device__ __forceinline__ unsigned cvt_pk_bf16(float lo, float hi) { f32x2cv v = {lo, hi}; bf16x2cv b = __builtin_convertvector(v, bf16x2cv); return __builtin_bit_cast(unsigned, b); }
typedef float f32x2 __attribute__((ext_vector_type(2)));
__device__ __forceinline__ f32x2 gelu_pk(f32x2 v) {
    const f32x2 av = __builtin_elementwise_abs(v), d = av * 0.2316418882f + 1.0f;
    f32x2 t; t.x = __builtin_amdgcn_rcpf(d.x); t.y = __builtin_amdgcn_rcpf(d.y);
    f32x2 q = t * 0.5307027145f + (-0.7265760135f); q = q * t + 0.7107068705f; q = q * t + (-0.142248368f); q = q * t + 0.127414796f; q = q * t;
    const f32x2 s = (v * v) * (-0.72134752044f);
    f32x2 e; e.x = __builtin_amdgcn_exp2f(s.x); e.y = __builtin_amdgcn_exp2f(s.y);
    const f32x2 m = v * (q * e), r = v - m;
    f32x2 o; o.x = v.x < 0.f ? m.x : r.x; o.y = v.y < 0.f ? m.y : r.y; return o;
}

struct EpiF32 {
    static constexpr bool PERM = false, AFTER_DRAIN = false;
    float* C; int ldc; const float* bias;
    __device__ __forceinline__ void operator()(const f32x4 (&acc)[2][2][4][2], const Unit& u, int wr, int wc, int fr, int fq) const {
        const int row0 = u.pm * BM + wr * 64 + fr, col0 = u.pn * BM + wc * 32 + 4 * fq;
        f32x4 bv[2][2];
#pragma unroll
        for (int bj = 0; bj < 2; ++bj)
#pragma unroll
            for (int n = 0; n < 2; ++n) bv[bj][n] = bias ? *(const f32x4*)(bias + col0 + bj * HALF + n * 16) : (f32x4){0.f, 0.f, 0.f, 0.f};
#pragma unroll
        for (int ai = 0; ai < 2; ++ai)
#pragma unroll
            for (int m = 0; m < 4; ++m) { float* rowp = C + (size_t)(row0 + ai * HALF + m * 16) * ldc + col0;
#pragma unroll
                for (int bj = 0; bj < 2; ++bj)
#pragma unroll
                    for (int n = 0; n < 2; ++n) *(f32x4*)(rowp + bj * HALF + n * 16) = acc[ai][bj][m][n] + bv[bj][n]; }
    }
};
template <int ACT  > struct EpiBf16 {
    static constexpr bool PERM = true, AFTER_DRAIN = false;
    bf16_t* O; int ldc; const float* bias; int split_cols; size_t split_stride;
    __device__ __forceinline__ void operator()(const f32x4 (&acc)[2][2][4][2], const Unit& u, int wr, int wc, int fr, int fq) const {
        const int row0 = u.pm * BM + wr * 64 + fr; int colt = u.pn * BM; bf16_t* base = O;
        if (split_cols) { const int t = colt / split_cols; base += (size_t)t * split_stride; colt -= t * split_cols; }
        const int col0 = colt + wc * 32 + 8 * fq, bcol0 = u.pn * BM + wc * 32 + 8 * fq;
        f32x4 bv[2][2];
#pragma unroll
        for (int bj = 0; bj < 2; ++bj)
#pragma unroll
            for (int n = 0; n < 2; ++n) bv[bj][n] = bias ? *(const f32x4*)(bias + bcol0 + bj * HALF + 4 * n) : (f32x4){0.f, 0.f, 0.f, 0.f};
#pragma unroll
        for (int ai = 0; ai < 2; ++ai)
#pragma unroll
            for (int m = 0; m < 4; ++m) { bf16_t* rowp = base + (size_t)(row0 + ai * HALF + m * 16) * ldc + col0;
#pragma unroll
                for (int bj = 0; bj < 2; ++bj) { f32x4 v0 = acc[ai][bj][m][0] + bv[bj][0], v1 = acc[ai][bj][m][1] + bv[bj][1];
                    if (ACT == 1) { f32x2 a = gelu_pk((f32x2){v0[0], v0[1]}), b = gelu_pk((f32x2){v0[2], v0[3]}), c = gelu_pk((f32x2){v1[0], v1[1]}), d = gelu_pk((f32x2){v1[2], v1[3]});
                        v0 = (f32x4){a.x, a.y, b.x, b.y}; v1 = (f32x4){c.x, c.y, d.x, d.y}; }
                    if (ACT == 2) {
#pragma unroll
                        for (int j = 0; j < 4; ++j) { v0[j] = 0.5f * v0[j] * (1.0f + erff(v0[j] * 0.70710678f)); v1[j] = 0.5f * v1[j] * (1.0f + erff(v1[j] * 0.70710678f)); } }
                    u32x4 w; w.x = cvt_pk_bf16(v0[0], v0[1]); w.y = cvt_pk_bf16(v0[2], v0[3]); w.z = cvt_pk_bf16(v1[0], v1[1]); w.w = cvt_pk_bf16(v1[2], v1[3]);
                    *(u32x4*)(rowp + bj * HALF) = w; } }
    }
};
template <class Epi, class Sched, bool STAMP = false>
__device__ __forceinline__ void gemm_phase(PG8_LAS unsigned char* lds, const Gemm g, const Sched& S, const Epi& E, unsigned long long* stamps) {
    const int tid = tidx_(), wid = __builtin_amdgcn_readfirstlane(tid >> 6), lane = tid & 63, wr = wid >> 2, wc = wid & 3, fr = lane & 15, fq = lane >> 4;
    const int K = g.K, nt = K / BK;
    int ts_lo = 0, ts_hi = 0, nts = 0; const unsigned long long rt_entry = STAMP ? (unsigned long long)wall_clock64() : 0ull;
#define PG8_STAMP() do { if (STAMP && wid == 0 && nts < 64) { const unsigned long long _c = (unsigned long long)clock64(); \
        ts_lo = (lane == nts) ? (int)(unsigned)_c : ts_lo; ts_hi = (lane == nts) ? (int)(unsigned)(_c >> 32) : ts_hi; ++nts; } } while (0)
    PG8_STAMP();
    unsigned voffA[2], voffB[2];
#pragma unroll
    for (int i = 0; i < 2; ++i) { int R, C; stage_rc(tid * 16 + i * 8192, R, C); const int Rb = Epi::PERM ? ((R & ~31) + perm32(R & 31)) : R;
        voffA[i] = (unsigned)(R * K + C) * 2u; voffB[i] = (unsigned)(Rb * K + C) * 2u; }
    const size_t kstep = (size_t)(BK * 2);
    const size_t hstep = (size_t)HALF * K * 2;
    const size_t tstep = 2 * hstep;
    const unsigned ldsw = (unsigned)wid * 1024u;
    const int aoff = lds_byte(wr * 64 + fr, fq * 8), boff = lds_byte(wc * 32 + fr, fq * 8);
#define PG8_SA(b, h) (((b) * 2 + (h)) * HTB)
#define PG8_SB(b, h) ((4 + (b) * 2 + (h)) * HTB)
#define PG8_STAGE(bufoff, gbase, voff) do { _Pragma("unroll") for (int _i = 0; _i < 2; ++_i) \
        __builtin_amdgcn_global_load_lds((const unsigned*)((const char*)(gbase) + (voff)[_i]), (PG8_LAS unsigned*)(lds + (bufoff) + ldsw + _i * 8192), 16, 0, 0); } while (0)
#define PG8_LDA(dst, b, h) do { _Pragma("unroll") for (int m = 0; m < 4; ++m) _Pragma("unroll") for (int k = 0; k < 2; ++k) dst[m][k] = *(const PG8_LAS bf16x8*)(lds + PG8_SA(b, h) + aoff + m * 2048 + k * 1024); } while (0)
#define PG8_LDB(dst, b, h) do { _Pragma("unroll") for (int n = 0; n < 2; ++n) _Pragma("unroll") for (int k = 0; k < 2; ++k) dst[n][k] = *(const PG8_LAS bf16x8*)(lds + PG8_SB(b, h) + boff + n * 2048 + k * 1024); } while (0)
#define PG8_MMA(ai, bj, At, Bt) do { __builtin_amdgcn_s_setprio(1); _Pragma("unroll") for (int m = 0; m < 4; ++m) _Pragma("unroll") for (int n = 0; n < 2; ++n) _Pragma("unroll") for (int k = 0; k < 2; ++k) \
        acc[ai][bj][m][n] = __builtin_amdgcn_mfma_f32_16x16x32_bf16(Bt[n][k], At[m][k], acc[ai][bj][m][n], 0, 0, 0); __builtin_amdgcn_s_setprio(0); } while (0)
#define PG8_WAIT_V(n) asm volatile("s_waitcnt vmcnt(" #n ")" ::: "memory")
#define PG8_WAIT_L(n) asm volatile("s_waitcnt lgkmcnt(" #n ")" ::: "memory")
#define PG8_BAR __builtin_amdgcn_s_barrier()
#define PG8_SCHED __builtin_amdgcn_sched_barrier(0)
    Unit cur, nxt; int ui = 0;
    if (!S.next(0, cur)) return;
    f32x4 acc[2][2][4][2];
#pragma unroll
    for (int a = 0; a < 2; ++a)
#pragma unroll
        for (int b = 0; b < 2; ++b)
#pragma unroll
            for (int m = 0; m < 4; ++m)
#pragma unroll
                for (int n = 0; n < 2; ++n) acc[a][b][m][n] = (f32x4){0.f, 0.f, 0.f, 0.f};
    bf16x8 At[4][2], B0[2][2], B1[2][2];
    const char* cA = (const char*)g.A + (size_t)cur.pm * tstep; const char* cB = (const char*)g.Bt + (size_t)cur.pn * tstep;
    S.a_ready(cur);
    PG8_STAGE(PG8_SB(0, 0), cB, voffB); PG8_STAGE(PG8_SA(0, 0), cA, voffA); PG8_STAGE(PG8_SB(0, 1), cB + hstep, voffB); PG8_STAGE(PG8_SA(0, 1), cA + hstep, voffA);
    if (wr == 1) PG8_BAR;
    PG8_WAIT_V(4); PG8_BAR;
    PG8_STAGE(PG8_SB(1, 0), cB + kstep, voffB); PG8_STAGE(PG8_SA(1, 0), cA + kstep, voffA); PG8_STAGE(PG8_SB(1, 1), cB + hstep + kstep, voffB);
    PG8_WAIT_V(6); PG8_BAR;
    PG8_STAMP();
    for (;;) {
        const bool has_next = S.next(ui + 1, nxt);
        const char* nA = has_next ? (const char*)g.A + (size_t)nxt.pm * tstep : cA; const char* nB = has_next ? (const char*)g.Bt + (size_t)nxt.pn * tstep : cB;
        for (int t = 0; t < nt; t += 2) {
            const bool last = (t == nt - 2);
            const char* a1 = cA + (size_t)(t + 1) * kstep;
            const char* a2 = last ? nA : cA + (size_t)(t + 2) * kstep; const char* b2 = last ? nB : cB + (size_t)(t + 2) * kstep;
            const char* a3 = a2 + kstep; const char* b3 = b2 + kstep;
            if (last && has_next) S.a_ready(nxt);
            PG8_LDB(B0, 0, 0); PG8_SCHED; PG8_LDA(At, 0, 0); PG8_STAGE(PG8_SA(1, 1), a1 + hstep, voffA);
            PG8_WAIT_L(8); PG8_BAR; PG8_WAIT_L(0); PG8_MMA(0, 0, At, B0); PG8_BAR; PG8_SCHED;
            PG8_LDB(B1, 0, 1); PG8_STAGE(PG8_SB(0, 0), b2, voffB);
            PG8_BAR; PG8_WAIT_L(0); PG8_MMA(0, 1, At, B1); PG8_BAR;
            PG8_LDA(At, 0, 1); PG8_STAGE(PG8_SA(0, 0), a2, voffA);
            PG8_BAR; PG8_WAIT_L(0); PG8_MMA(1, 0, At, B0); PG8_BAR; PG8_SCHED;
            PG8_STAGE(PG8_SB(0, 1), b2 + hstep, voffB);
            PG8_WAIT_V(6); PG8_BAR; PG8_MMA(1, 1, At, B1); PG8_BAR;
            PG8_LDB(B0, 1, 0); PG8_SCHED; PG8_LDA(At, 1, 0); PG8_STAGE(PG8_SA(0, 1), a2 + hstep, voffA);
            PG8_WAIT_L(8); PG8_BAR; PG8_WAIT_L(0); PG8_MMA(0, 0, At, B0); PG8_BAR; PG8_SCHED;
            PG8_LDB(B1, 1, 1); PG8_STAGE(PG8_SB(1, 0), b3, voffB);
            PG8_BAR; PG8_WAIT_L(0); PG8_MMA(0, 1, At, B1); PG8_BAR;
            PG8_LDA(At, 1, 1); PG8_STAGE(PG8_SA(1, 0), a3, voffA);
            PG8_BAR; PG8_WAIT_L(0); PG8_MMA(1, 0, At, B0); PG8_BAR; PG8_SCHED;
            PG8_STAGE(PG8_SB(1, 1), b3 + hstep, voffB);
            PG8_WAIT_V(6); PG8_BAR; PG8_MMA(1, 1, At, B1); PG8_BAR;
        }
        PG8_STAMP();
        if constexpr (!Epi::AFTER_DRAIN) { E(acc, cur, wr, wc, fr, fq); S.done(cur); }
        PG8_STAMP();
        if (!has_next) break;
#pragma unroll
        for (int a = 0; a < 2; ++a)
#pragma unroll
            for (int b = 0; b < 2; ++b)
#pragma unroll
                for (int m = 0; m < 4; ++m)
#pragma unroll
                    for (int n = 0; n < 2; ++n) acc[a][b][m][n] = (f32x4){0.f, 0.f, 0.f, 0.f};
        cur = nxt; cA = nA; cB = nB; ++ui;
    }
    PG8_WAIT_V(0);
    if (wr == 0) PG8_BAR;
    PG8_BAR;
    if constexpr (Epi::AFTER_DRAIN) { E.fused(acc, cur, wr, wc, fr, fq, lds, wid, lane); S.done(cur); }
    PG8_STAMP();
    if (STAMP && wid == 0) { stamps[lane] = lane < nts ? (((unsigned long long)(unsigned)ts_hi << 32) | (unsigned)ts_lo) : 0ull;
        if (lane == 62) stamps[62] = rt_entry; if (lane == 63) stamps[63] = (unsigned long long)wall_clock64(); }
#undef PG8_STAMP
#undef PG8_SA
#undef PG8_SB
#undef PG8_STAGE
#undef PG8_LDA
#undef PG8_LDB
#undef PG8_MMA
#undef PG8_WAIT_V
#undef PG8_WAIT_L
#undef PG8_BAR
#undef PG8_SCHED
}
}
#define LAS __attribute__((address_space(3)))
#define XB_TMO      128
#define XB_XCNT(j)  (256  + 64 * (j))
#define XB_XSUB(j)  (1280 + 64 * (j))
#define XB_XGEN(j)  (2304 + 64 * (j))
#define XB_TOP      3328
#define XB_TOPGEN   3392
#define XCD_BAR_WORDS 3456
#define XB_SPIN_CAP (1u << 18)

__device__ __forceinline__ unsigned xb_ld(unsigned* p)              { return __hip_atomic_load(p, __ATOMIC_RELAXED, __HIP_MEMORY_SCOPE_AGENT); }
__device__ __forceinline__ unsigned xb_add(unsigned* p, unsigned v) { return __hip_atomic_fetch_add(p, v, __ATOMIC_RELAXED, __HIP_MEMORY_SCOPE_AGENT); }
__device__ __forceinline__ unsigned xb_xcc_id() { return (unsigned)__builtin_amdgcn_s_getreg((3 << 11) | 20) & 0xFu; }
#define XB_SPIN(cond, bar) do { unsigned _sp = 0; while (cond) { __builtin_amdgcn_s_sleep(1); \
    if ((++_sp & 255u) == 0u) { if (xb_ld(&(bar)[XB_TMO])) break; if (_sp > XB_SPIN_CAP) { atomicAdd(&(bar)[XB_TMO], 1u); break; } } } } while (0)

struct XcdBarrier {
    unsigned* bar; unsigned x;
    volatile LAS unsigned* st;
};

__device__ __forceinline__ XcdBarrier xcd_barrier_post(unsigned* bar, volatile LAS unsigned* st) {
    XcdBarrier b; b.bar = bar; b.x = xb_xcc_id(); b.st = st;
    if (threadIdx.x == 0) (void)xb_add(&bar[XB_XCNT(b.x)], 1u);
    return b;
}
__device__ __forceinline__ void xcd_barrier_complete(unsigned* bar, unsigned x, unsigned& nloc, unsigned& nx) {
    const unsigned G = gridDim.x * gridDim.y * gridDim.z;
    unsigned sum, cnt, mine, sp = 0u;
    for (;;) {
        sum = 0u; cnt = 0u; mine = 0u;
#pragma unroll
        for (unsigned j = 0; j < 16; ++j) { const unsigned c = xb_ld(&bar[XB_XCNT(j)]); sum += c; cnt += (c > 0u) ? 1u : 0u; mine = (j == x) ? c : mine; }
        if (sum == G) break;
        __builtin_amdgcn_s_sleep(1);
        if ((++sp & 255u) == 0u) { if (xb_ld(&bar[XB_TMO])) break; if (sp > XB_SPIN_CAP) { atomicAdd(&bar[XB_TMO], 1u); break; } }
    }
    nloc = mine > 0u ? mine : 1u; nx = cnt > 0u ? cnt : 1u;
}

__device__ __forceinline__ void xcd_barrier(const XcdBarrier& b) {
    asm volatile("s_waitcnt vmcnt(0)" ::: "memory");
    __syncthreads();
    if (threadIdx.x == 0) {
        unsigned* bar = b.bar;
        __builtin_amdgcn_s_waitcnt(0);
        unsigned nloc = b.st[0], nx = b.st[1];
        if (nloc == 0u) { xcd_barrier_complete(bar, b.x, nloc, nx); b.st[0] = nloc; b.st[1] = nx; }
        const unsigned old = xb_add(&bar[XB_XSUB(b.x)], 1u);
        const unsigned gen = old / nloc;
        if (old + 1u == (gen + 1u) * nloc) {
            __builtin_amdgcn_fence(__ATOMIC_RELEASE, "agent");
            asm volatile("s_waitcnt vmcnt(0)" ::: "memory");
            const unsigned og = xb_add(&bar[XB_TOP], 1u);
            const unsigned tg = og / nx;
            if (og + 1u == (tg + 1u) * nx) xb_add(&bar[XB_TOPGEN], 1u);
            else XB_SPIN(xb_ld(&bar[XB_TOPGEN]) == tg, bar);
            __builtin_amdgcn_fence(__ATOMIC_ACQUIRE, "agent");
            xb_add(&bar[XB_XGEN(b.x)], 1u);
            asm volatile("s_waitcnt vmcnt(0)" ::: "memory");
        } else {
            XB_SPIN(xb_ld(&bar[XB_XGEN(b.x)]) == gen, bar);
            __builtin_amdgcn_fence(__ATOMIC_ACQUIRE, "agent");
            asm volatile("s_waitcnt vmcnt(0)" ::: "memory");
        }
    }
    __syncthreads();
}


using pg8::bf16_t; using pg8::bf16x8; using pg8::f32x4; using pg8::u32x4; using pg8::cvt_pk_bf16;
typedef unsigned u32x2 __attribute__((ext_vector_type(2)));
#define DEVI __device__ __forceinline__

constexpr int NPR = 16384, NRV = 16512, NRP = 16640;
constexpr int LDS_BYTES = 135168;
constexpr int LDS_MISC = 131072;

constexpr size_t WS_CTL = 0;
constexpr size_t WS_WT_MOD = 32768;
constexpr size_t WS_WT_INAB = WS_WT_MOD + 25165824;
constexpr size_t WS_WT_OUTAB = WS_WT_INAB + 25165824;
constexpr size_t WS_WT_CIN = WS_WT_OUTAB + 8388608;
constexpr size_t WS_WT_GLU = WS_WT_CIN + 8388608;
constexpr size_t WS_WT_COUT = WS_WT_GLU + 4194304;
constexpr size_t WS_WT_LRU = WS_WT_COUT + 4194304;
constexpr size_t WS_SILUC = WS_WT_LRU + 1048576;
constexpr size_t WS_MOD = WS_SILUC + 524288;
constexpr size_t WS_TAIL = WS_MOD + 12582912;
constexpr size_t WS_YBUF = WS_TAIL + 1064960;
constexpr size_t WS_PROJ = WS_YBUF + 68157440;
constexpr size_t WS_UT = WS_PROJ + 204472320;
constexpr size_t WS_WB = WS_UT + 33554432;
constexpr size_t WS_QT = WS_WB + 33554432;
constexpr size_t WS_KT = WS_QT + 33554432;
constexpr size_t WS_EGL = WS_KT + 33554432;
constexpr size_t WS_WT_TAIL = WS_EGL + 8192;
constexpr size_t WS_END = WS_WT_TAIL + 65536;
constexpr size_t WS_QK = WS_WT_MOD;
constexpr size_t WS_Y2 = WS_YBUF + 34078720;

constexpr size_t O_YP = 0, O_YS = 16777216, O_PCA = O_YS + 131072, O_PLRU = O_PCA + 49152, O_PCB = O_PLRU + 16384, O_PDEL = O_PCB + 147456,
                 O_PSR = O_PDEL + 2097152, O_PSI = O_PSR + 65536, O_SCA = O_PSI + 65536, O_SLRU = O_SCA + 786432, O_SCB = O_SLRU + 262144,
                 O_SDEL = O_SCB + 2359296, O_SSR = O_SDEL + 33554432, O_SSI = O_SSR + 1048576, O_END = O_SSI + 1048576;

enum { I_XP = 0, I_XS, I_CP, I_CS, I_SCA, I_SLRU, I_SCB, I_SDEL, I_SSR, I_SSI, I_NORMW, I_MODW, I_MODB, I_ABIN, I_ABOUT, I_CAW, I_CAB, I_GXW, I_GXB, I_GAW, I_GAB, I_APAR,
       I_CBW, I_ALOG, I_DTB, I_GNW, I_CIN, I_COUT, I_ARE, I_AIM, I_BRE, I_BIM, I_CRE, I_CIM, I_S5D, I_LOGDT, I_GLUW, I_GLUB, I_FNW, N_IN };

struct Params {
  const float* in[N_IN];
  float* out;
  unsigned char* ws;
  int ph_lo, ph_hi;
};

typedef const Params __attribute__((address_space(4)))* KP;
DEVI float bf2f(unsigned v16) { return __uint_as_float(v16 << 16); }
DEVI float bflo(unsigned w) { return __uint_as_float(w << 16); }
DEVI float bfhi(unsigned w) { return __uint_as_float(w & 0xffff0000u); }
DEVI bf16_t f2bf(float f) { return (bf16_t)(cvt_pk_bf16(f, 0.f) & 0xffffu); }
DEVI float fexp_(float x) { return __builtin_amdgcn_exp2f(x * 1.4426950408889634f); }
DEVI float sigmoidf_(float x) { return __builtin_amdgcn_rcpf(1.f + fexp_(-x)); }
DEVI float siluf_(float x) { return x * __builtin_amdgcn_rcpf(1.f + fexp_(-x)); }
DEVI float softplusf_(float x) { return x > 20.f ? x : log1pf(__expf(x)); }
DEVI float geluf_(float x) { const float z = 0.7978845608028654f * (x + 0.044715f * x * x * x); const float e = fexp_(2.f * z); return x - x * __builtin_amdgcn_rcpf(1.f + e); }
DEVI void lds_barrier() { asm volatile("s_waitcnt lgkmcnt(0)" ::: "memory"); __builtin_amdgcn_s_barrier(); asm volatile("" ::: "memory"); }
DEVI float wave_sum(float v) {
#pragma unroll
  for (int o = 32; o >= 1; o >>= 1) v += __shfl_xor(v, o);
  return v;
}
DEVI void unpack8(const u32x4 w, float (&f)[8]) { f[0] = bflo(w.x); f[1] = bfhi(w.x); f[2] = bflo(w.y); f[3] = bfhi(w.y); f[4] = bflo(w.z); f[5] = bfhi(w.z); f[6] = bflo(w.w); f[7] = bfhi(w.w); }
DEVI u32x4 pack8(const float (&f)[8]) { u32x4 w; w.x = cvt_pk_bf16(f[0], f[1]); w.y = cvt_pk_bf16(f[2], f[3]); w.z = cvt_pk_bf16(f[4], f[5]); w.w = cvt_pk_bf16(f[6], f[7]); return w; }
DEVI bf16x8 as_bf16x8(const u32x4 w) { union { u32x4 u; bf16x8 b; } c; c.u = w; return c.b; }
DEVI f32x4 mfma16(bf16x8 a, bf16x8 b, f32x4 c) { return __builtin_amdgcn_mfma_f32_16x16x32_bf16(a, b, c, 0, 0, 0); }

struct EpiRes {
  static constexpr bool PERM = false, AFTER_DRAIN = false;
  const float* xp; const float* xs; float* xo; const float* gate;
  __device__ __forceinline__ void operator()(const f32x4 (&acc)[2][2][4][2], const pg8::Unit& u, int wr, int wc, int fr, int fq) const {
    const int row0 = u.pm * 256 + wr * 64 + fr, col0 = u.pn * 256 + wc * 32 + 4 * fq;
#pragma unroll
    for (int ai = 0; ai < 2; ++ai)
#pragma unroll
      for (int m = 0; m < 4; ++m) {
        const int row = row0 + ai * 128 + m * 16;
        if (row < NRV) {
          const float* xi = (row < NPR ? xp + (size_t)row * 1024 : xs + (size_t)(row - NPR) * 1024) + col0;
          const int mrow = row < NPR ? (row >> 11) : 8 + (row - NPR);
          const float* gp = gate + (size_t)mrow * 12288 + col0;
          float* op = xo + (size_t)row * 1024 + col0;
#pragma unroll
          for (int bj = 0; bj < 2; ++bj)
#pragma unroll
            for (int n = 0; n < 2; ++n) {
              const f32x4 xv = *(const f32x4*)(xi + bj * 128 + n * 16), gv = *(const f32x4*)(gp + bj * 128 + n * 16);
              *(f32x4*)(op + bj * 128 + n * 16) = xv + gv * acc[ai][bj][m][n];
            }
        }
      }
  }
};
struct EpiGlu {
  static constexpr bool PERM = true, AFTER_DRAIN = false;
  const bf16_t* y1; const bf16_t* z; bf16_t* y2; const float* bias;
  __device__ __forceinline__ void operator()(const f32x4 (&acc)[2][2][4][2], const pg8::Unit& u, int wr, int wc, int fr, int fq) const {
    const int row0 = u.pm * 256 + wr * 64 + fr, col0 = u.pn * 256 + wc * 32 + 8 * fq;
#pragma unroll
    for (int ai = 0; ai < 2; ++ai)
#pragma unroll
      for (int m = 0; m < 4; ++m) {
        const int row = row0 + ai * 128 + m * 16;
#pragma unroll
        for (int bj = 0; bj < 2; ++bj) {
          const int col = col0 + bj * 128;
          const f32x4 b0 = *(const f32x4*)(bias + col), b1 = *(const f32x4*)(bias + col + 4);
          const u32x4 yw = *(const u32x4*)(y1 + (size_t)row * 1024 + col), zw = *(const u32x4*)(z + (size_t)row * 2048 + col);
          float yf[8], zf[8], o[8]; unpack8(yw, yf); unpack8(zw, zf);
          const f32x4 a0 = acc[ai][bj][m][0] + b0, a1 = acc[ai][bj][m][1] + b1;
#pragma unroll
          for (int e = 0; e < 4; ++e) { o[e] = yf[e] * sigmoidf_(a0[e]) * siluf_(zf[e]); o[4 + e] = yf[4 + e] * sigmoidf_(a1[e]) * siluf_(zf[4 + e]); }
          *(u32x4*)(y2 + (size_t)row * 1024 + col) = pack8(o);
        }
      }
  }
};

struct TileDesc { const float* src; bf16_t* dst; int ldsrc, lddst, k0, n0; };
DEVI TileDesc prep_tile(KP p, int t) {
  TileDesc d; int tt = t;
  if (tt < 3072) { const int mat = tt / 768, r = tt % 768; d.k0 = (r / 48) * 64; d.n0 = (r % 48) * 64; d.src = p->in[I_MODW] + (size_t)mat * 1024 * 3072; d.ldsrc = 3072; d.dst = (bf16_t*)(p->ws + WS_WT_MOD) + (size_t)mat * 3072 * 1024; d.lddst = 1024; }
  else if ((tt -= 3072) < 3072) { const int mat = tt / 1536, r = tt % 1536; d.k0 = (r / 96) * 64; d.n0 = (r % 96) * 64; d.src = p->in[I_ABIN] + (size_t)mat * 1024 * 6160; d.ldsrc = 6160; d.dst = (bf16_t*)(p->ws + WS_WT_INAB) + (size_t)mat * 6144 * 1024; d.lddst = 1024; }
  else if ((tt -= 3072) < 1024) { const int mat = tt / 512, r = tt % 512; d.k0 = (r / 16) * 64; d.n0 = (r % 16) * 64; d.src = p->in[I_ABOUT] + (size_t)mat * 2048 * 1024; d.ldsrc = 1024; d.dst = (bf16_t*)(p->ws + WS_WT_OUTAB) + (size_t)mat * 1024 * 2048; d.lddst = 2048; }
  else if ((tt -= 1024) < 1024) { const int mat = tt / 512, r = tt % 512; d.k0 = (r / 32) * 64; d.n0 = (r % 32) * 64; d.src = p->in[I_CIN] + (size_t)mat * 1024 * 2048; d.ldsrc = 2048; d.dst = (bf16_t*)(p->ws + WS_WT_CIN) + (size_t)mat * 2048 * 1024; d.lddst = 1024; }
  else if ((tt -= 1024) < 512) { const int mat = tt / 256, r = tt % 256; d.k0 = (r / 16) * 64; d.n0 = (r % 16) * 64; d.src = p->in[I_COUT] + (size_t)mat * 1024 * 1024; d.ldsrc = 1024; d.dst = (bf16_t*)(p->ws + WS_WT_COUT) + (size_t)mat * 1024 * 1024; d.lddst = 1024; }
  else if ((tt -= 512) < 512) { const int mat = tt / 256, r = tt % 256; d.k0 = (r / 16) * 64; d.n0 = (r % 16) * 64; d.src = p->in[I_GLUW] + (size_t)mat * 1024 * 1024; d.ldsrc = 1024; d.dst = (bf16_t*)(p->ws + WS_WT_GLU) + (size_t)mat * 1024 * 1024; d.lddst = 1024; }
  else { tt -= 512; const int gate = tt / 64; const int r2 = tt % 64; const int mat = r2 / 4, r = r2 % 4;
    d.k0 = (r / 2) * 64; d.n0 = (r % 2) * 64; d.src = p->in[gate ? I_GAW : I_GXW] + (size_t)mat * 16384; d.ldsrc = 128;
    d.dst = (bf16_t*)(p->ws + WS_WT_LRU) + (size_t)(((mat >> 3) * 2 + gate) * 8 + (mat & 7)) * 16384; d.lddst = 128; }
  return d;
}
DEVI void phase_prep(KP p, float* lds) {
  const int tid = tidx_(), tx = tid & 15, ty = tid >> 4, nn = tid >> 3, ks = (tid & 7) * 8;
  for (int t0 = bidx_(); t0 < 9344; t0 += 4 * gdim_()) {
    float4 v[4][2];
#pragma unroll
    for (int q = 0; q < 4; ++q) { const int t = t0 + q * gdim_();
      if (t < 9344) { const TileDesc d = prep_tile(p, t);
#pragma unroll
        for (int pp = 0; pp < 2; ++pp) v[q][pp] = *(const float4*)(d.src + (size_t)(d.k0 + ty + pp * 32) * d.ldsrc + d.n0 + tx * 4); } }
#pragma unroll
    for (int q = 0; q < 4; ++q) { float* tile = lds + q * 4160;
#pragma unroll
      for (int pp = 0; pp < 2; ++pp) { const int k = ty + pp * 32; tile[k * 65 + tx * 4 + 0] = v[q][pp].x; tile[k * 65 + tx * 4 + 1] = v[q][pp].y; tile[k * 65 + tx * 4 + 2] = v[q][pp].z; tile[k * 65 + tx * 4 + 3] = v[q][pp].w; } }
    lds_barrier();
#pragma unroll
    for (int q = 0; q < 4; ++q) { const int t = t0 + q * gdim_();
      if (t < 9344) { const TileDesc d = prep_tile(p, t); const float* tile = lds + q * 4160; float f[8];
#pragma unroll
        for (int jx = 0; jx < 8; ++jx) f[jx] = tile[(ks + jx) * 65 + nn];
        *(u32x4*)(d.dst + (size_t)(d.n0 + nn) * d.lddst + d.k0 + ks) = pack8(f); } }
    lds_barrier();
  }
  { bf16_t* wtt = (bf16_t*)(p->ws + WS_WT_TAIL);
    for (int e = bidx_() * 512 + tidx_(); e < 32768; e += gdim_() * 512) { const int jj = e >> 14, cc = (e >> 10) & 15, k = e & 1023;
      wtt[e] = f2bf(p->in[I_ABIN][(size_t)jj * 1024 * 6160 + (size_t)k * 6160 + 6144 + cc]); } }
  bf16_t* sc = (bf16_t*)(p->ws + WS_SILUC);
  for (int e = bidx_() * 512 + tidx_(); e < 256 * 1024 / 4; e += gdim_() * 512) {
    const int row = e >> 8, c4 = (e & 255) * 4; float4 v = make_float4(0.f, 0.f, 0.f, 0.f);
    if (row < 8) v = *(const float4*)(p->in[I_CP] + row * 1024 + c4); else if (row < 136) v = *(const float4*)(p->in[I_CS] + (row - 8) * 1024 + c4);
    u32x2 w; w.x = cvt_pk_bf16(row < 136 ? siluf_(v.x) : 0.f, row < 136 ? siluf_(v.y) : 0.f); w.y = cvt_pk_bf16(row < 136 ? siluf_(v.z) : 0.f, row < 136 ? siluf_(v.w) : 0.f);
    *(u32x2*)(sc + row * 1024 + c4) = w;
  }
}

DEVI void norm_row2(const float* x0, const float* x1, bool two, const float (&wm)[16], const float (&sh)[16], bf16_t* h0, bf16_t* h1, int lane) {
  float4 v0[4], v1[4]; float s0 = 0.f, s1 = 0.f;
#pragma unroll
  for (int i = 0; i < 4; ++i) { v0[i] = *(const float4*)(x0 + i * 256 + lane * 4); v1[i] = two ? *(const float4*)(x1 + i * 256 + lane * 4) : make_float4(0.f, 0.f, 0.f, 0.f); }
#pragma unroll
  for (int i = 0; i < 4; ++i) { s0 += v0[i].x * v0[i].x + v0[i].y * v0[i].y + v0[i].z * v0[i].z + v0[i].w * v0[i].w; s1 += v1[i].x * v1[i].x + v1[i].y * v1[i].y + v1[i].z * v1[i].z + v1[i].w * v1[i].w; }
#pragma unroll
  for (int o = 32; o >= 1; o >>= 1) { s0 += __shfl_xor(s0, o); s1 += __shfl_xor(s1, o); }
  const float r0 = __builtin_amdgcn_rsqf(s0 * (1.f / 1024.f) + 1e-6f), r1 = __builtin_amdgcn_rsqf(s1 * (1.f / 1024.f) + 1e-6f);
#pragma unroll
  for (int i = 0; i < 4; ++i) { const int k = i * 256 + lane * 4;
    u32x2 w; w.x = cvt_pk_bf16(v0[i].x * r0 * wm[i * 4 + 0] + sh[i * 4 + 0], v0[i].y * r0 * wm[i * 4 + 1] + sh[i * 4 + 1]); w.y = cvt_pk_bf16(v0[i].z * r0 * wm[i * 4 + 2] + sh[i * 4 + 2], v0[i].w * r0 * wm[i * 4 + 3] + sh[i * 4 + 3]);
    *(u32x2*)(h0 + k) = w;
    if (two) { u32x2 w2; w2.x = cvt_pk_bf16(v1[i].x * r1 * wm[i * 4 + 0] + sh[i * 4 + 0], v1[i].y * r1 * wm[i * 4 + 1] + sh[i * 4 + 1]); w2.y = cvt_pk_bf16(v1[i].z * r1 * wm[i * 4 + 2] + sh[i * 4 + 2], v1[i].w * r1 * wm[i * 4 + 3] + sh[i * 4 + 3]);
      *(u32x2*)(h1 + k) = w2; } }
}
DEVI void norm_coefs(KP p, int layer, int mrow, int lane, float (&wm)[16], float (&sh)[16]) {
  const float* nw = p->in[I_NORMW] + layer * 1024;
  const float* md = (const float*)(p->ws + WS_MOD) + (size_t)mrow * 12288 + layer * 3072;
#pragma unroll
  for (int i = 0; i < 4; ++i) { const int k = i * 256 + lane * 4; const float4 w4 = *(const float4*)(nw + k), s4 = *(const float4*)(md + k), c4 = *(const float4*)(md + 1024 + k);
    wm[i * 4 + 0] = w4.x * (1.f + c4.x); wm[i * 4 + 1] = w4.y * (1.f + c4.y); wm[i * 4 + 2] = w4.z * (1.f + c4.z); wm[i * 4 + 3] = w4.w * (1.f + c4.w);
    sh[i * 4 + 0] = s4.x; sh[i * 4 + 1] = s4.y; sh[i * 4 + 2] = s4.z; sh[i * 4 + 3] = s4.w; }
}
DEVI void phase_norm(KP p, int layer, float* lds) {
  const int tid = tidx_(), lane = tid & 63, wave = tid >> 6;
  bf16_t* hb = (bf16_t*)(p->ws + WS_YBUF);
  float wm[16], sh[16];
  for (int gw = bidx_() * 8 + wave; gw < 2048; gw += gdim_() * 8) {
    const int r0 = gw * 8;
    norm_coefs(p, layer, r0 >> 11, lane, wm, sh);
    const float* xb = (layer == 0) ? p->in[I_XP] : p->out;
#pragma unroll 2
    for (int i = 0; i < 8; i += 2) norm_row2(xb + (size_t)(r0 + i) * 1024, xb + (size_t)(r0 + i + 1) * 1024, true, wm, sh, hb + (size_t)(r0 + i) * 1024, hb + (size_t)(r0 + i + 1) * 1024, lane);
    if (gw < 128) {
      norm_coefs(p, layer, 8 + gw, lane, wm, sh);
      const float* xs = (layer == 0) ? p->in[I_XS] + (size_t)gw * 1024 : p->out + (size_t)(NPR + gw) * 1024;
      norm_row2(xs, xs, false, wm, sh, hb + (size_t)(NPR + gw) * 1024, hb, lane);
    }
  }
}
DEVI void tail_gemm(KP p, int j) {
  const int tid = tidx_(), lane = tid & 63, wave = tid >> 6, l15 = lane & 15, lq = lane >> 4;
  const bf16_t* hb = (const bf16_t*)(p->ws + WS_YBUF);
  const bf16_t* bp = (const bf16_t*)(p->ws + WS_WT_TAIL) + (size_t)j * 16384 + l15 * 1024 + lq * 8;
  float* tl = (float*)(p->ws + WS_TAIL);
  for (int t = bidx_() * 8 + wave; t < 1032; t += gdim_() * 8) {
    const bf16_t* ap = hb + (size_t)(t * 16 + l15) * 1024 + lq * 8;
    f32x4 acc0 = (f32x4){0.f, 0.f, 0.f, 0.f}, acc1 = (f32x4){0.f, 0.f, 0.f, 0.f};
#pragma unroll 1
    for (int k0 = 0; k0 < 1024; k0 += 256) {
      u32x4 a[8], b[8];
#pragma unroll
      for (int u = 0; u < 8; ++u) { a[u] = *(const u32x4*)(ap + k0 + u * 32); b[u] = *(const u32x4*)(bp + k0 + u * 32); }
#pragma unroll
      for (int u = 0; u < 8; u += 2) { acc0 = mfma16(as_bf16x8(a[u]), as_bf16x8(b[u]), acc0); acc1 = mfma16(as_bf16x8(a[u + 1]), as_bf16x8(b[u + 1]), acc1); }
    }
    acc0 = acc0 + acc1;
#pragma unroll
    for (int r = 0; r < 4; ++r) tl[(size_t)(t * 16 + lq * 4 + r) * 16 + l15] = acc0[r];
  }
}

DEVI void lru_item(KP p, int j, int item, unsigned char* lds) {
  const int tid = tidx_(), lane = tid & 63, wave = tid >> 6;
  const bool prompt = item < 128;
  const int b = prompt ? (item >> 4) : 0, hd = prompt ? ((item >> 1) & 7) : ((item - 128) >> 1), half = item & 1;
  bf16_t* WX = (bf16_t*)lds;
  bf16_t* XA = (bf16_t*)(lds + 34816);
  float* AA = (float*)(lds + 52224);
  float* BB = (float*)(lds + 69632);
  bf16_t* RAW = (bf16_t*)(lds + 87040);
  float* CAR = (float*)(lds + 105472);
  const bf16_t* proj = (const bf16_t*)(p->ws + WS_PROJ);
  bf16_t* ybuf = (bf16_t*)(p->ws + WS_YBUF);
  { const bf16_t* wt = (const bf16_t*)(p->ws + WS_WT_LRU);
#pragma unroll
    for (int q = 0; q < 4; ++q) { const int e = tid + q * 512, gate = e >> 10, o = (e & 1023) >> 4, c8 = e & 15;
      *(u32x4*)(WX + (gate * 64 + o) * 136 + c8 * 8) = *(const u32x4*)(wt + ((size_t)((j * 2 + gate) * 8 + hd) * 128 + half * 64 + o) * 128 + c8 * 8); } }
  const int ch8 = tid & 15, rsub = tid >> 4, chb = hd * 128 + ch8 * 8;
  float cw[4][8], cb[8];
#pragma unroll
  for (int t = 0; t < 4; ++t)
#pragma unroll
    for (int e = 0; e < 8; ++e) cw[t][e] = p->in[I_CAW][(size_t)(j * 4 + t) * 1024 + chb + e];
#pragma unroll
  for (int e = 0; e < 8; ++e) cb[e] = p->in[I_CAB][j * 1024 + chb + e];
  const int rt = wave >> 1, chh = wave & 1, l15 = lane & 15, lq = lane >> 4;
  float gxb[2], gab[2], spv[2];
#pragma unroll
  for (int c2 = 0; c2 < 2; ++c2) { const int gch = hd * 128 + half * 64 + chh * 32 + c2 * 16 + l15;
    gxb[c2] = p->in[I_GXB][j * 1024 + gch]; gab[c2] = p->in[I_GAB][j * 1024 + gch]; spv[c2] = softplusf_(-p->in[I_APAR][j * 1024 + gch]); }
  const int sch = hd * 128 + half * 64 + lane;
  float hcar = 0.f;
  const int ntiles = prompt ? 32 : 2;
  u32x4 pre[3];
  if (prompt) {
#pragma unroll
    for (int q = 0; q < 3; ++q) { const int e = tid + q * 512, row = e >> 4, c8 = e & 15, t = row - 3; pre[q] = (u32x4){0u, 0u, 0u, 0u};
      if (e < 1072 && t >= 0) pre[q] = *(const u32x4*)(proj + (size_t)(b * 2048 + t) * 6144 + hd * 128 + c8 * 8); }
  }
  for (int tile = 0; tile < ntiles; ++tile) {
    bf16_t zav[8];
#pragma unroll
    for (int i = 0; i < 8; ++i) { const size_t grow = prompt ? (size_t)(b * 2048 + tile * 64 + wave * 8 + i) : (size_t)(NPR + tile * 64 + wave * 8 + i); zav[i] = proj[grow * 6144 + 1024 + sch]; }
    if (prompt) {
#pragma unroll
      for (int q = 0; q < 3; ++q) { const int e = tid + q * 512; if (e < 1072) *(u32x4*)(RAW + (e >> 4) * 136 + (e & 15) * 8) = pre[q]; }
      if (tile + 1 < ntiles) {
#pragma unroll
        for (int q = 0; q < 3; ++q) { const int e = tid + q * 512, row = e >> 4, c8 = e & 15, t = (tile + 1) * 64 + row - 3;
          if (e < 1072) pre[q] = *(const u32x4*)(proj + (size_t)(b * 2048 + t) * 6144 + hd * 128 + c8 * 8); }
      }
      lds_barrier();
#pragma unroll
      for (int pp = 0; pp < 2; ++pp) {
        const int i = rsub + pp * 32; float acc[8];
#pragma unroll
        for (int e = 0; e < 8; ++e) acc[e] = cb[e];
#pragma unroll
        for (int tap = 0; tap < 4; ++tap) { float xf[8]; unpack8(*(const u32x4*)(RAW + (i + tap) * 136 + ch8 * 8), xf);
#pragma unroll
          for (int e = 0; e < 8; ++e) acc[e] += cw[tap][e] * xf[e]; }
        *(u32x4*)(XA + i * 136 + ch8 * 8) = pack8(acc);
      }
      if (tile == 31 && half == 0 && tid < 48) { const int r3 = tid >> 4, c8 = tid & 15; float xf[8]; unpack8(*(const u32x4*)(RAW + (64 + r3) * 136 + c8 * 8), xf);
        float* o = p->out + O_PCA + (size_t)((j * 8 + b) * 3 + r3) * 1024 + hd * 128 + c8 * 8;
        *(float4*)o = make_float4(xf[0], xf[1], xf[2], xf[3]); *(float4*)(o + 4) = make_float4(xf[4], xf[5], xf[6], xf[7]); }
    } else {
#pragma unroll
      for (int pp = 0; pp < 2; ++pp) {
        const int i = rsub + pp * 32; float acc[8], x3[8];
#pragma unroll
        for (int e = 0; e < 8; ++e) acc[e] = cb[e];
        const int brow = tile * 64 + i;
        const float* st = p->in[I_SCA] + (size_t)((j * 128 + brow) * 3) * 1024 + chb;
        float* so = p->out + O_SCA + (size_t)((j * 128 + brow) * 3) * 1024 + chb;
#pragma unroll
        for (int tap = 0; tap < 3; ++tap) { const float4 s0 = *(const float4*)(st + tap * 1024), s1 = *(const float4*)(st + tap * 1024 + 4);
          const float xf[8] = {s0.x, s0.y, s0.z, s0.w, s1.x, s1.y, s1.z, s1.w};
#pragma unroll
          for (int e = 0; e < 8; ++e) acc[e] += cw[tap][e] * xf[e];
          if (tap >= 1 && half == 0) { *(float4*)(so + (tap - 1) * 1024) = s0; *(float4*)(so + (tap - 1) * 1024 + 4) = s1; } }
        const u32x4 w = *(const u32x4*)(proj + (size_t)(NPR + brow) * 6144 + chb); unpack8(w, x3);
#pragma unroll
        for (int e = 0; e < 8; ++e) acc[e] += cw[3][e] * x3[e];
        if (half == 0) { *(float4*)(so + 2 * 1024) = make_float4(x3[0], x3[1], x3[2], x3[3]); *(float4*)(so + 2 * 1024 + 4) = make_float4(x3[4], x3[5], x3[6], x3[7]); }
        *(u32x4*)(XA + i * 136 + ch8 * 8) = pack8(acc);
      }
    }
    lds_barrier();
    f32x4 accx[2], acca[2];
#pragma unroll
    for (int c2 = 0; c2 < 2; ++c2) { accx[c2] = (f32x4){0.f, 0.f, 0.f, 0.f}; acca[c2] = (f32x4){0.f, 0.f, 0.f, 0.f}; }
#pragma unroll
    for (int kk = 0; kk < 4; ++kk) {
      const bf16x8 a = *(const bf16x8*)(XA + (rt * 16 + l15) * 136 + lq * 8 + kk * 32);
#pragma unroll
      for (int c2 = 0; c2 < 2; ++c2) {
        const bf16x8 bx = *(const bf16x8*)(WX + (chh * 32 + c2 * 16 + l15) * 136 + lq * 8 + kk * 32);
        const bf16x8 ba = *(const bf16x8*)(WX + (64 + chh * 32 + c2 * 16 + l15) * 136 + lq * 8 + kk * 32);
        accx[c2] = mfma16(a, bx, accx[c2]); acca[c2] = mfma16(a, ba, acca[c2]);
      }
    }
#pragma unroll
    for (int c2 = 0; c2 < 2; ++c2)
#pragma unroll
      for (int r = 0; r < 4; ++r) {
        const int row = rt * 16 + lq * 4 + r, oc = chh * 32 + c2 * 16 + l15;
        const float gx = sigmoidf_(accx[c2][r] + gxb[c2]), ga = sigmoidf_(acca[c2][r] + gab[c2]);
        const float log_a = -8.f * ga * spv[c2];
        const float a = fexp_(log_a);
        float mult = __builtin_amdgcn_sqrtf(fmaxf(1.f - a * a, 0.f));
        if (prompt && tile == 0 && row == 0) mult = 1.f;
        const float xv = bf2f(XA[row * 136 + half * 64 + oc]);
        AA[row * 68 + oc] = a; BB[row * 68 + oc] = mult * gx * xv;
      }
    lds_barrier();
    float hl[8], pc[8];
    { float h = 0.f, P = 1.f;
#pragma unroll
      for (int i = 0; i < 8; ++i) { const float a = AA[(wave * 8 + i) * 68 + lane], bv = BB[(wave * 8 + i) * 68 + lane];
        if (prompt) { h = a * h + bv; P *= a; hl[i] = h; pc[i] = P; } else { hl[i] = bv; pc[i] = a; } }
      CAR[(wave * 64 + lane) * 2] = P; CAR[(wave * 64 + lane) * 2 + 1] = h; }
    lds_barrier();
    float cin = 0.f;
    if (prompt) { float c = hcar;
#pragma unroll
      for (int s = 0; s < 8; ++s) { const float Ps = CAR[(s * 64 + lane) * 2], Es = CAR[(s * 64 + lane) * 2 + 1]; if (s == wave) cin = c; c = Ps * c + Es; }
      hcar = c; }
#pragma unroll
    for (int i = 0; i < 8; ++i) {
      const int rowl = tile * 64 + wave * 8 + i;
      float hv;
      if (prompt) hv = hl[i] + pc[i] * cin;
      else { const float h0 = p->in[I_SLRU][(size_t)(j * 128 + rowl) * 1024 + sch]; hv = pc[i] * h0 + hl[i]; p->out[O_SLRU + (size_t)(j * 128 + rowl) * 1024 + sch] = hv; }
      const size_t grow = prompt ? (size_t)(b * 2048 + rowl) : (size_t)(NPR + rowl);
      ybuf[grow * 2048 + sch] = f2bf(hv * siluf_(bf2f(zav[i])));
    }
  }
  if (prompt && wave == 0) p->out[O_PLRU + (size_t)(j * 8 + b) * 1024 + sch] = hcar;
}

DEVI void gdn_prep_item(KP p, int j, int cid, unsigned char* lds) {
  const int tid = tidx_(), lane = tid & 63, wave = tid >> 6;
  const int b = cid >> 8, h = (cid >> 5) & 7, c = cid & 31;
  const int row0 = b * 2048 + c * 64;
  bf16_t* QN = (bf16_t*)lds; bf16_t* KN = (bf16_t*)(lds + 17408); bf16_t* VN = (bf16_t*)(lds + 34816);
  float* AM = (float*)(lds + 52224); float* GC = (float*)(lds + 69632); float* BETA = (float*)(lds + 69888); float* BEG = (float*)(lds + 70144);
  const bf16_t* proj = (const bf16_t*)(p->ws + WS_PROJ);
  const float* tl = (const float*)(p->ws + WS_TAIL);
  if (wave == 0) {
    const float* t = tl + (size_t)(row0 + lane) * 16;
    float g = -fexp_(p->in[I_ALOG][j * 8 + h]) * softplusf_(t[8 + h] + p->in[I_DTB][j * 8 + h]);
    const float beta = sigmoidf_(t[h]);
#pragma unroll
    for (int o = 1; o < 64; o <<= 1) { const float v = __shfl_up(g, o); if (lane >= o) g += v; }
    GC[lane] = g; BETA[lane] = beta; BEG[lane] = beta * fexp_(g);
  }
  bf16_t* RAWB = (bf16_t*)(lds + 70656);
  bf16_t* AMB = (bf16_t*)(lds + 70656);
  bf16_t* XT = (bf16_t*)(lds + 79872);
  float* CORR = (float*)lds;
  float* CW = (float*)(lds + 123184);
  {
    u32x4 rv[7];
#pragma unroll
    for (int q = 0; q < 7; ++q) { const int e = tid + 512 * q, row = e / 48, c16 = e - row * 48, tt = c * 64 + row - 3; rv[q] = (u32x4){0u, 0u, 0u, 0u};
      if (e < 3216 && tt >= 0) rv[q] = *(const u32x4*)(proj + (size_t)(b * 2048 + tt) * 6144 + 2048 + (c16 >> 4) * 1024 + h * 128 + (c16 & 15) * 8); }
    float4 wv = make_float4(0.f, 0.f, 0.f, 0.f);
    if (tid < 384) { const int tap = tid / 96, lc = (tid - tap * 96) * 4; wv = *(const float4*)(p->in[I_CBW] + (size_t)(j * 4 + tap) * 3072 + (lc >> 7) * 1024 + h * 128 + (lc & 127)); }
#pragma unroll
    for (int q = 0; q < 7; ++q) { const int e = tid + 512 * q, row = e / 48, c16 = e - row * 48; if (e < 3216) *(u32x4*)(RAWB + row * 392 + c16 * 8) = rv[q]; }
    if (tid < 384) { const int tap = tid / 96, lc = (tid - tap * 96) * 4; *(float4*)(CW + tap * 384 + lc) = wv; }
  }
  lds_barrier();
  if (c == 31 && tid < 144) { const int r3 = tid / 48, c16 = tid - r3 * 48; float xf[8]; unpack8(*(const u32x4*)(RAWB + (64 + r3) * 392 + c16 * 8), xf);
    float* o = p->out + O_PCB + (size_t)((j * 8 + b) * 3 + r3) * 3072 + (c16 >> 4) * 1024 + h * 128 + (c16 & 15) * 8;
    *(float4*)o = make_float4(xf[0], xf[1], xf[2], xf[3]); *(float4*)(o + 4) = make_float4(xf[4], xf[5], xf[6], xf[7]); }
#pragma unroll 2
  for (int pi = 0; pi < 6; ++pi) {
    const int pair = tid + 512 * pi, part = pair >> 10, rem = pair & 1023, i = rem >> 4, cgp = rem & 15;
    float acc[8];
#pragma unroll
    for (int e = 0; e < 8; ++e) acc[e] = 0.f;
#pragma unroll
    for (int tap = 0; tap < 4; ++tap) { float xf[8]; unpack8(*(const u32x4*)(RAWB + (i + tap) * 392 + part * 128 + cgp * 8), xf);
      const float4 w0 = *(const float4*)(CW + tap * 384 + part * 128 + cgp * 8), w1 = *(const float4*)(CW + tap * 384 + part * 128 + cgp * 8 + 4);
      acc[0] += w0.x * xf[0]; acc[1] += w0.y * xf[1]; acc[2] += w0.z * xf[2]; acc[3] += w0.w * xf[3];
      acc[4] += w1.x * xf[4]; acc[5] += w1.y * xf[5]; acc[6] += w1.z * xf[6]; acc[7] += w1.w * xf[7]; }
    float ss = 0.f;
#pragma unroll
    for (int e = 0; e < 8; ++e) { acc[e] = siluf_(acc[e]); ss += acc[e] * acc[e]; }
    ss += __shfl_xor(ss, 1); ss += __shfl_xor(ss, 2); ss += __shfl_xor(ss, 4); ss += __shfl_xor(ss, 8);
    float scl = 1.f;
    if (part == 0) scl = __builtin_amdgcn_rsqf(ss + 1e-6f) * 0.08838834764831845f; else if (part == 1) scl = __builtin_amdgcn_rsqf(ss + 1e-6f);
#pragma unroll
    for (int e = 0; e < 8; ++e) acc[e] *= scl;
    bf16_t* dstp = part == 0 ? QN : (part == 1 ? KN : VN);
    *(u32x4*)(dstp + i * 136 + cgp * 8) = pack8(acc);
  }
  lds_barrier();
  {
    const int rt = wave >> 1, ctp = (wave & 1) * 2, l15 = lane & 15, lq = lane >> 4;
    f32x4 kka[2], qka[2];
#pragma unroll
    for (int c2 = 0; c2 < 2; ++c2) { kka[c2] = (f32x4){0.f, 0.f, 0.f, 0.f}; qka[c2] = (f32x4){0.f, 0.f, 0.f, 0.f}; }
#pragma unroll
    for (int kk = 0; kk < 4; ++kk) {
      const bf16x8 ak = *(const bf16x8*)(KN + (rt * 16 + l15) * 136 + lq * 8 + kk * 32);
      const bf16x8 aq = *(const bf16x8*)(QN + (rt * 16 + l15) * 136 + lq * 8 + kk * 32);
#pragma unroll
      for (int c2 = 0; c2 < 2; ++c2) { const bf16x8 bk = *(const bf16x8*)(KN + ((ctp + c2) * 16 + l15) * 136 + lq * 8 + kk * 32);
        kka[c2] = mfma16(ak, bk, kka[c2]); qka[c2] = mfma16(aq, bk, qka[c2]); }
    }
    bf16_t* qkg = (bf16_t*)(p->ws + WS_QK) + (size_t)cid * 4096;
#pragma unroll
    for (int c2 = 0; c2 < 2; ++c2)
#pragma unroll
      for (int r = 0; r < 4; ++r) {
        const int i = rt * 16 + lq * 4 + r, jj = (ctp + c2) * 16 + l15;
        const float dec = fexp_(fminf(GC[i] - GC[jj], 0.f));
        const float aval = (i > jj) ? BETA[i] * kka[c2][r] * dec : 0.f;
        AM[i * 68 + jj] = aval; AMB[i * 72 + jj] = f2bf(aval);
        qkg[(((i >> 4) * 2 + (jj >> 5)) * 64 + ((jj & 31) >> 3) * 16 + (i & 15)) * 8 + (jj & 7)] = f2bf((i >= jj) ? qka[c2][r] * dec : 0.f);
      }
  }
  lds_barrier();
  const int cc = tid & 255;
  const bf16_t* rsrc = (cc < 128) ? (VN + cc) : (KN + (cc - 128));
  const float* rfac = (cc < 128) ? BETA : BEG;
#pragma unroll
  for (int bi = 0; bi < 4; ++bi) {
    if (bi > 0) {
      const int l15 = lane & 15, lq = lane >> 4;
#pragma unroll
      for (int n2 = 0; n2 < 2; ++n2) { const int nt = wave * 2 + n2; f32x4 acc = (f32x4){0.f, 0.f, 0.f, 0.f};
#pragma unroll
        for (int kk = 0; kk < (bi * 16 + 31) / 32; ++kk) { const int k0 = lq * 8 + kk * 32; const bool valid = k0 < bi * 16;
          u32x4 av = *(const u32x4*)(AMB + (bi * 16 + l15) * 72 + k0), bv = *(const u32x4*)(XT + (nt * 16 + l15) * 72 + k0);
          if (!valid) { av = (u32x4){0u, 0u, 0u, 0u}; bv = (u32x4){0u, 0u, 0u, 0u}; }
          acc = mfma16(as_bf16x8(av), as_bf16x8(bv), acc); }
#pragma unroll
        for (int r = 0; r < 4; ++r) CORR[(lq * 4 + r) * 260 + nt * 16 + l15] = acc[r]; }
      lds_barrier();
    }
    if (tid < 256) {
      float xb[16], rh[16];
#pragma unroll
      for (int ii = 0; ii < 16; ++ii) { const int i = bi * 16 + ii; rh[ii] = bf2f(rsrc[i * 136]) * rfac[i]; if (bi > 0) rh[ii] -= CORR[ii * 260 + cc]; }
#pragma unroll
      for (int rg = 0; rg < 4; ++rg) {
        f32x4 a[4][4];
#pragma unroll
        for (int q = 0; q < 4; ++q)
#pragma unroll
          for (int g4 = 0; g4 <= rg; ++g4) a[q][g4] = *(const f32x4*)(AM + (bi * 16 + rg * 4 + q) * 68 + bi * 16 + g4 * 4);
#pragma unroll
        for (int q = 0; q < 4; ++q) { const int ii = rg * 4 + q; float s = rh[ii];
#pragma unroll
          for (int jj = 0; jj < ii; ++jj) s -= a[q][jj >> 2][jj & 3] * xb[jj];
          xb[ii] = s; }
        asm volatile("" : "+v"(xb[rg * 4 + 3]) :: "memory");
      }
      u32x4 w0, w1;
      w0.x = cvt_pk_bf16(xb[0], xb[1]); w0.y = cvt_pk_bf16(xb[2], xb[3]); w0.z = cvt_pk_bf16(xb[4], xb[5]); w0.w = cvt_pk_bf16(xb[6], xb[7]);
      w1.x = cvt_pk_bf16(xb[8], xb[9]); w1.y = cvt_pk_bf16(xb[10], xb[11]); w1.z = cvt_pk_bf16(xb[12], xb[13]); w1.w = cvt_pk_bf16(xb[14], xb[15]);
      if (bi < 3) { *(u32x4*)(XT + cc * 72 + bi * 16) = w0; *(u32x4*)(XT + cc * 72 + bi * 16 + 8) = w1; }
      if (cc < 128) {
        bf16_t* ut = (bf16_t*)(p->ws + WS_UT) + (size_t)cid * 8192 + cc * 64 + bi * 16;
        *(u32x4*)ut = w0; *(u32x4*)(ut + 8) = w1;
      } else {
        const int dk = cc - 128;
        bf16_t* wb = (bf16_t*)(p->ws + WS_WB) + (size_t)cid * 8192 + ((bi * 4 + (dk >> 5)) * 64 + ((dk & 31) >> 3) * 16) * 8 + (dk & 7);
#pragma unroll
        for (int ii = 0; ii < 16; ++ii) wb[ii * 8] = f2bf(xb[ii]);
      }
    } else if (bi == 0) {
      const int t2 = tid - 256;
      { const int i = t2 >> 2, dseg = (t2 & 3) * 32; const float eg = fexp_(GC[i]);
        bf16_t* qt = (bf16_t*)(p->ws + WS_QT) + (size_t)cid * 8192 + (((i >> 4) * 4 + (t2 & 3)) * 64 + (i & 15)) * 8;
#pragma unroll
        for (int s = 0; s < 4; ++s) { float f[8]; unpack8(*(const u32x4*)(QN + i * 136 + dseg + s * 8), f);
#pragma unroll
          for (int e = 0; e < 8; ++e) f[e] *= eg;
          *(u32x4*)(qt + s * 128) = pack8(f); } }
      { const int d = t2 >> 1, iseg = (t2 & 1) * 32; const float gl = GC[63];
        bf16_t* kt = (bf16_t*)(p->ws + WS_KT) + (size_t)cid * 8192 + (((d >> 4) * 2 + (t2 & 1)) * 64 + (d & 15)) * 8;
#pragma unroll
        for (int s = 0; s < 4; ++s) { float f[8];
#pragma unroll
          for (int e = 0; e < 8; ++e) { const int i = iseg + s * 8 + e; f[e] = bf2f(KN[i * 136 + d]) * fexp_(gl - GC[i]); }
          *(u32x4*)(kt + s * 128) = pack8(f); } }
      if (t2 == 0) ((float*)(p->ws + WS_EGL))[cid] = fexp_(GC[63]);
    }
    if (bi < 3) lds_barrier();
  }
}

DEVI void gdn_decode_item(KP p, int j, int item, unsigned char* lds) {
  const int tid = tidx_(), lane = tid & 63, wave = tid >> 6;
  const int b = item >> 3, h = item & 7;
  const size_t row = NPR + b;
  float* QKV = (float*)lds; float* RED = (float*)(lds + 1536); float* PART = (float*)(lds + 2048);
  const bf16_t* proj = (const bf16_t*)(p->ws + WS_PROJ);
  const int dv4 = tid & 31, dkq = tid >> 5;
  const float* S0 = p->in[I_SDEL] + (size_t)((j * 128 + b) * 8 + h) * 16384;
  float4 s[8];
#pragma unroll
  for (int r = 0; r < 8; ++r) s[r] = *(const float4*)(S0 + (dkq * 8 + r) * 128 + dv4 * 4);
  const float* t = (const float*)(p->ws + WS_TAIL) + row * 16;
  const float traw_a = t[8 + h], traw_b = t[h], alog = p->in[I_ALOG][j * 8 + h], dtb = p->in[I_DTB][j * 8 + h];
  if (tid < 384) {
    const int part = tid >> 7, ch = tid & 127, col = part * 1024 + h * 128 + ch;
    const float* st = p->in[I_SCB] + (size_t)((j * 128 + b) * 3) * 3072 + col;
    const float x0 = st[0], x1 = st[3072], x2 = st[6144], x3 = bf2f(proj[row * 6144 + 2048 + col]);
    const float* cw = p->in[I_CBW] + (size_t)(j * 4) * 3072 + col;
    const float val = siluf_(cw[0] * x0 + cw[3072] * x1 + cw[6144] * x2 + cw[9216] * x3);
    float* so = p->out + O_SCB + (size_t)((j * 128 + b) * 3) * 3072 + col;
    so[0] = x1; so[3072] = x2; so[6144] = x3;
    QKV[tid] = val;
    const float ss = wave_sum(val * val);
    if (lane == 0) RED[wave] = ss;
  }
  lds_barrier();
  const float rq = __builtin_amdgcn_rsqf(RED[0] + RED[1] + 1e-6f) * 0.08838834764831845f, rk = __builtin_amdgcn_rsqf(RED[2] + RED[3] + 1e-6f);
  const float g = -fexp_(alog) * softplusf_(traw_a + dtb);
  const float beta = sigmoidf_(traw_b), eg = fexp_(g);
  float* S1 = p->out + O_SDEL + (size_t)((j * 128 + b) * 8 + h) * 16384;
  float4 pt = make_float4(0.f, 0.f, 0.f, 0.f);
#pragma unroll
  for (int r = 0; r < 8; ++r) { const int dk = dkq * 8 + r; const float kd = QKV[128 + dk] * rk;
    pt.x += s[r].x * kd; pt.y += s[r].y * kd; pt.z += s[r].z * kd; pt.w += s[r].w * kd; }
  *(float4*)(PART + dkq * 128 + dv4 * 4) = pt;
  lds_barrier();
  float4 kv = make_float4(0.f, 0.f, 0.f, 0.f);
#pragma unroll
  for (int q = 0; q < 16; ++q) { const float4 v = *(const float4*)(PART + q * 128 + dv4 * 4); kv.x += v.x; kv.y += v.y; kv.z += v.z; kv.w += v.w; }
  const float4 vv = *(const float4*)(QKV + 256 + dv4 * 4);
  float4 vn; vn.x = beta * (vv.x - eg * kv.x); vn.y = beta * (vv.y - eg * kv.y); vn.z = beta * (vv.z - eg * kv.z); vn.w = beta * (vv.w - eg * kv.w);
  lds_barrier();
  float4 po = make_float4(0.f, 0.f, 0.f, 0.f);
#pragma unroll
  for (int r = 0; r < 8; ++r) { const int dk = dkq * 8 + r; const float kd = QKV[128 + dk] * rk, qd = QKV[dk] * rq;
    float4 n; n.x = eg * s[r].x + kd * vn.x; n.y = eg * s[r].y + kd * vn.y; n.z = eg * s[r].z + kd * vn.z; n.w = eg * s[r].w + kd * vn.w;
    *(float4*)(S1 + dk * 128 + dv4 * 4) = n;
    po.x += n.x * qd; po.y += n.y * qd; po.z += n.z * qd; po.w += n.w * qd; }
  *(float4*)(PART + dkq * 128 + dv4 * 4) = po;
  lds_barrier();
  float o = 0.f;
  if (tid < 128) {
#pragma unroll
    for (int q = 0; q < 16; ++q) o += PART[q * 128 + tid];
    const float ss = wave_sum(o * o);
    if (lane == 0) RED[8 + wave] = ss;
  }
  lds_barrier();
  if (tid < 128) {
    const float rinv = __builtin_amdgcn_rsqf((RED[8] + RED[9]) * (1.f / 128.f) + 1e-6f);
    const float zb = bf2f(proj[row * 6144 + 5120 + h * 128 + tid]);
    ((bf16_t*)(p->ws + WS_YBUF))[row * 2048 + 1024 + h * 128 + tid] = f2bf(o * rinv * p->in[I_GNW][j * 128 + tid] * siluf_(zb));
  }
}

DEVI void phase_mixprep(KP p, int layer, unsigned char* lds, int ph, int submask) {
  const int j = layer >> 1;
  unsigned* ctr = (unsigned*)(p->ws + WS_CTL) + 4096 + ph;
  int* slot = (int*)(lds + LDS_MISC);
  const bool lead = tidx_() == 0;
  int nxt = 0; if (lead) nxt = (int)atomicAdd(ctr, 1u);
  for (;;) {
    if (lead) *slot = nxt;
    lds_barrier();
    const int it = *slot;
    lds_barrier();
    if (it >= 3216) break;
    if (lead) nxt = (int)atomicAdd(ctr, 1u);
    if (it < 144) { if (submask & 1) lru_item(p, j, it, lds); }
    else if (it < 2192) { if (submask & 2) gdn_prep_item(p, j, it - 144, lds); }
    else { if (submask & 4) gdn_decode_item(p, j, it - 2192, lds); }
  }
}

struct GdnFrags { u32x4 wf[4], qf[4], qkf[2], ktf[2][2]; u32x2 uf; float egl; };
DEVI void gdn_load(GdnFrags& f, KP p, int cid, int s, int rt, int ct, int l15, int lq) {
  const bf16_t* wb = (const bf16_t*)(p->ws + WS_WB) + (size_t)cid * 8192;
  const bf16_t* qt = (const bf16_t*)(p->ws + WS_QT) + (size_t)cid * 8192;
  const bf16_t* kt = (const bf16_t*)(p->ws + WS_KT) + (size_t)cid * 8192;
  const bf16_t* qk = (const bf16_t*)(p->ws + WS_QK) + (size_t)cid * 4096;
  const bf16_t* ut = (const bf16_t*)(p->ws + WS_UT) + (size_t)cid * 8192;
  const int ln = lq * 16 + l15;
#pragma unroll
  for (int kk = 0; kk < 4; ++kk) { f.wf[kk] = *(const u32x4*)(wb + ((rt * 4 + kk) * 64 + ln) * 8); f.qf[kk] = *(const u32x4*)(qt + ((rt * 4 + kk) * 64 + ln) * 8); }
#pragma unroll
  for (int kk = 0; kk < 2; ++kk) { f.qkf[kk] = *(const u32x4*)(qk + ((rt * 2 + kk) * 64 + ln) * 8);
#pragma unroll
    for (int d2 = 0; d2 < 2; ++d2) f.ktf[d2][kk] = *(const u32x4*)(kt + (((rt * 2 + d2) * 2 + kk) * 64 + ln) * 8); }
  f.uf = *(const u32x2*)(ut + (s * 32 + ct * 16 + l15) * 64 + rt * 16 + lq * 4);
  f.egl = ((const float*)(p->ws + WS_EGL))[cid];
}
DEVI void phase_gdnseq(KP p, int layer, unsigned char* lds) {
  const int tid = tidx_(), lane = tid & 63, wave = tid >> 6;
  const int j = layer >> 1, rt = wave >> 1, ct = wave & 1, l15 = lane & 15, lq = lane >> 4;
  bf16_t* ST = (bf16_t*)lds;
  bf16_t* VT = (bf16_t*)(lds + 8704);
  bf16_t* ybuf = (bf16_t*)(p->ws + WS_YBUF);
  unsigned dsum = 0u;
  for (int item = bidx_(); item < 256; item += gdim_()) {
    const int xcd = item & 7, idx = item >> 3, bh = xcd * 8 + (idx >> 2), s = idx & 3, b = bh >> 3, h = bh & 7;
    __syncthreads();
    for (int e = tid; e < 32 * 136 / 2; e += 512) ((unsigned*)ST)[e] = 0u;
    f32x4 sacc[2]; sacc[0] = (f32x4){0.f, 0.f, 0.f, 0.f}; sacc[1] = (f32x4){0.f, 0.f, 0.f, 0.f};
    GdnFrags nx; gdn_load(nx, p, bh * 32, s, rt, ct, l15, lq);
    __syncthreads();
    unsigned dprev = 0u; f32x4 oprev = (f32x4){0.f, 0.f, 0.f, 0.f};
    for (int c = 0; c < 32; ++c) {
      const GdnFrags cu = nx;
      if (c > 0) {
        bf16_t* yo = ybuf + (size_t)(b * 2048 + (c - 1) * 64 + rt * 16 + lq * 4) * 2048 + 1024 + h * 128 + s * 32 + ct * 16 + l15;
#pragma unroll
        for (int r = 0; r < 4; ++r) yo[(size_t)r * 2048] = f2bf(oprev[r]);
        asm volatile("" ::: "memory");
      }
      if (c + 1 < 32) gdn_load(nx, p, bh * 32 + c + 1, s, rt, ct, l15, lq);
      f32x4 wsa = (f32x4){0.f, 0.f, 0.f, 0.f}, oa = (f32x4){0.f, 0.f, 0.f, 0.f};
#pragma unroll
      for (int kk = 0; kk < 4; ++kk) { const bf16x8 sb = *(const bf16x8*)(ST + (ct * 16 + l15) * 136 + lq * 8 + kk * 32);
        wsa = mfma16(as_bf16x8(cu.wf[kk]), sb, wsa); oa = mfma16(as_bf16x8(cu.qf[kk]), sb, oa); }
      { const float u0 = bflo(cu.uf.x), u1 = bfhi(cu.uf.x), u2 = bflo(cu.uf.y), u3 = bfhi(cu.uf.y);
        u32x2 w; w.x = cvt_pk_bf16(u0 - wsa[0], u1 - wsa[1]); w.y = cvt_pk_bf16(u2 - wsa[2], u3 - wsa[3]);
        *(u32x2*)(VT + (ct * 16 + l15) * 72 + rt * 16 + lq * 4) = w; }
      lds_barrier();
      bf16x8 vb[2];
#pragma unroll
      for (int kk = 0; kk < 2; ++kk) vb[kk] = *(const bf16x8*)(VT + (ct * 16 + l15) * 72 + lq * 8 + kk * 32);
#pragma unroll
      for (int kk = 0; kk < 2; ++kk) oa = mfma16(as_bf16x8(cu.qkf[kk]), vb[kk], oa);
#pragma unroll
      for (int d2 = 0; d2 < 2; ++d2) { sacc[d2] = sacc[d2] * cu.egl;
#pragma unroll
        for (int kk = 0; kk < 2; ++kk) sacc[d2] = mfma16(as_bf16x8(cu.ktf[d2][kk]), vb[kk], sacc[d2]); }
      oprev = oa;
#pragma unroll
      for (int d2 = 0; d2 < 2; ++d2) { u32x2 w; w.x = cvt_pk_bf16(sacc[d2][0], sacc[d2][1]); w.y = cvt_pk_bf16(sacc[d2][2], sacc[d2][3]);
        *(u32x2*)(ST + (ct * 16 + l15) * 136 + (rt * 2 + d2) * 16 + lq * 4) = w; }
      lds_barrier();
    }
    { bf16_t* yo = ybuf + (size_t)(b * 2048 + 31 * 64 + rt * 16 + lq * 4) * 2048 + 1024 + h * 128 + s * 32 + ct * 16 + l15;
#pragma unroll
      for (int r = 0; r < 4; ++r) yo[(size_t)r * 2048] = f2bf(oprev[r]); }
    float* pd = p->out + O_PDEL + (size_t)((j * 8 + b) * 8 + h) * 16384;
#pragma unroll
    for (int d2 = 0; d2 < 2; ++d2)
#pragma unroll
      for (int r = 0; r < 4; ++r) pd[(size_t)((rt * 2 + d2) * 16 + lq * 4 + r) * 128 + s * 32 + ct * 16 + l15] = sacc[d2][r];
  }
  if (dsum == 0x9e3779b9u) ((unsigned*)(p->ws + WS_CTL))[5000] = dsum;
}

DEVI void phase_onorm(KP p, int layer) {
  const int tid = tidx_(), lane = tid & 63, wave = tid >> 6, j = layer >> 1;
  bf16_t* ybuf = (bf16_t*)(p->ws + WS_YBUF); const bf16_t* proj = (const bf16_t*)(p->ws + WS_PROJ);
  float gw[16];
#pragma unroll
  for (int e = 0; e < 16; ++e) gw[e] = p->in[I_GNW][j * 128 + ((lane * 16 + e) & 127)];
  const int rstep = gdim_() * 8;
  for (int r = bidx_() * 8 + wave; r < NPR; r += 2 * rstep) {
    const bool two = r + rstep < NPR;
    bf16_t* yp[2]; u32x4 yv[2][2], zv[2][2];
#pragma unroll
    for (int q = 0; q < 2; ++q) { const int rr = (q == 0 || two) ? r + q * rstep : r;
      yp[q] = ybuf + (size_t)rr * 2048 + 1024 + lane * 16; const bf16_t* zp = proj + (size_t)rr * 6144 + 5120 + lane * 16;
      yv[q][0] = *(const u32x4*)yp[q]; yv[q][1] = *(const u32x4*)(yp[q] + 8); zv[q][0] = *(const u32x4*)zp; zv[q][1] = *(const u32x4*)(zp + 8); }
#pragma unroll
    for (int q = 0; q < 2; ++q) {
      float o[16], z[16]; { float t[8]; unpack8(yv[q][0], t);
#pragma unroll
        for (int e = 0; e < 8; ++e) o[e] = t[e];
        unpack8(yv[q][1], t);
#pragma unroll
        for (int e = 0; e < 8; ++e) o[8 + e] = t[e];
        unpack8(zv[q][0], t);
#pragma unroll
        for (int e = 0; e < 8; ++e) z[e] = t[e];
        unpack8(zv[q][1], t);
#pragma unroll
        for (int e = 0; e < 8; ++e) z[8 + e] = t[e]; }
      float ss = 0.f;
#pragma unroll
      for (int e = 0; e < 16; ++e) ss += o[e] * o[e];
      ss += __shfl_xor(ss, 1); ss += __shfl_xor(ss, 2); ss += __shfl_xor(ss, 4);
      const float rinv = __builtin_amdgcn_rsqf(ss * (1.f / 128.f) + 1e-6f);
      float a[8], cq[8];
#pragma unroll
      for (int e = 0; e < 8; ++e) { a[e] = o[e] * rinv * gw[e] * siluf_(z[e]); cq[e] = o[8 + e] * rinv * gw[8 + e] * siluf_(z[8 + e]); }
      if (q == 0 || two) { *(u32x4*)yp[q] = pack8(a); *(u32x4*)(yp[q] + 8) = pack8(cq); }
    }
  }
}

struct S5C { bf16x8 Bf[8], Cf[4]; float abr, abi, dch; };
template <bool OUT, bool SAMPLE>
DEVI void s5_chunks(KP p, const S5C& c, int jc, int g, size_t rbase, int nch, int sgrp, float& xr, float& xi, float* BU, bf16_t* XB, int lane) {
  const int l15 = lane & 15, lq = lane >> 4;
  const bf16_t* proj = (const bf16_t*)(p->ws + WS_PROJ);
  bf16_t* y1 = (bf16_t*)(p->ws + WS_YBUF);
  u32x4 unx = (u32x4){0u, 0u, 0u, 0u}; bf16_t uenx[4] = {0, 0, 0, 0};
  if (lq < 2) unx = *(const u32x4*)(proj + (rbase + l15) * 2048 + g * 16 + lq * 8);
  if (OUT) {
#pragma unroll
    for (int r = 0; r < 4; ++r) uenx[r] = proj[(rbase + lq * 4 + r) * 2048 + g * 16 + l15]; }
  for (int ck = 0; ck < nch; ++ck) {
    const size_t row0 = rbase + (size_t)ck * 16;
    const u32x4 ucur = unx; bf16_t uec[4];
#pragma unroll
    for (int r = 0; r < 4; ++r) uec[r] = uenx[r];
    if (ck + 1 < nch) { if (lq < 2) unx = *(const u32x4*)(proj + (row0 + 16 + l15) * 2048 + g * 16 + lq * 8);
      if (OUT) {
#pragma unroll
        for (int r = 0; r < 4; ++r) uenx[r] = proj[(row0 + 16 + lq * 4 + r) * 2048 + g * 16 + l15]; } }
#pragma unroll
    for (int nt = 0; nt < 8; ++nt) { const f32x4 acc = mfma16(as_bf16x8(ucur), c.Bf[nt], (f32x4){0.f, 0.f, 0.f, 0.f});
      *(f32x4*)(BU + (nt * 16 + l15) * 20 + lq * 4) = acc; }
    asm volatile("s_waitcnt lgkmcnt(0)" ::: "memory");
    float br[16], bi[16];
#pragma unroll
    for (int t4 = 0; t4 < 4; ++t4) { const f32x4 a = *(const f32x4*)(BU + lane * 20 + t4 * 4), b = *(const f32x4*)(BU + (64 + lane) * 20 + t4 * 4);
#pragma unroll
      for (int e = 0; e < 4; ++e) { br[t4 * 4 + e] = a[e]; bi[t4 * 4 + e] = b[e]; } }
    if (!SAMPLE) {
#pragma unroll
      for (int t = 0; t < 16; ++t) { const float nr = c.abr * xr - c.abi * xi + br[t], ni = c.abr * xi + c.abi * xr + bi[t]; xr = nr; xi = ni;
        if (OUT) *(unsigned*)(XB + t * 136 + 2 * lane) = cvt_pk_bf16(xr, xi); }
    } else {
#pragma unroll
      for (int t = 0; t < 16; ++t) { const size_t si = ((size_t)(jc * 128 + sgrp * 16 + t) * 64 + g) * 64 + lane;
        const float x0r = p->in[I_SSR][si], x0i = p->in[I_SSI][si];
        const float nr = c.abr * x0r - c.abi * x0i + br[t], ni = c.abr * x0i + c.abi * x0r + bi[t];
        p->out[O_SSR + si] = nr; p->out[O_SSI + si] = ni;
        *(unsigned*)(XB + t * 136 + 2 * lane) = cvt_pk_bf16(nr, ni); }
    }
    if (OUT) {
      asm volatile("s_waitcnt lgkmcnt(0)" ::: "memory");
      f32x4 ya = (f32x4){0.f, 0.f, 0.f, 0.f};
#pragma unroll
      for (int kk = 0; kk < 4; ++kk) ya = mfma16(*(const bf16x8*)(XB + l15 * 136 + lq * 8 + kk * 32), c.Cf[kk], ya);
#pragma unroll
      for (int r = 0; r < 4; ++r) { const float y = ya[r] + c.dch * bf2f(uec[r]); y1[(row0 + lq * 4 + r) * 1024 + g * 16 + l15] = f2bf(geluf_(y)); }
    }
  }
}
DEVI void s5_setup(KP p, S5C& c, int jc, int g, int lane) {
  const int l15 = lane & 15, lq = lane >> 4, gi = jc * 64 + g;
  const float dt = __expf(p->in[I_LOGDT][gi]);
  { const float are = p->in[I_ARE][gi * 64 + lane], aim = p->in[I_AIM][gi * 64 + lane]; const float mag = __expf(are * dt); c.abr = mag * __cosf(aim * dt); c.abi = mag * __sinf(aim * dt); }
#pragma unroll
  for (int nt = 0; nt < 8; ++nt) {
    float v[8];
#pragma unroll
    for (int e = 0; e < 8; ++e) v[e] = 0.f;
    if (lq < 2) {
      const int pp = (nt & 3) * 16 + l15;
      const float are = p->in[I_ARE][gi * 64 + pp], aim = p->in[I_AIM][gi * 64 + pp]; const float mag = __expf(are * dt); const float sn = __sinf(aim * dt), cs = __cosf(aim * dt);
      const float nr = mag * cs - 1.f, ni = mag * sn, den = 1.f / (are * are + aim * aim);
      const float cr = (nr * are + ni * aim) * den, ci = (ni * are - nr * aim) * den;
      const float* br = p->in[I_BRE] + (size_t)(gi * 64 + pp) * 16 + lq * 8; const float* bi = p->in[I_BIM] + (size_t)(gi * 64 + pp) * 16 + lq * 8;
#pragma unroll
      for (int e = 0; e < 8; ++e) v[e] = (nt >= 4) ? (cr * bi[e] + ci * br[e]) : (cr * br[e] - ci * bi[e]);
    }
    c.Bf[nt] = as_bf16x8(pack8(v));
  }
#pragma unroll
  for (int kk = 0; kk < 4; ++kk) { const int p0 = lq * 4 + kk * 16;
    const float* sre = p->in[I_CRE] + (size_t)(gi * 16 + l15) * 64 + p0; const float* sim = p->in[I_CIM] + (size_t)(gi * 16 + l15) * 64 + p0; float v[8];
#pragma unroll
    for (int m = 0; m < 4; ++m) { v[2 * m] = sre[m]; v[2 * m + 1] = -sim[m]; }
    c.Cf[kk] = as_bf16x8(pack8(v)); }
  c.dch = p->in[I_S5D][jc * 1024 + g * 16 + l15];
}
DEVI void phase_s5(KP p, int layer, unsigned char* lds) {
  const int tid = tidx_(), lane = tid & 63, wave = tid >> 6, jc = layer >> 1;
  float* BU = (float*)(lds + wave * 14592);
  bf16_t* XB = (bf16_t*)(lds + wave * 14592 + 10240);
  float* EX = (float*)(lds + 116736);
  const int cb = wave >> 2, seg = wave & 3;
  for (int cp = bidx_(); cp < 256; cp += gdim_()) {
    const int q = cp * 2 + cb, b = q >> 6, g = q & 63;
    S5C c; s5_setup(p, c, jc, g, lane);
    float xr = 0.f, xi = 0.f;
    const size_t rbase = (size_t)b * 2048 + (size_t)seg * 512;
    const int nch2 = 32;
    if (seg < 3) {
      s5_chunks<false, false>(p, c, jc, g, rbase, 32, 0, xr, xi, BU, XB, lane);
      EX[wave * 128 + lane] = xr; EX[wave * 128 + 64 + lane] = xi;
    } else {
      const int qs = cp * 2 + cb, gs = qs & 63, sgrp = qs >> 6;
      S5C cs; s5_setup(p, cs, jc, gs, lane);
      float dr = 0.f, di = 0.f;
      s5_chunks<true, true>(p, cs, jc, gs, (size_t)(NPR + sgrp * 16), 1, sgrp, dr, di, BU, XB, lane);
    }
    __syncthreads();
    float pr = c.abr, pi = c.abi;
#pragma unroll
    for (int s = 0; s < 9; ++s) { const float nr = pr * pr - pi * pi, ni = 2.f * pr * pi; pr = nr; pi = ni; }
    xr = 0.f; xi = 0.f;
    for (int s = 0; s < seg; ++s) { const float er = EX[(cb * 4 + s) * 128 + lane], ei = EX[(cb * 4 + s) * 128 + 64 + lane];
      const float nr = pr * xr - pi * xi + er, ni = pr * xi + pi * xr + ei; xr = nr; xi = ni; }
    s5_chunks<true, false>(p, c, jc, g, rbase, nch2, 0, xr, xi, BU, XB, lane);
    if (seg == 3) { const size_t si = ((size_t)(jc * 8 + b) * 64 + g) * 64 + lane; p->out[O_PSR + si] = xr; p->out[O_PSI + si] = xi; }
    __syncthreads();
  }
}

DEVI void phase_final(KP p) {
  const int tid = tidx_(), lane = tid & 63, wave = tid >> 6;
  const float* nw = p->in[I_FNW];
  float4 w4[4];
#pragma unroll
  for (int i = 0; i < 4; ++i) w4[i] = *(const float4*)(nw + i * 256 + lane * 4);
  for (int r = (bidx_() * 8 + wave) * 2; r < NRV; r += gdim_() * 16) {
    float* x0 = p->out + (size_t)r * 1024; float* x1 = x0 + 1024; float4 v0[4], v1[4]; float s0 = 0.f, s1 = 0.f;
#pragma unroll
    for (int i = 0; i < 4; ++i) { v0[i] = *(const float4*)(x0 + i * 256 + lane * 4); v1[i] = *(const float4*)(x1 + i * 256 + lane * 4); }
#pragma unroll
    for (int i = 0; i < 4; ++i) { s0 += v0[i].x * v0[i].x + v0[i].y * v0[i].y + v0[i].z * v0[i].z + v0[i].w * v0[i].w; s1 += v1[i].x * v1[i].x + v1[i].y * v1[i].y + v1[i].z * v1[i].z + v1[i].w * v1[i].w; }
#pragma unroll
    for (int o = 32; o >= 1; o >>= 1) { s0 += __shfl_xor(s0, o); s1 += __shfl_xor(s1, o); }
    const float r0 = __builtin_amdgcn_rsqf(s0 * (1.f / 1024.f) + 1e-6f), r1 = __builtin_amdgcn_rsqf(s1 * (1.f / 1024.f) + 1e-6f);
#pragma unroll
    for (int i = 0; i < 4; ++i) { float4 o; o.x = v0[i].x * r0 * w4[i].x; o.y = v0[i].y * r0 * w4[i].y; o.z = v0[i].z * r0 * w4[i].z; o.w = v0[i].w * r0 * w4[i].w; *(float4*)(x0 + i * 256 + lane * 4) = o;
      float4 q; q.x = v1[i].x * r1 * w4[i].x; q.y = v1[i].y * r1 * w4[i].y; q.z = v1[i].z * r1 * w4[i].z; q.w = v1[i].w * r1 * w4[i].w; *(float4*)(x1 + i * 256 + lane * 4) = q; }
  }
}

template <class F>
DEVI void sample_gemm(const bf16_t* __restrict__ A, int lda, const bf16_t* __restrict__ Bt, int N, int K, F&& epi, float* red) {
  const int tid = tidx_(), lane = tid & 63, wave = tid >> 6, l15 = lane & 15, lq = lane >> 4, rt2 = wave & 1, kq = wave >> 1;
  const int kq_len = K >> 2, nitems = (N / 16) * 4;
  for (int it = gdim_() - 1 - bidx_(); it < nitems; it += gdim_()) {
    const int s = it >> 2, rg = it & 3, row0 = rg * 32 + rt2 * 16;
    const bf16_t* ap = A + (size_t)(row0 + l15) * lda + lq * 8 + kq * kq_len;
    const bf16_t* bp = Bt + (size_t)(s * 16 + l15) * K + lq * 8 + kq * kq_len;
    f32x4 acc0 = (f32x4){0.f, 0.f, 0.f, 0.f}, acc1 = (f32x4){0.f, 0.f, 0.f, 0.f};
    for (int k0 = 0; k0 < kq_len; k0 += 256) {
      u32x4 a[8], b[8];
#pragma unroll
      for (int u = 0; u < 8; ++u) { a[u] = *(const u32x4*)(ap + k0 + u * 32); b[u] = *(const u32x4*)(bp + k0 + u * 32); }
#pragma unroll
      for (int u = 0; u < 8; u += 2) { acc0 = mfma16(as_bf16x8(a[u]), as_bf16x8(b[u]), acc0); acc1 = mfma16(as_bf16x8(a[u + 1]), as_bf16x8(b[u + 1]), acc1); }
    }
    acc0 = acc0 + acc1;
    lds_barrier();
    *(f32x4*)(red + ((kq * 2 + rt2) * 64 + lane) * 4) = acc0;
    lds_barrier();
    if (kq == 0) {
      f32x4 t = acc0;
#pragma unroll
      for (int q = 1; q < 4; ++q) t = t + *(const f32x4*)(red + ((q * 2 + rt2) * 64 + lane) * 4);
#pragma unroll
      for (int r = 0; r < 4; ++r) epi(row0 + lq * 4 + r, s * 16 + l15, t[r]);
    }
  }
}

constexpr int N_PHASES = 25;
#ifndef PROBE_SUB
#define PROBE_SUB 7
#endif
#ifndef ONLY_KIND
#define ONLY_KIND -1
#endif
#define KON(k) ((ONLY_KIND < 0 || ONLY_KIND == (k)) && kind == (k))
__global__ void __launch_bounds__(512, 2) mega(Params p_unused) {
  extern __shared__ __attribute__((aligned(16))) unsigned char shm[];
  cg::grid_group grid = cg::this_grid();
  PG8_LAS unsigned char* ldsg = (PG8_LAS unsigned char*)shm;
  KP p0 = (KP)__builtin_amdgcn_kernarg_segment_ptr();
  const int ph_lo = p0->ph_lo, ph_hi = p0->ph_hi;
  volatile LAS unsigned* xst = (volatile LAS unsigned*)(ldsg + LDS_MISC + 16);
  if (threadIdx.x == 0) { xst[0] = 0u; xst[1] = 0u; }
  __syncthreads();
  XcdBarrier xb = xcd_barrier_post((unsigned*)(p0->ws + WS_CTL), xst);
  int rep = 0;
  for (int ph = ph_lo; ph < ph_hi; ++ph) {
    KP p = p0; asm volatile("" : "+s"(p));
    int kind, layer = 0;
    if (ph == 0) kind = 0; else if (ph == 1) kind = 1; else if (ph == 24) kind = 12;
    else { const int q = ph - 2, pair = q / 11, rem = q % 11;
      if (rem < 6) { layer = 2 * pair; kind = (rem == 0) ? 2 : 2 + rem; }
      else { layer = 2 * pair + 1; const int s = rem - 6; kind = (s == 0) ? 2 : 7 + s; } }
    const int j = layer >> 1;
    if (KON(0)) phase_prep(p, (float*)shm);
    else if (KON(2)) phase_norm(p, layer, (float*)shm);
    else if (KON(4)) phase_mixprep(p, layer, shm, ph + 32 * rep, rep ? PROBE_SUB : 7);
    else if (KON(5)) phase_gdnseq(p, layer, shm);
    else if (KON(6)) phase_onorm(p, layer);
    else if (KON(9)) phase_s5(p, layer, shm);
    else if (KON(12)) phase_final(p);
    else if (KON(1)) {
      pg8::Gemm g{(const bf16_t*)(p->ws + WS_SILUC), (const bf16_t*)(p->ws + WS_WT_MOD), 256, 12288, 1024};
      pg8::StaticOrder S; S.init(256, 12288, gdim_(), bidx_());
      pg8::EpiF32 E{(float*)(p->ws + WS_MOD), 12288, p->in[I_MODB]};
      pg8::gemm_phase<pg8::EpiF32, pg8::StaticOrder, false>(ldsg, g, S, E, nullptr);
    } else if (KON(3) || KON(8)) {
      const bool ab = kind == 3; const int N = ab ? 6144 : 2048;
      const bf16_t* Bt = ab ? (const bf16_t*)(p->ws + WS_WT_INAB) + (size_t)j * 6144 * 1024 : (const bf16_t*)(p->ws + WS_WT_CIN) + (size_t)j * 2048 * 1024;
      pg8::Gemm g{(const bf16_t*)(p->ws + WS_YBUF), Bt, NPR, N, 1024};
      pg8::StaticOrder S; S.init(NPR, N, gdim_(), bidx_());
      pg8::EpiBf16<0> E{(bf16_t*)(p->ws + WS_PROJ), N, nullptr, 0, 0};
      pg8::gemm_phase<pg8::EpiBf16<0>, pg8::StaticOrder, false>(ldsg, g, S, E, nullptr);
      bf16_t* po = (bf16_t*)(p->ws + WS_PROJ) + (size_t)NPR * N;
      sample_gemm((const bf16_t*)(p->ws + WS_YBUF) + (size_t)NPR * 1024, 1024, Bt, N, 1024, [&](int r, int c, float v) { po[(size_t)r * N + c] = f2bf(v); }, (float*)shm);
      if (ab) tail_gemm(p, j);
    } else if (KON(7) || KON(11)) {
      const bool ab = kind == 7; const int K = ab ? 2048 : 1024;
      const bf16_t* Ab = ab ? (const bf16_t*)(p->ws + WS_YBUF) : (const bf16_t*)(p->ws + WS_Y2);
      const bf16_t* Bt = ab ? (const bf16_t*)(p->ws + WS_WT_OUTAB) + (size_t)j * 1024 * 2048 : (const bf16_t*)(p->ws + WS_WT_COUT) + (size_t)j * 1024 * 1024;
      pg8::Gemm g{Ab, Bt, NPR, 1024, K};
      pg8::StaticOrder S; S.init(NPR, 1024, gdim_(), bidx_());
      const float* gatep = (const float*)(p->ws + WS_MOD) + layer * 3072 + 2048;
      EpiRes E{layer == 0 ? p->in[I_XP] : p->out, layer == 0 ? p->in[I_XS] : p->out + (size_t)NPR * 1024, p->out, gatep};
      pg8::gemm_phase<EpiRes, pg8::StaticOrder, false>(ldsg, g, S, E, nullptr);
      const float* xsi = layer == 0 ? p->in[I_XS] : p->out + (size_t)NPR * 1024; float* xso = p->out + (size_t)NPR * 1024;
      sample_gemm(Ab + (size_t)NPR * K, K, Bt, 1024, K, [&](int r, int c, float v) { xso[(size_t)r * 1024 + c] = xsi[(size_t)r * 1024 + c] + gatep[(size_t)(8 + r) * 12288 + c] * v; }, (float*)shm);
    } else if (KON(10)) {
      const bf16_t* Bt = (const bf16_t*)(p->ws + WS_WT_GLU) + (size_t)j * 1024 * 1024;
      pg8::Gemm g{(const bf16_t*)(p->ws + WS_YBUF), Bt, NPR, 1024, 1024};
      pg8::StaticOrder S; S.init(NPR, 1024, gdim_(), bidx_());
      const float* gb = p->in[I_GLUB] + j * 1024;
      EpiGlu E{(const bf16_t*)(p->ws + WS_YBUF), (const bf16_t*)(p->ws + WS_PROJ) + 1024, (bf16_t*)(p->ws + WS_Y2), gb};
      pg8::gemm_phase<EpiGlu, pg8::StaticOrder, false>(ldsg, g, S, E, nullptr);
      const bf16_t* y1s = (const bf16_t*)(p->ws + WS_YBUF) + (size_t)NPR * 1024; const bf16_t* zs = (const bf16_t*)(p->ws + WS_PROJ) + (size_t)NPR * 2048 + 1024; bf16_t* y2s = (bf16_t*)(p->ws + WS_Y2) + (size_t)NPR * 1024;
      sample_gemm(y1s, 1024, Bt, 1024, 1024, [&](int r, int c, float v) { y2s[(size_t)r * 1024 + c] = f2bf(bf2f(y1s[(size_t)r * 1024 + c]) * sigmoidf_(v + gb[c]) * siluf_(bf2f(zs[(size_t)r * 2048 + c]))); }, (float*)shm);
    }
#ifdef REPEAT_KIND
    if (kind == REPEAT_KIND && rep == 0) { rep = 1; --ph; } else rep = 0;
#endif
    if (ph + 1 < ph_hi) { if (ph_hi > 100000) grid.sync();
      xcd_barrier(xb); }
  }
}

#ifndef MK_MULTI
#define MK_MULTI 0
#endif
#ifndef PH_HI
#define PH_HI N_PHASES
#endif
extern "C" void kernel_launch(void* const* d_in, const int* in_sizes, int n_in, void* d_out, int out_size, void* d_ws, size_t ws_size, hipStream_t stream) {
  static int grid = 0;
  if (grid == 0) {
    if (n_in != N_IN || (size_t)out_size != O_END || ws_size < WS_END) { fprintf(stderr, "kernel_launch: unexpected shapes: n_in %d out %d ws %zu (need %zu)\n", n_in, out_size, ws_size, (size_t)WS_END); grid = -1; return; }
    int dev = 0, cus = 0, per_cu = 0;
    if (hipGetDevice(&dev) != hipSuccess || hipDeviceGetAttribute(&cus, hipDeviceAttributeMultiprocessorCount, dev) != hipSuccess) { grid = -1; return; }
    if (hipFuncSetAttribute((const void*)mega, hipFuncAttributeMaxDynamicSharedMemorySize, LDS_BYTES) != hipSuccess) { fprintf(stderr, "kernel_launch: hipFuncSetAttribute failed\n"); grid = -1; return; }
    if (hipOccupancyMaxActiveBlocksPerMultiprocessor(&per_cu, (const void*)mega, 512, LDS_BYTES) != hipSuccess || per_cu < 1) { fprintf(stderr, "kernel_launch: occupancy query says %d\n", per_cu); per_cu = 1; }
    (void)hipGetLastError();
    grid = cus;
  }
  if (grid < 0) return;
  if (hipMemsetAsync((char*)d_ws + WS_CTL, 0, 32768, stream) != hipSuccess) { fprintf(stderr, "kernel_launch: memset failed\n"); return; }
  Params p{};
  for (int i = 0; i < N_IN; ++i) p.in[i] = (const float*)d_in[i];
  p.out = (float*)d_out; p.ws = (unsigned char*)d_ws;
#if MK_MULTI
  for (int ph = 0; ph < N_PHASES; ++ph) { p.ph_lo = ph; p.ph_hi = ph + 1; hipLaunchKernelGGL(mega, dim3(grid), dim3(512), LDS_BYTES, stream, p); }
#else
  p.ph_lo = 0; p.ph_hi = PH_HI;
  void* args[] = {&p};
  hipError_t e = hipLaunchCooperativeKernel((void*)mega, dim3(grid), dim3(512), args, LDS_BYTES, stream);
  if (e != hipSuccess) fprintf(stderr, "kernel_launch: cooperative launch failed: %s (grid %d)\n", hipGetErrorString(e), grid);
#endif
}
```

```cpp
#include <hip/hip_runtime.h>
#include <hip/hip_cooperative_groups.h>
#include <cstdio>
namespace cg = cooperative_groups;
__device__ __forceinline__ int tidx_() { int t = threadIdx.x; asm volatile("" : "+v"(t)); return t; }
__device__ __forceinline__ int bidx_() { int t = blockIdx.x; asm volatile("" : "+s"(t)); return t; }
__device__ __forceinline__ int gdim_() { int t = gridDim.x; asm volatile("" : "+s"(t)); return t; }
namespace pg8 {
#define PG8_LAS __attribute__((address_space(3)))
typedef unsigned short bf16_t;
typedef short bf16x8 __attribute__((ext_vector_type(8)));
typedef float f32x4 __attribute__((ext_vector_type(4)));
typedef unsigned u32x4 __attribute__((ext_vector_type(4)));
constexpr int BM = 256, BK = 64, HALF = 128, HTB = HALF * BK * 2  , STAGE_BYTES = 8 * HTB, NXCD = 8, WGM = 8;

__host__ __device__ __forceinline__ int lds_byte(int r, int c) { const int st = (r >> 4) * 2 + (c >> 5), rr = r & 15, cc = c & 31, ob = rr * 64 + cc * 2; return st * 1024 + (ob ^ (((ob >> 9) & 1) << 5)); }
__host__ __device__ __forceinline__ void stage_rc(int b, int& R, int& C) { const int st = b / 1024, sb = b % 1024, swz = sb ^ (((sb >> 9) & 1) << 5); R = (st >> 1) * 16 + swz / 64; C = (st & 1) * 32 + (swz % 64) / 2; }
__host__ __device__ __forceinline__ int perm32(int rho) { const int n = rho >> 4, i = rho & 15; return 8 * (i >> 2) + 4 * n + (i & 3); }

struct Unit { int pm, pn; };
struct Gemm { const bf16_t* A; const bf16_t* Bt; int M, N, K; };

struct StaticOrder {
    int nM, nN, nwg, G, c;
    __host__ __device__ void init(int M, int N, int G_, int c_) { nM = M / BM; nN = N / BM; nwg = nM * nN; G = G_; c = c_; }
    __host__ __device__ bool next(int i, Unit& u) const {
        const long L = (long)i * G + c; if (L >= nwg) return false;
        int wgid = (int)L; { const int q = nwg / NXCD, r = nwg % NXCD, xcd = wgid % NXCD, off = wgid / NXCD; wgid = (xcd < r ? xcd * (q + 1) : r * (q + 1) + (xcd - r) * q) + off; }
        const int nig = WGM * nN, gid = wgid / nig, fm = gid * WGM, gsz = (nM - fm) < WGM ? (nM - fm) : WGM;
        u.pm = fm + ((wgid % nig) % gsz); u.pn = (wgid % nig) / gsz; return true;
    }
    __device__ __forceinline__ void a_ready(const Unit&) const {}
    __device__ __forceinline__ void done(const Unit&) const {}
};
typedef float f32x2cv __attribute__((ext_vector_type(2)));
typedef __bf16 bf16x2cv __attribute__((ext_vector_type(2)));
__device__ __forceinline__ unsigned cvt_pk_bf16(float lo, float hi) { f32x2cv v = {lo, hi}; bf16x2cv b = __builtin_convertvector(v, bf16x2cv); return __builtin_bit_cast(unsigned, b); }
typedef float f32x2 __attribute__((ext_vector_type(2)));
__device__ __forceinline__ f32x2 gelu_pk(f32x2 v) {
    const f32x2 av = __builtin_elementwise_abs(v), d = av * 0.2316418882f + 1.0f;
    f32x2 t; t.x = __builtin_amdgcn_rcpf(d.x); t.y = __builtin_amdgcn_rcpf(d.y);
    f32x2 q = t * 0.5307027145f + (-0.7265760135f); q = q * t + 0.7107068705f; q = q * t + (-0.142248368f); q = q * t + 0.127414796f; q = q * t;
    const f32x2 s = (v * v) * (-0.72134752044f);
    f32x2 e; e.x = __builtin_amdgcn_exp2f(s.x); e.y = __builtin_amdgcn_exp2f(s.y);
    const f32x2 m = v * (q * e), r = v - m;
    f32x2 o; o.x = v.x < 0.f ? m.x : r.x; o.y = v.y < 0.f ? m.y : r.y; return o;
}

struct EpiF32 {
    static constexpr bool PERM = false, AFTER_DRAIN = false;
    float* C; int ldc; const float* bias;
    __device__ __forceinline__ void operator()(const f32x4 (&acc)[2][2][4][2], const Unit& u, int wr, int wc, int fr, int fq) const {
        const int row0 = u.pm * BM + wr * 64 + fr, col0 = u.pn * BM + wc * 32 + 4 * fq;
        f32x4 bv[2][2];
#pragma unroll
        for (int bj = 0; bj < 2; ++bj)
#pragma unroll
            for (int n = 0; n < 2; ++n) bv[bj][n] = bias ? *(const f32x4*)(bias + col0 + bj * HALF + n * 16) : (f32x4){0.f, 0.f, 0.f, 0.f};
#pragma unroll
        for (int ai = 0; ai < 2; ++ai)
#pragma unroll
            for (int m = 0; m < 4; ++m) { float* rowp = C + (size_t)(row0 + ai * HALF + m * 16) * ldc + col0;
#pragma unroll
                for (int bj = 0; bj < 2; ++bj)
#pragma unroll
                    for (int n = 0; n < 2; ++n) *(f32x4*)(rowp + bj * HALF + n * 16) = acc[ai][bj][m][n] + bv[bj][n]; }
    }
};
template <int ACT  > struct EpiBf16 {
    static constexpr bool PERM = true, AFTER_DRAIN = false;
    bf16_t* O; int ldc; const float* bias; int split_cols; size_t split_stride;
    __device__ __forceinline__ void operator()(const f32x4 (&acc)[2][2][4][2], const Unit& u, int wr, int wc, int fr, int fq) const {
        const int row0 = u.pm * BM + wr * 64 + fr; int colt = u.pn * BM; bf16_t* base = O;
        if (split_cols) { const int t = colt / split_cols; base += (size_t)t * split_stride; colt -= t * split_cols; }
        const int col0 = colt + wc * 32 + 8 * fq, bcol0 = u.pn * BM + wc * 32 + 8 * fq;
        f32x4 bv[2][2];
#pragma unroll
        for (int bj = 0; bj < 2; ++bj)
#pragma unroll
            for (int n = 0; n < 2; ++n) bv[bj][n] = bias ? *(const f32x4*)(bias + bcol0 + bj * HALF + 4 * n) : (f32x4){0.f, 0.f, 0.f, 0.f};
#pragma unroll
        for (int ai = 0; ai < 2; ++ai)
#pragma unroll
            for (int m = 0; m < 4; ++m) { bf16_t* rowp = base + (size_t)(row0 + ai * HALF + m * 16) * ldc + col0;
#pragma unroll
                for (int bj = 0; bj < 2; ++bj) { f32x4 v0 = acc[ai][bj][m][0] + bv[bj][0], v1 = acc[ai][bj][m][1] + bv[bj][1];
                    if (ACT == 1) { f32x2 a = gelu_pk((f32x2){v0[0], v0[1]}), b = gelu_pk((f32x2){v0[2], v0[3]}), c = gelu_pk((f32x2){v1[0], v1[1]}), d = gelu_pk((f32x2){v1[2], v1[3]});
                        v0 = (f32x4){a.x, a.y, b.x, b.y}; v1 = (f32x4){c.x, c.y, d.x, d.y}; }
                    if (ACT == 2) {
#pragma unroll
                        for (int j = 0; j < 4; ++j) { v0[j] = 0.5f * v0[j] * (1.0f + erff(v0[j] * 0.70710678f)); v1[j] = 0.5f * v1[j] * (1.0f + erff(v1[j] * 0.70710678f)); } }
                    u32x4 w; w.x = cvt_pk_bf16(v0[0], v0[1]); w.y = cvt_pk_bf16(v0[2], v0[3]); w.z = cvt_pk_bf16(v1[0], v1[1]); w.w = cvt_pk_bf16(v1[2], v1[3]);
                    *(u32x4*)(rowp + bj * HALF) = w; } }
    }
};
template <class Epi, class Sched, bool STAMP = false>
__device__ __forceinline__ void gemm_phase(PG8_LAS unsigned char* lds, const Gemm g, const Sched& S, const Epi& E, unsigned long long* stamps) {
    const int tid = tidx_(), wid = __builtin_amdgcn_readfirstlane(tid >> 6), lane = tid & 63, wr = wid >> 2, wc = wid & 3, fr = lane & 15, fq = lane >> 4;
    const int K = g.K, nt = K / BK;
    int ts_lo = 0, ts_hi = 0, nts = 0; const unsigned long long rt_entry = STAMP ? (unsigned long long)wall_clock64() : 0ull;
#define PG8_STAMP() do { if (STAMP && wid == 0 && nts < 64) { const unsigned long long _c = (unsigned long long)clock64(); \
        ts_lo = (lane == nts) ? (int)(unsigned)_c : ts_lo; ts_hi = (lane == nts) ? (int)(unsigned)(_c >> 32) : ts_hi; ++nts; } } while (0)
    PG8_STAMP();
    unsigned voffA[2], voffB[2];
#pragma unroll
    for (int i = 0; i < 2; ++i) { int R, C; stage_rc(tid * 16 + i * 8192, R, C); const int Rb = Epi::PERM ? ((R & ~31) + perm32(R & 31)) : R;
        voffA[i] = (unsigned)(R * K + C) * 2u; voffB[i] = (unsigned)(Rb * K + C) * 2u; }
    const size_t kstep = (size_t)(BK * 2);
    const size_t hstep = (size_t)HALF * K * 2;
    const size_t tstep = 2 * hstep;
    const unsigned ldsw = (unsigned)wid * 1024u;
    const int aoff = lds_byte(wr * 64 + fr, fq * 8), boff = lds_byte(wc * 32 + fr, fq * 8);
#define PG8_SA(b, h) (((b) * 2 + (h)) * HTB)
#define PG8_SB(b, h) ((4 + (b) * 2 + (h)) * HTB)
#define PG8_STAGE(bufoff, gbase, voff) do { _Pragma("unroll") for (int _i = 0; _i < 2; ++_i) \
        __builtin_amdgcn_global_load_lds((const unsigned*)((const char*)(gbase) + (voff)[_i]), (PG8_LAS unsigned*)(lds + (bufoff) + ldsw + _i * 8192), 16, 0, 0); } while (0)
#define PG8_LDA(dst, b, h) do { _Pragma("unroll") for (int m = 0; m < 4; ++m) _Pragma("unroll") for (int k = 0; k < 2; ++k) dst[m][k] = *(const PG8_LAS bf16x8*)(lds + PG8_SA(b, h) + aoff + m * 2048 + k * 1024); } while (0)
#define PG8_LDB(dst, b, h) do { _Pragma("unroll") for (int n = 0; n < 2; ++n) _Pragma("unroll") for (int k = 0; k < 2; ++k) dst[n][k] = *(const PG8_LAS bf16x8*)(lds + PG8_SB(b, h) + boff + n * 2048 + k * 1024); } while (0)
#define PG8_MMA(ai, bj, At, Bt) do { __builtin_amdgcn_s_setprio(1); _Pragma("unroll") for (int m = 0; m < 4; ++m) _Pragma("unroll") for (int n = 0; n < 2; ++n) _Pragma("unroll") for (int k = 0; k < 2; ++k) \
        acc[ai][bj][m][n] = __builtin_amdgcn_mfma_f32_16x16x32_bf16(Bt[n][k], At[m][k], acc[ai][bj][m][n], 0, 0, 0); __builtin_amdgcn_s_setprio(0); } while (0)
#define PG8_WAIT_V(n) asm volatile("s_waitcnt vmcnt(" #n ")" ::: "memory")
#define PG8_WAIT_L(n) asm volatile("s_waitcnt lgkmcnt(" #n ")" ::: "memory")
#define PG8_BAR __builtin_amdgcn_s_barrier()
#define PG8_SCHED __builtin_amdgcn_sched_barrier(0)
    Unit cur, nxt; int ui = 0;
    if (!S.next(0, cur)) return;
    f32x4 acc[2][2][4][2];
#pragma unroll
    for (int a = 0; a < 2; ++a)
#pragma unroll
        for (int b = 0; b < 2; ++b)
#pragma unroll
            for (int m = 0; m < 4; ++m)
#pragma unroll
                for (int n = 0; n < 2; ++n) acc[a][b][m][n] = (f32x4){0.f, 0.f, 0.f, 0.f};
    bf16x8 At[4][2], B0[2][2], B1[2][2];
    const char* cA = (const char*)g.A + (size_t)cur.pm * tstep; const char* cB = (const char*)g.Bt + (size_t)cur.pn * tstep;
    S.a_ready(cur);
    PG8_STAGE(PG8_SB(0, 0), cB, voffB); PG8_STAGE(PG8_SA(0, 0), cA, voffA); PG8_STAGE(PG8_SB(0, 1), cB + hstep, voffB); PG8_STAGE(PG8_SA(0, 1), cA + hstep, voffA);
    if (wr == 1) PG8_BAR;
    PG8_WAIT_V(4); PG8_BAR;
    PG8_STAGE(PG8_SB(1, 0), cB + kstep, voffB); PG8_STAGE(PG8_SA(1, 0), cA + kstep, voffA); PG8_STAGE(PG8_SB(1, 1), cB + hstep + kstep, voffB);
    PG8_WAIT_V(6); PG8_BAR;
    PG8_STAMP();
    for (;;) {
        const bool has_next = S.next(ui + 1, nxt);
        const char* nA = has_next ? (const char*)g.A + (size_t)nxt.pm * tstep : cA; const char* nB = has_next ? (const char*)g.Bt + (size_t)nxt.pn * tstep : cB;
        for (int t = 0; t < nt; t += 2) {
            const bool last = (t == nt - 2);
            const char* a1 = cA + (size_t)(t + 1) * kstep;
            const char* a2 = last ? nA : cA + (size_t)(t + 2) * kstep; const char* b2 = last ? nB : cB + (size_t)(t + 2) * kstep;
            const char* a3 = a2 + kstep; const char* b3 = b2 + kstep;
            if (last && has_next) S.a_ready(nxt);
            PG8_LDB(B0, 0, 0); PG8_SCHED; PG8_LDA(At, 0, 0); PG8_STAGE(PG8_SA(1, 1), a1 + hstep, voffA);
            PG8_WAIT_L(8); PG8_BAR; PG8_WAIT_L(0); PG8_MMA(0, 0, At, B0); PG8_BAR; PG8_SCHED;
            PG8_LDB(B1, 0, 1); PG8_STAGE(PG8_SB(0, 0), b2, voffB);
            PG8_BAR; PG8_WAIT_L(0); PG8_MMA(0, 1, At, B1); PG8_BAR;
            PG8_LDA(At, 0, 1); PG8_STAGE(PG8_SA(0, 0), a2, voffA);
            PG8_BAR; PG8_WAIT_L(0); PG8_MMA(1, 0, At, B0); PG8_BAR; PG8_SCHED;
            PG8_STAGE(PG8_SB(0, 1), b2 + hstep, voffB);
            PG8_WAIT_V(6); PG8_BAR; PG8_MMA(1, 1, At, B1); PG8_BAR;
            PG8_LDB(B0, 1, 0); PG8_SCHED; PG8_LDA(At, 1, 0); PG8_STAGE(PG8_SA(0, 1), a2 + hstep, voffA);
            PG8_WAIT_L(8); PG8_BAR; PG8_WAIT_L(0); PG8_MMA(0, 0, At, B0); PG8_BAR; PG8_SCHED;
            PG8_LDB(B1, 1, 1); PG8_STAGE(PG8_SB(1, 0), b3, voffB);
            PG8_BAR; PG8_WAIT_L(0); PG8_MMA(0, 1, At, B1); PG8_BAR;
            PG8_LDA(At, 1, 1); PG8_STAGE(PG8_SA(1, 0), a3, voffA);
            PG8_BAR; PG8_WAIT_L(0); PG8_MMA(1, 0, At, B0); PG8_BAR; PG8_SCHED;
            PG8_STAGE(PG8_SB(1, 1), b3 + hstep, voffB);
            PG8_WAIT_V(6); PG8_BAR; PG8_MMA(1, 1, At, B1); PG8_BAR;
        }
        PG8_STAMP();
        if constexpr (!Epi::AFTER_DRAIN) { E(acc, cur, wr, wc, fr, fq); S.done(cur); }
        PG8_STAMP();
        if (!has_next) break;
#pragma unroll
        for (int a = 0; a < 2; ++a)
#pragma unroll
            for (int b = 0; b < 2; ++b)
#pragma unroll
                for (int m = 0; m < 4; ++m)
#pragma unroll
                    for (int n = 0; n < 2; ++n) acc[a][b][m][n] = (f32x4){0.f, 0.f, 0.f, 0.f};
        cur = nxt; cA = nA; cB = nB; ++ui;
    }
    PG8_WAIT_V(0);
    if (wr == 0) PG8_BAR;
    PG8_BAR;
    if constexpr (Epi::AFTER_DRAIN) { E.fused(acc, cur, wr, wc, fr, fq, lds, wid, lane); S.done(cur); }
    PG8_STAMP();
    if (STAMP && wid == 0) { stamps[lane] = lane < nts ? (((unsigned long long)(unsigned)ts_hi << 32) | (unsigned)ts_lo) : 0ull;
        if (lane == 62) stamps[62] = rt_entry; if (lane == 63) stamps[63] = (unsigned long long)wall_clock64(); }
#undef PG8_STAMP
#undef PG8_SA
#undef PG8_SB
#undef PG8_STAGE
#undef PG8_LDA
#undef PG8_LDB
#undef PG8_MMA
#undef PG8_WAIT_V
#undef PG8_WAIT_L
#undef PG8_BAR
#undef PG8_SCHED
}
}
#define LAS __attribute__((address_space(3)))
#define XB_TMO      128
#define XB_XCNT(j)  (256  + 64 * (j))
#define XB_XSUB(j)  (1280 + 64 * (j))
#define XB_XGEN(j)  (2304 + 64 * (j))
#define XB_TOP      3328
#define XB_TOPGEN   3392
#define XCD_BAR_WORDS 3456
#define XB_SPIN_CAP (1u << 18)

__device__ __forceinline__ unsigned xb_ld(unsigned* p)              { return __hip_atomic_load(p, __ATOMIC_RELAXED, __HIP_MEMORY_SCOPE_AGENT); }
__device__ __forceinline__ unsigned xb_add(unsigned* p, unsigned v) { return __hip_atomic_fetch_add(p, v, __ATOMIC_RELAXED, __HIP_MEMORY_SCOPE_AGENT); }
__device__ __forceinline__ unsigned xb_xcc_id() { return (unsigned)__builtin_amdgcn_s_getreg((3 << 11) | 20) & 0xFu; }
#define XB_SPIN(cond, bar) do { unsigned _sp = 0; while (cond) { __builtin_amdgcn_s_sleep(1); \
    if ((++_sp & 255u) == 0u) { if (xb_ld(&(bar)[XB_TMO])) break; if (_sp > XB_SPIN_CAP) { atomicAdd(&(bar)[XB_TMO], 1u); break; } } } } while (0)

struct XcdBarrier {
    unsigned* bar; unsigned x;
    volatile LAS unsigned* st;
};

__device__ __forceinline__ XcdBarrier xcd_barrier_post(unsigned* bar, volatile LAS unsigned* st) {
    XcdBarrier b; b.bar = bar; b.x = xb_xcc_id(); b.st = st;
    if (threadIdx.x == 0) (void)xb_add(&bar[XB_XCNT(b.x)], 1u);
    return b;
}
__device__ __forceinline__ void xcd_barrier_complete(unsigned* bar, unsigned x, unsigned& nloc, unsigned& nx) {
    const unsigned G = gridDim.x * gridDim.y * gridDim.z;
    unsigned sum, cnt, mine, sp = 0u;
    for (;;) {
        sum = 0u; cnt = 0u; mine = 0u;
#pragma unroll
        for (unsigned j = 0; j < 16; ++j) { const unsigned c = xb_ld(&bar[XB_XCNT(j)]); sum += c; cnt += (c > 0u) ? 1u : 0u; mine = (j == x) ? c : mine; }
        if (sum == G) break;
        __builtin_amdgcn_s_sleep(1);
        if ((++sp & 255u) == 0u) { if (xb_ld(&bar[XB_TMO])) break; if (sp > XB_SPIN_CAP) { atomicAdd(&bar[XB_TMO], 1u); break; } }
    }
    nloc = mine > 0u ? mine : 1u; nx = cnt > 0u ? cnt : 1u;
}

__device__ __forceinline__ void xcd_barrier(const XcdBarrier& b) {
    asm volatile("s_waitcnt vmcnt(0)" ::: "memory");
    __syncthreads();
    if (threadIdx.x == 0) {
        unsigned* bar = b.bar;
        __builtin_amdgcn_s_waitcnt(0);
        unsigned nloc = b.st[0], nx = b.st[1];
        if (nloc == 0u) { xcd_barrier_complete(bar, b.x, nloc, nx); b.st[0] = nloc; b.st[1] = nx; }
        const unsigned old = xb_add(&bar[XB_XSUB(b.x)], 1u);
        const unsigned gen = old / nloc;
        if (old + 1u == (gen + 1u) * nloc) {
            __builtin_amdgcn_fence(__ATOMIC_RELEASE, "agent");
            asm volatile("s_waitcnt vmcnt(0)" ::: "memory");
            const unsigned og = xb_add(&bar[XB_TOP], 1u);
            const unsigned tg = og / nx;
            if (og + 1u == (tg + 1u) * nx) xb_add(&bar[XB_TOPGEN], 1u);
            else XB_SPIN(xb_ld(&bar[XB_TOPGEN]) == tg, bar);
            __builtin_amdgcn_fence(__ATOMIC_ACQUIRE, "agent");
            xb_add(&bar[XB_XGEN(b.x)], 1u);
            asm volatile("s_waitcnt vmcnt(0)" ::: "memory");
        } else {
            XB_SPIN(xb_ld(&bar[XB_XGEN(b.x)]) == gen, bar);
            __builtin_amdgcn_fence(__ATOMIC_ACQUIRE, "agent");
            asm volatile("s_waitcnt vmcnt(0)" ::: "memory");
        }
    }
    __syncthreads();
}


using pg8::bf16_t; using pg8::bf16x8; using pg8::f32x4; using pg8::u32x4; using pg8::cvt_pk_bf16;
typedef unsigned u32x2 __attribute__((ext_vector_type(2)));
#define DEVI __device__ __forceinline__

constexpr int NPR = 16384, NRV = 16512, NRP = 16640;
constexpr int LDS_BYTES = 135168;
constexpr int LDS_MISC = 131072;

constexpr size_t WS_CTL = 0;
constexpr size_t WS_WT_MOD = 32768;
constexpr size_t WS_WT_INAB = WS_WT_MOD + 25165824;
constexpr size_t WS_WT_OUTAB = WS_WT_INAB + 25165824;
constexpr size_t WS_WT_CIN = WS_WT_OUTAB + 8388608;
constexpr size_t WS_WT_GLU = WS_WT_CIN + 8388608;
constexpr size_t WS_WT_COUT = WS_WT_GLU + 4194304;
constexpr size_t WS_WT_LRU = WS_WT_COUT + 4194304;
constexpr size_t WS_SILUC = WS_WT_LRU + 1048576;
constexpr size_t WS_MOD = WS_SILUC + 524288;
constexpr size_t WS_TAIL = WS_MOD + 12582912;
constexpr size_t WS_YBUF = WS_TAIL + 1064960;
constexpr size_t WS_PROJ = WS_YBUF + 68157440;
constexpr size_t WS_UT = WS_PROJ + 204472320;
constexpr size_t WS_WB = WS_UT + 33554432;
constexpr size_t WS_QT = WS_WB + 33554432;
constexpr size_t WS_KT = WS_QT + 33554432;
constexpr size_t WS_EGL = WS_KT + 33554432;
constexpr size_t WS_WT_TAIL = WS_EGL + 8192;
constexpr size_t WS_END = WS_WT_TAIL + 65536;
constexpr size_t WS_QK = WS_WT_MOD;
constexpr size_t WS_Y2 = WS_YBUF + 34078720;

constexpr size_t O_YP = 0, O_YS = 16777216, O_PCA = O_YS + 131072, O_PLRU = O_PCA + 49152, O_PCB = O_PLRU + 16384, O_PDEL = O_PCB + 147456,
                 O_PSR = O_PDEL + 2097152, O_PSI = O_PSR + 65536, O_SCA = O_PSI + 65536, O_SLRU = O_SCA + 786432, O_SCB = O_SLRU + 262144,
                 O_SDEL = O_SCB + 2359296, O_SSR = O_SDEL + 33554432, O_SSI = O_SSR + 1048576, O_END = O_SSI + 1048576;

enum { I_XP = 0, I_XS, I_CP, I_CS, I_SCA, I_SLRU, I_SCB, I_SDEL, I_SSR, I_SSI, I_NORMW, I_MODW, I_MODB, I_ABIN, I_ABOUT, I_CAW, I_CAB, I_GXW, I_GXB, I_GAW, I_GAB, I_APAR,
       I_CBW, I_ALOG, I_DTB, I_GNW, I_CIN, I_COUT, I_ARE, I_AIM, I_BRE, I_BIM, I_CRE, I_CIM, I_S5D, I_LOGDT, I_GLUW, I_GLUB, I_FNW, N_IN };

struct Params {
  const float* in[N_IN];
  float* out;
  unsigned char* ws;
  int ph_lo, ph_hi;
};

typedef const Params __attribute__((address_space(4)))* KP;
DEVI float bf2f(unsigned v16) { return __uint_as_float(v16 << 16); }
DEVI float bflo(unsigned w) { return __uint_as_float(w << 16); }
DEVI float bfhi(unsigned w) { return __uint_as_float(w & 0xffff0000u); }
DEVI bf16_t f2bf(float f) { return (bf16_t)(cvt_pk_bf16(f, 0.f) & 0xffffu); }
DEVI float fexp_(float x) { return __builtin_amdgcn_exp2f(x * 1.4426950408889634f); }
DEVI float sigmoidf_(float x) { return __builtin_amdgcn_rcpf(1.f + fexp_(-x)); }
DEVI float siluf_(float x) { return x * __builtin_amdgcn_rcpf(1.f + fexp_(-x)); }
DEVI float softplusf_(float x) { return x > 20.f ? x : log1pf(__expf(x)); }
DEVI float geluf_(float x) { const float z = 0.7978845608028654f * (x + 0.044715f * x * x * x); const float e = fexp_(2.f * z); return x - x * __builtin_amdgcn_rcpf(1.f + e); }
DEVI void lds_barrier() { asm volatile("s_waitcnt lgkmcnt(0)" ::: "memory"); __builtin_amdgcn_s_barrier(); asm volatile("" ::: "memory"); }
DEVI float wave_sum(float v) {
#pragma unroll
  for (int o = 32; o >= 1; o >>= 1) v += __shfl_xor(v, o);
  return v;
}
DEVI void unpack8(const u32x4 w, float (&f)[8]) { f[0] = bflo(w.x); f[1] = bfhi(w.x); f[2] = bflo(w.y); f[3] = bfhi(w.y); f[4] = bflo(w.z); f[5] = bfhi(w.z); f[6] = bflo(w.w); f[7] = bfhi(w.w); }
DEVI u32x4 pack8(const float (&f)[8]) { u32x4 w; w.x = cvt_pk_bf16(f[0], f[1]); w.y = cvt_pk_bf16(f[2], f[3]); w.z = cvt_pk_bf16(f[4], f[5]); w.w = cvt_pk_bf16(f[6], f[7]); return w; }
DEVI bf16x8 as_bf16x8(const u32x4 w) { union { u32x4 u; bf16x8 b; } c; c.u = w; return c.b; }
DEVI f32x4 mfma16(bf16x8 a, bf16x8 b, f32x4 c) { return __builtin_amdgcn_mfma_f32_16x16x32_bf16(a, b, c, 0, 0, 0); }

struct EpiRes {
  static constexpr bool PERM = false, AFTER_DRAIN = false;
  const float* xp; const float* xs; float* xo; const float* gate;
  __device__ __forceinline__ void operator()(const f32x4 (&acc)[2][2][4][2], const pg8::Unit& u, int wr, int wc, int fr, int fq) const {
    const int row0 = u.pm * 256 + wr * 64 + fr, col0 = u.pn * 256 + wc * 32 + 4 * fq;
#pragma unroll
    for (int ai = 0; ai < 2; ++ai)
#pragma unroll
      for (int m = 0; m < 4; ++m) {
        const int row = row0 + ai * 128 + m * 16;
        if (row < NRV) {
          const float* xi = (row < NPR ? xp + (size_t)row * 1024 : xs + (size_t)(row - NPR) * 1024) + col0;
          const int mrow = row < NPR ? (row >> 11) : 8 + (row - NPR);
          const float* gp = gate + (size_t)mrow * 12288 + col0;
          float* op = xo + (size_t)row * 1024 + col0;
#pragma unroll
          for (int bj = 0; bj < 2; ++bj)
#pragma unroll
            for (int n = 0; n < 2; ++n) {
              const f32x4 xv = *(const f32x4*)(xi + bj * 128 + n * 16), gv = *(const f32x4*)(gp + bj * 128 + n * 16);
              *(f32x4*)(op + bj * 128 + n * 16) = xv + gv * acc[ai][bj][m][n];
            }
        }
      }
  }
};
struct EpiGlu {
  static constexpr bool PERM = true, AFTER_DRAIN = false;
  const bf16_t* y1; const bf16_t* z; bf16_t* y2; const float* bias;
  __device__ __forceinline__ void operator()(const f32x4 (&acc)[2][2][4][2], const pg8::Unit& u, int wr, int wc, int fr, int fq) const {
    const int row0 = u.pm * 256 + wr * 64 + fr, col0 = u.pn * 256 + wc * 32 + 8 * fq;
#pragma unroll
    for (int ai = 0; ai < 2; ++ai)
#pragma unroll
      for (int m = 0; m < 4; ++m) {
        const int row = row0 + ai * 128 + m * 16;
#pragma unroll
        for (int bj = 0; bj < 2; ++bj) {
          const int col = col0 + bj * 128;
          const f32x4 b0 = *(const f32x4*)(bias + col), b1 = *(const f32x4*)(bias + col + 4);
          const u32x4 yw = *(const u32x4*)(y1 + (size_t)row * 1024 + col), zw = *(const u32x4*)(z + (size_t)row * 2048 + col);
          float yf[8], zf[8], o[8]; unpack8(yw, yf); unpack8(zw, zf);
          const f32x4 a0 = acc[ai][bj][m][0] + b0, a1 = acc[ai][bj][m][1] + b1;
#pragma unroll
          for (int e = 0; e < 4; ++e) { o[e] = yf[e] * sigmoidf_(a0[e]) * siluf_(zf[e]); o[4 + e] = yf[4 + e] * sigmoidf_(a1[e]) * siluf_(zf[4 + e]); }
          *(u32x4*)(y2 + (size_t)row * 1024 + col) = pack8(o);
        }
      }
  }
};

struct TileDesc { const float* src; bf16_t* dst; int ldsrc, lddst, k0, n0; };
DEVI TileDesc prep_tile(KP p, int t) {
  TileDesc d; int tt = t;
  if (tt < 3072) { const int mat = tt / 768, r = tt % 768; d.k0 = (r / 48) * 64; d.n0 = (r % 48) * 64; d.src = p->in[I_MODW] + (size_t)mat * 1024 * 3072; d.ldsrc = 3072; d.dst = (bf16_t*)(p->ws + WS_WT_MOD) + (size_t)mat * 3072 * 1024; d.lddst = 1024; }
  else if ((tt -= 3072) < 3072) { const int mat = tt / 1536, r = tt % 1536; d.k0 = (r / 96) * 64; d.n0 = (r % 96) * 64; d.src = p->in[I_ABIN] + (size_t)mat * 1024 * 6160; d.ldsrc = 6160; d.dst = (bf16_t*)(p->ws + WS_WT_INAB) + (size_t)mat * 6144 * 1024; d.lddst = 1024; }
  else if ((tt -= 3072) < 1024) { const int mat = tt / 512, r = tt % 512; d.k0 = (r / 16) * 64; d.n0 = (r % 16) * 64; d.src = p->in[I_ABOUT] + (size_t)mat * 2048 * 1024; d.ldsrc = 1024; d.dst = (bf16_t*)(p->ws + WS_WT_OUTAB) + (size_t)mat * 1024 * 2048; d.lddst = 2048; }
  else if ((tt -= 1024) < 1024) { const int mat = tt / 512, r = tt % 512; d.k0 = (r / 32) * 64; d.n0 = (r % 32) * 64; d.src = p->in[I_CIN] + (size_t)mat * 1024 * 2048; d.ldsrc = 2048; d.dst = (bf16_t*)(p->ws + WS_WT_CIN) + (size_t)mat * 2048 * 1024; d.lddst = 1024; }
  else if ((tt -= 1024) < 512) { const int mat = tt / 256, r = tt % 256; d.k0 = (r / 16) * 64; d.n0 = (r % 16) * 64; d.src = p->in[I_COUT] + (size_t)mat * 1024 * 1024; d.ldsrc = 1024; d.dst = (bf16_t*)(p->ws + WS_WT_COUT) + (size_t)mat * 1024 * 1024; d.lddst = 1024; }
  else if ((tt -= 512) < 512) { const int mat = tt / 256, r = tt % 256; d.k0 = (r / 16) * 64; d.n0 = (r % 16) * 64; d.src = p->in[I_GLUW] + (size_t)mat * 1024 * 1024; d.ldsrc = 1024; d.dst = (bf16_t*)(p->ws + WS_WT_GLU) + (size_t)mat * 1024 * 1024; d.lddst = 1024; }
  else { tt -= 512; const int gate = tt / 64; const int r2 = tt % 64; const int mat = r2 / 4, r = r2 % 4;
    d.k0 = (r / 2) * 64; d.n0 = (r % 2) * 64; d.src = p->in[gate ? I_GAW : I_GXW] + (size_t)mat * 16384; d.ldsrc = 128;
    d.dst = (bf16_t*)(p->ws + WS_WT_LRU) + (size_t)(((mat >> 3) * 2 + gate) * 8 + (mat & 7)) * 16384; d.lddst = 128; }
  return d;
}
DEVI void phase_prep(KP p, float* lds) {
  const int tid = tidx_(), tx = tid & 15, ty = tid >> 4, nn = tid >> 3, ks = (tid & 7) * 8;
  for (int t0 = bidx_(); t0 < 9344; t0 += 4 * gdim_()) {
    float4 v[4][2];
#pragma unroll
    for (int q = 0; q < 4; ++q) { const int t = t0 + q * gdim_();
      if (t < 9344) { const TileDesc d = prep_tile(p, t);
#pragma unroll
        for (int pp = 0; pp < 2; ++pp) v[q][pp] = *(const float4*)(d.src + (size_t)(d.k0 + ty + pp * 32) * d.ldsrc + d.n0 + tx * 4); } }
#pragma unroll
    for (int q = 0; q < 4; ++q) { float* tile = lds + q * 4160;
#pragma unroll
      for (int pp = 0; pp < 2; ++pp) { const int k = ty + pp * 32; tile[k * 65 + tx * 4 + 0] = v[q][pp].x; tile[k * 65 + tx * 4 + 1] = v[q][pp].y; tile[k * 65 + tx * 4 + 2] = v[q][pp].z; tile[k * 65 + tx * 4 + 3] = v[q][pp].w; } }
    lds_barrier();
#pragma unroll
    for (int q = 0; q < 4; ++q) { const int t = t0 + q * gdim_();
      if (t < 9344) { const TileDesc d = prep_tile(p, t); const float* tile = lds + q * 4160; float f[8];
#pragma unroll
        for (int jx = 0; jx < 8; ++jx) f[jx] = tile[(ks + jx) * 65 + nn];
        *(u32x4*)(d.dst + (size_t)(d.n0 + nn) * d.lddst + d.k0 + ks) = pack8(f); } }
    lds_barrier();
  }
  { bf16_t* wtt = (bf16_t*)(p->ws + WS_WT_TAIL);
    for (int e = bidx_() * 512 + tidx_(); e < 32768; e += gdim_() * 512) { const int jj = e >> 14, cc = (e >> 10) & 15, k = e & 1023;
      wtt[e] = f2bf(p->in[I_ABIN][(size_t)jj * 1024 * 6160 + (size_t)k * 6160 + 6144 + cc]); } }
  bf16_t* sc = (bf16_t*)(p->ws + WS_SILUC);
  for (int e = bidx_() * 512 + tidx_(); e < 256 * 1024 / 4; e += gdim_() * 512) {
    const int row = e >> 8, c4 = (e & 255) * 4; float4 v = make_float4(0.f, 0.f, 0.f, 0.f);
    if (row < 8) v = *(const float4*)(p->in[I_CP] + row * 1024 + c4); else if (row < 136) v = *(const float4*)(p->in[I_CS] + (row - 8) * 1024 + c4);
    u32x2 w; w.x = cvt_pk_bf16(row < 136 ? siluf_(v.x) : 0.f, row < 136 ? siluf_(v.y) : 0.f); w.y = cvt_pk_bf16(row < 136 ? siluf_(v.z) : 0.f, row < 136 ? siluf_(v.w) : 0.f);
    *(u32x2*)(sc + row * 1024 + c4) = w;
  }
}

DEVI void norm_row2(const float* x0, const float* x1, bool two, const float (&wm)[16], const float (&sh)[16], bf16_t* h0, bf16_t* h1, int lane) {
  float4 v0[4], v1[4]; float s0 = 0.f, s1 = 0.f;
#pragma unroll
  for (int i = 0; i < 4; ++i) { v0[i] = *(const float4*)(x0 + i * 256 + lane * 4); v1[i] = two ? *(const float4*)(x1 + i * 256 + lane * 4) : make_float4(0.f, 0.f, 0.f, 0.f); }
#pragma unroll
  for (int i = 0; i < 4; ++i) { s0 += v0[i].x * v0[i].x + v0[i].y * v0[i].y + v0[i].z * v0[i].z + v0[i].w * v0[i].w; s1 += v1[i].x * v1[i].x + v1[i].y * v1[i].y + v1[i].z * v1[i].z + v1[i].w * v1[i].w; }
#pragma unroll
  for (int o = 32; o >= 1; o >>= 1) { s0 += __shfl_xor(s0, o); s1 += __shfl_xor(s1, o); }
  const float r0 = __builtin_amdgcn_rsqf(s0 * (1.f / 1024.f) + 1e-6f), r1 = __builtin_amdgcn_rsqf(s1 * (1.f / 1024.f) + 1e-6f);
#pragma unroll
  for (int i = 0; i < 4; ++i) { const int k = i * 256 + lane * 4;
    u32x2 w; w.x = cvt_pk_bf16(v0[i].x * r0 * wm[i * 4 + 0] + sh[i * 4 + 0], v0[i].y * r0 * wm[i * 4 + 1] + sh[i * 4 + 1]); w.y = cvt_pk_bf16(v0[i].z * r0 * wm[i * 4 + 2] + sh[i * 4 + 2], v0[i].w * r0 * wm[i * 4 + 3] + sh[i * 4 + 3]);
    *(u32x2*)(h0 + k) = w;
    if (two) { u32x2 w2; w2.x = cvt_pk_bf16(v1[i].x * r1 * wm[i * 4 + 0] + sh[i * 4 + 0], v1[i].y * r1 * wm[i * 4 + 1] + sh[i * 4 + 1]); w2.y = cvt_pk_bf16(v1[i].z * r1 * wm[i * 4 + 2] + sh[i * 4 + 2], v1[i].w * r1 * wm[i * 4 + 3] + sh[i * 4 + 3]);
      *(u32x2*)(h1 + k) = w2; } }
}
DEVI void norm_coefs(KP p, int layer, int mrow, int lane, float (&wm)[16], float (&sh)[16]) {
  const float* nw = p->in[I_NORMW] + layer * 1024;
  const float* md = (const float*)(p->ws + WS_MOD) + (size_t)mrow * 12288 + layer * 3072;
#pragma unroll
  for (int i = 0; i < 4; ++i) { const int k = i * 256 + lane * 4; const float4 w4 = *(const float4*)(nw + k), s4 = *(const float4*)(md + k), c4 = *(const float4*)(md + 1024 + k);
    wm[i * 4 + 0] = w4.x * (1.f + c4.x); wm[i * 4 + 1] = w4.y * (1.f + c4.y); wm[i * 4 + 2] = w4.z * (1.f + c4.z); wm[i * 4 + 3] = w4.w * (1.f + c4.w);
    sh[i * 4 + 0] = s4.x; sh[i * 4 + 1] = s4.y; sh[i * 4 + 2] = s4.z; sh[i * 4 + 3] = s4.w; }
}
DEVI void phase_norm(KP p, int layer, float* lds) {
  const int tid = tidx_(), lane = tid & 63, wave = tid >> 6;
  bf16_t* hb = (bf16_t*)(p->ws + WS_YBUF);
  float wm[16], sh[16];
  for (int gw = bidx_() * 8 + wave; gw < 2048; gw += gdim_() * 8) {
    const int r0 = gw * 8;
    norm_coefs(p, layer, r0 >> 11, lane, wm, sh);
    const float* xb = (layer == 0) ? p->in[I_XP] : p->out;
#pragma unroll 2
    for (int i = 0; i < 8; i += 2) norm_row2(xb + (size_t)(r0 + i) * 1024, xb + (size_t)(r0 + i + 1) * 1024, true, wm, sh, hb + (size_t)(r0 + i) * 1024, hb + (size_t)(r0 + i + 1) * 1024, lane);
    if (gw < 128) {
      norm_coefs(p, layer, 8 + gw, lane, wm, sh);
      const float* xs = (layer == 0) ? p->in[I_XS] + (size_t)gw * 1024 : p->out + (size_t)(NPR + gw) * 1024;
      norm_row2(xs, xs, false, wm, sh, hb + (size_t)(NPR + gw) * 1024, hb, lane);
    }
  }
}
DEVI void tail_gemm(KP p, int j) {
  const int tid = tidx_(), lane = tid & 63, wave = tid >> 6, l15 = lane & 15, lq = lane >> 4;
  const bf16_t* hb = (const bf16_t*)(p->ws + WS_YBUF);
  const bf16_t* bp = (const bf16_t*)(p->ws + WS_WT_TAIL) + (size_t)j * 16384 + l15 * 1024 + lq * 8;
  float* tl = (float*)(p->ws + WS_TAIL);
  for (int t = bidx_() * 8 + wave; t < 1032; t += gdim_() * 8) {
    const bf16_t* ap = hb + (size_t)(t * 16 + l15) * 1024 + lq * 8;
    f32x4 acc0 = (f32x4){0.f, 0.f, 0.f, 0.f}, acc1 = (f32x4){0.f, 0.f, 0.f, 0.f};
#pragma unroll 1
    for (int k0 = 0; k0 < 1024; k0 += 256) {
      u32x4 a[8], b[8];
#pragma unroll
      for (int u = 0; u < 8; ++u) { a[u] = *(const u32x4*)(ap + k0 + u * 32); b[u] = *(const u32x4*)(bp + k0 + u * 32); }
#pragma unroll
      for (int u = 0; u < 8; u += 2) { acc0 = mfma16(as_bf16x8(a[u]), as_bf16x8(b[u]), acc0); acc1 = mfma16(as_bf16x8(a[u + 1]), as_bf16x8(b[u + 1]), acc1); }
    }
    acc0 = acc0 + acc1;
#pragma unroll
    for (int r = 0; r < 4; ++r) tl[(size_t)(t * 16 + lq * 4 + r) * 16 + l15] = acc0[r];
  }
}

DEVI void lru_item(KP p, int j, int item, unsigned char* lds) {
  const int tid = tidx_(), lane = tid & 63, wave = tid >> 6;
  const bool prompt = item < 128;
  const int b = prompt ? (item >> 4) : 0, hd = prompt ? ((item >> 1) & 7) : ((item - 128) >> 1), half = item & 1;
  bf16_t* WX = (bf16_t*)lds;
  bf16_t* XA = (bf16_t*)(lds + 34816);
  float* AA = (float*)(lds + 52224);
  float* BB = (float*)(lds + 69632);
  bf16_t* RAW = (bf16_t*)(lds + 87040);
  float* CAR = (float*)(lds + 105472);
  const bf16_t* proj = (const bf16_t*)(p->ws + WS_PROJ);
  bf16_t* ybuf = (bf16_t*)(p->ws + WS_YBUF);
  { const bf16_t* wt = (const bf16_t*)(p->ws + WS_WT_LRU);
#pragma unroll
    for (int q = 0; q < 4; ++q) { const int e = tid + q * 512, gate = e >> 10, o = (e & 1023) >> 4, c8 = e & 15;
      *(u32x4*)(WX + (gate * 64 + o) * 136 + c8 * 8) = *(const u32x4*)(wt + ((size_t)((j * 2 + gate) * 8 + hd) * 128 + half * 64 + o) * 128 + c8 * 8); } }
  const int ch8 = tid & 15, rsub = tid >> 4, chb = hd * 128 + ch8 * 8;
  float cw[4][8], cb[8];
#pragma unroll
  for (int t = 0; t < 4; ++t)
#pragma unroll
    for (int e = 0; e < 8; ++e) cw[t][e] = p->in[I_CAW][(size_t)(j * 4 + t) * 1024 + chb + e];
#pragma unroll
  for (int e = 0; e < 8; ++e) cb[e] = p->in[I_CAB][j * 1024 + chb + e];
  const int rt = wave >> 1, chh = wave & 1, l15 = lane & 15, lq = lane >> 4;
  float gxb[2], gab[2], spv[2];
#pragma unroll
  for (int c2 = 0; c2 < 2; ++c2) { const int gch = hd * 128 + half * 64 + chh * 32 + c2 * 16 + l15;
    gxb[c2] = p->in[I_GXB][j * 1024 + gch]; gab[c2] = p->in[I_GAB][j * 1024 + gch]; spv[c2] = softplusf_(-p->in[I_APAR][j * 1024 + gch]); }
  const int sch = hd * 128 + half * 64 + lane;
  float hcar = 0.f;
  const int ntiles = prompt ? 32 : 2;
  u32x4 pre[3];
  if (prompt) {
#pragma unroll
    for (int q = 0; q < 3; ++q) { const int e = tid + q * 512, row = e >> 4, c8 = e & 15, t = row - 3; pre[q] = (u32x4){0u, 0u, 0u, 0u};
      if (e < 1072 && t >= 0) pre[q] = *(const u32x4*)(proj + (size_t)(b * 2048 + t) * 6144 + hd * 128 + c8 * 8); }
  }
  for (int tile = 0; tile < ntiles; ++tile) {
    bf16_t zav[8];
#pragma unroll
    for (int i = 0; i < 8; ++i) { const size_t grow = prompt ? (size_t)(b * 2048 + tile * 64 + wave * 8 + i) : (size_t)(NPR + tile * 64 + wave * 8 + i); zav[i] = proj[grow * 6144 + 1024 + sch]; }
    if (prompt) {
#pragma unroll
      for (int q = 0; q < 3; ++q) { const int e = tid + q * 512; if (e < 1072) *(u32x4*)(RAW + (e >> 4) * 136 + (e & 15) * 8) = pre[q]; }
      if (tile + 1 < ntiles) {
#pragma unroll
        for (int q = 0; q < 3; ++q) { const int e = tid + q * 512, row = e >> 4, c8 = e & 15, t = (tile + 1) * 64 + row - 3;
          if (e < 1072) pre[q] = *(const u32x4*)(proj + (size_t)(b * 2048 + t) * 6144 + hd * 128 + c8 * 8); }
      }
      lds_barrier();
#pragma unroll
      for (int pp = 0; pp < 2; ++pp) {
        const int i = rsub + pp * 32; float acc[8];
#pragma unroll
        for (int e = 0; e < 8; ++e) acc[e] = cb[e];
#pragma unroll
        for (int tap = 0; tap < 4; ++tap) { float xf[8]; unpack8(*(const u32x4*)(RAW + (i + tap) * 136 + ch8 * 8), xf);
#pragma unroll
          for (int e = 0; e < 8; ++e) acc[e] += cw[tap][e] * xf[e]; }
        *(u32x4*)(XA + i * 136 + ch8 * 8) = pack8(acc);
      }
      if (tile == 31 && half == 0 && tid < 48) { const int r3 = tid >> 4, c8 = tid & 15; float xf[8]; unpack8(*(const u32x4*)(RAW + (64 + r3) * 136 + c8 * 8), xf);
        float* o = p->out + O_PCA + (size_t)((j * 8 + b) * 3 + r3) * 1024 + hd * 128 + c8 * 8;
        *(float4*)o = make_float4(xf[0], xf[1], xf[2], xf[3]); *(float4*)(o + 4) = make_float4(xf[4], xf[5], xf[6], xf[7]); }
    } else {
#pragma unroll
      for (int pp = 0; pp < 2; ++pp) {
        const int i = rsub + pp * 32; float acc[8], x3[8];
#pragma unroll
        for (int e = 0; e < 8; ++e) acc[e] = cb[e];
        const int brow = tile * 64 + i;
        const float* st = p->in[I_SCA] + (size_t)((j * 128 + brow) * 3) * 1024 + chb;
        float* so = p->out + O_SCA + (size_t)((j * 128 + brow) * 3) * 1024 + chb;
#pragma unroll
        for (int tap = 0; tap < 3; ++tap) { const float4 s0 = *(const float4*)(st + tap * 1024), s1 = *(const float4*)(st + tap * 1024 + 4);
          const float xf[8] = {s0.x, s0.y, s0.z, s0.w, s1.x, s1.y, s1.z, s1.w};
#pragma unroll
          for (int e = 0; e < 8; ++e) acc[e] += cw[tap][e] * xf[e];
          if (tap >= 1 && half == 0) { *(float4*)(so + (tap - 1) * 1024) = s0; *(float4*)(so + (tap - 1) * 1024 + 4) = s1; } }
        const u32x4 w = *(const u32x4*)(proj + (size_t)(NPR + brow) * 6144 + chb); unpack8(w, x3);
#pragma unroll
        for (int e = 0; e < 8; ++e) acc[e] += cw[3][e] * x3[e];
        if (half == 0) { *(float4*)(so + 2 * 1024) = make_float4(x3[0], x3[1], x3[2], x3[3]); *(float4*)(so + 2 * 1024 + 4) = make_float4(x3[4], x3[5], x3[6], x3[7]); }
        *(u32x4*)(XA + i * 136 + ch8 * 8) = pack8(acc);
      }
    }
    lds_barrier();
    f32x4 accx[2], acca[2];
#pragma unroll
    for (int c2 = 0; c2 < 2; ++c2) { accx[c2] = (f32x4){0.f, 0.f, 0.f, 0.f}; acca[c2] = (f32x4){0.f, 0.f, 0.f, 0.f}; }
#pragma unroll
    for (int kk = 0; kk < 4; ++kk) {
      const bf16x8 a = *(const bf16x8*)(XA + (rt * 16 + l15) * 136 + lq * 8 + kk * 32);
#pragma unroll
      for (int c2 = 0; c2 < 2; ++c2) {
        const bf16x8 bx = *(const bf16x8*)(WX + (chh * 32 + c2 * 16 + l15) * 136 + lq * 8 + kk * 32);
        const bf16x8 ba = *(const bf16x8*)(WX + (64 + chh * 32 + c2 * 16 + l15) * 136 + lq * 8 + kk * 32);
        accx[c2] = mfma16(a, bx, accx[c2]); acca[c2] = mfma16(a, ba, acca[c2]);
      }
    }
#pragma unroll
    for (int c2 = 0; c2 < 2; ++c2)
#pragma unroll
      for (int r = 0; r < 4; ++r) {
        const int row = rt * 16 + lq * 4 + r, oc = chh * 32 + c2 * 16 + l15;
        const float gx = sigmoidf_(accx[c2][r] + gxb[c2]), ga = sigmoidf_(acca[c2][r] + gab[c2]);
        const float log_a = -8.f * ga * spv[c2];
        const float a = fexp_(log_a);
        float mult = __builtin_amdgcn_sqrtf(fmaxf(1.f - a * a, 0.f));
        if (prompt && tile == 0 && row == 0) mult = 1.f;
        const float xv = bf2f(XA[row * 136 + half * 64 + oc]);
        AA[row * 68 + oc] = a; BB[row * 68 + oc] = mult * gx * xv;
      }
    lds_barrier();
    float hl[8], pc[8];
    { float h = 0.f, P = 1.f;
#pragma unroll
      for (int i = 0; i < 8; ++i) { const float a = AA[(wave * 8 + i) * 68 + lane], bv = BB[(wave * 8 + i) * 68 + lane];
        if (prompt) { h = a * h + bv; P *= a; hl[i] = h; pc[i] = P; } else { hl[i] = bv; pc[i] = a; } }
      CAR[(wave * 64 + lane) * 2] = P; CAR[(wave * 64 + lane) * 2 + 1] = h; }
    lds_barrier();
    float cin = 0.f;
    if (prompt) { float c = hcar;
#pragma unroll
      for (int s = 0; s < 8; ++s) { const float Ps = CAR[(s * 64 + lane) * 2], Es = CAR[(s * 64 + lane) * 2 + 1]; if (s == wave) cin = c; c = Ps * c + Es; }
      hcar = c; }
#pragma unroll
    for (int i = 0; i < 8; ++i) {
      const int rowl = tile * 64 + wave * 8 + i;
      float hv;
      if (prompt) hv = hl[i] + pc[i] * cin;
      else { const float h0 = p->in[I_SLRU][(size_t)(j * 128 + rowl) * 1024 + sch]; hv = pc[i] * h0 + hl[i]; p->out[O_SLRU + (size_t)(j * 128 + rowl) * 1024 + sch] = hv; }
      const size_t grow = prompt ? (size_t)(b * 2048 + rowl) : (size_t)(NPR + rowl);
      ybuf[grow * 2048 + sch] = f2bf(hv * siluf_(bf2f(zav[i])));
    }
  }
  if (prompt && wave == 0) p->out[O_PLRU + (size_t)(j * 8 + b) * 1024 + sch] = hcar;
}

DEVI void gdn_prep_item(KP p, int j, int cid, unsigned char* lds) {
  const int tid = tidx_(), lane = tid & 63, wave = tid >> 6;
  const int b = cid >> 8, h = (cid >> 5) & 7, c = cid & 31;
  const int row0 = b * 2048 + c * 64;
  bf16_t* QN = (bf16_t*)lds; bf16_t* KN = (bf16_t*)(lds + 17408); bf16_t* VN = (bf16_t*)(lds + 34816);
  float* AM = (float*)(lds + 52224); float* GC = (float*)(lds + 69632); float* BETA = (float*)(lds + 69888); float* BEG = (float*)(lds + 70144);
  const bf16_t* proj = (const bf16_t*)(p->ws + WS_PROJ);
  const float* tl = (const float*)(p->ws + WS_TAIL);
  if (wave == 0) {
    const float* t = tl + (size_t)(row0 + lane) * 16;
    float g = -fexp_(p->in[I_ALOG][j * 8 + h]) * softplusf_(t[8 + h] + p->in[I_DTB][j * 8 + h]);
    const float beta = sigmoidf_(t[h]);
#pragma unroll
    for (int o = 1; o < 64; o <<= 1) { const float v = __shfl_up(g, o); if (lane >= o) g += v; }
    GC[lane] = g; BETA[lane] = beta; BEG[lane] = beta * fexp_(g);
  }
  bf16_t* RAWB = (bf16_t*)(lds + 70656);
  bf16_t* AMB = (bf16_t*)(lds + 70656);
  bf16_t* XT = (bf16_t*)(lds + 79872);
  float* CORR = (float*)lds;
  float* CW = (float*)(lds + 123184);
  {
    u32x4 rv[7];
#pragma unroll
    for (int q = 0; q < 7; ++q) { const int e = tid + 512 * q, row = e / 48, c16 = e - row * 48, tt = c * 64 + row - 3; rv[q] = (u32x4){0u, 0u, 0u, 0u};
      if (e < 3216 && tt >= 0) rv[q] = *(const u32x4*)(proj + (size_t)(b * 2048 + tt) * 6144 + 2048 + (c16 >> 4) * 1024 + h * 128 + (c16 & 15) * 8); }
    float4 wv = make_float4(0.f, 0.f, 0.f, 0.f);
    if (tid < 384) { const int tap = tid / 96, lc = (tid - tap * 96) * 4; wv = *(const float4*)(p->in[I_CBW] + (size_t)(j * 4 + tap) * 3072 + (lc >> 7) * 1024 + h * 128 + (lc & 127)); }
#pragma unroll
    for (int q = 0; q < 7; ++q) { const int e = tid + 512 * q, row = e / 48, c16 = e - row * 48; if (e < 3216) *(u32x4*)(RAWB + row * 392 + c16 * 8) = rv[q]; }
    if (tid < 384) { const int tap = tid / 96, lc = (tid - tap * 96) * 4; *(float4*)(CW + tap * 384 + lc) = wv; }
  }
  lds_barrier();
  if (c == 31 && tid < 144) { const int r3 = tid / 48, c16 = tid - r3 * 48; float xf[8]; unpack8(*(const u32x4*)(RAWB + (64 + r3) * 392 + c16 * 8), xf);
    float* o = p->out + O_PCB + (size_t)((j * 8 + b) * 3 + r3) * 3072 + (c16 >> 4) * 1024 + h * 128 + (c16 & 15) * 8;
    *(float4*)o = make_float4(xf[0], xf[1], xf[2], xf[3]); *(float4*)(o + 4) = make_float4(xf[4], xf[5], xf[6], xf[7]); }
#pragma unroll 2
  for (int pi = 0; pi < 6; ++pi) {
    const int pair = tid + 512 * pi, part = pair >> 10, rem = pair & 1023, i = rem >> 4, cgp = rem & 15;
    float acc[8];
#pragma unroll
    for (int e = 0; e < 8; ++e) acc[e] = 0.f;
#pragma unroll
    for (int tap = 0; tap < 4; ++tap) { float xf[8]; unpack8(*(const u32x4*)(RAWB + (i + tap) * 392 + part * 128 + cgp * 8), xf);
      const float4 w0 = *(const float4*)(CW + tap * 384 + part * 128 + cgp * 8), w1 = *(const float4*)(CW + tap * 384 + part * 128 + cgp * 8 + 4);
      acc[0] += w0.x * xf[0]; acc[1] += w0.y * xf[1]; acc[2] += w0.z * xf[2]; acc[3] += w0.w * xf[3];
      acc[4] += w1.x * xf[4]; acc[5] += w1.y * xf[5]; acc[6] += w1.z * xf[6]; acc[7] += w1.w * xf[7]; }
    float ss = 0.f;
#pragma unroll
    for (int e = 0; e < 8; ++e) { acc[e] = siluf_(acc[e]); ss += acc[e] * acc[e]; }
    ss += __shfl_xor(ss, 1); ss += __shfl_xor(ss, 2); ss += __shfl_xor(ss, 4); ss += __shfl_xor(ss, 8);
    float scl = 1.f;
    if (part == 0) scl = __builtin_amdgcn_rsqf(ss + 1e-6f) * 0.08838834764831845f; else if (part == 1) scl = __builtin_amdgcn_rsqf(ss + 1e-6f);
#pragma unroll
    for (int e = 0; e < 8; ++e) acc[e] *= scl;
    bf16_t* dstp = part == 0 ? QN : (part == 1 ? KN : VN);
    *(u32x4*)(dstp + i * 136 + cgp * 8) = pack8(acc);
  }
  lds_barrier();
  {
    const int rt = wave >> 1, ctp = (wave & 1) * 2, l15 = lane & 15, lq = lane >> 4;
    f32x4 kka[2], qka[2];
#pragma unroll
    for (int c2 = 0; c2 < 2; ++c2) { kka[c2] = (f32x4){0.f, 0.f, 0.f, 0.f}; qka[c2] = (f32x4){0.f, 0.f, 0.f, 0.f}; }
#pragma unroll
    for (int kk = 0; kk < 4; ++kk) {
      const bf16x8 ak = *(const bf16x8*)(KN + (rt * 16 + l15) * 136 + lq * 8 + kk * 32);
      const bf16x8 aq = *(const bf16x8*)(QN + (rt * 16 + l15) * 136 + lq * 8 + kk * 32);
#pragma unroll
      for (int c2 = 0; c2 < 2; ++c2) { const bf16x8 bk = *(const bf16x8*)(KN + ((ctp + c2) * 16 + l15) * 136 + lq * 8 + kk * 32);
        kka[c2] = mfma16(ak, bk, kka[c2]); qka[c2] = mfma16(aq, bk, qka[c2]); }
    }
    bf16_t* qkg = (bf16_t*)(p->ws + WS_QK) + (size_t)cid * 4096;
#pragma unroll
    for (int c2 = 0; c2 < 2; ++c2)
#pragma unroll
      for (int r = 0; r < 4; ++r) {
        const int i = rt * 16 + lq * 4 + r, jj = (ctp + c2) * 16 + l15;
        const float dec = fexp_(fminf(GC[i] - GC[jj], 0.f));
        const float aval = (i > jj) ? BETA[i] * kka[c2][r] * dec : 0.f;
        AM[i * 68 + jj] = aval; AMB[i * 72 + jj] = f2bf(aval);
        qkg[(((i >> 4) * 2 + (jj >> 5)) * 64 + ((jj & 31) >> 3) * 16 + (i & 15)) * 8 + (jj & 7)] = f2bf((i >= jj) ? qka[c2][r] * dec : 0.f);
      }
  }
  lds_barrier();
  const int cc = tid & 255;
  const bf16_t* rsrc = (cc < 128) ? (VN + cc) : (KN + (cc - 128));
  const float* rfac = (cc < 128) ? BETA : BEG;
#pragma unroll
  for (int bi = 0; bi < 4; ++bi) {
    if (bi > 0) {
      const int l15 = lane & 15, lq = lane >> 4;
#pragma unroll
      for (int n2 = 0; n2 < 2; ++n2) { const int nt = wave * 2 + n2; f32x4 acc = (f32x4){0.f, 0.f, 0.f, 0.f};
#pragma unroll
        for (int kk = 0; kk < (bi * 16 + 31) / 32; ++kk) { const int k0 = lq * 8 + kk * 32; const bool valid = k0 < bi * 16;
          u32x4 av = *(const u32x4*)(AMB + (bi * 16 + l15) * 72 + k0), bv = *(const u32x4*)(XT + (nt * 16 + l15) * 72 + k0);
          if (!valid) { av = (u32x4){0u, 0u, 0u, 0u}; bv = (u32x4){0u, 0u, 0u, 0u}; }
          acc = mfma16(as_bf16x8(av), as_bf16x8(bv), acc); }
#pragma unroll
        for (int r = 0; r < 4; ++r) CORR[(lq * 4 + r) * 260 + nt * 16 + l15] = acc[r]; }
      lds_barrier();
    }
    if (tid < 256) {
      float xb[16], rh[16];
#pragma unroll
      for (int ii = 0; ii < 16; ++ii) { const int i = bi * 16 + ii; rh[ii] = bf2f(rsrc[i * 136]) * rfac[i]; if (bi > 0) rh[ii] -= CORR[ii * 260 + cc]; }
#pragma unroll
      for (int rg = 0; rg < 4; ++rg) {
        f32x4 a[4][4];
#pragma unroll
        for (int q = 0; q < 4; ++q)
#pragma unroll
          for (int g4 = 0; g4 <= rg; ++g4) a[q][g4] = *(const f32x4*)(AM + (bi * 16 + rg * 4 + q) * 68 + bi * 16 + g4 * 4);
#pragma unroll
        for (int q = 0; q < 4; ++q) { const int ii = rg * 4 + q; float s = rh[ii];
#pragma unroll
          for (int jj = 0; jj < ii; ++jj) s -= a[q][jj >> 2][jj & 3] * xb[jj];
          xb[ii] = s; }
        asm volatile("" : "+v"(xb[rg * 4 + 3]) :: "memory");
      }
      u32x4 w0, w1;
      w0.x = cvt_pk_bf16(xb[0], xb[1]); w0.y = cvt_pk_bf16(xb[2], xb[3]); w0.z = cvt_pk_bf16(xb[4], xb[5]); w0.w = cvt_pk_bf16(xb[6], xb[7]);
      w1.x = cvt_pk_bf16(xb[8], xb[9]); w1.y = cvt_pk_bf16(xb[10], xb[11]); w1.z = cvt_pk_bf16(xb[12], xb[13]); w1.w = cvt_pk_bf16(xb[14], xb[15]);
      if (bi < 3) { *(u32x4*)(XT + cc * 72 + bi * 16) = w0; *(u32x4*)(XT + cc * 72 + bi * 16 + 8) = w1; }
      if (cc < 128) {
        bf16_t* ut = (bf16_t*)(p->ws + WS_UT) + (size_t)cid * 8192 + cc * 64 + bi * 16;
        *(u32x4*)ut = w0; *(u32x4*)(ut + 8) = w1;
      } else {
        const int dk = cc - 128;
        bf16_t* wb = (bf16_t*)(p->ws + WS_WB) + (size_t)cid * 8192 + ((bi * 4 + (dk >> 5)) * 64 + ((dk & 31) >> 3) * 16) * 8 + (dk & 7);
#pragma unroll
        for (int ii = 0; ii < 16; ++ii) wb[ii * 8] = f2bf(xb[ii]);
      }
    } else if (bi == 0) {
      const int t2 = tid - 256;
      { const int i = t2 >> 2, dseg = (t2 & 3) * 32; const float eg = fexp_(GC[i]);
        bf16_t* qt = (bf16_t*)(p->ws + WS_QT) + (size_t)cid * 8192 + (((i >> 4) * 4 + (t2 & 3)) * 64 + (i & 15)) * 8;
#pragma unroll
        for (int s = 0; s < 4; ++s) { float f[8]; unpack8(*(const u32x4*)(QN + i * 136 + dseg + s * 8), f);
#pragma unroll
          for (int e = 0; e < 8; ++e) f[e] *= eg;
          *(u32x4*)(qt + s * 128) = pack8(f); } }
      { const int d = t2 >> 1, iseg = (t2 & 1) * 32; const float gl = GC[63];
        bf16_t* kt = (bf16_t*)(p->ws + WS_KT) + (size_t)cid * 8192 + (((d >> 4) * 2 + (t2 & 1)) * 64 + (d & 15)) * 8;
#pragma unroll
        for (int s = 0; s < 4; ++s) { float f[8];
#pragma unroll
          for (int e = 0; e < 8; ++e) { const int i = iseg + s * 8 + e; f[e] = bf2f(KN[i * 136 + d]) * fexp_(gl - GC[i]); }
          *(u32x4*)(kt + s * 128) = pack8(f); } }
      if (t2 == 0) ((float*)(p->ws + WS_EGL))[cid] = fexp_(GC[63]);
    }
    if (bi < 3) lds_barrier();
  }
}

DEVI void gdn_decode_item(KP p, int j, int item, unsigned char* lds) {
  const int tid = tidx_(), lane = tid & 63, wave = tid >> 6;
  const int b = item >> 3, h = item & 7;
  const size_t row = NPR + b;
  float* QKV = (float*)lds; float* RED = (float*)(lds + 1536); float* PART = (float*)(lds + 2048);
  const bf16_t* proj = (const bf16_t*)(p->ws + WS_PROJ);
  const int dv4 = tid & 31, dkq = tid >> 5;
  const float* S0 = p->in[I_SDEL] + (size_t)((j * 128 + b) * 8 + h) * 16384;
  float4 s[8];
#pragma unroll
  for (int r = 0; r < 8; ++r) { const f32x4 t4 = __builtin_nontemporal_load((const f32x4*)(S0 + (dkq * 8 + r) * 128 + dv4 * 4)); s[r] = make_float4(t4[0], t4[1], t4[2], t4[3]); }
  const float* t = (const float*)(p->ws + WS_TAIL) + row * 16;
  const float traw_a = t[8 + h], traw_b = t[h], alog = p->in[I_ALOG][j * 8 + h], dtb = p->in[I_DTB][j * 8 + h];
  if (tid < 384) {
    const int part = tid >> 7, ch = tid & 127, col = part * 1024 + h * 128 + ch;
    const float* st = p->in[I_SCB] + (size_t)((j * 128 + b) * 3) * 3072 + col;
    const float x0 = st[0], x1 = st[3072], x2 = st[6144], x3 = bf2f(proj[row * 6144 + 2048 + col]);
    const float* cw = p->in[I_CBW] + (size_t)(j * 4) * 3072 + col;
    const float val = siluf_(cw[0] * x0 + cw[3072] * x1 + cw[6144] * x2 + cw[9216] * x3);
    float* so = p->out + O_SCB + (size_t)((j * 128 + b) * 3) * 3072 + col;
    so[0] = x1; so[3072] = x2; so[6144] = x3;
    QKV[tid] = val;
    const float ss = wave_sum(val * val);
    if (lane == 0) RED[wave] = ss;
  }
  lds_barrier();
  const float rq = __builtin_amdgcn_rsqf(RED[0] + RED[1] + 1e-6f) * 0.08838834764831845f, rk = __builtin_amdgcn_rsqf(RED[2] + RED[3] + 1e-6f);
  const float g = -fexp_(alog) * softplusf_(traw_a + dtb);
  const float beta = sigmoidf_(traw_b), eg = fexp_(g);
  float* S1 = p->out + O_SDEL + (size_t)((j * 128 + b) * 8 + h) * 16384;
  float4 pt = make_float4(0.f, 0.f, 0.f, 0.f);
#pragma unroll
  for (int r = 0; r < 8; ++r) { const int dk = dkq * 8 + r; const float kd = QKV[128 + dk] * rk;
    pt.x += s[r].x * kd; pt.y += s[r].y * kd; pt.z += s[r].z * kd; pt.w += s[r].w * kd; }
  *(float4*)(PART + dkq * 128 + dv4 * 4) = pt;
  lds_barrier();
  float4 kv = make_float4(0.f, 0.f, 0.f, 0.f);
#pragma unroll
  for (int q = 0; q < 16; ++q) { const float4 v = *(const float4*)(PART + q * 128 + dv4 * 4); kv.x += v.x; kv.y += v.y; kv.z += v.z; kv.w += v.w; }
  const float4 vv = *(const float4*)(QKV + 256 + dv4 * 4);
  float4 vn; vn.x = beta * (vv.x - eg * kv.x); vn.y = beta * (vv.y - eg * kv.y); vn.z = beta * (vv.z - eg * kv.z); vn.w = beta * (vv.w - eg * kv.w);
  lds_barrier();
  float4 po = make_float4(0.f, 0.f, 0.f, 0.f);
#pragma unroll
  for (int r = 0; r < 8; ++r) { const int dk = dkq * 8 + r; const float kd = QKV[128 + dk] * rk, qd = QKV[dk] * rq;
    float4 n; n.x = eg * s[r].x + kd * vn.x; n.y = eg * s[r].y + kd * vn.y; n.z = eg * s[r].z + kd * vn.z; n.w = eg * s[r].w + kd * vn.w;
    __builtin_nontemporal_store((f32x4){n.x, n.y, n.z, n.w}, (f32x4*)(S1 + dk * 128 + dv4 * 4));
    po.x += n.x * qd; po.y += n.y * qd; po.z += n.z * qd; po.w += n.w * qd; }
  *(float4*)(PART + dkq * 128 + dv4 * 4) = po;
  lds_barrier();
  float o = 0.f;
  if (tid < 128) {
#pragma unroll
    for (int q = 0; q < 16; ++q) o += PART[q * 128 + tid];
    const float ss = wave_sum(o * o);
    if (lane == 0) RED[8 + wave] = ss;
  }
  lds_barrier();
  if (tid < 128) {
    const float rinv = __builtin_amdgcn_rsqf((RED[8] + RED[9]) * (1.f / 128.f) + 1e-6f);
    const float zb = bf2f(proj[row * 6144 + 5120 + h * 128 + tid]);
    ((bf16_t*)(p->ws + WS_YBUF))[row * 2048 + 1024 + h * 128 + tid] = f2bf(o * rinv * p->in[I_GNW][j * 128 + tid] * siluf_(zb));
  }
}

DEVI void phase_mixprep(KP p, int layer, unsigned char* lds, int ph, int submask) {
  const int j = layer >> 1;
  unsigned* ctr = (unsigned*)(p->ws + WS_CTL) + 4096 + ph;
  int* slot = (int*)(lds + LDS_MISC);
  const bool lead = tidx_() == 0;
  int nxt = 0; if (lead) nxt = (int)atomicAdd(ctr, 1u);
  for (;;) {
    if (lead) *slot = nxt;
    lds_barrier();
    const int it = *slot;
    lds_barrier();
    if (it >= 3216) break;
    if (lead) nxt = (int)atomicAdd(ctr, 1u);
    if (it < 144) { if (submask & 1) lru_item(p, j, it, lds); }
    else if (it < 2192) { if (submask & 2) gdn_prep_item(p, j, it - 144, lds); }
    else { if (submask & 4) gdn_decode_item(p, j, it - 2192, lds); }
  }
}

struct GdnFrags { u32x4 wf[4], qf[4], qkf[2], ktf[2][2]; u32x2 uf; float egl; };
DEVI void gdn_load(GdnFrags& f, KP p, int cid, int s, int rt, int ct, int l15, int lq) {
  const bf16_t* wb = (const bf16_t*)(p->ws + WS_WB) + (size_t)cid * 8192;
  const bf16_t* qt = (const bf16_t*)(p->ws + WS_QT) + (size_t)cid * 8192;
  const bf16_t* kt = (const bf16_t*)(p->ws + WS_KT) + (size_t)cid * 8192;
  const bf16_t* qk = (const bf16_t*)(p->ws + WS_QK) + (size_t)cid * 4096;
  const bf16_t* ut = (const bf16_t*)(p->ws + WS_UT) + (size_t)cid * 8192;
  const int ln = lq * 16 + l15;
#pragma unroll
  for (int kk = 0; kk < 4; ++kk) { f.wf[kk] = *(const u32x4*)(wb + ((rt * 4 + kk) * 64 + ln) * 8); f.qf[kk] = *(const u32x4*)(qt + ((rt * 4 + kk) * 64 + ln) * 8); }
#pragma unroll
  for (int kk = 0; kk < 2; ++kk) { f.qkf[kk] = *(const u32x4*)(qk + ((rt * 2 + kk) * 64 + ln) * 8);
#pragma unroll
    for (int d2 = 0; d2 < 2; ++d2) f.ktf[d2][kk] = *(const u32x4*)(kt + (((rt * 2 + d2) * 2 + kk) * 64 + ln) * 8); }
  f.uf = *(const u32x2*)(ut + (s * 32 + ct * 16 + l15) * 64 + rt * 16 + lq * 4);
  f.egl = ((const float*)(p->ws + WS_EGL))[cid];
}
DEVI void phase_gdnseq(KP p, int layer, unsigned char* lds) {
  const int tid = tidx_(), lane = tid & 63, wave = tid >> 6;
  const int j = layer >> 1, rt = wave >> 1, ct = wave & 1, l15 = lane & 15, lq = lane >> 4;
  bf16_t* ST = (bf16_t*)lds;
  bf16_t* VT = (bf16_t*)(lds + 8704);
  bf16_t* ybuf = (bf16_t*)(p->ws + WS_YBUF);
  unsigned dsum = 0u;
  for (int item = bidx_(); item < 256; item += gdim_()) {
    const int xcd = item & 7, idx = item >> 3, bh = xcd * 8 + (idx >> 2), s = idx & 3, b = bh >> 3, h = bh & 7;
    __syncthreads();
    for (int e = tid; e < 32 * 136 / 2; e += 512) ((unsigned*)ST)[e] = 0u;
    f32x4 sacc[2]; sacc[0] = (f32x4){0.f, 0.f, 0.f, 0.f}; sacc[1] = (f32x4){0.f, 0.f, 0.f, 0.f};
    GdnFrags nx; gdn_load(nx, p, bh * 32, s, rt, ct, l15, lq);
    __syncthreads();
    unsigned dprev = 0u; f32x4 oprev = (f32x4){0.f, 0.f, 0.f, 0.f};
    for (int c = 0; c < 32; ++c) {
      const GdnFrags cu = nx;
      if (c > 0) {
        bf16_t* yo = ybuf + (size_t)(b * 2048 + (c - 1) * 64 + rt * 16 + lq * 4) * 2048 + 1024 + h * 128 + s * 32 + ct * 16 + l15;
#pragma unroll
        for (int r = 0; r < 4; ++r) yo[(size_t)r * 2048] = f2bf(oprev[r]);
        asm volatile("" ::: "memory");
      }
      if (c + 1 < 32) gdn_load(nx, p, bh * 32 + c + 1, s, rt, ct, l15, lq);
      f32x4 wsa = (f32x4){0.f, 0.f, 0.f, 0.f}, oa = (f32x4){0.f, 0.f, 0.f, 0.f};
#pragma unroll
      for (int kk = 0; kk < 4; ++kk) { const bf16x8 sb = *(const bf16x8*)(ST + (ct * 16 + l15) * 136 + lq * 8 + kk * 32);
        wsa = mfma16(as_bf16x8(cu.wf[kk]), sb, wsa); oa = mfma16(as_bf16x8(cu.qf[kk]), sb, oa); }
      { const float u0 = bflo(cu.uf.x), u1 = bfhi(cu.uf.x), u2 = bflo(cu.uf.y), u3 = bfhi(cu.uf.y);
        u32x2 w; w.x = cvt_pk_bf16(u0 - wsa[0], u1 - wsa[1]); w.y = cvt_pk_bf16(u2 - wsa[2], u3 - wsa[3]);
        *(u32x2*)(VT + (ct * 16 + l15) * 72 + rt * 16 + lq * 4) = w; }
      lds_barrier();
      bf16x8 vb[2];
#pragma unroll
      for (int kk = 0; kk < 2; ++kk) vb[kk] = *(const bf16x8*)(VT + (ct * 16 + l15) * 72 + lq * 8 + kk * 32);
#pragma unroll
      for (int kk = 0; kk < 2; ++kk) oa = mfma16(as_bf16x8(cu.qkf[kk]), vb[kk], oa);
#pragma unroll
      for (int d2 = 0; d2 < 2; ++d2) { sacc[d2] = sacc[d2] * cu.egl;
#pragma unroll
        for (int kk = 0; kk < 2; ++kk) sacc[d2] = mfma16(as_bf16x8(cu.ktf[d2][kk]), vb[kk], sacc[d2]); }
      oprev = oa;
#pragma unroll
      for (int d2 = 0; d2 < 2; ++d2) { u32x2 w; w.x = cvt_pk_bf16(sacc[d2][0], sacc[d2][1]); w.y = cvt_pk_bf16(sacc[d2][2], sacc[d2][3]);
        *(u32x2*)(ST + (ct * 16 + l15) * 136 + (rt * 2 + d2) * 16 + lq * 4) = w; }
      lds_barrier();
    }
    { bf16_t* yo = ybuf + (size_t)(b * 2048 + 31 * 64 + rt * 16 + lq * 4) * 2048 + 1024 + h * 128 + s * 32 + ct * 16 + l15;
#pragma unroll
      for (int r = 0; r < 4; ++r) yo[(size_t)r * 2048] = f2bf(oprev[r]); }
    float* pd = p->out + O_PDEL + (size_t)((j * 8 + b) * 8 + h) * 16384;
#pragma unroll
    for (int d2 = 0; d2 < 2; ++d2)
#pragma unroll
      for (int r = 0; r < 4; ++r) pd[(size_t)((rt * 2 + d2) * 16 + lq * 4 + r) * 128 + s * 32 + ct * 16 + l15] = sacc[d2][r];
  }
  if (dsum == 0x9e3779b9u) ((unsigned*)(p->ws + WS_CTL))[5000] = dsum;
}

DEVI void phase_onorm(KP p, int layer) {
  const int tid = tidx_(), lane = tid & 63, wave = tid >> 6, j = layer >> 1;
  bf16_t* ybuf = (bf16_t*)(p->ws + WS_YBUF); const bf16_t* proj = (const bf16_t*)(p->ws + WS_PROJ);
  float gw[16];
#pragma unroll
  for (int e = 0; e < 16; ++e) gw[e] = p->in[I_GNW][j * 128 + ((lane * 16 + e) & 127)];
  const int rstep = gdim_() * 8;
  for (int r = bidx_() * 8 + wave; r < NPR; r += 2 * rstep) {
    const bool two = r + rstep < NPR;
    bf16_t* yp[2]; u32x4 yv[2][2], zv[2][2];
#pragma unroll
    for (int q = 0; q < 2; ++q) { const int rr = (q == 0 || two) ? r + q * rstep : r;
      yp[q] = ybuf + (size_t)rr * 2048 + 1024 + lane * 16; const bf16_t* zp = proj + (size_t)rr * 6144 + 5120 + lane * 16;
      yv[q][0] = *(const u32x4*)yp[q]; yv[q][1] = *(const u32x4*)(yp[q] + 8); zv[q][0] = *(const u32x4*)zp; zv[q][1] = *(const u32x4*)(zp + 8); }
#pragma unroll
    for (int q = 0; q < 2; ++q) {
      float o[16], z[16]; { float t[8]; unpack8(yv[q][0], t);
#pragma unroll
        for (int e = 0; e < 8; ++e) o[e] = t[e];
        unpack8(yv[q][1], t);
#pragma unroll
        for (int e = 0; e < 8; ++e) o[8 + e] = t[e];
        unpack8(zv[q][0], t);
#pragma unroll
        for (int e = 0; e < 8; ++e) z[e] = t[e];
        unpack8(zv[q][1], t);
#pragma unroll
        for (int e = 0; e < 8; ++e) z[8 + e] = t[e]; }
      float ss = 0.f;
#pragma unroll
      for (int e = 0; e < 16; ++e) ss += o[e] * o[e];
      ss += __shfl_xor(ss, 1); ss += __shfl_xor(ss, 2); ss += __shfl_xor(ss, 4);
      const float rinv = __builtin_amdgcn_rsqf(ss * (1.f / 128.f) + 1e-6f);
      float a[8], cq[8];
#pragma unroll
      for (int e = 0; e < 8; ++e) { a[e] = o[e] * rinv * gw[e] * siluf_(z[e]); cq[e] = o[8 + e] * rinv * gw[8 + e] * siluf_(z[8 + e]); }
      if (q == 0 || two) { *(u32x4*)yp[q] = pack8(a); *(u32x4*)(yp[q] + 8) = pack8(cq); }
    }
  }
}

struct S5C { bf16x8 Bf[8], Cf[4]; float abr, abi, dch; };
template <bool OUT, bool SAMPLE>
DEVI void s5_chunks(KP p, const S5C& c, int jc, int g, size_t rbase, int nch, int sgrp, float& xr, float& xi, float* BU, bf16_t* XB, int lane) {
  const int l15 = lane & 15, lq = lane >> 4;
  const bf16_t* proj = (const bf16_t*)(p->ws + WS_PROJ);
  bf16_t* y1 = (bf16_t*)(p->ws + WS_YBUF);
  u32x4 unx = (u32x4){0u, 0u, 0u, 0u}; bf16_t uenx[4] = {0, 0, 0, 0};
  if (lq < 2) unx = *(const u32x4*)(proj + (rbase + l15) * 2048 + g * 16 + lq * 8);
  if (OUT) {
#pragma unroll
    for (int r = 0; r < 4; ++r) uenx[r] = proj[(rbase + lq * 4 + r) * 2048 + g * 16 + l15]; }
  for (int ck = 0; ck < nch; ++ck) {
    const size_t row0 = rbase + (size_t)ck * 16;
    const u32x4 ucur = unx; bf16_t uec[4];
#pragma unroll
    for (int r = 0; r < 4; ++r) uec[r] = uenx[r];
    if (ck + 1 < nch) { if (lq < 2) unx = *(const u32x4*)(proj + (row0 + 16 + l15) * 2048 + g * 16 + lq * 8);
      if (OUT) {
#pragma unroll
        for (int r = 0; r < 4; ++r) uenx[r] = proj[(row0 + 16 + lq * 4 + r) * 2048 + g * 16 + l15]; } }
#pragma unroll
    for (int nt = 0; nt < 8; ++nt) { const f32x4 acc = mfma16(as_bf16x8(ucur), c.Bf[nt], (f32x4){0.f, 0.f, 0.f, 0.f});
      *(f32x4*)(BU + (nt * 16 + l15) * 20 + lq * 4) = acc; }
    asm volatile("s_waitcnt lgkmcnt(0)" ::: "memory");
    float br[16], bi[16];
#pragma unroll
    for (int t4 = 0; t4 < 4; ++t4) { const f32x4 a = *(const f32x4*)(BU + lane * 20 + t4 * 4), b = *(const f32x4*)(BU + (64 + lane) * 20 + t4 * 4);
#pragma unroll
      for (int e = 0; e < 4; ++e) { br[t4 * 4 + e] = a[e]; bi[t4 * 4 + e] = b[e]; } }
    if (!SAMPLE) {
#pragma unroll
      for (int t = 0; t < 16; ++t) { const float nr = c.abr * xr - c.abi * xi + br[t], ni = c.abr * xi + c.abi * xr + bi[t]; xr = nr; xi = ni;
        if (OUT) *(unsigned*)(XB + t * 136 + 2 * lane) = cvt_pk_bf16(xr, xi); }
    } else {
#pragma unroll
      for (int t = 0; t < 16; ++t) { const size_t si = ((size_t)(jc * 128 + sgrp * 16 + t) * 64 + g) * 64 + lane;
        const float x0r = p->in[I_SSR][si], x0i = p->in[I_SSI][si];
        const float nr = c.abr * x0r - c.abi * x0i + br[t], ni = c.abr * x0i + c.abi * x0r + bi[t];
        p->out[O_SSR + si] = nr; p->out[O_SSI + si] = ni;
        *(unsigned*)(XB + t * 136 + 2 * lane) = cvt_pk_bf16(nr, ni); }
    }
    if (OUT) {
      asm volatile("s_waitcnt lgkmcnt(0)" ::: "memory");
      f32x4 ya = (f32x4){0.f, 0.f, 0.f, 0.f};
#pragma unroll
      for (int kk = 0; kk < 4; ++kk) ya = mfma16(*(const bf16x8*)(XB + l15 * 136 + lq * 8 + kk * 32), c.Cf[kk], ya);
#pragma unroll
      for (int r = 0; r < 4; ++r) { const float y = ya[r] + c.dch * bf2f(uec[r]); y1[(row0 + lq * 4 + r) * 1024 + g * 16 + l15] = f2bf(geluf_(y)); }
    }
  }
}
DEVI void s5_setup(KP p, S5C& c, int jc, int g, int lane) {
  const int l15 = lane & 15, lq = lane >> 4, gi = jc * 64 + g;
  const float dt = __expf(p->in[I_LOGDT][gi]);
  { const float are = p->in[I_ARE][gi * 64 + lane], aim = p->in[I_AIM][gi * 64 + lane]; const float mag = __expf(are * dt); c.abr = mag * __cosf(aim * dt); c.abi = mag * __sinf(aim * dt); }
#pragma unroll
  for (int nt = 0; nt < 8; ++nt) {
    float v[8];
#pragma unroll
    for (int e = 0; e < 8; ++e) v[e] = 0.f;
    if (lq < 2) {
      const int pp = (nt & 3) * 16 + l15;
      const float are = p->in[I_ARE][gi * 64 + pp], aim = p->in[I_AIM][gi * 64 + pp]; const float mag = __expf(are * dt); const float sn = __sinf(aim * dt), cs = __cosf(aim * dt);
      const float nr = mag * cs - 1.f, ni = mag * sn, den = 1.f / (are * are + aim * aim);
      const float cr = (nr * are + ni * aim) * den, ci = (ni * are - nr * aim) * den;
      const float* br = p->in[I_BRE] + (size_t)(gi * 64 + pp) * 16 + lq * 8; const float* bi = p->in[I_BIM] + (size_t)(gi * 64 + pp) * 16 + lq * 8;
#pragma unroll
      for (int e = 0; e < 8; ++e) v[e] = (nt >= 4) ? (cr * bi[e] + ci * br[e]) : (cr * br[e] - ci * bi[e]);
    }
    c.Bf[nt] = as_bf16x8(pack8(v));
  }
#pragma unroll
  for (int kk = 0; kk < 4; ++kk) { const int p0 = lq * 4 + kk * 16;
    const float* sre = p->in[I_CRE] + (size_t)(gi * 16 + l15) * 64 + p0; const float* sim = p->in[I_CIM] + (size_t)(gi * 16 + l15) * 64 + p0; float v[8];
#pragma unroll
    for (int m = 0; m < 4; ++m) { v[2 * m] = sre[m]; v[2 * m + 1] = -sim[m]; }
    c.Cf[kk] = as_bf16x8(pack8(v)); }
  c.dch = p->in[I_S5D][jc * 1024 + g * 16 + l15];
}
DEVI void phase_s5(KP p, int layer, unsigned char* lds) {
  const int tid = tidx_(), lane = tid & 63, wave = tid >> 6, jc = layer >> 1;
  float* BU = (float*)(lds + wave * 14592);
  bf16_t* XB = (bf16_t*)(lds + wave * 14592 + 10240);
  float* EX = (float*)(lds + 116736);
  const int cb = wave >> 2, seg = wave & 3;
  for (int cp = bidx_(); cp < 256; cp += gdim_()) {
    const int q = cp * 2 + cb, b = q >> 6, g = q & 63;
    S5C c; s5_setup(p, c, jc, g, lane);
    float xr = 0.f, xi = 0.f;
    const size_t rbase = (size_t)b * 2048 + (size_t)seg * 512;
    const int nch2 = 32;
    if (seg < 3) {
      s5_chunks<false, false>(p, c, jc, g, rbase, 32, 0, xr, xi, BU, XB, lane);
      EX[wave * 128 + lane] = xr; EX[wave * 128 + 64 + lane] = xi;
    } else {
      const int qs = cp * 2 + cb, gs = qs & 63, sgrp = qs >> 6;
      S5C cs; s5_setup(p, cs, jc, gs, lane);
      float dr = 0.f, di = 0.f;
      s5_chunks<true, true>(p, cs, jc, gs, (size_t)(NPR + sgrp * 16), 1, sgrp, dr, di, BU, XB, lane);
    }
    __syncthreads();
    float pr = c.abr, pi = c.abi;
#pragma unroll
    for (int s = 0; s < 9; ++s) { const float nr = pr * pr - pi * pi, ni = 2.f * pr * pi; pr = nr; pi = ni; }
    xr = 0.f; xi = 0.f;
    for (int s = 0; s < seg; ++s) { const float er = EX[(cb * 4 + s) * 128 + lane], ei = EX[(cb * 4 + s) * 128 + 64 + lane];
      const float nr = pr * xr - pi * xi + er, ni = pr * xi + pi * xr + ei; xr = nr; xi = ni; }
    s5_chunks<true, false>(p, c, jc, g, rbase, nch2, 0, xr, xi, BU, XB, lane);
    if (seg == 3) { const size_t si = ((size_t)(jc * 8 + b) * 64 + g) * 64 + lane; p->out[O_PSR + si] = xr; p->out[O_PSI + si] = xi; }
    __syncthreads();
  }
}

DEVI void phase_final(KP p) {
  const int tid = tidx_(), lane = tid & 63, wave = tid >> 6;
  const float* nw = p->in[I_FNW];
  float4 w4[4];
#pragma unroll
  for (int i = 0; i < 4; ++i) w4[i] = *(const float4*)(nw + i * 256 + lane * 4);
  for (int r = (bidx_() * 8 + wave) * 2; r < NRV; r += gdim_() * 16) {
    float* x0 = p->out + (size_t)r * 1024; float* x1 = x0 + 1024; float4 v0[4], v1[4]; float s0 = 0.f, s1 = 0.f;
#pragma unroll
    for (int i = 0; i < 4; ++i) { v0[i] = *(const float4*)(x0 + i * 256 + lane * 4); v1[i] = *(const float4*)(x1 + i * 256 + lane * 4); }
#pragma unroll
    for (int i = 0; i < 4; ++i) { s0 += v0[i].x * v0[i].x + v0[i].y * v0[i].y + v0[i].z * v0[i].z + v0[i].w * v0[i].w; s1 += v1[i].x * v1[i].x + v1[i].y * v1[i].y + v1[i].z * v1[i].z + v1[i].w * v1[i].w; }
#pragma unroll
    for (int o = 32; o >= 1; o >>= 1) { s0 += __shfl_xor(s0, o); s1 += __shfl_xor(s1, o); }
    const float r0 = __builtin_amdgcn_rsqf(s0 * (1.f / 1024.f) + 1e-6f), r1 = __builtin_amdgcn_rsqf(s1 * (1.f / 1024.f) + 1e-6f);
#pragma unroll
    for (int i = 0; i < 4; ++i) { float4 o; o.x = v0[i].x * r0 * w4[i].x; o.y = v0[i].y * r0 * w4[i].y; o.z = v0[i].z * r0 * w4[i].z; o.w = v0[i].w * r0 * w4[i].w; *(float4*)(x0 + i * 256 + lane * 4) = o;
      float4 q; q.x = v1[i].x * r1 * w4[i].x; q.y = v1[i].y * r1 * w4[i].y; q.z = v1[i].z * r1 * w4[i].z; q.w = v1[i].w * r1 * w4[i].w; *(float4*)(x1 + i * 256 + lane * 4) = q; }
  }
}

template <class F>
DEVI void sample_gemm(const bf16_t* __restrict__ A, int lda, const bf16_t* __restrict__ Bt, int N, int K, F&& epi, float* red) {
  const int tid = tidx_(), lane = tid & 63, wave = tid >> 6, l15 = lane & 15, lq = lane >> 4, rt2 = wave & 1, kq = wave >> 1;
  const int kq_len = K >> 2, nitems = (N / 16) * 4;
  for (int it = gdim_() - 1 - bidx_(); it < nitems; it += gdim_()) {
    const int s = it >> 2, rg = it & 3, row0 = rg * 32 + rt2 * 16;
    const bf16_t* ap = A + (size_t)(row0 + l15) * lda + lq * 8 + kq * kq_len;
    const bf16_t* bp = Bt + (size_t)(s * 16 + l15) * K + lq * 8 + kq * kq_len;
    f32x4 acc0 = (f32x4){0.f, 0.f, 0.f, 0.f}, acc1 = (f32x4){0.f, 0.f, 0.f, 0.f};
    for (int k0 = 0; k0 < kq_len; k0 += 256) {
      u32x4 a[8], b[8];
#pragma unroll
      for (int u = 0; u < 8; ++u) { a[u] = *(const u32x4*)(ap + k0 + u * 32); b[u] = *(const u32x4*)(bp + k0 + u * 32); }
#pragma unroll
      for (int u = 0; u < 8; u += 2) { acc0 = mfma16(as_bf16x8(a[u]), as_bf16x8(b[u]), acc0); acc1 = mfma16(as_bf16x8(a[u + 1]), as_bf16x8(b[u + 1]), acc1); }
    }
    acc0 = acc0 + acc1;
    lds_barrier();
    *(f32x4*)(red + ((kq * 2 + rt2) * 64 + lane) * 4) = acc0;
    lds_barrier();
    if (kq == 0) {
      f32x4 t = acc0;
#pragma unroll
      for (int q = 1; q < 4; ++q) t = t + *(const f32x4*)(red + ((q * 2 + rt2) * 64 + lane) * 4);
#pragma unroll
      for (int r = 0; r < 4; ++r) epi(row0 + lq * 4 + r, s * 16 + l15, t[r]);
    }
  }
}

constexpr int N_PHASES = 25;
#ifndef PROBE_SUB
#define PROBE_SUB 7
#endif
#ifndef ONLY_KIND
#define ONLY_KIND -1
#endif
#define KON(k) ((ONLY_KIND < 0 || ONLY_KIND == (k)) && kind == (k))
__global__ void __launch_bounds__(512, 2) mega(Params p_unused) {
  extern __shared__ __attribute__((aligned(16))) unsigned char shm[];
  cg::grid_group grid = cg::this_grid();
  PG8_LAS unsigned char* ldsg = (PG8_LAS unsigned char*)shm;
  KP p0 = (KP)__builtin_amdgcn_kernarg_segment_ptr();
  const int ph_lo = p0->ph_lo, ph_hi = p0->ph_hi;
  volatile LAS unsigned* xst = (volatile LAS unsigned*)(ldsg + LDS_MISC + 16);
  if (threadIdx.x == 0) { xst[0] = 0u; xst[1] = 0u; }
  __syncthreads();
  XcdBarrier xb = xcd_barrier_post((unsigned*)(p0->ws + WS_CTL), xst);
  int rep = 0;
  for (int ph = ph_lo; ph < ph_hi; ++ph) {
    KP p = p0; asm volatile("" : "+s"(p));
    int kind, layer = 0;
    if (ph == 0) kind = 0; else if (ph == 1) kind = 1; else if (ph == 24) kind = 12;
    else { const int q = ph - 2, pair = q / 11, rem = q % 11;
      if (rem < 6) { layer = 2 * pair; kind = (rem == 0) ? 2 : 2 + rem; }
      else { layer = 2 * pair + 1; const int s = rem - 6; kind = (s == 0) ? 2 : 7 + s; } }
    const int j = layer >> 1;
    if (KON(0)) phase_prep(p, (float*)shm);
    else if (KON(2)) phase_norm(p, layer, (float*)shm);
    else if (KON(4)) phase_mixprep(p, layer, shm, ph + 32 * rep, rep ? PROBE_SUB : 7);
    else if (KON(5)) phase_gdnseq(p, layer, shm);
    else if (KON(6)) phase_onorm(p, layer);
    else if (KON(9)) phase_s5(p, layer, shm);
    else if (KON(12)) phase_final(p);
    else if (KON(1)) {
      pg8::Gemm g{(const bf16_t*)(p->ws + WS_SILUC), (const bf16_t*)(p->ws + WS_WT_MOD), 256, 12288, 1024};
      pg8::StaticOrder S; S.init(256, 12288, gdim_(), bidx_());
      pg8::EpiF32 E{(float*)(p->ws + WS_MOD), 12288, p->in[I_MODB]};
      pg8::gemm_phase<pg8::EpiF32, pg8::StaticOrder, false>(ldsg, g, S, E, nullptr);
    } else if (KON(3) || KON(8)) {
      const bool ab = kind == 3; const int N = ab ? 6144 : 2048;
      const bf16_t* Bt = ab ? (const bf16_t*)(p->ws + WS_WT_INAB) + (size_t)j * 6144 * 1024 : (const bf16_t*)(p->ws + WS_WT_CIN) + (size_t)j * 2048 * 1024;
      pg8::Gemm g{(const bf16_t*)(p->ws + WS_YBUF), Bt, NPR, N, 1024};
      pg8::StaticOrder S; S.init(NPR, N, gdim_(), bidx_());
      pg8::EpiBf16<0> E{(bf16_t*)(p->ws + WS_PROJ), N, nullptr, 0, 0};
      pg8::gemm_phase<pg8::EpiBf16<0>, pg8::StaticOrder, false>(ldsg, g, S, E, nullptr);
      bf16_t* po = (bf16_t*)(p->ws + WS_PROJ) + (size_t)NPR * N;
      sample_gemm((const bf16_t*)(p->ws + WS_YBUF) + (size_t)NPR * 1024, 1024, Bt, N, 1024, [&](int r, int c, float v) { po[(size_t)r * N + c] = f2bf(v); }, (float*)shm);
      if (ab) tail_gemm(p, j);
    } else if (KON(7) || KON(11)) {
      const bool ab = kind == 7; const int K = ab ? 2048 : 1024;
      const bf16_t* Ab = ab ? (const bf16_t*)(p->ws + WS_YBUF) : (const bf16_t*)(p->ws + WS_Y2);
      const bf16_t* Bt = ab ? (const bf16_t*)(p->ws + WS_WT_OUTAB) + (size_t)j * 1024 * 2048 : (const bf16_t*)(p->ws + WS_WT_COUT) + (size_t)j * 1024 * 1024;
      pg8::Gemm g{Ab, Bt, NPR, 1024, K};
      pg8::StaticOrder S; S.init(NPR, 1024, gdim_(), bidx_());
      const float* gatep = (const float*)(p->ws + WS_MOD) + layer * 3072 + 2048;
      EpiRes E{layer == 0 ? p->in[I_XP] : p->out, layer == 0 ? p->in[I_XS] : p->out + (size_t)NPR * 1024, p->out, gatep};
      pg8::gemm_phase<EpiRes, pg8::StaticOrder, false>(ldsg, g, S, E, nullptr);
      const float* xsi = layer == 0 ? p->in[I_XS] : p->out + (size_t)NPR * 1024; float* xso = p->out + (size_t)NPR * 1024;
      sample_gemm(Ab + (size_t)NPR * K, K, Bt, 1024, K, [&](int r, int c, float v) { xso[(size_t)r * 1024 + c] = xsi[(size_t)r * 1024 + c] + gatep[(size_t)(8 + r) * 12288 + c] * v; }, (float*)shm);
    } else if (KON(10)) {
      const bf16_t* Bt = (const bf16_t*)(p->ws + WS_WT_GLU) + (size_t)j * 1024 * 1024;
      pg8::Gemm g{(const bf16_t*)(p->ws + WS_YBUF), Bt, NPR, 1024, 1024};
      pg8::StaticOrder S; S.init(NPR, 1024, gdim_(), bidx_());
      const float* gb = p->in[I_GLUB] + j * 1024;
      EpiGlu E{(const bf16_t*)(p->ws + WS_YBUF), (const bf16_t*)(p->ws + WS_PROJ) + 1024, (bf16_t*)(p->ws + WS_Y2), gb};
      pg8::gemm_phase<EpiGlu, pg8::StaticOrder, false>(ldsg, g, S, E, nullptr);
      const bf16_t* y1s = (const bf16_t*)(p->ws + WS_YBUF) + (size_t)NPR * 1024; const bf16_t* zs = (const bf16_t*)(p->ws + WS_PROJ) + (size_t)NPR * 2048 + 1024; bf16_t* y2s = (bf16_t*)(p->ws + WS_Y2) + (size_t)NPR * 1024;
      sample_gemm(y1s, 1024, Bt, 1024, 1024, [&](int r, int c, float v) { y2s[(size_t)r * 1024 + c] = f2bf(bf2f(y1s[(size_t)r * 1024 + c]) * sigmoidf_(v + gb[c]) * siluf_(bf2f(zs[(size_t)r * 2048 + c]))); }, (float*)shm);
    }
#ifdef REPEAT_KIND
    if (kind == REPEAT_KIND && rep == 0) { rep = 1; --ph; } else rep = 0;
#endif
    if (ph + 1 < ph_hi) { if (ph_hi > 100000) grid.sync();
      xcd_barrier(xb); }
  }
}

#ifndef MK_MULTI
#define MK_MULTI 0
#endif
#ifndef PH_HI
#define PH_HI N_PHASES
#endif
extern "C" void kernel_launch(void* const* d_in, const int* in_sizes, int n_in, void* d_out, int out_size, void* d_ws, size_t ws_size, hipStream_t stream) {
  static int grid = 0;
  if (grid == 0) {
    if (n_in != N_IN || (size_t)out_size != O_END || ws_size < WS_END) { fprintf(stderr, "kernel_launch: unexpected shapes: n_in %d out %d ws %zu (need %zu)\n", n_in, out_size, ws_size, (size_t)WS_END); grid = -1; return; }
    int dev = 0, cus = 0, per_cu = 0;
    if (hipGetDevice(&dev) != hipSuccess || hipDeviceGetAttribute(&cus, hipDeviceAttributeMultiprocessorCount, dev) != hipSuccess) { grid = -1; return; }
    if (hipFuncSetAttribute((const void*)mega, hipFuncAttributeMaxDynamicSharedMemorySize, LDS_BYTES) != hipSuccess) { fprintf(stderr, "kernel_launch: hipFuncSetAttribute failed\n"); grid = -1; return; }
    if (hipOccupancyMaxActiveBlocksPerMultiprocessor(&per_cu, (const void*)mega, 512, LDS_BYTES) != hipSuccess || per_cu < 1) { fprintf(stderr, "kernel_launch: occupancy query says %d\n", per_cu); per_cu = 1; }
    (void)hipGetLastError();
    grid = cus;
  }
  if (grid < 0) return;
  if (hipMemsetAsync((char*)d_ws + WS_CTL, 0, 32768, stream) != hipSuccess) { fprintf(stderr, "kernel_launch: memset failed\n"); return; }
  Params p{};
  for (int i = 0; i < N_IN; ++i) p.in[i] = (const float*)d_in[i];
  p.out = (float*)d_out; p.ws = (unsigned char*)d_ws;
#if MK_MULTI
  for (int ph = 0; ph < N_PHASES; ++ph) { p.ph_lo = ph; p.ph_hi = ph + 1; hipLaunchKernelGGL(mega, dim3(grid), dim3(512), LDS_BYTES, stream, p); }
#else
  p.ph_lo = 0; p.ph_hi = PH_HI;
  void* args[] = {&p};
  hipError_t e = hipLaunchCooperativeKernel((void*)mega, dim3(grid), dim3(512), args, LDS_BYTES, stream);
  if (e != hipSuccess) fprintf(stderr, "kernel_launch: cooperative launch failed: %s (grid %d)\n", hipGetErrorString(e), grid);
#endif
}
```

```cpp
#include <hip/hip_runtime.h>
#include <hip/hip_cooperative_groups.h>
#include <cstdio>
namespace cg = cooperative_groups;
__device__ __forceinline__ int tidx_() { int t = threadIdx.x; asm volatile("" : "+v"(t)); return t; }
__device__ __forceinline__ int bidx_() { int t = blockIdx.x; asm volatile("" : "+s"(t)); return t; }
__device__ __forceinline__ int gdim_() { int t = gridDim.x; asm volatile("" : "+s"(t)); return t; }
namespace pg8 {
#define PG8_LAS __attribute__((address_space(3)))
typedef unsigned short bf16_t;
typedef short bf16x8 __attribute__((ext_vector_type(8)));
typedef float f32x4 __attribute__((ext_vector_type(4)));
typedef unsigned u32x4 __attribute__((ext_vector_type(4)));
constexpr int BM = 256, BK = 64, HALF = 128, HTB = HALF * BK * 2  , STAGE_BYTES = 8 * HTB, NXCD = 8, WGM = 8;

__host__ __device__ __forceinline__ int lds_byte(int r, int c) { const int st = (r >> 4) * 2 + (c >> 5), rr = r & 15, cc = c & 31, ob = rr * 64 + cc * 2; return st * 1024 + (ob ^ (((ob >> 9) & 1) << 5)); }
__host__ __device__ __forceinline__ void stage_rc(int b, int& R, int& C) { const int st = b / 1024, sb = b % 1024, swz = sb ^ (((sb >> 9) & 1) << 5); R = (st >> 1) * 16 + swz / 64; C = (st & 1) * 32 + (swz % 64) / 2; }
__host__ __device__ __forceinline__ int perm32(int rho) { const int n = rho >> 4, i = rho & 15; return 8 * (i >> 2) + 4 * n + (i & 3); }

struct Unit { int pm, pn; };
struct Gemm { const bf16_t* A; const bf16_t* Bt; int M, N, K; };

struct StaticOrder {
    int nM, nN, nwg, G, c;
    __host__ __device__ void init(int M, int N, int G_, int c_) { nM = M / BM; nN = N / BM; nwg = nM * nN; G = G_; c = c_; }
    __host__ __device__ bool next(int i, Unit& u) const {
        const long L = (long)i * G + c; if (L >= nwg) return false;
        int wgid = (int)L; { const int q = nwg / NXCD, r = nwg % NXCD, xcd = wgid % NXCD, off = wgid / NXCD; wgid = (xcd < r ? xcd * (q + 1) : r * (q + 1) + (xcd - r) * q) + off; }
        const int nig = WGM * nN, gid = wgid / nig, fm = gid * WGM, gsz = (nM - fm) < WGM ? (nM - fm) : WGM;
        u.pm = fm + ((wgid % nig) % gsz); u.pn = (wgid % nig) / gsz; return true;
    }
    __device__ __forceinline__ void a_ready(const Unit&) const {}
    __device__ __forceinline__ void done(const Unit&) const {}
};
typedef float f32x2cv __attribute__((ext_vector_type(2)));
typedef __bf16 bf16x2cv __attribute__((ext_vector_type(2)));
__device__ __forceinline__ unsigned cvt_pk_bf16(float lo, float hi) { f32x2cv v = {lo, hi}; bf16x2cv b = __builtin_convertvector(v, bf16x2cv); return __builtin_bit_cast(unsigned, b); }
typedef float f32x2 __attribute__((ext_vector_type(2)));
__device__ __forceinline__ f32x2 gelu_pk(f32x2 v) {
    const f32x2 av = __builtin_elementwise_abs(v), d = av * 0.2316418882f + 1.0f;
    f32x2 t; t.x = __builtin_amdgcn_rcpf(d.x); t.y = __builtin_amdgcn_rcpf(d.y);
    f32x2 q = t * 0.5307027145f + (-0.7265760135f); q = q * t + 0.7107068705f; q = q * t + (-0.142248368f); q = q * t + 0.127414796f; q = q * t;
    const f32x2 s = (v * v) * (-0.72134752044f);
    f32x2 e; e.x = __builtin_amdgcn_exp2f(s.x); e.y = __builtin_amdgcn_exp2f(s.y);
    const f32x2 m = v * (q * e), r = v - m;
    f32x2 o; o.x = v.x < 0.f ? m.x : r.x; o.y = v.y < 0.f ? m.y : r.y; return o;
}

struct EpiF32 {
    static constexpr bool PERM = false, AFTER_DRAIN = false;
    float* C; int ldc; const float* bias;
    __device__ __forceinline__ void operator()(const f32x4 (&acc)[2][2][4][2], const Unit& u, int wr, int wc, int fr, int fq) const {
        const int row0 = u.pm * BM + wr * 64 + fr, col0 = u.pn * BM + wc * 32 + 4 * fq;
        f32x4 bv[2][2];
#pragma unroll
        for (int bj = 0; bj < 2; ++bj)
#pragma unroll
            for (int n = 0; n < 2; ++n) bv[bj][n] = bias ? *(const f32x4*)(bias + col0 + bj * HALF + n * 16) : (f32x4){0.f, 0.f, 0.f, 0.f};
#pragma unroll
        for (int ai = 0; ai < 2; ++ai)
#pragma unroll
            for (int m = 0; m < 4; ++m) { float* rowp = C + (size_t)(row0 + ai * HALF + m * 16) * ldc + col0;
#pragma unroll
                for (int bj = 0; bj < 2; ++bj)
#pragma unroll
                    for (int n = 0; n < 2; ++n) *(f32x4*)(rowp + bj * HALF + n * 16) = acc[ai][bj][m][n] + bv[bj][n]; }
    }
};
template <int ACT  > struct EpiBf16 {
    static constexpr bool PERM = true, AFTER_DRAIN = false;
    bf16_t* O; int ldc; const float* bias; int split_cols; size_t split_stride;
    __device__ __forceinline__ void operator()(const f32x4 (&acc)[2][2][4][2], const Unit& u, int wr, int wc, int fr, int fq) const {
        const int row0 = u.pm * BM + wr * 64 + fr; int colt = u.pn * BM; bf16_t* base = O;
        if (split_cols) { const int t = colt / split_cols; base += (size_t)t * split_stride; colt -= t * split_cols; }
        const int col0 = colt + wc * 32 + 8 * fq, bcol0 = u.pn * BM + wc * 32 + 8 * fq;
        f32x4 bv[2][2];
#pragma unroll
        for (int bj = 0; bj < 2; ++bj)
#pragma unroll
            for (int n = 0; n < 2; ++n) bv[bj][n] = bias ? *(const f32x4*)(bias + bcol0 + bj * HALF + 4 * n) : (f32x4){0.f, 0.f, 0.f, 0.f};
#pragma unroll
        for (int ai = 0; ai < 2; ++ai)
#pragma unroll
            for (int m = 0; m < 4; ++m) { bf16_t* rowp = base + (size_t)(row0 + ai * HALF + m * 16) * ldc + col0;
#pragma unroll
                for (int bj = 0; bj < 2; ++bj) { f32x4 v0 = acc[ai][bj][m][0] + bv[bj][0], v1 = acc[ai][bj][m][1] + bv[bj][1];
                    if (ACT == 1) { f32x2 a = gelu_pk((f32x2){v0[0], v0[1]}), b = gelu_pk((f32x2){v0[2], v0[3]}), c = gelu_pk((f32x2){v1[0], v1[1]}), d = gelu_pk((f32x2){v1[2], v1[3]});
                        v0 = (f32x4){a.x, a.y, b.x, b.y}; v1 = (f32x4){c.x, c.y, d.x, d.y}; }
                    if (ACT == 2) {
#pragma unroll
                        for (int j = 0; j < 4; ++j) { v0[j] = 0.5f * v0[j] * (1.0f + erff(v0[j] * 0.70710678f)); v1[j] = 0.5f * v1[j] * (1.0f + erff(v1[j] * 0.70710678f)); } }
                    u32x4 w; w.x = cvt_pk_bf16(v0[0], v0[1]); w.y = cvt_pk_bf16(v0[2], v0[3]); w.z = cvt_pk_bf16(v1[0], v1[1]); w.w = cvt_pk_bf16(v1[2], v1[3]);
                    *(u32x4*)(rowp + bj * HALF) = w; } }
    }
};
template <class Epi, class Sched, bool STAMP = false>
__device__ __forceinline__ void gemm_phase(PG8_LAS unsigned char* lds, const Gemm g, const Sched& S, const Epi& E, unsigned long long* stamps) {
    const int tid = tidx_(), wid = __builtin_amdgcn_readfirstlane(tid >> 6), lane = tid & 63, wr = wid >> 2, wc = wid & 3, fr = lane & 15, fq = lane >> 4;
    const int K = g.K, nt = K / BK;
    int ts_lo = 0, ts_hi = 0, nts = 0; const unsigned long long rt_entry = STAMP ? (unsigned long long)wall_clock64() : 0ull;
#define PG8_STAMP() do { if (STAMP && wid == 0 && nts < 64) { const unsigned long long _c = (unsigned long long)clock64(); \
        ts_lo = (lane == nts) ? (int)(unsigned)_c : ts_lo; ts_hi = (lane == nts) ? (int)(unsigned)(_c >> 32) : ts_hi; ++nts; } } while (0)
    PG8_STAMP();
    unsigned voffA[2], voffB[2];
#pragma unroll
    for (int i = 0; i < 2; ++i) { int R, C; stage_rc(tid * 16 + i * 8192, R, C); const int Rb = Epi::PERM ? ((R & ~31) + perm32(R & 31)) : R;
        voffA[i] = (unsigned)(R * K + C) * 2u; voffB[i] = (unsigned)(Rb * K + C) * 2u; }
    const size_t kstep = (size_t)(BK * 2);
    const size_t hstep = (size_t)HALF * K * 2;
    const size_t tstep = 2 * hstep;
    const unsigned ldsw = (unsigned)wid * 1024u;
    const int aoff = lds_byte(wr * 64 + fr, fq * 8), boff = lds_byte(wc * 32 + fr, fq * 8);
#define PG8_SA(b, h) (((b) * 2 + (h)) * HTB)
#define PG8_SB(b, h) ((4 + (b) * 2 + (h)) * HTB)
#define PG8_STAGE(bufoff, gbase, voff) do { _Pragma("unroll") for (int _i = 0; _i < 2; ++_i) \
        __builtin_amdgcn_global_load_lds((const unsigned*)((const char*)(gbase) + (voff)[_i]), (PG8_LAS unsigned*)(lds + (bufoff) + ldsw + _i * 8192), 16, 0, 0); } while (0)
#define PG8_LDA(dst, b, h) do { _Pragma("unroll") for (int m = 0; m < 4; ++m) _Pragma("unroll") for (int k = 0; k < 2; ++k) dst[m][k] = *(const PG8_LAS bf16x8*)(lds + PG8_SA(b, h) + aoff + m * 2048 + k * 1024); } while (0)
#define PG8_LDB(dst, b, h) do { _Pragma("unroll") for (int n = 0; n < 2; ++n) _Pragma("unroll") for (int k = 0; k < 2; ++k) dst[n][k] = *(const PG8_LAS bf16x8*)(lds + PG8_SB(b, h) + boff + n * 2048 + k * 1024); } while (0)
#define PG8_MMA(ai, bj, At, Bt) do { __builtin_amdgcn_s_setprio(1); _Pragma("unroll") for (int m = 0; m < 4; ++m) _Pragma("unroll") for (int n = 0; n < 2; ++n) _Pragma("unroll") for (int k = 0; k < 2; ++k) \
        acc[ai][bj][m][n] = __builtin_amdgcn_mfma_f32_16x16x32_bf16(Bt[n][k], At[m][k], acc[ai][bj][m][n], 0, 0, 0); __builtin_amdgcn_s_setprio(0); } while (0)
#define PG8_WAIT_V(n) asm volatile("s_waitcnt vmcnt(" #n ")" ::: "memory")
#define PG8_WAIT_L(n) asm volatile("s_waitcnt lgkmcnt(" #n ")" ::: "memory")
#define PG8_BAR __builtin_amdgcn_s_barrier()
#define PG8_SCHED __builtin_amdgcn_sched_barrier(0)
    Unit cur, nxt; int ui = 0;
    if (!S.next(0, cur)) return;
    f32x4 acc[2][2][4][2];
#pragma unroll
    for (int a = 0; a < 2; ++a)
#pragma unroll
        for (int b = 0; b < 2; ++b)
#pragma unroll
            for (int m = 0; m < 4; ++m)
#pragma unroll
                for (int n = 0; n < 2; ++n) acc[a][b][m][n] = (f32x4){0.f, 0.f, 0.f, 0.f};
    bf16x8 At[4][2], B0[2][2], B1[2][2];
    const char* cA = (const char*)g.A + (size_t)cur.pm * tstep; const char* cB = (const char*)g.Bt + (size_t)cur.pn * tstep;
    S.a_ready(cur);
    PG8_STAGE(PG8_SB(0, 0), cB, voffB); PG8_STAGE(PG8_SA(0, 0), cA, voffA); PG8_STAGE(PG8_SB(0, 1), cB + hstep, voffB); PG8_STAGE(PG8_SA(0, 1), cA + hstep, voffA);
    if (wr == 1) PG8_BAR;
    PG8_WAIT_V(4); PG8_BAR;
    PG8_STAGE(PG8_SB(1, 0), cB + kstep, voffB); PG8_STAGE(PG8_SA(1, 0), cA + kstep, voffA); PG8_STAGE(PG8_SB(1, 1), cB + hstep + kstep, voffB);
    PG8_WAIT_V(6); PG8_BAR;
    PG8_STAMP();
    for (;;) {
        const bool has_next = S.next(ui + 1, nxt);
        const char* nA = has_next ? (const char*)g.A + (size_t)nxt.pm * tstep : cA; const char* nB = has_next ? (const char*)g.Bt + (size_t)nxt.pn * tstep : cB;
        for (int t = 0; t < nt; t += 2) {
            const bool last = (t == nt - 2);
            const char* a1 = cA + (size_t)(t + 1) * kstep;
            const char* a2 = last ? nA : cA + (size_t)(t + 2) * kstep; const char* b2 = last ? nB : cB + (size_t)(t + 2) * kstep;
            const char* a3 = a2 + kstep; const char* b3 = b2 + kstep;
            if (last && has_next) S.a_ready(nxt);
            PG8_LDB(B0, 0, 0); PG8_SCHED; PG8_LDA(At, 0, 0); PG8_STAGE(PG8_SA(1, 1), a1 + hstep, voffA);
            PG8_WAIT_L(8); PG8_BAR; PG8_WAIT_L(0); PG8_MMA(0, 0, At, B0); PG8_BAR; PG8_SCHED;
            PG8_LDB(B1, 0, 1); PG8_STAGE(PG8_SB(0, 0), b2, voffB);
            PG8_BAR; PG8_WAIT_L(0); PG8_MMA(0, 1, At, B1); PG8_BAR;
            PG8_LDA(At, 0, 1); PG8_STAGE(PG8_SA(0, 0), a2, voffA);
            PG8_BAR; PG8_WAIT_L(0); PG8_MMA(1, 0, At, B0); PG8_BAR; PG8_SCHED;
            PG8_STAGE(PG8_SB(0, 1), b2 + hstep, voffB);
            PG8_WAIT_V(6); PG8_BAR; PG8_MMA(1, 1, At, B1); PG8_BAR;
            PG8_LDB(B0, 1, 0); PG8_SCHED; PG8_LDA(At, 1, 0); PG8_STAGE(PG8_SA(0, 1), a2 + hstep, voffA);
            PG8_WAIT_L(8); PG8_BAR; PG8_WAIT_L(0); PG8_MMA(0, 0, At, B0); PG8_BAR; PG8_SCHED;
            PG8_LDB(B1, 1, 1); PG8_STAGE(PG8_SB(1, 0), b3, voffB);
            PG8_BAR; PG8_WAIT_L(0); PG8_MMA(0, 1, At, B1); PG8_BAR;
            PG8_LDA(At, 1, 1); PG8_STAGE(PG8_SA(1, 0), a3, voffA);
            PG8_BAR; PG8_WAIT_L(0); PG8_MMA(1, 0, At, B0); PG8_BAR; PG8_SCHED;
            PG8_STAGE(PG8_SB(1, 1), b3 + hstep, voffB);
            PG8_WAIT_V(6); PG8_BAR; PG8_MMA(1, 1, At, B1); PG8_BAR;
        }
        PG8_STAMP();
        if constexpr (!Epi::AFTER_DRAIN) { E(acc, cur, wr, wc, fr, fq); S.done(cur); }
        PG8_STAMP();
        if (!has_next) break;
#pragma unroll
        for (int a = 0; a < 2; ++a)
#pragma unroll
            for (int b = 0; b < 2; ++b)
#pragma unroll
                for (int m = 0; m < 4; ++m)
#pragma unroll
                    for (int n = 0; n < 2; ++n) acc[a][b][m][n] = (f32x4){0.f, 0.f, 0.f, 0.f};
        cur = nxt; cA = nA; cB = nB; ++ui;
    }
    PG8_WAIT_V(0);
    if (wr == 0) PG8_BAR;
    PG8_BAR;
    if constexpr (Epi::AFTER_DRAIN) { E.fused(acc, cur, wr, wc, fr, fq, lds, wid, lane); S.done(cur); }
    PG8_STAMP();
    if (STAMP && wid == 0) { stamps[lane] = lane < nts ? (((unsigned long long)(unsigned)ts_hi << 32) | (unsigned)ts_lo) : 0ull;
        if (lane == 62) stamps[62] = rt_entry; if (lane == 63) stamps[63] = (unsigned long long)wall_clock64(); }
#undef PG8_STAMP
#undef PG8_SA
#undef PG8_SB
#undef PG8_STAGE
#undef PG8_LDA
#undef PG8_LDB
#undef PG8_MMA
#undef PG8_WAIT_V
#undef PG8_WAIT_L
#undef PG8_BAR
#undef PG8_SCHED
}
}
#define LAS __attribute__((address_space(3)))
#define XB_TMO      128
#define XB_XCNT(j)  (256  + 64 * (j))
#define XB_XSUB(j)  (1280 + 64 * (j))
#define XB_XGEN(j)  (2304 + 64 * (j))
#define XB_TOP      3328
#define XB_TOPGEN   3392
#define XCD_BAR_WORDS 3456
#define XB_SPIN_CAP (1u << 18)

__device__ __forceinline__ unsigned xb_ld(unsigned* p)              { return __hip_atomic_load(p, __ATOMIC_RELAXED, __HIP_MEMORY_SCOPE_AGENT); }
__device__ __forceinline__ unsigned xb_add(unsigned* p, unsigned v) { return __hip_atomic_fetch_add(p, v, __ATOMIC_RELAXED, __HIP_MEMORY_SCOPE_AGENT); }
__device__ __forceinline__ unsigned xb_xcc_id() { return (unsigned)__builtin_amdgcn_s_getreg((3 << 11) | 20) & 0xFu; }
#define XB_SPIN(cond, bar) do { unsigned _sp = 0; while (cond) { __builtin_amdgcn_s_sleep(1); \
    if ((++_sp & 255u) == 0u) { if (xb_ld(&(bar)[XB_TMO])) break; if (_sp > XB_SPIN_CAP) { atomicAdd(&(bar)[XB_TMO], 1u); break; } } } } while (0)

struct XcdBarrier {
    unsigned* bar; unsigned x;
    volatile LAS unsigned* st;
};

__device__ __forceinline__ XcdBarrier xcd_barrier_post(unsigned* bar, volatile LAS unsigned* st) {
    XcdBarrier b; b.bar = bar; b.x = xb_xcc_id(); b.st = st;
    if (threadIdx.x == 0) (void)xb_add(&bar[XB_XCNT(b.x)], 1u);
    return b;
}
__device__ __forceinline__ void xcd_barrier_complete(unsigned* bar, unsigned x, unsigned& nloc, unsigned& nx) {
    const unsigned G = gridDim.x * gridDim.y * gridDim.z;
    unsigned sum, cnt, mine, sp = 0u;
    for (;;) {
        sum = 0u; cnt = 0u; mine = 0u;
#pragma unroll
        for (unsigned j = 0; j < 16; ++j) { const unsigned c = xb_ld(&bar[XB_XCNT(j)]); sum += c; cnt += (c > 0u) ? 1u : 0u; mine = (j == x) ? c : mine; }
        if (sum == G) break;
        __builtin_amdgcn_s_sleep(1);
        if ((++sp & 255u) == 0u) { if (xb_ld(&bar[XB_TMO])) break; if (sp > XB_SPIN_CAP) { atomicAdd(&bar[XB_TMO], 1u); break; } }
    }
    nloc = mine > 0u ? mine : 1u; nx = cnt > 0u ? cnt : 1u;
}

__device__ __forceinline__ void xcd_barrier(const XcdBarrier& b) {
    asm volatile("s_waitcnt vmcnt(0)" ::: "memory");
    __syncthreads();
    if (threadIdx.x == 0) {
        unsigned* bar = b.bar;
        __builtin_amdgcn_s_waitcnt(0);
        unsigned nloc = b.st[0], nx = b.st[1];
        if (nloc == 0u) { xcd_barrier_complete(bar, b.x, nloc, nx); b.st[0] = nloc; b.st[1] = nx; }
        const unsigned old = xb_add(&bar[XB_XSUB(b.x)], 1u);
        const unsigned gen = old / nloc;
        if (old + 1u == (gen + 1u) * nloc) {
            __builtin_amdgcn_fence(__ATOMIC_RELEASE, "agent");
            asm volatile("s_waitcnt vmcnt(0)" ::: "memory");
            const unsigned og = xb_add(&bar[XB_TOP], 1u);
            const unsigned tg = og / nx;
            if (og + 1u == (tg + 1u) * nx) xb_add(&bar[XB_TOPGEN], 1u);
            else XB_SPIN(xb_ld(&bar[XB_TOPGEN]) == tg, bar);
            __builtin_amdgcn_fence(__ATOMIC_ACQUIRE, "agent");
            xb_add(&bar[XB_XGEN(b.x)], 1u);
            asm volatile("s_waitcnt vmcnt(0)" ::: "memory");
        } else {
            XB_SPIN(xb_ld(&bar[XB_XGEN(b.x)]) == gen, bar);
            __builtin_amdgcn_fence(__ATOMIC_ACQUIRE, "agent");
            asm volatile("s_waitcnt vmcnt(0)" ::: "memory");
        }
    }
    __syncthreads();
}


using pg8::bf16_t; using pg8::bf16x8; using pg8::f32x4; using pg8::u32x4; using pg8::cvt_pk_bf16;
typedef unsigned u32x2 __attribute__((ext_vector_type(2)));
#define DEVI __device__ __forceinline__

constexpr int NPR = 16384, NRV = 16512, NRP = 16640;
constexpr int LDS_BYTES = 135168;
constexpr int LDS_MISC = 131072;

constexpr size_t WS_CTL = 0;
constexpr size_t WS_WT_MOD = 32768;
constexpr size_t WS_WT_INAB = WS_WT_MOD + 25165824;
constexpr size_t WS_WT_OUTAB = WS_WT_INAB + 25165824;
constexpr size_t WS_WT_CIN = WS_WT_OUTAB + 8388608;
constexpr size_t WS_WT_GLU = WS_WT_CIN + 8388608;
constexpr size_t WS_WT_COUT = WS_WT_GLU + 4194304;
constexpr size_t WS_WT_LRU = WS_WT_COUT + 4194304;
constexpr size_t WS_SILUC = WS_WT_LRU + 1048576;
constexpr size_t WS_MOD = WS_SILUC + 524288;
constexpr size_t WS_TAIL = WS_MOD + 12582912;
constexpr size_t WS_YBUF = WS_TAIL + 1064960;
constexpr size_t WS_PROJ = WS_YBUF + 68157440;
constexpr size_t WS_UT = WS_PROJ + 204472320;
constexpr size_t WS_WB = WS_UT + 33554432;
constexpr size_t WS_QT = WS_WB + 33554432;
constexpr size_t WS_KT = WS_QT + 33554432;
constexpr size_t WS_EGL = WS_KT + 33554432;
constexpr size_t WS_WT_TAIL = WS_EGL + 8192;
constexpr size_t WS_END = WS_WT_TAIL + 65536;
constexpr size_t WS_QK = WS_WT_MOD;
constexpr size_t WS_Y2 = WS_YBUF + 34078720;

constexpr size_t O_YP = 0, O_YS = 16777216, O_PCA = O_YS + 131072, O_PLRU = O_PCA + 49152, O_PCB = O_PLRU + 16384, O_PDEL = O_PCB + 147456,
                 O_PSR = O_PDEL + 2097152, O_PSI = O_PSR + 65536, O_SCA = O_PSI + 65536, O_SLRU = O_SCA + 786432, O_SCB = O_SLRU + 262144,
                 O_SDEL = O_SCB + 2359296, O_SSR = O_SDEL + 33554432, O_SSI = O_SSR + 1048576, O_END = O_SSI + 1048576;

enum { I_XP = 0, I_XS, I_CP, I_CS, I_SCA, I_SLRU, I_SCB, I_SDEL, I_SSR, I_SSI, I_NORMW, I_MODW, I_MODB, I_ABIN, I_ABOUT, I_CAW, I_CAB, I_GXW, I_GXB, I_GAW, I_GAB, I_APAR,
       I_CBW, I_ALOG, I_DTB, I_GNW, I_CIN, I_COUT, I_ARE, I_AIM, I_BRE, I_BIM, I_CRE, I_CIM, I_S5D, I_LOGDT, I_GLUW, I_GLUB, I_FNW, N_IN };

struct Params {
  const float* in[N_IN];
  float* out;
  unsigned char* ws;
  int ph_lo, ph_hi;
};

typedef const Params __attribute__((address_space(4)))* KP;
DEVI float bf2f(unsigned v16) { return __uint_as_float(v16 << 16); }
DEVI float bflo(unsigned w) { return __uint_as_float(w << 16); }
DEVI float bfhi(unsigned w) { return __uint_as_float(w & 0xffff0000u); }
DEVI bf16_t f2bf(float f) { return (bf16_t)(cvt_pk_bf16(f, 0.f) & 0xffffu); }
DEVI float fexp_(float x) { return __builtin_amdgcn_exp2f(x * 1.4426950408889634f); }
DEVI float sigmoidf_(float x) { return __builtin_amdgcn_rcpf(1.f + fexp_(-x)); }
DEVI float siluf_(float x) { return x * __builtin_amdgcn_rcpf(1.f + fexp_(-x)); }
DEVI float softplusf_(float x) { return x > 20.f ? x : log1pf(__expf(x)); }
DEVI float geluf_(float x) { const float z = 0.7978845608028654f * (x + 0.044715f * x * x * x); const float e = fexp_(2.f * z); return x - x * __builtin_amdgcn_rcpf(1.f + e); }
DEVI void lds_barrier() { asm volatile("s_waitcnt lgkmcnt(0)" ::: "memory"); __builtin_amdgcn_s_barrier(); asm volatile("" ::: "memory"); }
DEVI float wave_sum(float v) {
#pragma unroll
  for (int o = 32; o >= 1; o >>= 1) v += __shfl_xor(v, o);
  return v;
}
DEVI void unpack8(const u32x4 w, float (&f)[8]) { f[0] = bflo(w.x); f[1] = bfhi(w.x); f[2] = bflo(w.y); f[3] = bfhi(w.y); f[4] = bflo(w.z); f[5] = bfhi(w.z); f[6] = bflo(w.w); f[7] = bfhi(w.w); }
DEVI u32x4 pack8(const float (&f)[8]) { u32x4 w; w.x = cvt_pk_bf16(f[0], f[1]); w.y = cvt_pk_bf16(f[2], f[3]); w.z = cvt_pk_bf16(f[4], f[5]); w.w = cvt_pk_bf16(f[6], f[7]); return w; }
DEVI bf16x8 as_bf16x8(const u32x4 w) { union { u32x4 u; bf16x8 b; } c; c.u = w; return c.b; }
DEVI f32x4 mfma16(bf16x8 a, bf16x8 b, f32x4 c) { return __builtin_amdgcn_mfma_f32_16x16x32_bf16(a, b, c, 0, 0, 0); }

struct EpiRes {
  static constexpr bool PERM = false, AFTER_DRAIN = false;
  const float* xp; const float* xs; float* xo; const float* gate;
  __device__ __forceinline__ void operator()(const f32x4 (&acc)[2][2][4][2], const pg8::Unit& u, int wr, int wc, int fr, int fq) const {
    const int row0 = u.pm * 256 + wr * 64 + fr, col0 = u.pn * 256 + wc * 32 + 4 * fq;
#pragma unroll
    for (int ai = 0; ai < 2; ++ai)
#pragma unroll
      for (int m = 0; m < 4; ++m) {
        const int row = row0 + ai * 128 + m * 16;
        if (row < NRV) {
          const float* xi = (row < NPR ? xp + (size_t)row * 1024 : xs + (size_t)(row - NPR) * 1024) + col0;
          const int mrow = row < NPR ? (row >> 11) : 8 + (row - NPR);
          const float* gp = gate + (size_t)mrow * 12288 + col0;
          float* op = xo + (size_t)row * 1024 + col0;
#pragma unroll
          for (int bj = 0; bj < 2; ++bj)
#pragma unroll
            for (int n = 0; n < 2; ++n) {
              const f32x4 xv = *(const f32x4*)(xi + bj * 128 + n * 16), gv = *(const f32x4*)(gp + bj * 128 + n * 16);
              *(f32x4*)(op + bj * 128 + n * 16) = xv + gv * acc[ai][bj][m][n];
            }
        }
      }
  }
};
struct EpiGlu {
  static constexpr bool PERM = true, AFTER_DRAIN = false;
  const bf16_t* y1; const bf16_t* z; bf16_t* y2; const float* bias;
  __device__ __forceinline__ void operator()(const f32x4 (&acc)[2][2][4][2], const pg8::Unit& u, int wr, int wc, int fr, int fq) const {
    const int row0 = u.pm * 256 + wr * 64 + fr, col0 = u.pn * 256 + wc * 32 + 8 * fq;
#pragma unroll
    for (int ai = 0; ai < 2; ++ai)
#pragma unroll
      for (int m = 0; m < 4; ++m) {
        const int row = row0 + ai * 128 + m * 16;
#pragma unroll
        for (int bj = 0; bj < 2; ++bj) {
          const int col = col0 + bj * 128;
          const f32x4 b0 = *(const f32x4*)(bias + col), b1 = *(const f32x4*)(bias + col + 4);
          const u32x4 yw = *(const u32x4*)(y1 + (size_t)row * 1024 + col), zw = *(const u32x4*)(z + (size_t)row * 2048 + col);
          float yf[8], zf[8], o[8]; unpack8(yw, yf); unpack8(zw, zf);
          const f32x4 a0 = acc[ai][bj][m][0] + b0, a1 = acc[ai][bj][m][1] + b1;
#pragma unroll
          for (int e = 0; e < 4; ++e) { o[e] = yf[e] * sigmoidf_(a0[e]) * siluf_(zf[e]); o[4 + e] = yf[4 + e] * sigmoidf_(a1[e]) * siluf_(zf[4 + e]); }
          *(u32x4*)(y2 + (size_t)row * 1024 + col) = pack8(o);
        }
      }
  }
};

struct TileDesc { const float* src; bf16_t* dst; int ldsrc, lddst, k0, n0; };
DEVI TileDesc prep_tile(KP p, int t) {
  TileDesc d; int tt = t;
  if (tt < 3072) { const int mat = tt / 768, r = tt % 768; d.k0 = (r / 48) * 64; d.n0 = (r % 48) * 64; d.src = p->in[I_MODW] + (size_t)mat * 1024 * 3072; d.ldsrc = 3072; d.dst = (bf16_t*)(p->ws + WS_WT_MOD) + (size_t)mat * 3072 * 1024; d.lddst = 1024; }
  else if ((tt -= 3072) < 3072) { const int mat = tt / 1536, r = tt % 1536; d.k0 = (r / 96) * 64; d.n0 = (r % 96) * 64; d.src = p->in[I_ABIN] + (size_t)mat * 1024 * 6160; d.ldsrc = 6160; d.dst = (bf16_t*)(p->ws + WS_WT_INAB) + (size_t)mat * 6144 * 1024; d.lddst = 1024; }
  else if ((tt -= 3072) < 1024) { const int mat = tt / 512, r = tt % 512; d.k0 = (r / 16) * 64; d.n0 = (r % 16) * 64; d.src = p->in[I_ABOUT] + (size_t)mat * 2048 * 1024; d.ldsrc = 1024; d.dst = (bf16_t*)(p->ws + WS_WT_OUTAB) + (size_t)mat * 1024 * 2048; d.lddst = 2048; }
  else if ((tt -= 1024) < 1024) { const int mat = tt / 512, r = tt % 512; d.k0 = (r / 32) * 64; d.n0 = (r % 32) * 64; d.src = p->in[I_CIN] + (size_t)mat * 1024 * 2048; d.ldsrc = 2048; d.dst = (bf16_t*)(p->ws + WS_WT_CIN) + (size_t)mat * 2048 * 1024; d.lddst = 1024; }
  else if ((tt -= 1024) < 512) { const int mat = tt / 256, r = tt % 256; d.k0 = (r / 16) * 64; d.n0 = (r % 16) * 64; d.src = p->in[I_COUT] + (size_t)mat * 1024 * 1024; d.ldsrc = 1024; d.dst = (bf16_t*)(p->ws + WS_WT_COUT) + (size_t)mat * 1024 * 1024; d.lddst = 1024; }
  else if ((tt -= 512) < 512) { const int mat = tt / 256, r = tt % 256; d.k0 = (r / 16) * 64; d.n0 = (r % 16) * 64; d.src = p->in[I_GLUW] + (size_t)mat * 1024 * 1024; d.ldsrc = 1024; d.dst = (bf16_t*)(p->ws + WS_WT_GLU) + (size_t)mat * 1024 * 1024; d.lddst = 1024; }
  else { tt -= 512; const int gate = tt / 64; const int r2 = tt % 64; const int mat = r2 / 4, r = r2 % 4;
    d.k0 = (r / 2) * 64; d.n0 = (r % 2) * 64; d.src = p->in[gate ? I_GAW : I_GXW] + (size_t)mat * 16384; d.ldsrc = 128;
    d.dst = (bf16_t*)(p->ws + WS_WT_LRU) + (size_t)(((mat >> 3) * 2 + gate) * 8 + (mat & 7)) * 16384; d.lddst = 128; }
  return d;
}
DEVI void phase_prep(KP p, float* lds) {
  const int tid = tidx_(), tx = tid & 15, ty = tid >> 4, nn = tid >> 3, ks = (tid & 7) * 8;
  for (int t0 = bidx_(); t0 < 9344; t0 += 4 * gdim_()) {
    float4 v[4][2];
#pragma unroll
    for (int q = 0; q < 4; ++q) { const int t = t0 + q * gdim_();
      if (t < 9344) { const TileDesc d = prep_tile(p, t);
#pragma unroll
        for (int pp = 0; pp < 2; ++pp) v[q][pp] = *(const float4*)(d.src + (size_t)(d.k0 + ty + pp * 32) * d.ldsrc + d.n0 + tx * 4); } }
#pragma unroll
    for (int q = 0; q < 4; ++q) { float* tile = lds + q * 4160;
#pragma unroll
      for (int pp = 0; pp < 2; ++pp) { const int k = ty + pp * 32; tile[k * 65 + tx * 4 + 0] = v[q][pp].x; tile[k * 65 + tx * 4 + 1] = v[q][pp].y; tile[k * 65 + tx * 4 + 2] = v[q][pp].z; tile[k * 65 + tx * 4 + 3] = v[q][pp].w; } }
    lds_barrier();
#pragma unroll
    for (int q = 0; q < 4; ++q) { const int t = t0 + q * gdim_();
      if (t < 9344) { const TileDesc d = prep_tile(p, t); const float* tile = lds + q * 4160; float f[8];
#pragma unroll
        for (int jx = 0; jx < 8; ++jx) f[jx] = tile[(ks + jx) * 65 + nn];
        *(u32x4*)(d.dst + (size_t)(d.n0 + nn) * d.lddst + d.k0 + ks) = pack8(f); } }
    lds_barrier();
  }
  { bf16_t* wtt = (bf16_t*)(p->ws + WS_WT_TAIL);
    for (int e = bidx_() * 512 + tidx_(); e < 32768; e += gdim_() * 512) { const int jj = e >> 14, cc = (e >> 10) & 15, k = e & 1023;
      wtt[e] = f2bf(p->in[I_ABIN][(size_t)jj * 1024 * 6160 + (size_t)k * 6160 + 6144 + cc]); } }
  bf16_t* sc = (bf16_t*)(p->ws + WS_SILUC);
  for (int e = bidx_() * 512 + tidx_(); e < 256 * 1024 / 4; e += gdim_() * 512) {
    const int row = e >> 8, c4 = (e & 255) * 4; float4 v = make_float4(0.f, 0.f, 0.f, 0.f);
    if (row < 8) v = *(const float4*)(p->in[I_CP] + row * 1024 + c4); else if (row < 136) v = *(const float4*)(p->in[I_CS] + (row - 8) * 1024 + c4);
    u32x2 w; w.x = cvt_pk_bf16(row < 136 ? siluf_(v.x) : 0.f, row < 136 ? siluf_(v.y) : 0.f); w.y = cvt_pk_bf16(row < 136 ? siluf_(v.z) : 0.f, row < 136 ? siluf_(v.w) : 0.f);
    *(u32x2*)(sc + row * 1024 + c4) = w;
  }
}

DEVI void norm_row2(const float* x0, const float* x1, bool two, const float (&wm)[16], const float (&sh)[16], bf16_t* h0, bf16_t* h1, int lane) {
  float4 v0[4], v1[4]; float s0 = 0.f, s1 = 0.f;
#pragma unroll
  for (int i = 0; i < 4; ++i) { v0[i] = *(const float4*)(x0 + i * 256 + lane * 4); v1[i] = two ? *(const float4*)(x1 + i * 256 + lane * 4) : make_float4(0.f, 0.f, 0.f, 0.f); }
#pragma unroll
  for (int i = 0; i < 4; ++i) { s0 += v0[i].x * v0[i].x + v0[i].y * v0[i].y + v0[i].z * v0[i].z + v0[i].w * v0[i].w; s1 += v1[i].x * v1[i].x + v1[i].y * v1[i].y + v1[i].z * v1[i].z + v1[i].w * v1[i].w; }
#pragma unroll
  for (int o = 32; o >= 1; o >>= 1) { s0 += __shfl_xor(s0, o); s1 += __shfl_xor(s1, o); }
  const float r0 = __builtin_amdgcn_rsqf(s0 * (1.f / 1024.f) + 1e-6f), r1 = __builtin_amdgcn_rsqf(s1 * (1.f / 1024.f) + 1e-6f);
#pragma unroll
  for (int i = 0; i < 4; ++i) { const int k = i * 256 + lane * 4;
    u32x2 w; w.x = cvt_pk_bf16(v0[i].x * r0 * wm[i * 4 + 0] + sh[i * 4 + 0], v0[i].y * r0 * wm[i * 4 + 1] + sh[i * 4 + 1]); w.y = cvt_pk_bf16(v0[i].z * r0 * wm[i * 4 + 2] + sh[i * 4 + 2], v0[i].w * r0 * wm[i * 4 + 3] + sh[i * 4 + 3]);
    *(u32x2*)(h0 + k) = w;
    if (two) { u32x2 w2; w2.x = cvt_pk_bf16(v1[i].x * r1 * wm[i * 4 + 0] + sh[i * 4 + 0], v1[i].y * r1 * wm[i * 4 + 1] + sh[i * 4 + 1]); w2.y = cvt_pk_bf16(v1[i].z * r1 * wm[i * 4 + 2] + sh[i * 4 + 2], v1[i].w * r1 * wm[i * 4 + 3] + sh[i * 4 + 3]);
      *(u32x2*)(h1 + k) = w2; } }
}
DEVI void norm_coefs(KP p, int layer, int mrow, int lane, float (&wm)[16], float (&sh)[16]) {
  const float* nw = p->in[I_NORMW] + layer * 1024;
  const float* md = (const float*)(p->ws + WS_MOD) + (size_t)mrow * 12288 + layer * 3072;
#pragma unroll
  for (int i = 0; i < 4; ++i) { const int k = i * 256 + lane * 4; const float4 w4 = *(const float4*)(nw + k), s4 = *(const float4*)(md + k), c4 = *(const float4*)(md + 1024 + k);
    wm[i * 4 + 0] = w4.x * (1.f + c4.x); wm[i * 4 + 1] = w4.y * (1.f + c4.y); wm[i * 4 + 2] = w4.z * (1.f + c4.z); wm[i * 4 + 3] = w4.w * (1.f + c4.w);
    sh[i * 4 + 0] = s4.x; sh[i * 4 + 1] = s4.y; sh[i * 4 + 2] = s4.z; sh[i * 4 + 3] = s4.w; }
}
DEVI void phase_norm(KP p, int layer, float* lds) {
  const int tid = tidx_(), lane = tid & 63, wave = tid >> 6;
  bf16_t* hb = (bf16_t*)(p->ws + WS_YBUF);
  float wm[16], sh[16];
  for (int gw = bidx_() * 8 + wave; gw < 2048; gw += gdim_() * 8) {
    const int r0 = gw * 8;
    norm_coefs(p, layer, r0 >> 11, lane, wm, sh);
    const float* xb = (layer == 0) ? p->in[I_XP] : p->out;
#pragma unroll 2
    for (int i = 0; i < 8; i += 2) norm_row2(xb + (size_t)(r0 + i) * 1024, xb + (size_t)(r0 + i + 1) * 1024, true, wm, sh, hb + (size_t)(r0 + i) * 1024, hb + (size_t)(r0 + i + 1) * 1024, lane);
    if (gw < 128) {
      norm_coefs(p, layer, 8 + gw, lane, wm, sh);
      const float* xs = (layer == 0) ? p->in[I_XS] + (size_t)gw * 1024 : p->out + (size_t)(NPR + gw) * 1024;
      norm_row2(xs, xs, false, wm, sh, hb + (size_t)(NPR + gw) * 1024, hb, lane);
    }
  }
}
DEVI void tail_gemm(KP p, int j) {
  const int tid = tidx_(), lane = tid & 63, wave = tid >> 6, l15 = lane & 15, lq = lane >> 4;
  const bf16_t* hb = (const bf16_t*)(p->ws + WS_YBUF);
  const bf16_t* bp = (const bf16_t*)(p->ws + WS_WT_TAIL) + (size_t)j * 16384 + l15 * 1024 + lq * 8;
  float* tl = (float*)(p->ws + WS_TAIL);
  for (int t = bidx_() * 8 + wave; t < 1032; t += gdim_() * 8) {
    const bf16_t* ap = hb + (size_t)(t * 16 + l15) * 1024 + lq * 8;
    f32x4 acc0 = (f32x4){0.f, 0.f, 0.f, 0.f}, acc1 = (f32x4){0.f, 0.f, 0.f, 0.f};
#pragma unroll 1
    for (int k0 = 0; k0 < 1024; k0 += 256) {
      u32x4 a[8], b[8];
#pragma unroll
      for (int u = 0; u < 8; ++u) { a[u] = *(const u32x4*)(ap + k0 + u * 32); b[u] = *(const u32x4*)(bp + k0 + u * 32); }
#pragma unroll
      for (int u = 0; u < 8; u += 2) { acc0 = mfma16(as_bf16x8(a[u]), as_bf16x8(b[u]), acc0); acc1 = mfma16(as_bf16x8(a[u + 1]), as_bf16x8(b[u + 1]), acc1); }
    }
    acc0 = acc0 + acc1;
#pragma unroll
    for (int r = 0; r < 4; ++r) tl[(size_t)(t * 16 + lq * 4 + r) * 16 + l15] = acc0[r];
  }
}

DEVI void lru_item(KP p, int j, int item, unsigned char* lds) {
  const int tid = tidx_(), lane = tid & 63, wave = tid >> 6;
  const bool prompt = item < 128;
  const int b = prompt ? (item >> 4) : 0, hd = prompt ? ((item >> 1) & 7) : ((item - 128) >> 1), half = item & 1;
  bf16_t* WX = (bf16_t*)lds;
  bf16_t* XA = (bf16_t*)(lds + 34816);
  float* AA = (float*)(lds + 52224);
  float* BB = (float*)(lds + 69632);
  bf16_t* RAW = (bf16_t*)(lds + 87040);
  float* CAR = (float*)(lds + 105472);
  const bf16_t* proj = (const bf16_t*)(p->ws + WS_PROJ);
  bf16_t* ybuf = (bf16_t*)(p->ws + WS_YBUF);
  { const bf16_t* wt = (const bf16_t*)(p->ws + WS_WT_LRU);
#pragma unroll
    for (int q = 0; q < 4; ++q) { const int e = tid + q * 512, gate = e >> 10, o = (e & 1023) >> 4, c8 = e & 15;
      *(u32x4*)(WX + (gate * 64 + o) * 136 + c8 * 8) = *(const u32x4*)(wt + ((size_t)((j * 2 + gate) * 8 + hd) * 128 + half * 64 + o) * 128 + c8 * 8); } }
  const int ch8 = tid & 15, rsub = tid >> 4, chb = hd * 128 + ch8 * 8;
  float cw[4][8], cb[8];
#pragma unroll
  for (int t = 0; t < 4; ++t)
#pragma unroll
    for (int e = 0; e < 8; ++e) cw[t][e] = p->in[I_CAW][(size_t)(j * 4 + t) * 1024 + chb + e];
#pragma unroll
  for (int e = 0; e < 8; ++e) cb[e] = p->in[I_CAB][j * 1024 + chb + e];
  const int rt = wave >> 1, chh = wave & 1, l15 = lane & 15, lq = lane >> 4;
  float gxb[2], gab[2], spv[2];
#pragma unroll
  for (int c2 = 0; c2 < 2; ++c2) { const int gch = hd * 128 + half * 64 + chh * 32 + c2 * 16 + l15;
    gxb[c2] = p->in[I_GXB][j * 1024 + gch]; gab[c2] = p->in[I_GAB][j * 1024 + gch]; spv[c2] = softplusf_(-p->in[I_APAR][j * 1024 + gch]); }
  const int sch = hd * 128 + half * 64 + lane;
  float hcar = 0.f;
  const int ntiles = prompt ? 32 : 2;
  u32x4 pre[3];
  if (prompt) {
#pragma unroll
    for (int q = 0; q < 3; ++q) { const int e = tid + q * 512, row = e >> 4, c8 = e & 15, t = row - 3; pre[q] = (u32x4){0u, 0u, 0u, 0u};
      if (e < 1072 && t >= 0) pre[q] = *(const u32x4*)(proj + (size_t)(b * 2048 + t) * 6144 + hd * 128 + c8 * 8); }
  }
  for (int tile = 0; tile < ntiles; ++tile) {
    bf16_t zav[8];
#pragma unroll
    for (int i = 0; i < 8; ++i) { const size_t grow = prompt ? (size_t)(b * 2048 + tile * 64 + wave * 8 + i) : (size_t)(NPR + tile * 64 + wave * 8 + i); zav[i] = proj[grow * 6144 + 1024 + sch]; }
    if (prompt) {
#pragma unroll
      for (int q = 0; q < 3; ++q) { const int e = tid + q * 512; if (e < 1072) *(u32x4*)(RAW + (e >> 4) * 136 + (e & 15) * 8) = pre[q]; }
      if (tile + 1 < ntiles) {
#pragma unroll
        for (int q = 0; q < 3; ++q) { const int e = tid + q * 512, row = e >> 4, c8 = e & 15, t = (tile + 1) * 64 + row - 3;
          if (e < 1072) pre[q] = *(const u32x4*)(proj + (size_t)(b * 2048 + t) * 6144 + hd * 128 + c8 * 8); }
      }
      lds_barrier();
#pragma unroll
      for (int pp = 0; pp < 2; ++pp) {
        const int i = rsub + pp * 32; float acc[8];
#pragma unroll
        for (int e = 0; e < 8; ++e) acc[e] = cb[e];
#pragma unroll
        for (int tap = 0; tap < 4; ++tap) { float xf[8]; unpack8(*(const u32x4*)(RAW + (i + tap) * 136 + ch8 * 8), xf);
#pragma unroll
          for (int e = 0; e < 8; ++e) acc[e] += cw[tap][e] * xf[e]; }
        *(u32x4*)(XA + i * 136 + ch8 * 8) = pack8(acc);
      }
      if (tile == 31 && half == 0 && tid < 48) { const int r3 = tid >> 4, c8 = tid & 15; float xf[8]; unpack8(*(const u32x4*)(RAW + (64 + r3) * 136 + c8 * 8), xf);
        float* o = p->out + O_PCA + (size_t)((j * 8 + b) * 3 + r3) * 1024 + hd * 128 + c8 * 8;
        *(float4*)o = make_float4(xf[0], xf[1], xf[2], xf[3]); *(float4*)(o + 4) = make_float4(xf[4], xf[5], xf[6], xf[7]); }
    } else {
#pragma unroll
      for (int pp = 0; pp < 2; ++pp) {
        const int i = rsub + pp * 32; float acc[8], x3[8];
#pragma unroll
        for (int e = 0; e < 8; ++e) acc[e] = cb[e];
        const int brow = tile * 64 + i;
        const float* st = p->in[I_SCA] + (size_t)((j * 128 + brow) * 3) * 1024 + chb;
        float* so = p->out + O_SCA + (size_t)((j * 128 + brow) * 3) * 1024 + chb;
#pragma unroll
        for (int tap = 0; tap < 3; ++tap) { const float4 s0 = *(const float4*)(st + tap * 1024), s1 = *(const float4*)(st + tap * 1024 + 4);
          const float xf[8] = {s0.x, s0.y, s0.z, s0.w, s1.x, s1.y, s1.z, s1.w};
#pragma unroll
          for (int e = 0; e < 8; ++e) acc[e] += cw[tap][e] * xf[e];
          if (tap >= 1 && half == 0) { *(float4*)(so + (tap - 1) * 1024) = s0; *(float4*)(so + (tap - 1) * 1024 + 4) = s1; } }
        const u32x4 w = *(const u32x4*)(proj + (size_t)(NPR + brow) * 6144 + chb); unpack8(w, x3);
#pragma unroll
        for (int e = 0; e < 8; ++e) acc[e] += cw[3][e] * x3[e];
        if (half == 0) { *(float4*)(so + 2 * 1024) = make_float4(x3[0], x3[1], x3[2], x3[3]); *(float4*)(so + 2 * 1024 + 4) = make_float4(x3[4], x3[5], x3[6], x3[7]); }
        *(u32x4*)(XA + i * 136 + ch8 * 8) = pack8(acc);
      }
    }
    lds_barrier();
    f32x4 accx[2], acca[2];
#pragma unroll
    for (int c2 = 0; c2 < 2; ++c2) { accx[c2] = (f32x4){0.f, 0.f, 0.f, 0.f}; acca[c2] = (f32x4){0.f, 0.f, 0.f, 0.f}; }
#pragma unroll
    for (int kk = 0; kk < 4; ++kk) {
      const bf16x8 a = *(const bf16x8*)(XA + (rt * 16 + l15) * 136 + lq * 8 + kk * 32);
#pragma unroll
      for (int c2 = 0; c2 < 2; ++c2) {
        const bf16x8 bx = *(const bf16x8*)(WX + (chh * 32 + c2 * 16 + l15) * 136 + lq * 8 + kk * 32);
        const bf16x8 ba = *(const bf16x8*)(WX + (64 + chh * 32 + c2 * 16 + l15) * 136 + lq * 8 + kk * 32);
        accx[c2] = mfma16(a, bx, accx[c2]); acca[c2] = mfma16(a, ba, acca[c2]);
      }
    }
#pragma unroll
    for (int c2 = 0; c2 < 2; ++c2)
#pragma unroll
      for (int r = 0; r < 4; ++r) {
        const int row = rt * 16 + lq * 4 + r, oc = chh * 32 + c2 * 16 + l15;
        const float gx = sigmoidf_(accx[c2][r] + gxb[c2]), ga = sigmoidf_(acca[c2][r] + gab[c2]);
        const float log_a = -8.f * ga * spv[c2];
        const float a = fexp_(log_a);
        float mult = __builtin_amdgcn_sqrtf(fmaxf(1.f - a * a, 0.f));
        if (prompt && tile == 0 && row == 0) mult = 1.f;
        const float xv = bf2f(XA[row * 136 + half * 64 + oc]);
        AA[row * 68 + oc] = a; BB[row * 68 + oc] = mult * gx * xv;
      }
    lds_barrier();
    float hl[8], pc[8];
    { float h = 0.f, P = 1.f;
#pragma unroll
      for (int i = 0; i < 8; ++i) { const float a = AA[(wave * 8 + i) * 68 + lane], bv = BB[(wave * 8 + i) * 68 + lane];
        if (prompt) { h = a * h + bv; P *= a; hl[i] = h; pc[i] = P; } else { hl[i] = bv; pc[i] = a; } }
      CAR[(wave * 64 + lane) * 2] = P; CAR[(wave * 64 + lane) * 2 + 1] = h; }
    lds_barrier();
    float cin = 0.f;
    if (prompt) { float c = hcar;
#pragma unroll
      for (int s = 0; s < 8; ++s) { const float Ps = CAR[(s * 64 + lane) * 2], Es = CAR[(s * 64 + lane) * 2 + 1]; if (s == wave) cin = c; c = Ps * c + Es; }
      hcar = c; }
#pragma unroll
    for (int i = 0; i < 8; ++i) {
      const int rowl = tile * 64 + wave * 8 + i;
      float hv;
      if (prompt) hv = hl[i] + pc[i] * cin;
      else { const float h0 = p->in[I_SLRU][(size_t)(j * 128 + rowl) * 1024 + sch]; hv = pc[i] * h0 + hl[i]; p->out[O_SLRU + (size_t)(j * 128 + rowl) * 1024 + sch] = hv; }
      const size_t grow = prompt ? (size_t)(b * 2048 + rowl) : (size_t)(NPR + rowl);
      ybuf[grow * 2048 + sch] = f2bf(hv * siluf_(bf2f(zav[i])));
    }
  }
  if (prompt && wave == 0) p->out[O_PLRU + (size_t)(j * 8 + b) * 1024 + sch] = hcar;
}

DEVI void gdn_prep_item(KP p, int j, int cid, unsigned char* lds) {
  const int tid = tidx_(), lane = tid & 63, wave = tid >> 6;
  const int b = cid >> 8, h = (cid >> 5) & 7, c = cid & 31;
  const int row0 = b * 2048 + c * 64;
  bf16_t* QN = (bf16_t*)lds; bf16_t* KN = (bf16_t*)(lds + 17408); bf16_t* VN = (bf16_t*)(lds + 34816);
  float* AM = (float*)(lds + 52224); float* GC = (float*)(lds + 69632); float* BETA = (float*)(lds + 69888); float* BEG = (float*)(lds + 70144);
  const bf16_t* proj = (const bf16_t*)(p->ws + WS_PROJ);
  const float* tl = (const float*)(p->ws + WS_TAIL);
  if (wave == 0) {
    const float* t = tl + (size_t)(row0 + lane) * 16;
    float g = -fexp_(p->in[I_ALOG][j * 8 + h]) * softplusf_(t[8 + h] + p->in[I_DTB][j * 8 + h]);
    const float beta = sigmoidf_(t[h]);
#pragma unroll
    for (int o = 1; o < 64; o <<= 1) { const float v = __shfl_up(g, o); if (lane >= o) g += v; }
    GC[lane] = g; BETA[lane] = beta; BEG[lane] = beta * fexp_(g);
  }
  bf16_t* RAWB = (bf16_t*)(lds + 70656);
  bf16_t* AMB = (bf16_t*)(lds + 70656);
  bf16_t* XT = (bf16_t*)(lds + 79872);
  float* CORR = (float*)lds;
  float* CW = (float*)(lds + 123184);
  {
    u32x4 rv[7];
#pragma unroll
    for (int q = 0; q < 7; ++q) { const int e = tid + 512 * q, row = e / 48, c16 = e - row * 48, tt = c * 64 + row - 3; rv[q] = (u32x4){0u, 0u, 0u, 0u};
      if (e < 3216 && tt >= 0) rv[q] = __builtin_nontemporal_load((const u32x4*)(proj + (size_t)(b * 2048 + tt) * 6144 + 2048 + (c16 >> 4) * 1024 + h * 128 + (c16 & 15) * 8)); }
    float4 wv = make_float4(0.f, 0.f, 0.f, 0.f);
    if (tid < 384) { const int tap = tid / 96, lc = (tid - tap * 96) * 4; wv = *(const float4*)(p->in[I_CBW] + (size_t)(j * 4 + tap) * 3072 + (lc >> 7) * 1024 + h * 128 + (lc & 127)); }
#pragma unroll
    for (int q = 0; q < 7; ++q) { const int e = tid + 512 * q, row = e / 48, c16 = e - row * 48; if (e < 3216) *(u32x4*)(RAWB + row * 392 + c16 * 8) = rv[q]; }
    if (tid < 384) { const int tap = tid / 96, lc = (tid - tap * 96) * 4; *(float4*)(CW + tap * 384 + lc) = wv; }
  }
  lds_barrier();
  if (c == 31 && tid < 144) { const int r3 = tid / 48, c16 = tid - r3 * 48; float xf[8]; unpack8(*(const u32x4*)(RAWB + (64 + r3) * 392 + c16 * 8), xf);
    float* o = p->out + O_PCB + (size_t)((j * 8 + b) * 3 + r3) * 3072 + (c16 >> 4) * 1024 + h * 128 + (c16 & 15) * 8;
    *(float4*)o = make_float4(xf[0], xf[1], xf[2], xf[3]); *(float4*)(o + 4) = make_float4(xf[4], xf[5], xf[6], xf[7]); }
#pragma unroll 2
  for (int pi = 0; pi < 6; ++pi) {
    const int pair = tid + 512 * pi, part = pair >> 10, rem = pair & 1023, i = rem >> 4, cgp = rem & 15;
    float acc[8];
#pragma unroll
    for (int e = 0; e < 8; ++e) acc[e] = 0.f;
#pragma unroll
    for (int tap = 0; tap < 4; ++tap) { float xf[8]; unpack8(*(const u32x4*)(RAWB + (i + tap) * 392 + part * 128 + cgp * 8), xf);
      const float4 w0 = *(const float4*)(CW + tap * 384 + part * 128 + cgp * 8), w1 = *(const float4*)(CW + tap * 384 + part * 128 + cgp * 8 + 4);
      acc[0] += w0.x * xf[0]; acc[1] += w0.y * xf[1]; acc[2] += w0.z * xf[2]; acc[3] += w0.w * xf[3];
      acc[4] += w1.x * xf[4]; acc[5] += w1.y * xf[5]; acc[6] += w1.z * xf[6]; acc[7] += w1.w * xf[7]; }
    float ss = 0.f;
#pragma unroll
    for (int e = 0; e < 8; ++e) { acc[e] = siluf_(acc[e]); ss += acc[e] * acc[e]; }
    ss += __shfl_xor(ss, 1); ss += __shfl_xor(ss, 2); ss += __shfl_xor(ss, 4); ss += __shfl_xor(ss, 8);
    float scl = 1.f;
    if (part == 0) scl = __builtin_amdgcn_rsqf(ss + 1e-6f) * 0.08838834764831845f; else if (part == 1) scl = __builtin_amdgcn_rsqf(ss + 1e-6f);
#pragma unroll
    for (int e = 0; e < 8; ++e) acc[e] *= scl;
    bf16_t* dstp = part == 0 ? QN : (part == 1 ? KN : VN);
    *(u32x4*)(dstp + i * 136 + cgp * 8) = pack8(acc);
  }
  lds_barrier();
  {
    const int rt = wave >> 1, ctp = (wave & 1) * 2, l15 = lane & 15, lq = lane >> 4;
    f32x4 kka[2], qka[2];
#pragma unroll
    for (int c2 = 0; c2 < 2; ++c2) { kka[c2] = (f32x4){0.f, 0.f, 0.f, 0.f}; qka[c2] = (f32x4){0.f, 0.f, 0.f, 0.f}; }
#pragma unroll
    for (int kk = 0; kk < 4; ++kk) {
      const bf16x8 ak = *(const bf16x8*)(KN + (rt * 16 + l15) * 136 + lq * 8 + kk * 32);
      const bf16x8 aq = *(const bf16x8*)(QN + (rt * 16 + l15) * 136 + lq * 8 + kk * 32);
#pragma unroll
      for (int c2 = 0; c2 < 2; ++c2) { const bf16x8 bk = *(const bf16x8*)(KN + ((ctp + c2) * 16 + l15) * 136 + lq * 8 + kk * 32);
        kka[c2] = mfma16(ak, bk, kka[c2]); qka[c2] = mfma16(aq, bk, qka[c2]); }
    }
    bf16_t* qkg = (bf16_t*)(p->ws + WS_QK) + (size_t)cid * 4096;
#pragma unroll
    for (int c2 = 0; c2 < 2; ++c2)
#pragma unroll
      for (int r = 0; r < 4; ++r) {
        const int i = rt * 16 + lq * 4 + r, jj = (ctp + c2) * 16 + l15;
        const float dec = fexp_(fminf(GC[i] - GC[jj], 0.f));
        const float aval = (i > jj) ? BETA[i] * kka[c2][r] * dec : 0.f;
        AM[i * 68 + jj] = aval; AMB[i * 72 + jj] = f2bf(aval);
        qkg[(((i >> 4) * 2 + (jj >> 5)) * 64 + ((jj & 31) >> 3) * 16 + (i & 15)) * 8 + (jj & 7)] = f2bf((i >= jj) ? qka[c2][r] * dec : 0.f);
      }
  }
  lds_barrier();
  const int cc = tid & 255;
  const bf16_t* rsrc = (cc < 128) ? (VN + cc) : (KN + (cc - 128));
  const float* rfac = (cc < 128) ? BETA : BEG;
#pragma unroll
  for (int bi = 0; bi < 4; ++bi) {
    if (bi > 0) {
      const int l15 = lane & 15, lq = lane >> 4;
#pragma unroll
      for (int n2 = 0; n2 < 2; ++n2) { const int nt = wave * 2 + n2; f32x4 acc = (f32x4){0.f, 0.f, 0.f, 0.f};
#pragma unroll
        for (int kk = 0; kk < (bi * 16 + 31) / 32; ++kk) { const int k0 = lq * 8 + kk * 32; const bool valid = k0 < bi * 16;
          u32x4 av = *(const u32x4*)(AMB + (bi * 16 + l15) * 72 + k0), bv = *(const u32x4*)(XT + (nt * 16 + l15) * 72 + k0);
          if (!valid) { av = (u32x4){0u, 0u, 0u, 0u}; bv = (u32x4){0u, 0u, 0u, 0u}; }
          acc = mfma16(as_bf16x8(av), as_bf16x8(bv), acc); }
#pragma unroll
        for (int r = 0; r < 4; ++r) CORR[(lq * 4 + r) * 260 + nt * 16 + l15] = acc[r]; }
      lds_barrier();
    }
    if (tid < 256) {
      float xb[16], rh[16];
#pragma unroll
      for (int ii = 0; ii < 16; ++ii) { const int i = bi * 16 + ii; rh[ii] = bf2f(rsrc[i * 136]) * rfac[i]; if (bi > 0) rh[ii] -= CORR[ii * 260 + cc]; }
#pragma unroll
      for (int rg = 0; rg < 4; ++rg) {
        f32x4 a[4][4];
#pragma unroll
        for (int q = 0; q < 4; ++q)
#pragma unroll
          for (int g4 = 0; g4 <= rg; ++g4) a[q][g4] = *(const f32x4*)(AM + (bi * 16 + rg * 4 + q) * 68 + bi * 16 + g4 * 4);
#pragma unroll
        for (int q = 0; q < 4; ++q) { const int ii = rg * 4 + q; float s = rh[ii];
#pragma unroll
          for (int jj = 0; jj < ii; ++jj) s -= a[q][jj >> 2][jj & 3] * xb[jj];
          xb[ii] = s; }
        asm volatile("" : "+v"(xb[rg * 4 + 3]) :: "memory");
      }
      u32x4 w0, w1;
      w0.x = cvt_pk_bf16(xb[0], xb[1]); w0.y = cvt_pk_bf16(xb[2], xb[3]); w0.z = cvt_pk_bf16(xb[4], xb[5]); w0.w = cvt_pk_bf16(xb[6], xb[7]);
      w1.x = cvt_pk_bf16(xb[8], xb[9]); w1.y = cvt_pk_bf16(xb[10], xb[11]); w1.z = cvt_pk_bf16(xb[12], xb[13]); w1.w = cvt_pk_bf16(xb[14], xb[15]);
      if (bi < 3) { *(u32x4*)(XT + cc * 72 + bi * 16) = w0; *(u32x4*)(XT + cc * 72 + bi * 16 + 8) = w1; }
      if (cc < 128) {
        bf16_t* ut = (bf16_t*)(p->ws + WS_UT) + (size_t)cid * 8192 + cc * 64 + bi * 16;
        *(u32x4*)ut = w0; *(u32x4*)(ut + 8) = w1;
      } else {
        const int dk = cc - 128;
        bf16_t* wb = (bf16_t*)(p->ws + WS_WB) + (size_t)cid * 8192 + ((bi * 4 + (dk >> 5)) * 64 + ((dk & 31) >> 3) * 16) * 8 + (dk & 7);
#pragma unroll
        for (int ii = 0; ii < 16; ++ii) wb[ii * 8] = f2bf(xb[ii]);
      }
    } else if (bi == 0) {
      const int t2 = tid - 256;
      { const int i = t2 >> 2, dseg = (t2 & 3) * 32; const float eg = fexp_(GC[i]);
        bf16_t* qt = (bf16_t*)(p->ws + WS_QT) + (size_t)cid * 8192 + (((i >> 4) * 4 + (t2 & 3)) * 64 + (i & 15)) * 8;
#pragma unroll
        for (int s = 0; s < 4; ++s) { float f[8]; unpack8(*(const u32x4*)(QN + i * 136 + dseg + s * 8), f);
#pragma unroll
          for (int e = 0; e < 8; ++e) f[e] *= eg;
          *(u32x4*)(qt + s * 128) = pack8(f); } }
      { const int d = t2 >> 1, iseg = (t2 & 1) * 32; const float gl = GC[63];
        bf16_t* kt = (bf16_t*)(p->ws + WS_KT) + (size_t)cid * 8192 + (((d >> 4) * 2 + (t2 & 1)) * 64 + (d & 15)) * 8;
#pragma unroll
        for (int s = 0; s < 4; ++s) { float f[8];
#pragma unroll
          for (int e = 0; e < 8; ++e) { const int i = iseg + s * 8 + e; f[e] = bf2f(KN[i * 136 + d]) * fexp_(gl - GC[i]); }
          *(u32x4*)(kt + s * 128) = pack8(f); } }
      if (t2 == 0) ((float*)(p->ws + WS_EGL))[cid] = fexp_(GC[63]);
    }
    if (bi < 3) lds_barrier();
  }
}

DEVI void gdn_decode_item(KP p, int j, int item, unsigned char* lds) {
  const int tid = tidx_(), lane = tid & 63, wave = tid >> 6;
  const int b = item >> 3, h = item & 7;
  const size_t row = NPR + b;
  float* QKV = (float*)lds; float* RED = (float*)(lds + 1536); float* PART = (float*)(lds + 2048);
  const bf16_t* proj = (const bf16_t*)(p->ws + WS_PROJ);
  const int dv4 = tid & 31, dkq = tid >> 5;
  const float* S0 = p->in[I_SDEL] + (size_t)((j * 128 + b) * 8 + h) * 16384;
  float4 s[8];
#pragma unroll
  for (int r = 0; r < 8; ++r) { const f32x4 t4 = __builtin_nontemporal_load((const f32x4*)(S0 + (dkq * 8 + r) * 128 + dv4 * 4)); s[r] = make_float4(t4[0], t4[1], t4[2], t4[3]); }
  const float* t = (const float*)(p->ws + WS_TAIL) + row * 16;
  const float traw_a = t[8 + h], traw_b = t[h], alog = p->in[I_ALOG][j * 8 + h], dtb = p->in[I_DTB][j * 8 + h];
  if (tid < 384) {
    const int part = tid >> 7, ch = tid & 127, col = part * 1024 + h * 128 + ch;
    const float* st = p->in[I_SCB] + (size_t)((j * 128 + b) * 3) * 3072 + col;
    const float x0 = st[0], x1 = st[3072], x2 = st[6144], x3 = bf2f(proj[row * 6144 + 2048 + col]);
    const float* cw = p->in[I_CBW] + (size_t)(j * 4) * 3072 + col;
    const float val = siluf_(cw[0] * x0 + cw[3072] * x1 + cw[6144] * x2 + cw[9216] * x3);
    float* so = p->out + O_SCB + (size_t)((j * 128 + b) * 3) * 3072 + col;
    so[0] = x1; so[3072] = x2; so[6144] = x3;
    QKV[tid] = val;
    const float ss = wave_sum(val * val);
    if (lane == 0) RED[wave] = ss;
  }
  lds_barrier();
  const float rq = __builtin_amdgcn_rsqf(RED[0] + RED[1] + 1e-6f) * 0.08838834764831845f, rk = __builtin_amdgcn_rsqf(RED[2] + RED[3] + 1e-6f);
  const float g = -fexp_(alog) * softplusf_(traw_a + dtb);
  const float beta = sigmoidf_(traw_b), eg = fexp_(g);
  float* S1 = p->out + O_SDEL + (size_t)((j * 128 + b) * 8 + h) * 16384;
  float4 pt = make_float4(0.f, 0.f, 0.f, 0.f);
#pragma unroll
  for (int r = 0; r < 8; ++r) { const int dk = dkq * 8 + r; const float kd = QKV[128 + dk] * rk;
    pt.x += s[r].x * kd; pt.y += s[r].y * kd; pt.z += s[r].z * kd; pt.w += s[r].w * kd; }
  *(float4*)(PART + dkq * 128 + dv4 * 4) = pt;
  lds_barrier();
  float4 kv = make_float4(0.f, 0.f, 0.f, 0.f);
#pragma unroll
  for (int q = 0; q < 16; ++q) { const float4 v = *(const float4*)(PART + q * 128 + dv4 * 4); kv.x += v.x; kv.y += v.y; kv.z += v.z; kv.w += v.w; }
  const float4 vv = *(const float4*)(QKV + 256 + dv4 * 4);
  float4 vn; vn.x = beta * (vv.x - eg * kv.x); vn.y = beta * (vv.y - eg * kv.y); vn.z = beta * (vv.z - eg * kv.z); vn.w = beta * (vv.w - eg * kv.w);
  lds_barrier();
  float4 po = make_float4(0.f, 0.f, 0.f, 0.f);
#pragma unroll
  for (int r = 0; r < 8; ++r) { const int dk = dkq * 8 + r; const float kd = QKV[128 + dk] * rk, qd = QKV[dk] * rq;
    float4 n; n.x = eg * s[r].x + kd * vn.x; n.y = eg * s[r].y + kd * vn.y; n.z = eg * s[r].z + kd * vn.z; n.w = eg * s[r].w + kd * vn.w;
    __builtin_nontemporal_store((f32x4){n.x, n.y, n.z, n.w}, (f32x4*)(S1 + dk * 128 + dv4 * 4));
    po.x += n.x * qd; po.y += n.y * qd; po.z += n.z * qd; po.w += n.w * qd; }
  *(float4*)(PART + dkq * 128 + dv4 * 4) = po;
  lds_barrier();
  float o = 0.f;
  if (tid < 128) {
#pragma unroll
    for (int q = 0; q < 16; ++q) o += PART[q * 128 + tid];
    const float ss = wave_sum(o * o);
    if (lane == 0) RED[8 + wave] = ss;
  }
  lds_barrier();
  if (tid < 128) {
    const float rinv = __builtin_amdgcn_rsqf((RED[8] + RED[9]) * (1.f / 128.f) + 1e-6f);
    const float zb = bf2f(proj[row * 6144 + 5120 + h * 128 + tid]);
    ((bf16_t*)(p->ws + WS_YBUF))[row * 2048 + 1024 + h * 128 + tid] = f2bf(o * rinv * p->in[I_GNW][j * 128 + tid] * siluf_(zb));
  }
}

DEVI void phase_mixprep(KP p, int layer, unsigned char* lds, int ph, int submask) {
  const int j = layer >> 1;
  unsigned* ctr = (unsigned*)(p->ws + WS_CTL) + 4096 + ph;
  int* slot = (int*)(lds + LDS_MISC);
  const bool lead = tidx_() == 0;
  int nxt = 0; if (lead) nxt = (int)atomicAdd(ctr, 1u);
  for (;;) {
    if (lead) *slot = nxt;
    lds_barrier();
    const int it = *slot;
    lds_barrier();
    if (it >= 3216) break;
    if (lead) nxt = (int)atomicAdd(ctr, 1u);
    if (it < 144) { if (submask & 1) lru_item(p, j, it, lds); }
    else if (it < 2192) { if (submask & 2) gdn_prep_item(p, j, it - 144, lds); }
    else { if (submask & 4) gdn_decode_item(p, j, it - 2192, lds); }
  }
}

struct GdnFrags { u32x4 wf[4], qf[4], qkf[2], ktf[2][2]; u32x2 uf; float egl; };
DEVI void gdn_load(GdnFrags& f, KP p, int cid, int s, int rt, int ct, int l15, int lq) {
  const bf16_t* wb = (const bf16_t*)(p->ws + WS_WB) + (size_t)cid * 8192;
  const bf16_t* qt = (const bf16_t*)(p->ws + WS_QT) + (size_t)cid * 8192;
  const bf16_t* kt = (const bf16_t*)(p->ws + WS_KT) + (size_t)cid * 8192;
  const bf16_t* qk = (const bf16_t*)(p->ws + WS_QK) + (size_t)cid * 4096;
  const bf16_t* ut = (const bf16_t*)(p->ws + WS_UT) + (size_t)cid * 8192;
  const int ln = lq * 16 + l15;
#pragma unroll
  for (int kk = 0; kk < 4; ++kk) { f.wf[kk] = *(const u32x4*)(wb + ((rt * 4 + kk) * 64 + ln) * 8); f.qf[kk] = *(const u32x4*)(qt + ((rt * 4 + kk) * 64 + ln) * 8); }
#pragma unroll
  for (int kk = 0; kk < 2; ++kk) { f.qkf[kk] = *(const u32x4*)(qk + ((rt * 2 + kk) * 64 + ln) * 8);
#pragma unroll
    for (int d2 = 0; d2 < 2; ++d2) f.ktf[d2][kk] = *(const u32x4*)(kt + (((rt * 2 + d2) * 2 + kk) * 64 + ln) * 8); }
  f.uf = *(const u32x2*)(ut + (s * 32 + ct * 16 + l15) * 64 + rt * 16 + lq * 4);
  f.egl = ((const float*)(p->ws + WS_EGL))[cid];
}
DEVI void phase_gdnseq(KP p, int layer, unsigned char* lds) {
  const int tid = tidx_(), lane = tid & 63, wave = tid >> 6;
  const int j = layer >> 1, rt = wave >> 1, ct = wave & 1, l15 = lane & 15, lq = lane >> 4;
  bf16_t* ST = (bf16_t*)lds;
  bf16_t* VT = (bf16_t*)(lds + 8704);
  bf16_t* ybuf = (bf16_t*)(p->ws + WS_YBUF);
  unsigned dsum = 0u;
  for (int item = bidx_(); item < 256; item += gdim_()) {
    const int xcd = item & 7, idx = item >> 3, bh = xcd * 8 + (idx >> 2), s = idx & 3, b = bh >> 3, h = bh & 7;
    __syncthreads();
    for (int e = tid; e < 32 * 136 / 2; e += 512) ((unsigned*)ST)[e] = 0u;
    f32x4 sacc[2]; sacc[0] = (f32x4){0.f, 0.f, 0.f, 0.f}; sacc[1] = (f32x4){0.f, 0.f, 0.f, 0.f};
    GdnFrags nx; gdn_load(nx, p, bh * 32, s, rt, ct, l15, lq);
    __syncthreads();
    unsigned dprev = 0u; f32x4 oprev = (f32x4){0.f, 0.f, 0.f, 0.f};
    for (int c = 0; c < 32; ++c) {
      const GdnFrags cu = nx;
      if (c > 0) {
        bf16_t* yo = ybuf + (size_t)(b * 2048 + (c - 1) * 64 + rt * 16 + lq * 4) * 2048 + 1024 + h * 128 + s * 32 + ct * 16 + l15;
#pragma unroll
        for (int r = 0; r < 4; ++r) yo[(size_t)r * 2048] = f2bf(oprev[r]);
        asm volatile("" ::: "memory");
      }
      if (c + 1 < 32) gdn_load(nx, p, bh * 32 + c + 1, s, rt, ct, l15, lq);
      f32x4 wsa = (f32x4){0.f, 0.f, 0.f, 0.f}, oa = (f32x4){0.f, 0.f, 0.f, 0.f};
#pragma unroll
      for (int kk = 0; kk < 4; ++kk) { const bf16x8 sb = *(const bf16x8*)(ST + (ct * 16 + l15) * 136 + lq * 8 + kk * 32);
        wsa = mfma16(as_bf16x8(cu.wf[kk]), sb, wsa); oa = mfma16(as_bf16x8(cu.qf[kk]), sb, oa); }
      { const float u0 = bflo(cu.uf.x), u1 = bfhi(cu.uf.x), u2 = bflo(cu.uf.y), u3 = bfhi(cu.uf.y);
        u32x2 w; w.x = cvt_pk_bf16(u0 - wsa[0], u1 - wsa[1]); w.y = cvt_pk_bf16(u2 - wsa[2], u3 - wsa[3]);
        *(u32x2*)(VT + (ct * 16 + l15) * 72 + rt * 16 + lq * 4) = w; }
      lds_barrier();
      bf16x8 vb[2];
#pragma unroll
      for (int kk = 0; kk < 2; ++kk) vb[kk] = *(const bf16x8*)(VT + (ct * 16 + l15) * 72 + lq * 8 + kk * 32);
#pragma unroll
      for (int kk = 0; kk < 2; ++kk) oa = mfma16(as_bf16x8(cu.qkf[kk]), vb[kk], oa);
#pragma unroll
      for (int d2 = 0; d2 < 2; ++d2) { sacc[d2] = sacc[d2] * cu.egl;
#pragma unroll
        for (int kk = 0; kk < 2; ++kk) sacc[d2] = mfma16(as_bf16x8(cu.ktf[d2][kk]), vb[kk], sacc[d2]); }
      oprev = oa;
#pragma unroll
      for (int d2 = 0; d2 < 2; ++d2) { u32x2 w; w.x = cvt_pk_bf16(sacc[d2][0], sacc[d2][1]); w.y = cvt_pk_bf16(sacc[d2][2], sacc[d2][3]);
        *(u32x2*)(ST + (ct * 16 + l15) * 136 + (rt * 2 + d2) * 16 + lq * 4) = w; }
      lds_barrier();
    }
    { bf16_t* yo = ybuf + (size_t)(b * 2048 + 31 * 64 + rt * 16 + lq * 4) * 2048 + 1024 + h * 128 + s * 32 + ct * 16 + l15;
#pragma unroll
      for (int r = 0; r < 4; ++r) yo[(size_t)r * 2048] = f2bf(oprev[r]); }
    float* pd = p->out + O_PDEL + (size_t)((j * 8 + b) * 8 + h) * 16384;
#pragma unroll
    for (int d2 = 0; d2 < 2; ++d2)
#pragma unroll
      for (int r = 0; r < 4; ++r) pd[(size_t)((rt * 2 + d2) * 16 + lq * 4 + r) * 128 + s * 32 + ct * 16 + l15] = sacc[d2][r];
  }
  if (dsum == 0x9e3779b9u) ((unsigned*)(p->ws + WS_CTL))[5000] = dsum;
}

DEVI void phase_onorm(KP p, int layer) {
  const int tid = tidx_(), lane = tid & 63, wave = tid >> 6, j = layer >> 1;
  bf16_t* ybuf = (bf16_t*)(p->ws + WS_YBUF); const bf16_t* proj = (const bf16_t*)(p->ws + WS_PROJ);
  float gw[16];
#pragma unroll
  for (int e = 0; e < 16; ++e) gw[e] = p->in[I_GNW][j * 128 + ((lane * 16 + e) & 127)];
  const int rstep = gdim_() * 8;
  for (int r = bidx_() * 8 + wave; r < NPR; r += 2 * rstep) {
    const bool two = r + rstep < NPR;
    bf16_t* yp[2]; u32x4 yv[2][2], zv[2][2];
#pragma unroll
    for (int q = 0; q < 2; ++q) { const int rr = (q == 0 || two) ? r + q * rstep : r;
      yp[q] = ybuf + (size_t)rr * 2048 + 1024 + lane * 16; const bf16_t* zp = proj + (size_t)rr * 6144 + 5120 + lane * 16;
      yv[q][0] = *(const u32x4*)yp[q]; yv[q][1] = *(const u32x4*)(yp[q] + 8); zv[q][0] = *(const u32x4*)zp; zv[q][1] = *(const u32x4*)(zp + 8); }
#pragma unroll
    for (int q = 0; q < 2; ++q) {
      float o[16], z[16]; { float t[8]; unpack8(yv[q][0], t);
#pragma unroll
        for (int e = 0; e < 8; ++e) o[e] = t[e];
        unpack8(yv[q][1], t);
#pragma unroll
        for (int e = 0; e < 8; ++e) o[8 + e] = t[e];
        unpack8(zv[q][0], t);
#pragma unroll
        for (int e = 0; e < 8; ++e) z[e] = t[e];
        unpack8(zv[q][1], t);
#pragma unroll
        for (int e = 0; e < 8; ++e) z[8 + e] = t[e]; }
      float ss = 0.f;
#pragma unroll
      for (int e = 0; e < 16; ++e) ss += o[e] * o[e];
      ss += __shfl_xor(ss, 1); ss += __shfl_xor(ss, 2); ss += __shfl_xor(ss, 4);
      const float rinv = __builtin_amdgcn_rsqf(ss * (1.f / 128.f) + 1e-6f);
      float a[8], cq[8];
#pragma unroll
      for (int e = 0; e < 8; ++e) { a[e] = o[e] * rinv * gw[e] * siluf_(z[e]); cq[e] = o[8 + e] * rinv * gw[8 + e] * siluf_(z[8 + e]); }
      if (q == 0 || two) { *(u32x4*)yp[q] = pack8(a); *(u32x4*)(yp[q] + 8) = pack8(cq); }
    }
  }
}

struct S5C { bf16x8 Bf[8], Cf[4]; float abr, abi, dch; };
template <bool OUT, bool SAMPLE>
DEVI void s5_chunks(KP p, const S5C& c, int jc, int g, size_t rbase, int nch, int sgrp, float& xr, float& xi, float* BU, bf16_t* XB, int lane) {
  const int l15 = lane & 15, lq = lane >> 4;
  const bf16_t* proj = (const bf16_t*)(p->ws + WS_PROJ);
  bf16_t* y1 = (bf16_t*)(p->ws + WS_YBUF);
  u32x4 unx = (u32x4){0u, 0u, 0u, 0u}; bf16_t uenx[4] = {0, 0, 0, 0};
  if (lq < 2) unx = *(const u32x4*)(proj + (rbase + l15) * 2048 + g * 16 + lq * 8);
  if (OUT) {
#pragma unroll
    for (int r = 0; r < 4; ++r) uenx[r] = proj[(rbase + lq * 4 + r) * 2048 + g * 16 + l15]; }
  for (int ck = 0; ck < nch; ++ck) {
    const size_t row0 = rbase + (size_t)ck * 16;
    const u32x4 ucur = unx; bf16_t uec[4];
#pragma unroll
    for (int r = 0; r < 4; ++r) uec[r] = uenx[r];
    if (ck + 1 < nch) { if (lq < 2) unx = *(const u32x4*)(proj + (row0 + 16 + l15) * 2048 + g * 16 + lq * 8);
      if (OUT) {
#pragma unroll
        for (int r = 0; r < 4; ++r) uenx[r] = proj[(row0 + 16 + lq * 4 + r) * 2048 + g * 16 + l15]; } }
#pragma unroll
    for (int nt = 0; nt < 8; ++nt) { const f32x4 acc = mfma16(as_bf16x8(ucur), c.Bf[nt], (f32x4){0.f, 0.f, 0.f, 0.f});
      *(f32x4*)(BU + (nt * 16 + l15) * 20 + lq * 4) = acc; }
    asm volatile("s_waitcnt lgkmcnt(0)" ::: "memory");
    float br[16], bi[16];
#pragma unroll
    for (int t4 = 0; t4 < 4; ++t4) { const f32x4 a = *(const f32x4*)(BU + lane * 20 + t4 * 4), b = *(const f32x4*)(BU + (64 + lane) * 20 + t4 * 4);
#pragma unroll
      for (int e = 0; e < 4; ++e) { br[t4 * 4 + e] = a[e]; bi[t4 * 4 + e] = b[e]; } }
    if (!SAMPLE) {
#pragma unroll
      for (int t = 0; t < 16; ++t) { const float nr = c.abr * xr - c.abi * xi + br[t], ni = c.abr * xi + c.abi * xr + bi[t]; xr = nr; xi = ni;
        if (OUT) *(unsigned*)(XB + t * 136 + 2 * lane) = cvt_pk_bf16(xr, xi); }
    } else {
#pragma unroll
      for (int t = 0; t < 16; ++t) { const size_t si = ((size_t)(jc * 128 + sgrp * 16 + t) * 64 + g) * 64 + lane;
        const float x0r = p->in[I_SSR][si], x0i = p->in[I_SSI][si];
        const float nr = c.abr * x0r - c.abi * x0i + br[t], ni = c.abr * x0i + c.abi * x0r + bi[t];
        p->out[O_SSR + si] = nr; p->out[O_SSI + si] = ni;
        *(unsigned*)(XB + t * 136 + 2 * lane) = cvt_pk_bf16(nr, ni); }
    }
    if (OUT) {
      asm volatile("s_waitcnt lgkmcnt(0)" ::: "memory");
      f32x4 ya = (f32x4){0.f, 0.f, 0.f, 0.f};
#pragma unroll
      for (int kk = 0; kk < 4; ++kk) ya = mfma16(*(const bf16x8*)(XB + l15 * 136 + lq * 8 + kk * 32), c.Cf[kk], ya);
#pragma unroll
      for (int r = 0; r < 4; ++r) { const float y = ya[r] + c.dch * bf2f(uec[r]); y1[(row0 + lq * 4 + r) * 1024 + g * 16 + l15] = f2bf(geluf_(y)); }
    }
  }
}
DEVI void s5_setup(KP p, S5C& c, int jc, int g, int lane) {
  const int l15 = lane & 15, lq = lane >> 4, gi = jc * 64 + g;
  const float dt = __expf(p->in[I_LOGDT][gi]);
  { const float are = p->in[I_ARE][gi * 64 + lane], aim = p->in[I_AIM][gi * 64 + lane]; const float mag = __expf(are * dt); c.abr = mag * __cosf(aim * dt); c.abi = mag * __sinf(aim * dt); }
#pragma unroll
  for (int nt = 0; nt < 8; ++nt) {
    float v[8];
#pragma unroll
    for (int e = 0; e < 8; ++e) v[e] = 0.f;
    if (lq < 2) {
      const int pp = (nt & 3) * 16 + l15;
      const float are = p->in[I_ARE][gi * 64 + pp], aim = p->in[I_AIM][gi * 64 + pp]; const float mag = __expf(are * dt); const float sn = __sinf(aim * dt), cs = __cosf(aim * dt);
      const float nr = mag * cs - 1.f, ni = mag * sn, den = 1.f / (are * are + aim * aim);
      const float cr = (nr * are + ni * aim) * den, ci = (ni * are - nr * aim) * den;
      const float* br = p->in[I_BRE] + (size_t)(gi * 64 + pp) * 16 + lq * 8; const float* bi = p->in[I_BIM] + (size_t)(gi * 64 + pp) * 16 + lq * 8;
#pragma unroll
      for (int e = 0; e < 8; ++e) v[e] = (nt >= 4) ? (cr * bi[e] + ci * br[e]) : (cr * br[e] - ci * bi[e]);
    }
    c.Bf[nt] = as_bf16x8(pack8(v));
  }
#pragma unroll
  for (int kk = 0; kk < 4; ++kk) { const int p0 = lq * 4 + kk * 16;
    const float* sre = p->in[I_CRE] + (size_t)(gi * 16 + l15) * 64 + p0; const float* sim = p->in[I_CIM] + (size_t)(gi * 16 + l15) * 64 + p0; float v[8];
#pragma unroll
    for (int m = 0; m < 4; ++m) { v[2 * m] = sre[m]; v[2 * m + 1] = -sim[m]; }
    c.Cf[kk] = as_bf16x8(pack8(v)); }
  c.dch = p->in[I_S5D][jc * 1024 + g * 16 + l15];
}
DEVI void phase_s5(KP p, int layer, unsigned char* lds) {
  const int tid = tidx_(), lane = tid & 63, wave = tid >> 6, jc = layer >> 1;
  float* BU = (float*)(lds + wave * 14592);
  bf16_t* XB = (bf16_t*)(lds + wave * 14592 + 10240);
  float* EX = (float*)(lds + 116736);
  const int cb = wave >> 2, seg = wave & 3;
  for (int cp = bidx_(); cp < 256; cp += gdim_()) {
    const int q = cp * 2 + cb, b = q >> 6, g = q & 63;
    S5C c; s5_setup(p, c, jc, g, lane);
    float xr = 0.f, xi = 0.f;
    const size_t rbase = (size_t)b * 2048 + (size_t)seg * 512;
    const int nch2 = 32;
    if (seg < 3) {
      s5_chunks<false, false>(p, c, jc, g, rbase, 32, 0, xr, xi, BU, XB, lane);
      EX[wave * 128 + lane] = xr; EX[wave * 128 + 64 + lane] = xi;
    } else {
      const int qs = cp * 2 + cb, gs = qs & 63, sgrp = qs >> 6;
      S5C cs; s5_setup(p, cs, jc, gs, lane);
      float dr = 0.f, di = 0.f;
      s5_chunks<true, true>(p, cs, jc, gs, (size_t)(NPR + sgrp * 16), 1, sgrp, dr, di, BU, XB, lane);
    }
    __syncthreads();
    float pr = c.abr, pi = c.abi;
#pragma unroll
    for (int s = 0; s < 9; ++s) { const float nr = pr * pr - pi * pi, ni = 2.f * pr * pi; pr = nr; pi = ni; }
    xr = 0.f; xi = 0.f;
    for (int s = 0; s < seg; ++s) { const float er = EX[(cb * 4 + s) * 128 + lane], ei = EX[(cb * 4 + s) * 128 + 64 + lane];
      const float nr = pr * xr - pi * xi + er, ni = pr * xi + pi * xr + ei; xr = nr; xi = ni; }
    s5_chunks<true, false>(p, c, jc, g, rbase, nch2, 0, xr, xi, BU, XB, lane);
    if (seg == 3) { const size_t si = ((size_t)(jc * 8 + b) * 64 + g) * 64 + lane; p->out[O_PSR + si] = xr; p->out[O_PSI + si] = xi; }
    __syncthreads();
  }
}

DEVI void phase_final(KP p) {
  const int tid = tidx_(), lane = tid & 63, wave = tid >> 6;
  const float* nw = p->in[I_FNW];
  float4 w4[4];
#pragma unroll
  for (int i = 0; i < 4; ++i) w4[i] = *(const float4*)(nw + i * 256 + lane * 4);
  for (int r = (bidx_() * 8 + wave) * 2; r < NRV; r += gdim_() * 16) {
    float* x0 = p->out + (size_t)r * 1024; float* x1 = x0 + 1024; float4 v0[4], v1[4]; float s0 = 0.f, s1 = 0.f;
#pragma unroll
    for (int i = 0; i < 4; ++i) { v0[i] = *(const float4*)(x0 + i * 256 + lane * 4); v1[i] = *(const float4*)(x1 + i * 256 + lane * 4); }
#pragma unroll
    for (int i = 0; i < 4; ++i) { s0 += v0[i].x * v0[i].x + v0[i].y * v0[i].y + v0[i].z * v0[i].z + v0[i].w * v0[i].w; s1 += v1[i].x * v1[i].x + v1[i].y * v1[i].y + v1[i].z * v1[i].z + v1[i].w * v1[i].w; }
#pragma unroll
    for (int o = 32; o >= 1; o >>= 1) { s0 += __shfl_xor(s0, o); s1 += __shfl_xor(s1, o); }
    const float r0 = __builtin_amdgcn_rsqf(s0 * (1.f / 1024.f) + 1e-6f), r1 = __builtin_amdgcn_rsqf(s1 * (1.f / 1024.f) + 1e-6f);
#pragma unroll
    for (int i = 0; i < 4; ++i) { float4 o; o.x = v0[i].x * r0 * w4[i].x; o.y = v0[i].y * r0 * w4[i].y; o.z = v0[i].z * r0 * w4[i].z; o.w = v0[i].w * r0 * w4[i].w; *(float4*)(x0 + i * 256 + lane * 4) = o;
      float4 q; q.x = v1[i].x * r1 * w4[i].x; q.y = v1[i].y * r1 * w4[i].y; q.z = v1[i].z * r1 * w4[i].z; q.w = v1[i].w * r1 * w4[i].w; *(float4*)(x1 + i * 256 + lane * 4) = q; }
  }
}

template <class F>
DEVI void sample_gemm(const bf16_t* __restrict__ A, int lda, const bf16_t* __restrict__ Bt, int N, int K, F&& epi, float* red) {
  const int tid = tidx_(), lane = tid & 63, wave = tid >> 6, l15 = lane & 15, lq = lane >> 4, rt2 = wave & 1, kq = wave >> 1;
  const int kq_len = K >> 2, nitems = (N / 16) * 4;
  for (int it = gdim_() - 1 - bidx_(); it < nitems; it += gdim_()) {
    const int s = it >> 2, rg = it & 3, row0 = rg * 32 + rt2 * 16;
    const bf16_t* ap = A + (size_t)(row0 + l15) * lda + lq * 8 + kq * kq_len;
    const bf16_t* bp = Bt + (size_t)(s * 16 + l15) * K + lq * 8 + kq * kq_len;
    f32x4 acc0 = (f32x4){0.f, 0.f, 0.f, 0.f}, acc1 = (f32x4){0.f, 0.f, 0.f, 0.f};
    for (int k0 = 0; k0 < kq_len; k0 += 256) {
      u32x4 a[8], b[8];
#pragma unroll
      for (int u = 0; u < 8; ++u) { a[u] = *(const u32x4*)(ap + k0 + u * 32); b[u] = *(const u32x4*)(bp + k0 + u * 32); }
#pragma unroll
      for (int u = 0; u < 8; u += 2) { acc0 = mfma16(as_bf16x8(a[u]), as_bf16x8(b[u]), acc0); acc1 = mfma16(as_bf16x8(a[u + 1]), as_bf16x8(b[u + 1]), acc1); }
    }
    acc0 = acc0 + acc1;
    lds_barrier();
    *(f32x4*)(red + ((kq * 2 + rt2) * 64 + lane) * 4) = acc0;
    lds_barrier();
    if (kq == 0) {
      f32x4 t = acc0;
#pragma unroll
      for (int q = 1; q < 4; ++q) t = t + *(const f32x4*)(red + ((q * 2 + rt2) * 64 + lane) * 4);
#pragma unroll
      for (int r = 0; r < 4; ++r) epi(row0 + lq * 4 + r, s * 16 + l15, t[r]);
    }
  }
}

constexpr int N_PHASES = 25;
#ifndef PROBE_SUB
#define PROBE_SUB 7
#endif
#ifndef ONLY_KIND
#define ONLY_KIND -1
#endif
#define KON(k) ((ONLY_KIND < 0 || ONLY_KIND == (k)) && kind == (k))
__global__ void __launch_bounds__(512, 2) mega(Params p_unused) {
  extern __shared__ __attribute__((aligned(16))) unsigned char shm[];
  cg::grid_group grid = cg::this_grid();
  PG8_LAS unsigned char* ldsg = (PG8_LAS unsigned char*)shm;
  KP p0 = (KP)__builtin_amdgcn_kernarg_segment_ptr();
  const int ph_lo = p0->ph_lo, ph_hi = p0->ph_hi;
  volatile LAS unsigned* xst = (volatile LAS unsigned*)(ldsg + LDS_MISC + 16);
  if (threadIdx.x == 0) { xst[0] = 0u; xst[1] = 0u; }
  __syncthreads();
  XcdBarrier xb = xcd_barrier_post((unsigned*)(p0->ws + WS_CTL), xst);
  int rep = 0;
  for (int ph = ph_lo; ph < ph_hi; ++ph) {
    KP p = p0; asm volatile("" : "+s"(p));
    int kind, layer = 0;
    if (ph == 0) kind = 0; else if (ph == 1) kind = 1; else if (ph == 24) kind = 12;
    else { const int q = ph - 2, pair = q / 11, rem = q % 11;
      if (rem < 6) { layer = 2 * pair; kind = (rem == 0) ? 2 : 2 + rem; }
      else { layer = 2 * pair + 1; const int s = rem - 6; kind = (s == 0) ? 2 : 7 + s; } }
    const int j = layer >> 1;
    if (KON(0)) phase_prep(p, (float*)shm);
    else if (KON(2)) phase_norm(p, layer, (float*)shm);
    else if (KON(4)) phase_mixprep(p, layer, shm, ph + 32 * rep, rep ? PROBE_SUB : 7);
    else if (KON(5)) phase_gdnseq(p, layer, shm);
    else if (KON(6)) phase_onorm(p, layer);
    else if (KON(9)) phase_s5(p, layer, shm);
    else if (KON(12)) phase_final(p);
    else if (KON(1)) {
      pg8::Gemm g{(const bf16_t*)(p->ws + WS_SILUC), (const bf16_t*)(p->ws + WS_WT_MOD), 256, 12288, 1024};
      pg8::StaticOrder S; S.init(256, 12288, gdim_(), bidx_());
      pg8::EpiF32 E{(float*)(p->ws + WS_MOD), 12288, p->in[I_MODB]};
      pg8::gemm_phase<pg8::EpiF32, pg8::StaticOrder, false>(ldsg, g, S, E, nullptr);
    } else if (KON(3) || KON(8)) {
      const bool ab = kind == 3; const int N = ab ? 6144 : 2048;
      const bf16_t* Bt = ab ? (const bf16_t*)(p->ws + WS_WT_INAB) + (size_t)j * 6144 * 1024 : (const bf16_t*)(p->ws + WS_WT_CIN) + (size_t)j * 2048 * 1024;
      pg8::Gemm g{(const bf16_t*)(p->ws + WS_YBUF), Bt, NPR, N, 1024};
      pg8::StaticOrder S; S.init(NPR, N, gdim_(), bidx_());
      pg8::EpiBf16<0> E{(bf16_t*)(p->ws + WS_PROJ), N, nullptr, 0, 0};
      pg8::gemm_phase<pg8::EpiBf16<0>, pg8::StaticOrder, false>(ldsg, g, S, E, nullptr);
      bf16_t* po = (bf16_t*)(p->ws + WS_PROJ) + (size_t)NPR * N;
      sample_gemm((const bf16_t*)(p->ws + WS_YBUF) + (size_t)NPR * 1024, 1024, Bt, N, 1024, [&](int r, int c, float v) { po[(size_t)r * N + c] = f2bf(v); }, (float*)shm);
      if (ab) tail_gemm(p, j);
    } else if (KON(7) || KON(11)) {
      const bool ab = kind == 7; const int K = ab ? 2048 : 1024;
      const bf16_t* Ab = ab ? (const bf16_t*)(p->ws + WS_YBUF) : (const bf16_t*)(p->ws + WS_Y2);
      const bf16_t* Bt = ab ? (const bf16_t*)(p->ws + WS_WT_OUTAB) + (size_t)j * 1024 * 2048 : (const bf16_t*)(p->ws + WS_WT_COUT) + (size_t)j * 1024 * 1024;
      pg8::Gemm g{Ab, Bt, NPR, 1024, K};
      pg8::StaticOrder S; S.init(NPR, 1024, gdim_(), bidx_());
      const float* gatep = (const float*)(p->ws + WS_MOD) + layer * 3072 + 2048;
      EpiRes E{layer == 0 ? p->in[I_XP] : p->out, layer == 0 ? p->in[I_XS] : p->out + (size_t)NPR * 1024, p->out, gatep};
      pg8::gemm_phase<EpiRes, pg8::StaticOrder, false>(ldsg, g, S, E, nullptr);
      const float* xsi = layer == 0 ? p->in[I_XS] : p->out + (size_t)NPR * 1024; float* xso = p->out + (size_t)NPR * 1024;
      sample_gemm(Ab + (size_t)NPR * K, K, Bt, 1024, K, [&](int r, int c, float v) { xso[(size_t)r * 1024 + c] = xsi[(size_t)r * 1024 + c] + gatep[(size_t)(8 + r) * 12288 + c] * v; }, (float*)shm);
    } else if (KON(10)) {
      const bf16_t* Bt = (const bf16_t*)(p->ws + WS_WT_GLU) + (size_t)j * 1024 * 1024;
      pg8::Gemm g{(const bf16_t*)(p->ws + WS_YBUF), Bt, NPR, 1024, 1024};
      pg8::StaticOrder S; S.init(NPR, 1024, gdim_(), bidx_());
      const float* gb = p->in[I_GLUB] + j * 1024;
      EpiGlu E{(const bf16_t*)(p->ws + WS_YBUF), (const bf16_t*)(p->ws + WS_PROJ) + 1024, (bf16_t*)(p->ws + WS_Y2), gb};
      pg8::gemm_phase<EpiGlu, pg8::StaticOrder, false>(ldsg, g, S, E, nullptr);
      const bf16_t* y1s = (const bf16_t*)(p->ws + WS_YBUF) + (size_t)NPR * 1024; const bf16_t* zs = (const bf16_t*)(p->ws + WS_PROJ) + (size_t)NPR * 2048 + 1024; bf16_t* y2s = (bf16_t*)(p->ws + WS_Y2) + (size_t)NPR * 1024;
      sample_gemm(y1s, 1024, Bt, 1024, 1024, [&](int r, int c, float v) { y2s[(size_t)r * 1024 + c] = f2bf(bf2f(y1s[(size_t)r * 1024 + c]) * sigmoidf_(v + gb[c]) * siluf_(bf2f(zs[(size_t)r * 2048 + c]))); }, (float*)shm);
    }
#ifdef REPEAT_KIND
    if (kind == REPEAT_KIND && rep == 0) { rep = 1; --ph; } else rep = 0;
#endif
    if (ph + 1 < ph_hi) { if (ph_hi > 100000) grid.sync();
      xcd_barrier(xb); }
  }
}

#ifndef MK_MULTI
#define MK_MULTI 0
#endif
#ifndef PH_HI
#define PH_HI N_PHASES
#endif
extern "C" void kernel_launch(void* const* d_in, const int* in_sizes, int n_in, void* d_out, int out_size, void* d_ws, size_t ws_size, hipStream_t stream) {
  static int grid = 0;
  if (grid == 0) {
    if (n_in != N_IN || (size_t)out_size != O_END || ws_size < WS_END) { fprintf(stderr, "kernel_launch: unexpected shapes: n_in %d out %d ws %zu (need %zu)\n", n_in, out_size, ws_size, (size_t)WS_END); grid = -1; return; }
    int dev = 0, cus = 0, per_cu = 0;
    if (hipGetDevice(&dev) != hipSuccess || hipDeviceGetAttribute(&cus, hipDeviceAttributeMultiprocessorCount, dev) != hipSuccess) { grid = -1; return; }
    if (hipFuncSetAttribute((const void*)mega, hipFuncAttributeMaxDynamicSharedMemorySize, LDS_BYTES) != hipSuccess) { fprintf(stderr, "kernel_launch: hipFuncSetAttribute failed\n"); grid = -1; return; }
    if (hipOccupancyMaxActiveBlocksPerMultiprocessor(&per_cu, (const void*)mega, 512, LDS_BYTES) != hipSuccess || per_cu < 1) { fprintf(stderr, "kernel_launch: occupancy query says %d\n", per_cu); per_cu = 1; }
    (void)hipGetLastError();
    grid = cus;
  }
  if (grid < 0) return;
  if (hipMemsetAsync((char*)d_ws + WS_CTL, 0, 32768, stream) != hipSuccess) { fprintf(stderr, "kernel_launch: memset failed\n"); return; }
  Params p{};
  for (int i = 0; i < N_IN; ++i) p.in[i] = (const float*)d_in[i];
  p.out = (float*)d_out; p.ws = (unsigned char*)d_ws;
#if MK_MULTI
  for (int ph = 0; ph < N_PHASES; ++ph) { p.ph_lo = ph; p.ph_hi = ph + 1; hipLaunchKernelGGL(mega, dim3(grid), dim3(512), LDS_BYTES, stream, p); }
#else
  p.ph_lo = 0; p.ph_hi = PH_HI;
  void* args[] = {&p};
  hipError_t e = hipLaunchCooperativeKernel((void*)mega, dim3(grid), dim3(512), args, LDS_BYTES, stream);
  if (e != hipSuccess) fprintf(stderr, "kernel_launch: cooperative launch failed: %s (grid %d)\n", hipGetErrorString(e), grid);
#endif
}
```
